# Optimizing an MI355X kernel written in HIP

```python
import jax, jax.numpy as jnp
from jax import lax
import numpy as np

D_MODEL = 1024
BATCH = 8
SEQ = 2048
DEPTH = 2

CHUNK = 64
HEAD_DIM = 64
SWA_HEADS = 8
SWA_KV_HEADS = 2
SWA_GROUP = SWA_HEADS // SWA_KV_HEADS
SWA_WINDOW = 128
SWA_WIN_CHUNKS = (SWA_WINDOW + CHUNK - 1) // CHUNK
RWKV_HEADS = 4
RWKV_W_RANK = 64
RWKV_A_RANK = 64
RWKV_G_RANK = 128
RWKV_GN_EPS = 64e-5
FOX_HEADS = 4
FOX_BLOCK = 128
DSA_HEADS = 4
IDX_HEADS = 4
IDX_DIM = 64
DSA_TOPK_MAX = 256
DSA_BLOCK = 128
D_FF = 2816
N_EXPERTS = 8
TOP_K = 2
D_FF_EXPERT = 1408
N_DENSE = (DEPTH + 1) // 2
N_MOE = DEPTH // 2
N_BRANCHES = 4
DN_ALPHA = (2 * DEPTH) ** 0.25
DN_BETA = (8 * DEPTH) ** -0.25
LN_EPS = 1e-5
ATTN_SCALE = HEAD_DIM ** -0.5
IDX_SCALE = IDX_DIM ** -0.5
IDX_W_SCALE = IDX_HEADS ** -0.5

SWA_Q = SWA_HEADS * HEAD_DIM
SWA_KV = SWA_KV_HEADS * HEAD_DIM
RWKV_W = RWKV_HEADS * HEAD_DIM
FOX_W = FOX_HEADS * HEAD_DIM
DSA_W = DSA_HEADS * HEAD_DIM
MIX_WIDTHS = (SWA_Q, RWKV_W, FOX_W, DSA_W)
MIX_WIDTH = SWA_Q + RWKV_W + FOX_W + DSA_W
SWA_SPLITS = (SWA_Q, SWA_KV, SWA_KV)
RWKV_SPLITS = (RWKV_W, RWKV_W, RWKV_W, RWKV_W_RANK, RWKV_A_RANK, RWKV_G_RANK)
FOX_SPLITS = (FOX_W, FOX_W, FOX_W, FOX_HEADS)
DSA_SPLITS = (DSA_W, HEAD_DIM, HEAD_DIM, IDX_HEADS * IDX_DIM, IDX_DIM, IDX_HEADS)
RWKV_IN = sum(RWKV_SPLITS)
GATE_COLS = N_BRANCHES * D_MODEL
IN_GROUPS = (sum(SWA_SPLITS), RWKV_IN, sum(FOX_SPLITS), sum(DSA_SPLITS), GATE_COLS)
D_IN = sum(IN_GROUPS)

kernel_name = 'hybrid_gated_4mixer_deepnorm_moe'


def split_cols(t, sizes, axis=-1):
    idx = [int(i) for i in np.cumsum(sizes)[:-1]]
    return jnp.split(t, idx, axis=axis)


def layer_norm(x, g, b):
    xf = x.astype(jnp.float32)
    mu = jnp.mean(xf, axis=-1, keepdims=True)
    var = jnp.mean(jnp.square(xf - mu), axis=-1, keepdims=True)
    return ((xf - mu) * lax.rsqrt(var + LN_EPS) * g + b).astype(x.dtype)


def swa_branch(q, k, v, sinks):
    B, S, _ = q.shape
    nc = S // CHUNK
    W = SWA_WIN_CHUNKS
    q = q.reshape(B, nc, CHUNK, SWA_KV_HEADS, SWA_GROUP, HEAD_DIM)
    pad = ((0, 0), (W, 0), (0, 0), (0, 0), (0, 0))
    kp = jnp.pad(k.reshape(B, nc, CHUNK, SWA_KV_HEADS, HEAD_DIM), pad)
    vp = jnp.pad(v.reshape(B, nc, CHUNK, SWA_KV_HEADS, HEAD_DIM), pad)
    kb = jnp.concatenate([kp[:, j:j + nc] for j in range(W + 1)], axis=2)
    vb = jnp.concatenate([vp[:, j:j + nc] for j in range(W + 1)], axis=2)
    key_chunk = jnp.arange(nc)[:, None] - W + jnp.arange(W + 1)[None, :]
    valid = jnp.repeat(key_chunk >= 0, CHUNK, axis=1)
    logits = jnp.einsum('bcqhgd,bckhd->bchgqk', q, kb).astype(jnp.float32) * ATTN_SCALE
    logits = jnp.where(valid[None, :, None, None, None, :], logits, -jnp.inf)
    sink = sinks.astype(jnp.float32).reshape(1, 1, SWA_KV_HEADS, SWA_GROUP, 1, 1)
    m = jnp.maximum(jnp.max(logits, axis=-1, keepdims=True), sink)
    e = jnp.exp(logits - m)
    p = e / (jnp.sum(e, axis=-1, keepdims=True) + jnp.exp(sink - m))
    o = jnp.einsum('bchgqk,bckhd->bcqhgd', p.astype(v.dtype), vb)
    return o.reshape(B, S, SWA_Q)


def rwkv7_branch(p, mu, w0, w_up, a0, a_up, g_up, k_k, k_a, r_k, gn_g, gn_b):
    B, S, _ = p.shape
    p_prev = jnp.pad(p[:, :-1], ((0, 0), (1, 0), (0, 0)))
    p = p + mu * (p_prev - p)
    r, k, v, w_lo, a_lo, g_lo = split_cols(p, RWKV_SPLITS)
    log_w = -jnp.exp(-jax.nn.softplus(-(w0 + jnp.tanh(w_lo) @ w_up).astype(jnp.float32)) - 0.5)
    a = jax.nn.sigmoid(a0 + a_lo @ a_up)
    g = jax.nn.sigmoid(g_lo) @ g_up
    hd = lambda t: t.reshape(B, S, RWKV_HEADS, HEAD_DIM).astype(jnp.float32)
    kk = hd(k * k_k)
    kk = kk * lax.rsqrt(jnp.sum(kk * kk, axis=-1, keepdims=True) + 1e-12)
    k = k * (1.0 + (a - 1.0) * k_a)
    r_h, k_h, v_h, a_h, w_h = hd(r), hd(k), hd(v), hd(a), hd(jnp.exp(log_w))
    seq = tuple(jnp.moveaxis(t, 1, 0) for t in (r_h, w_h, k_h, v_h, kk, a_h))

    def step(state, inp):
        r_t, w_t, k_t, v_t, kk_t, a_t = inp
        sa = jnp.einsum('bhvk,bhk->bhv', state, -kk_t)
        state = (state * w_t[:, :, None, :]
                 + sa[..., None] * (kk_t * a_t)[:, :, None, :]
                 + v_t[..., None] * k_t[:, :, None, :])
        return state, jnp.einsum('bhvk,bhk->bhv', state, r_t)

    s0 = jnp.zeros((B, RWKV_HEADS, HEAD_DIM, HEAD_DIM), jnp.float32)
    _, y = lax.scan(step, s0, seq)
    y = jnp.moveaxis(y, 0, 1)
    ym = jnp.mean(y, axis=-1, keepdims=True)
    yv = jnp.mean(jnp.square(y - ym), axis=-1, keepdims=True)
    y = ((y - ym) * lax.rsqrt(yv + RWKV_GN_EPS)).reshape(B, S, RWKV_W) * gn_g + gn_b
    bonus = (jnp.sum(r_h * k_h * r_k, axis=-1, keepdims=True) * v_h).reshape(B, S, RWKV_W)
    return ((y + bonus) * g).astype(p.dtype)


def fox_branch(q, k, v, f_logit, f_bias):
    B, S, _ = q.shape
    q = q.reshape(B, S, FOX_HEADS, HEAD_DIM)
    k = k.reshape(B, S, FOX_HEADS, HEAD_DIM)
    v = v.reshape(B, S, FOX_HEADS, HEAD_DIM)
    log_f = jax.nn.log_sigmoid(f_logit.astype(jnp.float32) + f_bias)
    c = jnp.cumsum(log_f, axis=1).transpose(0, 2, 1)
    outs = []
    for blk in range(S // FOX_BLOCK):
        lo, hi = blk * FOX_BLOCK, (blk + 1) * FOX_BLOCK
        logits = jnp.einsum('bqhd,bkhd->bhqk', q[:, lo:hi], k[:, :hi]).astype(jnp.float32) * ATTN_SCALE
        logits = logits + c[:, :, lo:hi, None] - c[:, :, None, :hi]
        causal = jnp.arange(lo, hi)[:, None] >= jnp.arange(hi)[None, :]
        logits = jnp.where(causal, logits, -jnp.inf)
        p = jax.nn.softmax(logits, axis=-1)
        outs.append(jnp.einsum('bhqk,bkhd->bqhd', p.astype(v.dtype), v[:, :hi]))
    return jnp.concatenate(outs, axis=1).reshape(B, S, FOX_W)


def dsa_branch(q, k, v, q_idx, k_idx, w_idx):
    B, S, _ = q.shape
    topk = min(DSA_TOPK_MAX, S // 4)
    nb = S // DSA_BLOCK
    qT = jnp.moveaxis(q.reshape(B, nb, DSA_BLOCK, DSA_HEADS, HEAD_DIM), 1, 0)
    qiT = jnp.moveaxis(q_idx.reshape(B, nb, DSA_BLOCK, IDX_HEADS, IDX_DIM), 1, 0)
    wiT = jnp.moveaxis(w_idx.reshape(B, nb, DSA_BLOCK, IDX_HEADS), 1, 0)
    key_chunk = jnp.arange(S) // CHUNK

    def block(args):
        blk, qb, qib, wib = args
        t = blk * DSA_BLOCK + jnp.arange(DSA_BLOCK)
        admissible = key_chunk[None, :] <= (t // CHUNK)[:, None]
        rel = jax.nn.relu(jnp.einsum('bqhd,bsd->bqhs', qib, k_idx) * IDX_SCALE)
        score = jnp.einsum('bqhs,bqh->bqs', rel, wib * IDX_W_SCALE).astype(jnp.float32)
        score = jnp.where(admissible[None], score, -jnp.inf)
        top_val, top_idx = lax.top_k(score, topk)
        valid = jnp.isfinite(top_val)
        k_sel = jax.vmap(lambda kk, ii: kk[ii])(k, top_idx)
        v_sel = jax.vmap(lambda vv, ii: vv[ii])(v, top_idx)
        logits = jnp.einsum('bqhd,bqkd->bqhk', qb, k_sel).astype(jnp.float32) * ATTN_SCALE
        logits = jnp.where(valid[:, :, None, :], logits, -jnp.inf)
        p = jax.nn.softmax(logits, axis=-1)
        return jnp.einsum('bqhk,bqkd->bqhd', p.astype(v.dtype), v_sel)

    outs = lax.map(block, (jnp.arange(nb), qT, qiT, wiT))
    return jnp.moveaxis(outs, 0, 1).reshape(B, S, DSA_W)


def mixer_block(x, w_in, sinks, mu, w0, w_up, a0, a_up, g_up, k_k, k_a, r_k, gn_g, gn_b,
                f_bias, gate_bias, w_branch, w_out):
    B, S, _ = x.shape
    p_swa, p_rwkv, p_fox, p_dsa, p_gate = split_cols(x @ w_in, IN_GROUPS)
    o_swa = swa_branch(*split_cols(p_swa, SWA_SPLITS), sinks)
    o_rwkv = rwkv7_branch(p_rwkv, mu, w0, w_up, a0, a_up, g_up, k_k, k_a, r_k, gn_g, gn_b)
    o_fox = fox_branch(*split_cols(p_fox, FOX_SPLITS), f_bias)
    o_dsa = dsa_branch(*split_cols(p_dsa, DSA_SPLITS))
    gates = jax.nn.sigmoid(p_gate.reshape(B, S, N_BRANCHES, D_MODEL) + gate_bias)
    w_rows = split_cols(w_branch, MIX_WIDTHS, axis=0)
    merged = jnp.zeros_like(x)
    for i, (o, w) in enumerate(zip((o_swa, o_rwkv, o_fox, o_dsa), w_rows)):
        merged = merged + gates[:, :, i] * (o @ w)
    return merged @ w_out


def swiglu(x, w1, w3, w2):
    return (jax.nn.silu(x @ w1) * (x @ w3)) @ w2


def moe_ffn(x, router_w, router_b, w1, w3, w2):
    logits = (x @ router_w).astype(jnp.float32) + router_b
    top_val, top_idx = lax.top_k(logits, TOP_K)
    weights = jax.nn.softmax(top_val, axis=-1)
    combine = jnp.sum(jax.nn.one_hot(top_idx, N_EXPERTS, dtype=jnp.float32) * weights[..., None], axis=-2)
    y = jnp.zeros_like(x)
    for e in range(N_EXPERTS):
        y = y + combine[..., e:e + 1].astype(x.dtype) * swiglu(x, w1[e], w3[e], w2[e])
    return y


def setup_inputs(seed: int = 0) -> dict:
    key = jax.random.key(seed)
    ks = iter(jax.random.split(key, 32))
    nrm = lambda shape, scale: scale * jax.random.normal(next(ks), shape, jnp.float32)
    unif = lambda shape, lo, hi: jax.random.uniform(next(ks), shape, jnp.float32, lo, hi)
    L = DEPTH
    return {
        'x': nrm((BATCH, SEQ, D_MODEL), 1.0),
        'w_in': nrm((L, D_MODEL, D_IN), D_MODEL ** -0.5),
        'swa_sinks': nrm((L, SWA_HEADS), 0.5),
        'rwkv_mu': unif((L, RWKV_IN), 0.0, 1.0),
        'rwkv_w0': unif((L, RWKV_W), -6.0, 1.0),
        'rwkv_w_up': nrm((L, RWKV_W_RANK, RWKV_W), 0.1),
        'rwkv_a0': nrm((L, RWKV_W), 0.1),
        'rwkv_a_up': nrm((L, RWKV_A_RANK, RWKV_W), RWKV_A_RANK ** -0.5),
        'rwkv_g_up': nrm((L, RWKV_G_RANK, RWKV_W), RWKV_G_RANK ** -0.5),
        'rwkv_k_k': 0.85 + nrm((L, RWKV_W), 0.05),
        'rwkv_k_a': 1.0 + nrm((L, RWKV_W), 0.05),
        'rwkv_r_k': nrm((L, RWKV_HEADS, HEAD_DIM), 0.1),
        'rwkv_gn_g': 1.0 + nrm((L, RWKV_W), 0.05),
        'rwkv_gn_b': nrm((L, RWKV_W), 0.02),
        'fox_f_bias': 2.0 + nrm((L, FOX_HEADS), 0.5),
        'gate_bias': nrm((L, N_BRANCHES, D_MODEL), 0.1),
        'w_branch': nrm((L, MIX_WIDTH, D_MODEL), (4 * HEAD_DIM) ** -0.5),
        'w_out': nrm((L, D_MODEL, D_MODEL), DN_BETA * D_MODEL ** -0.5),
        'ln_g': 1.0 + nrm((L, 2, D_MODEL), 0.05),
        'ln_b': nrm((L, 2, D_MODEL), 0.02),
        'ffn_w1': nrm((N_DENSE, D_MODEL, D_FF), D_MODEL ** -0.5),
        'ffn_w3': nrm((N_DENSE, D_MODEL, D_FF), D_MODEL ** -0.5),
        'ffn_w2': nrm((N_DENSE, D_FF, D_MODEL), DN_BETA * D_FF ** -0.5),
        'router_w': nrm((N_MOE, D_MODEL, N_EXPERTS), D_MODEL ** -0.5),
        'router_b': nrm((N_MOE, N_EXPERTS), 0.01),
        'exp_w1': nrm((N_MOE, N_EXPERTS, D_MODEL, D_FF_EXPERT), D_MODEL ** -0.5),
        'exp_w3': nrm((N_MOE, N_EXPERTS, D_MODEL, D_FF_EXPERT), D_MODEL ** -0.5),
        'exp_w2': nrm((N_MOE, N_EXPERTS, D_FF_EXPERT, D_MODEL), DN_BETA * D_FF_EXPERT ** -0.5),
    }


def reference(x, w_in, swa_sinks, rwkv_mu, rwkv_w0, rwkv_w_up, rwkv_a0, rwkv_a_up, rwkv_g_up,
              rwkv_k_k, rwkv_k_a, rwkv_r_k, rwkv_gn_g, rwkv_gn_b, fox_f_bias, gate_bias, w_branch,
              w_out, ln_g, ln_b, ffn_w1, ffn_w3, ffn_w2, router_w, router_b, exp_w1, exp_w3, exp_w2):
    for layer in range(DEPTH):
        y = mixer_block(x, w_in[layer], swa_sinks[layer], rwkv_mu[layer], rwkv_w0[layer],
                        rwkv_w_up[layer], rwkv_a0[layer], rwkv_a_up[layer], rwkv_g_up[layer],
                        rwkv_k_k[layer], rwkv_k_a[layer], rwkv_r_k[layer], rwkv_gn_g[layer],
                        rwkv_gn_b[layer], fox_f_bias[layer], gate_bias[layer], w_branch[layer],
                        w_out[layer])
        x = layer_norm(DN_ALPHA * x + y, ln_g[layer, 0], ln_b[layer, 0])
        j = layer // 2
        if layer % 2 == 0:
            y = swiglu(x, ffn_w1[j], ffn_w3[j], ffn_w2[j])
        else:
            y = moe_ffn(x, router_w[j], router_b[j], exp_w1[j], exp_w3[j], exp_w2[j])
        x = layer_norm(DN_ALPHA * x + y, ln_g[layer, 1], ln_b[layer, 1])
    return x
```

```cpp
#include <hip/hip_runtime.h>
#include <hip/hip_cooperative_groups.h>
#include <cstdio>
#include <cstdint>
namespace cg = cooperative_groups;

#ifndef FUSED
#define FUSED 0
#endif

#define LAS __attribute__((address_space(3)))
typedef unsigned short bf16_t;
typedef short bf16x8 __attribute__((ext_vector_type(8)));
typedef float f32x4 __attribute__((ext_vector_type(4)));
typedef float f32x2 __attribute__((ext_vector_type(2)));
typedef unsigned u32x4 __attribute__((ext_vector_type(4)));
typedef unsigned u32x2 __attribute__((ext_vector_type(2)));

constexpr int T = 16384, D = 1024, SEQ = 2048, NB = 8;
constexpr int NPM = 3328;
constexpr int C_SWA_Q = 0, C_SWA_K = 512, C_SWA_V = 640, C_RW = 768;
constexpr int C_FOX_Q = 1792, C_FOX_K = 2048, C_FOX_V = 2304;
constexpr int C_DSA_Q = 2560, C_DSA_K = 2816, C_DSA_V = 2880, C_DSA_QI = 2944, C_DSA_KI = 3200, C_FLOG = 3264, C_WIDX = 3268;
constexpr int D_IN = 7368, NWIN = 7424;
constexpr int OC = 1280;
constexpr int DFF = 2816, DFE = 1408, NE = 8;
constexpr int MAXROWS = 34816;
constexpr float DN_ALPHA = 1.41421356237f;
constexpr float LN_EPS = 1e-5f;

constexpr size_t MiB = 1u << 20;
constexpr size_t WS_CTL = 0;
constexpr size_t WS_WIN = 1 * MiB, WS_WB = 16 * MiB, WS_WO = 19 * MiB;
constexpr size_t WS_FOXC = 21 * MiB, WS_TOKE = 21 * MiB + 256 * 1024, WS_TOKW = 21 * MiB + 384 * 1024, WS_ROWTOK = 21 * MiB + 512 * 1024,
                 WS_ROWW = 21 * MiB + 768 * 1024, WS_WGCNT = 21 * MiB + 920 * 1024;
constexpr size_t WS_OCAT = 22 * MiB, WS_X1B = 22 * MiB;
constexpr size_t WS_PMIX = 62 * MiB, WS_MERGED = 62 * MiB, WS_MACC = 94 * MiB;
constexpr size_t WS_WF13 = 62 * MiB, WS_WF2_DENSE = 73 * MiB, WS_WF2_MOE = 106 * MiB, WS_H = 128 * MiB;
constexpr size_t WS_RW = 166 * MiB, WS_XB = 166 * MiB, WS_GSC = 198 * MiB, WS_AG = 222 * MiB;
constexpr size_t WS_BONUS = 278 * MiB;
constexpr size_t WS_END = 290 * MiB;
constexpr size_t RWSZ = 16 * MiB;

constexpr int LDS_BYTES = 155648;
constexpr int NTHREADS = 512;

struct Params { const float* in[28]; float* out; unsigned char* ws; };
enum { I_X = 0, I_WIN, I_SINKS, I_MU, I_W0, I_WUP, I_A0, I_AUP, I_GUP, I_KK, I_KA, I_RK, I_GNG, I_GNB, I_FB, I_GB, I_WBR, I_WOUT, I_LNG, I_LNB,
       I_F1, I_F3, I_F2, I_RTW, I_RTB, I_E1, I_E3, I_E2 };

__device__ __forceinline__ float bflo(unsigned u) { return __uint_as_float(u << 16); }
__device__ __forceinline__ float bfhi(unsigned u) { return __uint_as_float(u & 0xffff0000u); }
__device__ __forceinline__ float bf2f(bf16_t b) { return __uint_as_float((unsigned)b << 16); }
__device__ __forceinline__ unsigned f2bf(float f) { unsigned u = __float_as_uint(f); return (u + 0x7fffu + ((u >> 16) & 1u)) >> 16; }
__device__ __forceinline__ unsigned pk2(float lo, float hi) { return f2bf(lo) | (f2bf(hi) << 16); }
__device__ __forceinline__ float wave_sum(float v) {
#pragma unroll
    for (int o = 1; o < 64; o <<= 1) v += __shfl_xor(v, o);
    return v;
}
__device__ __forceinline__ float wave_max(float v) {
#pragma unroll
    for (int o = 1; o < 64; o <<= 1) v = fmaxf(v, __shfl_xor(v, o));
    return v;
}
__device__ __forceinline__ float sigm(float x) { return 1.f / (1.f + __expf(-x)); }
#define LDS_FENCE() asm volatile("s_waitcnt lgkmcnt(0)" ::: "memory")
__device__ __forceinline__ int my_tid() { int t = threadIdx.x; asm volatile("" : "+v"(t)); return t; }
__device__ __forceinline__ void unpack8(const u32x4 v, float* f) {
    f[0] = bflo(v.x); f[1] = bfhi(v.x); f[2] = bflo(v.y); f[3] = bfhi(v.y); f[4] = bflo(v.z); f[5] = bfhi(v.z); f[6] = bflo(v.w); f[7] = bfhi(v.w);
}

namespace mg {
constexpr int BM = 256, BK = 64, HALF = 128, HTB = HALF * BK * 2, STAGE_BYTES = 8 * HTB;
__device__ __forceinline__ int lds_byte(int r, int c) { const int st = (r >> 4) * 2 + (c >> 5), rr = r & 15, cc = c & 31, ob = rr * 64 + cc * 2; return st * 1024 + (ob ^ (((ob >> 9) & 1) << 5)); }
__device__ __forceinline__ void stage_rc(int b, int& R, int& C) { const int st = b / 1024, sb = b % 1024, swz = sb ^ (((sb >> 9) & 1) << 5); R = (st >> 1) * 16 + swz / 64; C = (st & 1) * 32 + (swz % 64) / 2; }
__device__ __forceinline__ int perm32(int rho) { const int n = rho >> 4, i = rho & 15; return 8 * (i >> 2) + 4 * n + (i & 3); }

struct Unit { const char* A; const char* B; unsigned ld; int nt; int pm, pn, tag; };

__device__ __forceinline__ bool static_tile(int i, int G, int c, int nM, int nN, int& pm, int& pn) {
    const int nwg = nM * nN; const long L = (long)i * G + c; if (L >= nwg) return false;
    int wgid = (int)L; { const int q = nwg / 8, r = nwg % 8, xcd = wgid % 8, off = wgid / 8; wgid = (xcd < r ? xcd * (q + 1) : r * (q + 1) + (xcd - r) * q) + off; }
    const int nig = 8 * nN, gid = wgid / nig, fm = gid * 8, gsz = (nM - fm) < 8 ? (nM - fm) : 8;
    pm = fm + ((wgid % nig) % gsz); pn = (wgid % nig) / gsz; return true;
}

template <class Sched, class Epi>
__device__ __forceinline__ void gemm_run(LAS unsigned char* lds, const Sched& S, const Epi& E) {
    const int tid = my_tid(), wid = __builtin_amdgcn_readfirstlane(tid >> 6), lane = tid & 63, wr = wid >> 2, wc = wid & 3, fr = lane & 15, fq = lane >> 4;
    int R0, C0; stage_rc(tid * 16, R0, C0); const unsigned RA = (unsigned)R0, RB = (unsigned)(Sched::PERM ? ((R0 & ~31) + perm32(R0 & 31)) : R0), C02 = (unsigned)C0 * 2u;
    const unsigned ldsw = (unsigned)wid * 1024u;
    const int aoff = lds_byte(wr * 64 + fr, fq * 8), boff = lds_byte(wc * 32 + fr, fq * 8);
#define MG_SA(b, h) (((b) * 2 + (h)) * HTB)
#define MG_SB(b, h) ((4 + (b) * 2 + (h)) * HTB)
#define MG_STAGE(bufoff, gptr, v0, s64) do { \
        __builtin_amdgcn_global_load_lds((const unsigned*)((gptr) + (v0)), (LAS unsigned*)(lds + (bufoff) + ldsw), 16, 0, 0); \
        __builtin_amdgcn_global_load_lds((const unsigned*)((gptr) + (s64) + (v0)), (LAS unsigned*)(lds + (bufoff) + ldsw + 8192), 16, 0, 0); } while (0)
#define MG_LDA(dst, b, h) do { _Pragma("unroll") for (int m = 0; m < 4; ++m) _Pragma("unroll") for (int k = 0; k < 2; ++k) dst[m][k] = *(const LAS bf16x8*)(lds + MG_SA(b, h) + aoff + m * 2048 + k * 1024); } while (0)
#define MG_LDB(dst, b, h) do { _Pragma("unroll") for (int n = 0; n < 2; ++n) _Pragma("unroll") for (int k = 0; k < 2; ++k) dst[n][k] = *(const LAS bf16x8*)(lds + MG_SB(b, h) + boff + n * 2048 + k * 1024); } while (0)
#define MG_MMA(ai, bj, At, Bt) do { __builtin_amdgcn_s_setprio(1); _Pragma("unroll") for (int m = 0; m < 4; ++m) _Pragma("unroll") for (int n = 0; n < 2; ++n) _Pragma("unroll") for (int k = 0; k < 2; ++k) \
        acc[ai][bj][m][n] = __builtin_amdgcn_mfma_f32_16x16x32_bf16(Bt[n][k], At[m][k], acc[ai][bj][m][n], 0, 0, 0); __builtin_amdgcn_s_setprio(0); } while (0)
#define MG_WAIT_V(n) asm volatile("s_waitcnt vmcnt(" #n ")" ::: "memory")
#define MG_WAIT_L(n) asm volatile("s_waitcnt lgkmcnt(" #n ")" ::: "memory")
#define MG_BAR __builtin_amdgcn_s_barrier()
#define MG_SCHED __builtin_amdgcn_sched_barrier(0)
    Unit cur; int ui = 0;
    if (!S.next(0, cur)) return;
    f32x4 acc[2][2][4][2];
#pragma unroll
    for (int a = 0; a < 2; ++a)
#pragma unroll
        for (int b = 0; b < 2; ++b)
#pragma unroll
            for (int m = 0; m < 4; ++m)
#pragma unroll
                for (int n = 0; n < 2; ++n) acc[a][b][m][n] = (f32x4){0.f, 0.f, 0.f, 0.f};
    bf16x8 At[4][2], B0[2][2], B1[2][2];
    const size_t kstep = (size_t)(BK * 2);
    {
        const char* cA = cur.A; const char* cB = cur.B; const unsigned ld = cur.ld, vA = RA * ld + C02, vB = RB * ld + C02, s64 = 64u * ld, sh = 128u * ld;
        MG_STAGE(MG_SB(0, 0), cB, vB, s64); MG_STAGE(MG_SB(0, 1), cB + sh, vB, s64); MG_STAGE(MG_SA(0, 0), cA, vA, s64); MG_STAGE(MG_SA(0, 1), cA + sh, vA, s64);
        if (wr == 1) MG_BAR;
        MG_WAIT_V(2); MG_BAR;
        MG_STAGE(MG_SB(1, 0), cB + kstep, vB, s64); MG_STAGE(MG_SA(1, 0), cA + kstep, vA, s64); MG_STAGE(MG_SB(1, 1), cB + sh + kstep, vB, s64);
        MG_WAIT_V(6); MG_BAR;
    }
    for (;;) {
        const char* cA = cur.A; const char* cB = cur.B; const unsigned cld = cur.ld; const int nt = cur.nt;
        for (int t = 0; t < nt; t += 2) {
            const bool last = (t == nt - 2);
            const char* a1 = cA + (size_t)(t + 1) * kstep;
            const char* a2 = cA + (size_t)(t + 2) * kstep; const char* b2 = cB + (size_t)(t + 2) * kstep; unsigned xld = cld;
            if (last) { Unit n2; if (S.next(ui + 1, n2)) { a2 = n2.A; b2 = n2.B; xld = n2.ld; } else { a2 = cA; b2 = cB; } }
            const char* a3 = a2 + kstep; const char* b3 = b2 + kstep;
            const unsigned cvA = RA * cld + C02, c64 = 64u * cld, ch = 128u * cld;
            const unsigned xvA = RA * xld + C02, xvB = RB * xld + C02, x64 = 64u * xld, xh = 128u * xld;
            MG_LDB(B0, 0, 0); MG_LDB(B1, 0, 1); MG_SCHED; MG_LDA(At, 0, 0); MG_STAGE(MG_SA(1, 1), a1 + ch, cvA, c64);
            MG_WAIT_V(8); MG_WAIT_L(0); MG_BAR; MG_MMA(0, 0, At, B0); MG_MMA(0, 1, At, B1); MG_BAR; MG_SCHED;
            MG_LDA(At, 0, 1); MG_STAGE(MG_SB(0, 0), b2, xvB, x64); MG_STAGE(MG_SB(0, 1), b2 + xh, xvB, x64); MG_STAGE(MG_SA(0, 0), a2, xvA, x64);
            MG_WAIT_V(8); MG_WAIT_L(0); MG_BAR; MG_MMA(1, 0, At, B0); MG_MMA(1, 1, At, B1); MG_BAR; MG_SCHED;
            MG_LDB(B0, 1, 0); MG_LDB(B1, 1, 1); MG_SCHED; MG_LDA(At, 1, 0); MG_STAGE(MG_SA(0, 1), a2 + xh, xvA, x64);
            MG_WAIT_V(8); MG_WAIT_L(0); MG_BAR; MG_MMA(0, 0, At, B0); MG_MMA(0, 1, At, B1); MG_BAR; MG_SCHED;
            MG_LDA(At, 1, 1); MG_STAGE(MG_SB(1, 0), b3, xvB, x64); MG_STAGE(MG_SB(1, 1), b3 + xh, xvB, x64); MG_STAGE(MG_SA(1, 0), a3, xvA, x64);
            MG_WAIT_V(8); MG_WAIT_L(0); MG_BAR; MG_MMA(1, 0, At, B0); MG_MMA(1, 1, At, B1); MG_BAR; MG_SCHED;
        }
        if (wr == 0) MG_BAR;
        { int e_fr = fr, e_fq = fq, e_tid = tid; asm volatile("" : "+v"(e_fr), "+v"(e_fq), "+v"(e_tid));
          E(acc, cur, wr, wc, e_fr, e_fq, e_tid); }
        Unit nxt;
        if (!S.next(ui + 1, nxt)) break;
#pragma unroll
        for (int a = 0; a < 2; ++a)
#pragma unroll
            for (int b = 0; b < 2; ++b)
#pragma unroll
                for (int m = 0; m < 4; ++m)
#pragma unroll
                    for (int n = 0; n < 2; ++n) acc[a][b][m][n] = (f32x4){0.f, 0.f, 0.f, 0.f};
        cur = nxt; ++ui;
        if (wr == 1) MG_BAR;
    }
    MG_WAIT_V(0);
    MG_BAR;
#undef MG_SA
#undef MG_SB
#undef MG_STAGE
#undef MG_LDA
#undef MG_LDB
#undef MG_MMA
#undef MG_WAIT_V
#undef MG_WAIT_L
#undef MG_BAR
#undef MG_SCHED
}
}

typedef f32x4 AccT[2][2][4][2];

__device__ __forceinline__ int rowmap(int mode, int n) {
    if (mode == 0) return n;
    if (mode == 1) { if (n < 2560) return n; if (n < 2564) return 3264 + (n - 2560); if (n < 3268) return n - 4; if (n < 3272) return n; return n + 56; }
    if (mode == 2) return 256 * (n >> 7) + (n & 127);
    return 256 * (n >> 7) + 128 + (n & 127);
}
__device__ __forceinline__ void tr_item(const float* __restrict__ W, int K, int N, bf16_t* WT, int ldt, int mode, int row_off, LAS float* scr, int item, int lane) {
    const int nblk = (N + 31) / 32, kb = item / nblk, nb = item % nblk, k0 = 64 * kb, n0 = 32 * nb;
    const int nl = lane & 31, n = n0 + nl;
#pragma unroll 8
    for (int i = 0; i < 32; ++i) { const int kk = 2 * i + (lane >> 5); scr[kk * 33 + nl] = (n < N) ? W[(size_t)(k0 + kk) * N + n] : 0.f; }
    LDS_FENCE();
    const int c = lane & 7;
#pragma unroll
    for (int j = 0; j < 4; ++j) { const int n2l = (lane >> 3) + 8 * j, n2 = n0 + n2l; const LAS float* s = scr + (8 * c) * 33 + n2l;
        u32x4 o; o.x = pk2(s[0 * 33], s[1 * 33]); o.y = pk2(s[2 * 33], s[3 * 33]); o.z = pk2(s[4 * 33], s[5 * 33]); o.w = pk2(s[6 * 33], s[7 * 33]);
        if (n2 < N) *(u32x4*)(WT + (size_t)(row_off + rowmap(mode, n2)) * ldt + k0 + 8 * c) = o; }
    LDS_FENCE();
}
__device__ __forceinline__ int tr_nitems(int K, int N) { return (K / 64) * ((N + 31) / 32); }

__device__ __forceinline__ void row_to_bf16(const float* xrow, bf16_t* orow, int lane) {
    const f32x4* xr = (const f32x4*)xrow + lane; unsigned long long* o8 = (unsigned long long*)orow + lane;
#pragma unroll
    for (int j = 0; j < 4; ++j) { const f32x4 v = xr[64 * j]; o8[64 * j] = (unsigned long long)pk2(v.x, v.y) | ((unsigned long long)pk2(v.z, v.w) << 32); }
}

__device__ __forceinline__ void ph_conv_mixer(const Params& p, int l, LAS unsigned char* lds) {
    const int tid_ = my_tid(); const int lane = tid_ & 63, wave = tid_ >> 6, gw = blockIdx.x * 8 + wave, NGW = gridDim.x * 8;
    LAS float* scr = (LAS float*)(lds + wave * 8448);
    const float* win = p.in[I_WIN] + (size_t)l * D * D_IN; const float* wbr = p.in[I_WBR] + (size_t)l * OC * D; const float* wo = p.in[I_WOUT] + (size_t)l * D * D;
    bf16_t* WIN = (bf16_t*)(p.ws + WS_WIN); bf16_t* WB = (bf16_t*)(p.ws + WS_WB); bf16_t* WO = (bf16_t*)(p.ws + WS_WO);
    const int n1 = tr_nitems(D, D_IN), n2 = tr_nitems(OC, D), n3 = tr_nitems(D, D);
    for (int it = gw; it < n1 + n2 + n3; it += NGW) {
        int r = it;
        if (r < n1) { tr_item(win, D, D_IN, WIN, D, 1, 0, scr, r, lane); continue; } r -= n1;
        if (r < n2) { tr_item(wbr, OC, D, WB, OC, 0, 0, scr, r, lane); continue; } r -= n2;
        tr_item(wo, D, D, WO, D, 0, 0, scr, r, lane);
    }
    if (l == 0) { bf16_t* XB = (bf16_t*)(p.ws + WS_XB); for (int m = gw; m < T; m += NGW) row_to_bf16(p.in[I_X] + (size_t)m * D, XB + (size_t)m * D, lane); }
}

struct SchedInproj {
    static constexpr int PERM = 1;
    const char* A; const char* B; int G, c;
    __device__ __forceinline__ bool next(int i, mg::Unit& u) const {
        int pm, pn; if (!mg::static_tile(i, G, c, T / 256, NPM / 256, pm, pn)) return false;
        u.A = A + (size_t)pm * 256 * 2048; u.B = B + (size_t)pn * 256 * 2048; u.ld = 2048; u.nt = 16; u.pm = pm; u.pn = pn; u.tag = 0; return true;
    }
};
struct EpiBf16Store {
    bf16_t* O; int ldo;
    __device__ __forceinline__ void operator()(const AccT& acc, const mg::Unit& u, int wr, int wc, int fr, int fq, int) const {
        const int row0 = u.pm * 256 + wr * 64 + fr, col0 = u.pn * 256 + wc * 32 + 8 * fq;
#pragma unroll
        for (int ai = 0; ai < 2; ++ai)
#pragma unroll
            for (int m = 0; m < 4; ++m) { bf16_t* rowp = O + (size_t)(row0 + ai * 128 + m * 16) * ldo + col0;
#pragma unroll
                for (int bj = 0; bj < 2; ++bj) { const f32x4 v0 = acc[ai][bj][m][0], v1 = acc[ai][bj][m][1];
                    u32x4 w; w.x = pk2(v0[0], v0[1]); w.y = pk2(v0[2], v0[3]); w.z = pk2(v1[0], v1[1]); w.w = pk2(v1[2], v1[3]);
                    *(u32x4*)(rowp + bj * 128) = w; } }
    }
};
__device__ __forceinline__ void ph_inproj(const Params& p, int l, LAS unsigned char* lds) {
    SchedInproj S{(const char*)(p.ws + WS_XB), (const char*)(p.ws + WS_WIN), (int)gridDim.x, (int)blockIdx.x};
    EpiBf16Store E{(bf16_t*)(p.ws + WS_PMIX), NPM};
    mg::gemm_run(lds, S, E);
}

__device__ __forceinline__ void ph_prep(const Params& p, int l, LAS unsigned char* lds) {
    const int tid = my_tid(), lane = tid & 63, wave = tid >> 6;
    const bf16_t* P = (const bf16_t*)(p.ws + WS_PMIX);
    if (blockIdx.x < 8 && wave < 4) {
        const int b = blockIdx.x, h = wave; const float fb = p.in[I_FB][l * 4 + h];
        float v[32]; float s = 0.f;
#pragma unroll
        for (int i = 0; i < 32; ++i) { const int t = 32 * lane + i; const float x = bf2f(P[(size_t)(b * SEQ + t) * NPM + C_FLOG + h]) + fb;
            const float ls = fminf(x, 0.f) - log1pf(__expf(-fabsf(x))); s += ls; v[i] = s; }
        float incl = s;
#pragma unroll
        for (int o = 1; o < 64; o <<= 1) { const float n = __shfl_up(incl, o); if (lane >= o) incl += n; }
        const float excl = incl - s; float* C = (float*)(p.ws + WS_FOXC) + (size_t)(b * 4 + h) * SEQ + 32 * lane;
#pragma unroll
        for (int i = 0; i < 32; ++i) C[i] = v[i] + excl;
    }
    LAS float* ps = (LAS float*)lds;
    const float* mu = p.in[I_MU] + l * 1024; const float* w0 = p.in[I_W0] + l * 256; const float* wup = p.in[I_WUP] + (size_t)l * 64 * 256;
    const float* a0 = p.in[I_A0] + l * 256; const float* aup = p.in[I_AUP] + (size_t)l * 64 * 256; const float* gup = p.in[I_GUP] + (size_t)l * 128 * 256;
    const float* kkw = p.in[I_KK] + l * 256; const float* kaw = p.in[I_KA] + l * 256; const float* rk = p.in[I_RK] + l * 256;
    float* RWr = (float*)(p.ws + WS_RW); float* RWw = RWr + (size_t)T * 256; float* RWk = RWw + (size_t)T * 256; float* RWv = RWk + (size_t)T * 256;
    float* RWkk = RWv + (size_t)T * 256; float* RWkka = RWkk + (size_t)T * 256; float* RWg = RWkka + (size_t)T * 256; float* BON = (float*)(p.ws + WS_BONUS);
    for (int it = blockIdx.x; it < T / 16; it += gridDim.x) {
        const int t0 = it * 16;
#pragma unroll
        for (int c4 = 0; c4 < 4; ++c4) { const int id = tid + 512 * c4, tt = id >> 7, ch = (id & 127) * 8, t = t0 + tt;
            const u32x4 cu = *(const u32x4*)(P + (size_t)t * NPM + C_RW + ch);
            u32x4 pv = (u32x4){0u, 0u, 0u, 0u}; if ((t & (SEQ - 1)) != 0) pv = *(const u32x4*)(P + (size_t)(t - 1) * NPM + C_RW + ch);
            float a[8], b[8]; unpack8(cu, a); unpack8(pv, b);
            const f32x4 m0 = *(const f32x4*)(mu + ch), m1 = *(const f32x4*)(mu + ch + 4); const float mm[8] = {m0.x, m0.y, m0.z, m0.w, m1.x, m1.y, m1.z, m1.w};
#pragma unroll
            for (int j = 0; j < 8; ++j) { float x = a[j] + mm[j] * (b[j] - a[j]); if (ch >= 768 && ch < 832) x = tanhf(x); else if (ch >= 896) x = sigm(x); a[j] = x; }
            *(LAS f32x4*)(ps + tt * 1024 + ch) = (f32x4){a[0], a[1], a[2], a[3]}; *(LAS f32x4*)(ps + tt * 1024 + ch + 4) = (f32x4){a[4], a[5], a[6], a[7]}; }
        __syncthreads();
        const int c = tid & 255, half = tid >> 8; const LAS float* pt = ps + (8 * half) * 1024;
        float aw[8], aa[8], ag[8];
#pragma unroll
        for (int i = 0; i < 8; ++i) { aw[i] = 0.f; aa[i] = 0.f; ag[i] = 0.f; }
        for (int j = 0; j < 64; ++j) { const float wu = wup[j * 256 + c], au = aup[j * 256 + c];
#pragma unroll
            for (int i = 0; i < 8; ++i) { aw[i] += pt[i * 1024 + 768 + j] * wu; aa[i] += pt[i * 1024 + 832 + j] * au; } }
        for (int j = 0; j < 128; ++j) { const float gu = gup[j * 256 + c];
#pragma unroll
            for (int i = 0; i < 8; ++i) ag[i] += pt[i * 1024 + 896 + j] * gu; }
        const float w0c = w0[c], a0c = a0[c], kkc = kkw[c], kac = kaw[c], rkc = rk[c];
#pragma unroll
        for (int i = 0; i < 8; ++i) { const int t = t0 + 8 * half + i; const size_t o = (size_t)t * 256 + c;
            const float r = pt[i * 1024 + c], k = pt[i * 1024 + 256 + c], v = pt[i * 1024 + 512 + c];
            const float w = __expf(-sigm(w0c + aw[i]) * 0.60653065971f), a = sigm(a0c + aa[i]);
            float kk = k * kkc; const float ss = wave_sum(kk * kk); kk *= rsqrtf(ss + 1e-12f);
            const float k2 = k * (1.f + (a - 1.f) * kac); const float bon = wave_sum(r * k2 * rkc);
            RWr[o] = r; RWw[o] = w; RWk[o] = k2; RWv[o] = v; RWkk[o] = kk; RWkka[o] = kk * a; RWg[o] = ag[i];
            if (lane == 0) BON[t * 4 + (c >> 6)] = bon; }
        __syncthreads();
    }
}

__device__ __forceinline__ void attend_keys(const float (&q)[64], float (&o)[64], float& m, float& l, const LAS float* Kt, const LAS float* Vt, int nk,
                                            const LAS float* bias, bool has_bias, int kmax) {
#pragma unroll 1
    for (int j = 0; j < nk; ++j) {
        const LAS f32x4* kr = (const LAS f32x4*)(Kt + j * 64);
        float s0 = 0.f, s1 = 0.f, s2 = 0.f, s3 = 0.f;
#pragma unroll
        for (int hf = 0; hf < 2; ++hf) {
#pragma unroll
            for (int d4 = 8 * hf; d4 < 8 * hf + 8; ++d4) { const f32x4 kv = kr[d4]; s0 += q[4 * d4] * kv.x; s1 += q[4 * d4 + 1] * kv.y; s2 += q[4 * d4 + 2] * kv.z; s3 += q[4 * d4 + 3] * kv.w; }
            __builtin_amdgcn_sched_barrier(0);
        }
        float s = (s0 + s1) + (s2 + s3);
        if (has_bias) s += bias[j];
        if (j > kmax) s = -INFINITY;
        if (__any(s > m)) {
            const float mn = fmaxf(m, s); const float sc = (mn > -INFINITY) ? __expf(m - mn) : 1.f; l *= sc;
#pragma unroll
            for (int d = 0; d < 64; ++d) o[d] *= sc;
            m = mn;
        }
        const float pj = (s > -INFINITY) ? __expf(s - m) : 0.f; l += pj;
        const LAS f32x4* vr = (const LAS f32x4*)(Vt + j * 64);
#pragma unroll
        for (int hf = 0; hf < 2; ++hf) {
#pragma unroll
            for (int d4 = 8 * hf; d4 < 8 * hf + 8; ++d4) { const f32x4 vv = vr[d4]; o[4 * d4] += pj * vv.x; o[4 * d4 + 1] += pj * vv.y; o[4 * d4 + 2] += pj * vv.z; o[4 * d4 + 3] += pj * vv.w; }
            __builtin_amdgcn_sched_barrier(0);
        }
    }
}
__device__ __forceinline__ void load_q64(const bf16_t* src, float scale, float (&q)[64]) {
#pragma unroll
    for (int c = 0; c < 8; ++c) { const u32x4 v = *(const u32x4*)(src + 8 * c); float f[8]; unpack8(v, f);
#pragma unroll
        for (int j = 0; j < 8; ++j) q[8 * c + j] = f[j] * scale; }
}
__device__ __forceinline__ void store_o64(bf16_t* dst, const float (&o)[64], float inv) {
#pragma unroll
    for (int c = 0; c < 8; ++c) { u32x4 w; w.x = pk2(o[8 * c] * inv, o[8 * c + 1] * inv); w.y = pk2(o[8 * c + 2] * inv, o[8 * c + 3] * inv);
        w.z = pk2(o[8 * c + 4] * inv, o[8 * c + 5] * inv); w.w = pk2(o[8 * c + 6] * inv, o[8 * c + 7] * inv); *(u32x4*)(dst + 8 * c) = w; }
}

__device__ __forceinline__ void swa_item(const Params& p, int l, int item, LAS unsigned char* lds) {
    const int tid = my_tid(); const int hk = item & 1, c = (item >> 1) & 31, b = item >> 6;
    const bf16_t* P = (const bf16_t*)(p.ws + WS_PMIX); bf16_t* OCT = (bf16_t*)(p.ws + WS_OCAT);
    LAS float* Kt = (LAS float*)lds; LAS float* Vt = (LAS float*)(lds + 49152);
    const int nch = (c + 1 < 3) ? (c + 1) : 3, nk = 64 * nch, kt0 = b * SEQ + (c - nch + 1) * 64;
    for (int id = tid; id < nk * 8; id += NTHREADS) { const int j = id >> 3, ch = (id & 7) * 8; const bf16_t* rp = P + (size_t)(kt0 + j) * NPM;
        float f[8]; unpack8(*(const u32x4*)(rp + C_SWA_K + hk * 64 + ch), f);
        *(LAS f32x4*)(Kt + j * 64 + ch) = (f32x4){f[0], f[1], f[2], f[3]}; *(LAS f32x4*)(Kt + j * 64 + ch + 4) = (f32x4){f[4], f[5], f[6], f[7]};
        unpack8(*(const u32x4*)(rp + C_SWA_V + hk * 64 + ch), f);
        *(LAS f32x4*)(Vt + j * 64 + ch) = (f32x4){f[0], f[1], f[2], f[3]}; *(LAS f32x4*)(Vt + j * 64 + ch + 4) = (f32x4){f[4], f[5], f[6], f[7]}; }
    __syncthreads();
    if (tid < 256) {
        const int g = tid >> 6, qi = tid & 63, head = hk * 4 + g, t = b * SEQ + c * 64 + qi;
        float q[64], o[64];
        load_q64(P + (size_t)t * NPM + C_SWA_Q + head * 64, 0.125f, q);
#pragma unroll
        for (int d = 0; d < 64; ++d) o[d] = 0.f;
        float m = p.in[I_SINKS][l * 8 + head], lsum = 1.f;
        attend_keys(q, o, m, lsum, Kt, Vt, nk, nullptr, false, 1 << 30);
        store_o64(OCT + (size_t)t * OC + head * 64, o, 1.f / lsum);
    }
    __syncthreads();
}

__device__ __forceinline__ void fox_item(const Params& p, int l, int item, LAS unsigned char* lds) {
    const int tid = my_tid(), qi = tid & 127, s = tid >> 7; const int qb = 15 - (item & 15), bh = item >> 4, b = bh >> 2, h = bh & 3;
    const bf16_t* P = (const bf16_t*)(p.ws + WS_PMIX); bf16_t* OCT = (bf16_t*)(p.ws + WS_OCAT); const float* FC = (const float*)(p.ws + WS_FOXC) + (size_t)bh * SEQ;
    LAS float* Kt = (LAS float*)(lds + s * 16384); LAS float* Vt = (LAS float*)(lds + 65536 + s * 16384); LAS float* Bs = (LAS float*)(lds + 131072 + s * 256);
    const int q0 = 128 * qb, tq = q0 + qi, row = b * SEQ + tq, ntile = 2 * qb + 2; const float cref = FC[q0];
    float q[64], o[64];
    load_q64(P + (size_t)row * NPM + C_FOX_Q + h * 64, 0.125f, q);
#pragma unroll
    for (int d = 0; d < 64; ++d) o[d] = 0.f;
    float m = -INFINITY, lsum = 0.f;
    for (int r = 0; 4 * r < ntile; ++r) {
        const int jt = 4 * r + s; const bool active = jt < ntile; const int k0 = 64 * jt;
        if (active) {
#pragma unroll
            for (int c4 = 0; c4 < 4; ++c4) { const int id = qi + 128 * c4, j = id >> 3, ch = (id & 7) * 8; const bf16_t* rp = P + (size_t)(b * SEQ + k0 + j) * NPM;
                float f[8]; unpack8(*(const u32x4*)(rp + C_FOX_K + h * 64 + ch), f);
                *(LAS f32x4*)(Kt + j * 64 + ch) = (f32x4){f[0], f[1], f[2], f[3]}; *(LAS f32x4*)(Kt + j * 64 + ch + 4) = (f32x4){f[4], f[5], f[6], f[7]};
                unpack8(*(const u32x4*)(rp + C_FOX_V + h * 64 + ch), f);
                *(LAS f32x4*)(Vt + j * 64 + ch) = (f32x4){f[0], f[1], f[2], f[3]}; *(LAS f32x4*)(Vt + j * 64 + ch + 4) = (f32x4){f[4], f[5], f[6], f[7]}; }
            if (qi < 64) Bs[qi] = cref - FC[k0 + qi];
        }
        __syncthreads();
        if (active) {
            const int wq_hi = q0 + (qi | 63);
            if (k0 <= wq_hi) attend_keys(q, o, m, lsum, Kt, Vt, 64, Bs, true, tq - k0);
        }
        __syncthreads();
    }
    LAS float* comb = (LAS float*)lds;
    comb[(s * 66 + 0) * 128 + qi] = m; comb[(s * 66 + 1) * 128 + qi] = lsum;
#pragma unroll
    for (int d = 0; d < 64; ++d) comb[(s * 66 + 2 + d) * 128 + qi] = o[d];
    __syncthreads();
    float ms[4], M = -INFINITY;
#pragma unroll
    for (int x = 0; x < 4; ++x) { ms[x] = comb[(x * 66) * 128 + qi]; M = fmaxf(M, ms[x]); }
    float wts[4], L = 0.f;
#pragma unroll
    for (int x = 0; x < 4; ++x) { wts[x] = __expf(ms[x] - M); L += wts[x] * comb[(x * 66 + 1) * 128 + qi]; }
    const float inv = 1.f / L; float od[16];
#pragma unroll
    for (int d = 0; d < 16; ++d) { float a = 0.f;
#pragma unroll
        for (int x = 0; x < 4; ++x) a += wts[x] * comb[(x * 66 + 2 + 16 * s + d) * 128 + qi];
        od[d] = a * inv; }
    bf16_t* dst = OCT + (size_t)row * OC + 768 + h * 64 + 16 * s;
    u32x4 w0, w1; w0.x = pk2(od[0], od[1]); w0.y = pk2(od[2], od[3]); w0.z = pk2(od[4], od[5]); w0.w = pk2(od[6], od[7]);
    w1.x = pk2(od[8], od[9]); w1.y = pk2(od[10], od[11]); w1.z = pk2(od[12], od[13]); w1.w = pk2(od[14], od[15]);
    *(u32x4*)dst = w0; *(u32x4*)(dst + 8) = w1;
    __syncthreads();
}

__device__ __forceinline__ unsigned fkey(float f) { const unsigned u = __float_as_uint(f); return (u & 0x80000000u) ? ~u : (u | 0x80000000u); }
__device__ __forceinline__ void dsa_item(const Params& p, int l, int item, LAS unsigned char* lds) {
    const int tid = my_tid(), lane0 = tid & 63, wave = tid >> 6; const int chunk = 31 - (item & 31), b = item >> 5;
    const bf16_t* P = (const bf16_t*)(p.ws + WS_PMIX); bf16_t* OCT = (bf16_t*)(p.ws + WS_OCAT);
    LAS float* QI = (LAS float*)(lds + wave * 8192); LAS float* QA = QI + 256; LAS int* LIST = (LAS int*)(QI + 512); LAS float* PR = QI + 768;
    LAS float* SC = (LAS float*)(lds + 65536 + wave * 8192);
    const int nadm = 64 * (chunk + 1);
    const bf16_t* Pb = P + (size_t)b * SEQ * NPM;
#pragma unroll 1
    for (int qq = 0; qq < 8; ++qq) {
        int lane = lane0; asm volatile("" : "+v"(lane));
        const int tpos = chunk * 64 + wave + 8 * qq; const bf16_t* qrow = Pb + (size_t)tpos * NPM;
        { const u32x2 a = *(const u32x2*)(qrow + C_DSA_QI + 4 * lane); *(LAS f32x4*)(QI + 4 * lane) = (f32x4){bflo(a.x), bfhi(a.x), bflo(a.y), bfhi(a.y)};
          const u32x2 c = *(const u32x2*)(qrow + C_DSA_Q + 4 * lane); *(LAS f32x4*)(QA + 4 * lane) = (f32x4){bflo(c.x) * 0.125f, bfhi(c.x) * 0.125f, bflo(c.y) * 0.125f, bfhi(c.y) * 0.125f}; }
        float wsc[4];
#pragma unroll
        for (int h = 0; h < 4; ++h) wsc[h] = bf2f(qrow[C_WIDX + h]) * 0.0625f;
        LDS_FENCE();
        for (int i = 0; i <= chunk; ++i) { const int kv = 64 * i + lane; const bf16_t* kr = Pb + (size_t)kv * NPM + C_DSA_KI;
            float a0 = 0.f, a1 = 0.f, a2 = 0.f, a3 = 0.f;
#pragma unroll
            for (int c = 0; c < 8; ++c) { float f[8]; unpack8(*(const u32x4*)(kr + 8 * c), f);
#pragma unroll
                for (int hh = 0; hh < 4; ++hh) { const f32x4 qa = *(const LAS f32x4*)(QI + hh * 64 + 8 * c), qb2 = *(const LAS f32x4*)(QI + hh * 64 + 8 * c + 4);
                    const float d = f[0] * qa.x + f[1] * qa.y + f[2] * qa.z + f[3] * qa.w + f[4] * qb2.x + f[5] * qb2.y + f[6] * qb2.z + f[7] * qb2.w;
                    if (hh == 0) a0 += d; else if (hh == 1) a1 += d; else if (hh == 2) a2 += d; else a3 += d; } }
            const float sc = fmaxf(a0, 0.f) * wsc[0] + fmaxf(a1, 0.f) * wsc[1] + fmaxf(a2, 0.f) * wsc[2] + fmaxf(a3, 0.f) * wsc[3];
            SC[kv] = sc + 0.f; }
        LDS_FENCE();
        int nsel;
        if (nadm <= 256) { nsel = nadm;
#pragma unroll
            for (int r = 0; r < 4; ++r) if (lane + 64 * r < nadm) LIST[lane + 64 * r] = lane + 64 * r;
        } else {
            unsigned key[32];
#pragma unroll
            for (int i = 0; i < 32; ++i) { const unsigned kq = fkey(SC[64 * i + lane]); key[i] = (64 * i + lane < nadm) ? kq : 0u; }
            unsigned Tk = 0u;
#pragma unroll 1
            for (int bit = 31; bit >= 0; --bit) { const unsigned cand = Tk | (1u << bit); int cl = 0;
#pragma unroll
                for (int i = 0; i < 32; ++i) cl += (key[i] >= cand) ? 1 : 0;
                const int cnt = (int)wave_sum((float)cl);
                if (cnt >= 256) Tk = cand; }
            int cgl = 0;
#pragma unroll
            for (int i = 0; i < 32; ++i) cgl += (key[i] > Tk) ? 1 : 0;
            const int cgt = (int)wave_sum((float)cgl);
            int quota = 256 - cgt, pos = 0; const unsigned long long ltm = (1ull << lane) - 1ull;
#pragma unroll
            for (int i = 0; i < 32; ++i) { const unsigned long long tm = __ballot(key[i] == Tk); const int tb = __builtin_popcountll(tm & ltm);
                const bool sel = (key[i] > Tk) || ((key[i] == Tk) && tb < quota);
                const unsigned long long sm = __ballot(sel); if (sel) LIST[pos + __builtin_popcountll(sm & ltm)] = 64 * i + lane;
                pos += __builtin_popcountll(sm); quota -= __builtin_popcountll(tm); if (quota < 0) quota = 0;
                __builtin_amdgcn_sched_barrier(0); }
            nsel = pos;
        }
        LDS_FENCE();
        float mx0 = -INFINITY, mx1 = -INFINITY, mx2 = -INFINITY, mx3 = -INFINITY;
#pragma unroll 1
        for (int r = 0; r < 4; ++r) { const int e = lane + 64 * r; const bool ok = e < nsel; const int kv = ok ? LIST[e] : 0; const bf16_t* kr = Pb + (size_t)kv * NPM + C_DSA_K;
            float a0 = 0.f, a1 = 0.f, a2 = 0.f, a3 = 0.f;
#pragma unroll
            for (int c = 0; c < 8; ++c) { float f[8]; unpack8(*(const u32x4*)(kr + 8 * c), f);
#pragma unroll
                for (int hh = 0; hh < 4; ++hh) { const f32x4 qa = *(const LAS f32x4*)(QA + hh * 64 + 8 * c), qb2 = *(const LAS f32x4*)(QA + hh * 64 + 8 * c + 4);
                    const float d = f[0] * qa.x + f[1] * qa.y + f[2] * qa.z + f[3] * qa.w + f[4] * qb2.x + f[5] * qb2.y + f[6] * qb2.z + f[7] * qb2.w;
                    if (hh == 0) a0 += d; else if (hh == 1) a1 += d; else if (hh == 2) a2 += d; else a3 += d; } }
            if (ok) { *(LAS f32x4*)(PR + 4 * e) = (f32x4){a0, a1, a2, a3}; mx0 = fmaxf(mx0, a0); mx1 = fmaxf(mx1, a1); mx2 = fmaxf(mx2, a2); mx3 = fmaxf(mx3, a3); }
            asm volatile("" ::: "memory"); }
        mx0 = wave_max(mx0); mx1 = wave_max(mx1); mx2 = wave_max(mx2); mx3 = wave_max(mx3);
        float ls[4] = {0.f, 0.f, 0.f, 0.f};
#pragma unroll 1
        for (int r = 0; r < 4; ++r) { const int e = lane + 64 * r;
            if (e < nsel) { f32x4 pe = *(const LAS f32x4*)(PR + 4 * e); pe.x = __expf(pe.x - mx0); pe.y = __expf(pe.y - mx1); pe.z = __expf(pe.z - mx2); pe.w = __expf(pe.w - mx3);
                ls[0] += pe.x; ls[1] += pe.y; ls[2] += pe.z; ls[3] += pe.w; *(LAS f32x4*)(PR + 4 * e) = pe; } }
#pragma unroll
        for (int hh = 0; hh < 4; ++hh) ls[hh] = wave_sum(ls[hh]);
        LDS_FENCE();
        float o0 = 0.f, o1 = 0.f, o2 = 0.f, o3 = 0.f;
        for (int e = 0; e < nsel; e += 4) {
#pragma unroll
            for (int u = 0; u < 4; ++u) { const int kv = LIST[e + u]; const f32x4 pe = *(const LAS f32x4*)(PR + 4 * (e + u));
                const float v = bf2f(Pb[(size_t)kv * NPM + C_DSA_V + lane]);
                o0 += pe.x * v; o1 += pe.y * v; o2 += pe.z * v; o3 += pe.w * v; } }
        bf16_t* dst = OCT + (size_t)(b * SEQ + tpos) * OC + 1024 + lane;
        dst[0] = (bf16_t)f2bf(o0 / ls[0]); dst[64] = (bf16_t)f2bf(o1 / ls[1]); dst[128] = (bf16_t)f2bf(o2 / ls[2]); dst[192] = (bf16_t)f2bf(o3 / ls[3]);
        LDS_FENCE();
    }
}

__device__ __forceinline__ void rwkv_scan(const Params& p, int l, int bh, LAS unsigned char* lds) {
    const int lane = my_tid() & 63; const int b = bh >> 2, h = bh & 3;
    const float* RWr = (const float*)(p.ws + WS_RW); const float* RWw = RWr + (size_t)T * 256; const float* RWk = RWw + (size_t)T * 256; const float* RWv = RWk + (size_t)T * 256;
    const float* RWkk = RWv + (size_t)T * 256; const float* RWkka = RWkk + (size_t)T * 256; const float* RWg = RWkka + (size_t)T * 256; const float* BON = (const float*)(p.ws + WS_BONUS);
    bf16_t* OCT = (bf16_t*)(p.ws + WS_OCAT);
    const float gng = p.in[I_GNG][l * 256 + h * 64 + lane], gnb = p.in[I_GNB][l * 256 + h * 64 + lane];
    LAS float* Lr = (LAS float*)lds; LAS float* Lw = Lr + 1024; LAS float* Lk = Lw + 1024; LAS float* Lkk = Lk + 1024; LAS float* Lka = Lkk + 1024;
    LAS float* Lv = Lka + 1024; LAS float* Lg = Lv + 1024; LAS float* Ly = Lg + 1024; LAS float* Lb = Ly + 1024;
    float S[64];
#pragma unroll
    for (int j = 0; j < 64; ++j) S[j] = 0.f;
#pragma unroll 1
    for (int tb = 0; tb < SEQ; tb += 16) {
        const size_t base = ((size_t)(b * SEQ + tb)) * 256 + h * 64 + lane;
#pragma unroll 4
        for (int i = 0; i < 16; ++i) { const size_t o = base + (size_t)i * 256; Lr[i * 64 + lane] = RWr[o]; Lw[i * 64 + lane] = RWw[o]; Lk[i * 64 + lane] = RWk[o];
            Lkk[i * 64 + lane] = RWkk[o]; Lka[i * 64 + lane] = RWkka[o]; Lv[i * 64 + lane] = RWv[o]; Lg[i * 64 + lane] = RWg[o]; }
        if (lane < 16) Lb[lane] = BON[(size_t)(b * SEQ + tb + lane) * 4 + h];
        LDS_FENCE();
#pragma unroll 1
        for (int i = 0; i < 16; ++i) {
            float s0 = 0.f, s1 = 0.f, s2 = 0.f, s3 = 0.f;
#pragma unroll
            for (int j4 = 0; j4 < 16; ++j4) { const f32x4 kk = *(const LAS f32x4*)(Lkk + i * 64 + 4 * j4); s0 += S[4 * j4] * kk.x; s1 += S[4 * j4 + 1] * kk.y; s2 += S[4 * j4 + 2] * kk.z; s3 += S[4 * j4 + 3] * kk.w; }
            const float sa = -((s0 + s1) + (s2 + s3)); const float v = Lv[i * 64 + lane];
            float y0 = 0.f, y1 = 0.f, y2 = 0.f, y3 = 0.f;
#pragma unroll
            for (int j4 = 0; j4 < 16; ++j4) { const f32x4 w = *(const LAS f32x4*)(Lw + i * 64 + 4 * j4), ka = *(const LAS f32x4*)(Lka + i * 64 + 4 * j4), k = *(const LAS f32x4*)(Lk + i * 64 + 4 * j4), r = *(const LAS f32x4*)(Lr + i * 64 + 4 * j4);
                S[4 * j4] = S[4 * j4] * w.x + sa * ka.x + v * k.x; S[4 * j4 + 1] = S[4 * j4 + 1] * w.y + sa * ka.y + v * k.y;
                S[4 * j4 + 2] = S[4 * j4 + 2] * w.z + sa * ka.z + v * k.z; S[4 * j4 + 3] = S[4 * j4 + 3] * w.w + sa * ka.w + v * k.w;
                y0 += S[4 * j4] * r.x; y1 += S[4 * j4 + 1] * r.y; y2 += S[4 * j4 + 2] * r.z; y3 += S[4 * j4 + 3] * r.w; }
            Ly[i * 64 + lane] = (y0 + y1) + (y2 + y3);
            asm volatile("" ::: "memory");
        }
        LDS_FENCE();
#pragma unroll 4
        for (int i = 0; i < 16; ++i) { const float yy = Ly[i * 64 + lane]; const float mean = wave_sum(yy) * (1.f / 64.f); const float d = yy - mean; const float var = wave_sum(d * d) * (1.f / 64.f);
            const float o = (d * rsqrtf(var + 64e-5f) * gng + gnb + Lb[i] * Lv[i * 64 + lane]) * Lg[i * 64 + lane];
            OCT[(size_t)(b * SEQ + tb + i) * OC + 512 + h * 64 + lane] = (bf16_t)f2bf(o); }
        LDS_FENCE();
    }
}

template <int WHICH  >
__device__ __forceinline__ void ph_mixers(const Params& p, int l, LAS unsigned char* lds) {
    const int tid = my_tid();
    unsigned* ctl = (unsigned*)(p.ws + WS_CTL);
    if (WHICH == 0 || WHICH == -1) { if (blockIdx.x < 32) { if (tid < 64) rwkv_scan(p, l, blockIdx.x, lds); __syncthreads(); } }
    LAS int* slot = (LAS int*)(lds + LDS_BYTES - 64);
    constexpr int NFOX = 512, NDSA = 256, NSWA = 512;
#define QUEUE_LOOP(word, N, CALL) for (;;) { if (tid == 0) *slot = (int)atomicAdd(ctl + 64 * (l + 1) + (word), 1u); __syncthreads(); const int it = *slot; __syncthreads(); if (it >= (N)) break; CALL; __syncthreads(); }
    if (WHICH == 1 || WHICH == -1) { QUEUE_LOOP(0, NFOX, fox_item(p, l, it, lds)) }
    if (WHICH == 2 || WHICH == -1) { QUEUE_LOOP(16, NDSA, dsa_item(p, l, it, lds)) }
    if (WHICH == 3 || WHICH == -1) { QUEUE_LOOP(32, NSWA, swa_item(p, l, it, lds)) }
#undef QUEUE_LOOP
}

__device__ __forceinline__ void ph_xb(const Params& p, int l, LAS unsigned char*) {
    const int tid_ = my_tid(); const int lane = tid_ & 63, wave = tid_ >> 6, gw = blockIdx.x * 8 + wave, NGW = gridDim.x * 8;
    const float* src = (l == 0) ? p.in[I_X] : p.out; bf16_t* XB = (bf16_t*)(p.ws + WS_XB);
    for (int m = gw; m < T; m += NGW) row_to_bf16(src + (size_t)m * D, XB + (size_t)m * D, lane);
}

struct SchedMerge {
    static constexpr int PERM = 1;
    const char* XB; const char* WIN; const char* OCT; const char* WB; int G, c;
    __device__ __forceinline__ bool next(int i, mg::Unit& u) const {
        int pm, pn; if (!mg::static_tile(i >> 3, G, c, T / 256, 4, pm, pn)) return false;
        const int j = i & 7, br = j >> 1; u.pm = pm; u.pn = pn; u.tag = j;
        if ((j & 1) == 0) { u.A = XB + (size_t)pm * 256 * 2048; u.B = WIN + (size_t)(3328 + 1024 * br + 256 * pn) * 2048; u.ld = 2048; u.nt = 16; }
        else { const int koff = (br == 0) ? 0 : 256 + 256 * br, kk = (br == 0) ? 512 : 256;
            u.A = OCT + (size_t)pm * 256 * (OC * 2) + koff * 2; u.B = WB + (size_t)pn * 256 * (OC * 2) + koff * 2; u.ld = OC * 2; u.nt = kk / 64; }
        return true;
    }
};
struct EpiMerge {
    const float* gbias; f32x4* gsc; f32x4* macc; bf16_t* MB;
    __device__ __forceinline__ void operator()(const AccT& acc, const mg::Unit& u, int wr, int wc, int fr, int fq, int tid) const {
        const int br = u.tag >> 1; const int col0 = u.pn * 256 + wc * 32 + 8 * fq, row0 = u.pm * 256 + wr * 64 + fr;
        if ((u.tag & 1) == 0) {
            f32x4 bv[2][2];
#pragma unroll
            for (int bj = 0; bj < 2; ++bj)
#pragma unroll
                for (int n = 0; n < 2; ++n) bv[bj][n] = *(const f32x4*)(gbias + br * 1024 + col0 + bj * 128 + 4 * n);
#pragma unroll
            for (int ai = 0; ai < 2; ++ai)
#pragma unroll
                for (int m = 0; m < 4; ++m)
#pragma unroll
                    for (int bj = 0; bj < 2; ++bj)
#pragma unroll
                        for (int n = 0; n < 2; ++n) { const f32x4 x = acc[ai][bj][m][n] + bv[bj][n]; f32x4 g;
#pragma unroll
                            for (int j = 0; j < 4; ++j) g[j] = sigm(x[j]);
                            gsc[((((ai * 4 + m) * 2 + bj) * 2 + n) * 512) + tid] = g; asm volatile("" ::: "memory"); }
        } else {
#pragma unroll
            for (int ai = 0; ai < 2; ++ai)
#pragma unroll
                for (int m = 0; m < 4; ++m) { bf16_t* rowp = MB + (size_t)(row0 + ai * 128 + m * 16) * D + col0;
#pragma unroll
                    for (int bj = 0; bj < 2; ++bj) { f32x4 r[2];
#pragma unroll
                        for (int n = 0; n < 2; ++n) { const int idx = ((((ai * 4 + m) * 2 + bj) * 2 + n) * 512) + tid; const f32x4 g = gsc[idx]; f32x4 v = g * acc[ai][bj][m][n];
                            if (br > 0) v += macc[idx]; if (br < 3) macc[idx] = v; r[n] = v; }
                        if (br == 3) { u32x4 w; w.x = pk2(r[0][0], r[0][1]); w.y = pk2(r[0][2], r[0][3]); w.z = pk2(r[1][0], r[1][1]); w.w = pk2(r[1][2], r[1][3]); *(u32x4*)(rowp + bj * 128) = w; }
                        asm volatile("" ::: "memory"); } }
        }
    }
};
__device__ __forceinline__ void ph_merge(const Params& p, int l, LAS unsigned char* lds) {
    SchedMerge S{(const char*)(p.ws + WS_XB), (const char*)(p.ws + WS_WIN), (const char*)(p.ws + WS_OCAT), (const char*)(p.ws + WS_WB), (int)gridDim.x, (int)blockIdx.x};
    EpiMerge E{p.in[I_GB] + (size_t)l * 4096, (f32x4*)(p.ws + WS_GSC) + (size_t)blockIdx.x * 16384, (f32x4*)(p.ws + WS_MACC) + (size_t)blockIdx.x * 16384, (bf16_t*)(p.ws + WS_MERGED)};
    mg::gemm_run(lds, S, E);
}

template <int PERM_, int NN, int K> struct SchedPlain {
    static constexpr int PERM = PERM_;
    const char* A; const char* B; int G, c;
    __device__ __forceinline__ bool next(int i, mg::Unit& u) const {
        int pm, pn; if (!mg::static_tile(i, G, c, T / 256, NN, pm, pn)) return false;
        u.A = A + (size_t)pm * 256 * K * 2; u.B = B + (size_t)pn * 256 * K * 2; u.ld = K * 2; u.nt = K / 64; u.pm = pm; u.pn = pn; u.tag = 0; return true;
    }
};
struct EpiResid {
    const float* base; float* out; float alpha;
    __device__ __forceinline__ void operator()(const AccT& acc, const mg::Unit& u, int wr, int wc, int fr, int fq, int) const {
        const int row0 = u.pm * 256 + wr * 64 + fr, col0 = u.pn * 256 + wc * 32 + 4 * fq;
#pragma unroll
        for (int ai = 0; ai < 2; ++ai)
#pragma unroll
            for (int m = 0; m < 4; ++m) { const size_t off = (size_t)(row0 + ai * 128 + m * 16) * D + col0;
#pragma unroll
                for (int bj = 0; bj < 2; ++bj)
#pragma unroll
                    for (int n = 0; n < 2; ++n) { const f32x4 bs = *(const f32x4*)(base + off + bj * 128 + n * 16); *(f32x4*)(out + off + bj * 128 + n * 16) = bs * alpha + acc[ai][bj][m][n]; } }
    }
};
__device__ __forceinline__ void ph_outproj(const Params& p, int l, LAS unsigned char* lds) {
    SchedPlain<0, 4, D> S{(const char*)(p.ws + WS_MERGED), (const char*)(p.ws + WS_WO), (int)gridDim.x, (int)blockIdx.x};
    EpiResid E{(l == 0) ? p.in[I_X] : p.out, p.out, DN_ALPHA};
    mg::gemm_run(lds, S, E);
}

__device__ __forceinline__ void ln_rows(const Params& p, int l, int mode, LAS unsigned char* lds) {
    const int tid = my_tid(), lane = tid & 63, wave = tid >> 6;
    const float* g = p.in[I_LNG] + (size_t)(l * 2 + mode) * D; const float* bb = p.in[I_LNB] + (size_t)(l * 2 + mode) * D;
    bf16_t* OB = (bf16_t*)(p.ws + (mode == 0 ? WS_X1B : WS_XB)); const bool wb = (mode == 0) || (l == 0);
    const bool moe = (mode == 0) && (l & 1); const float* rw = p.in[I_RTW] + (size_t)(l >> 1) * D * NE; const float* rb = p.in[I_RTB] + (l >> 1) * NE;
    int* TOKE = (int*)(p.ws + WS_TOKE); float* TOKW = (float*)(p.ws + WS_TOKW);
    f32x4 gv[4], bv[4];
#pragma unroll
    for (int j = 0; j < 4; ++j) { gv[j] = *(const f32x4*)(g + 4 * lane + 256 * j); bv[j] = *(const f32x4*)(bb + 4 * lane + 256 * j); }
    const int rows_per_wg = T / gridDim.x;
    for (int rr = wave; rr < rows_per_wg; rr += 8) {
        const int row = blockIdx.x * rows_per_wg + rr; float* xr = p.out + (size_t)row * D;
        f32x4 v[4]; float s = 0.f;
#pragma unroll
        for (int j = 0; j < 4; ++j) { v[j] = *(const f32x4*)(xr + 4 * lane + 256 * j); s += (v[j].x + v[j].y) + (v[j].z + v[j].w); }
        const float mean = wave_sum(s) * (1.f / D); float s2 = 0.f;
#pragma unroll
        for (int j = 0; j < 4; ++j) { v[j] = v[j] - mean; s2 += (v[j].x * v[j].x + v[j].y * v[j].y) + (v[j].z * v[j].z + v[j].w * v[j].w); }
        const float rstd = rsqrtf(wave_sum(s2) * (1.f / D) + LN_EPS);
        const float osc = (mode == 0) ? DN_ALPHA : 1.f;
#pragma unroll
        for (int j = 0; j < 4; ++j) { v[j] = v[j] * rstd * gv[j] + bv[j]; *(f32x4*)(xr + 4 * lane + 256 * j) = v[j] * osc;
            if (wb) *(unsigned long long*)(OB + (size_t)row * D + 4 * lane + 256 * j) = (unsigned long long)pk2(v[j].x, v[j].y) | ((unsigned long long)pk2(v[j].z, v[j].w) << 32); }
        if (moe) {
            float lg[8];
#pragma unroll
            for (int e = 0; e < 8; ++e) lg[e] = 0.f;
#pragma unroll
            for (int j = 0; j < 4; ++j)
#pragma unroll
                for (int q = 0; q < 4; ++q) { const int c = 4 * lane + 256 * j + q; const f32x4 w0 = *(const f32x4*)(rw + (size_t)c * 8), w1 = *(const f32x4*)(rw + (size_t)c * 8 + 4); const float x = v[j][q];
                    lg[0] += x * w0.x; lg[1] += x * w0.y; lg[2] += x * w0.z; lg[3] += x * w0.w; lg[4] += x * w1.x; lg[5] += x * w1.y; lg[6] += x * w1.z; lg[7] += x * w1.w; }
#pragma unroll
            for (int e = 0; e < 8; ++e) lg[e] = wave_sum(lg[e]) + rb[e];
            int e1 = 0; float v1 = lg[0];
#pragma unroll
            for (int e = 1; e < 8; ++e) if (lg[e] > v1) { v1 = lg[e]; e1 = e; }
            int e2 = -1; float v2 = -INFINITY;
#pragma unroll
            for (int e = 0; e < 8; ++e) if (e != e1 && lg[e] > v2) { v2 = lg[e]; e2 = e; }
            const float w1 = 1.f / (1.f + __expf(v2 - v1));
            if (lane == 0) { TOKE[row * 2] = e1; TOKE[row * 2 + 1] = e2; TOKW[row * 2] = w1; TOKW[row * 2 + 1] = 1.f - w1; }
        }
    }
    if (moe) {
        __syncthreads();
        if (tid < 8) { int cnt = 0; for (int rr = 0; rr < rows_per_wg; ++rr) { const int row = blockIdx.x * rows_per_wg + rr; cnt += (TOKE[row * 2] == tid) + (TOKE[row * 2 + 1] == tid); }
            ((int*)(p.ws + WS_WGCNT))[blockIdx.x * 8 + tid] = cnt; }
    }
}
__device__ __forceinline__ void ph_ln1(const Params& p, int l, LAS unsigned char* lds) {
    ln_rows(p, l, 0, lds);
    __syncthreads();
    const int tid_ = my_tid(); const int lane = tid_ & 63, wave = tid_ >> 6, gw = blockIdx.x * 8 + wave, NGW = gridDim.x * 8;
    LAS float* scr = (LAS float*)(lds + wave * 8448);
    bf16_t* W13 = (bf16_t*)(p.ws + WS_WF13);
    if ((l & 1) == 0) {
        const int j = l >> 1; const float* w1 = p.in[I_F1] + (size_t)j * D * DFF; const float* w3 = p.in[I_F3] + (size_t)j * D * DFF; const float* w2 = p.in[I_F2] + (size_t)j * DFF * D;
        bf16_t* W2 = (bf16_t*)(p.ws + WS_WF2_DENSE);
        const int n1 = tr_nitems(D, DFF), n2 = tr_nitems(DFF, D);
        for (int it = gw; it < 2 * n1 + n2; it += NGW) { int r = it;
            if (r < n1) { tr_item(w1, D, DFF, W13, D, 2, 0, scr, r, lane); continue; } r -= n1;
            if (r < n1) { tr_item(w3, D, DFF, W13, D, 3, 0, scr, r, lane); continue; } r -= n1;
            tr_item(w2, DFF, D, W2, DFF, 0, 0, scr, r, lane); }
    } else {
        const int j = l >> 1; bf16_t* W2 = (bf16_t*)(p.ws + WS_WF2_MOE);
        const int n1 = tr_nitems(D, DFE), n2 = tr_nitems(DFE, D), per = 2 * n1 + n2;
        for (int it = gw; it < NE * per; it += NGW) { const int e = it / per; int r = it % per;
            const float* w1 = p.in[I_E1] + ((size_t)j * NE + e) * D * DFE; const float* w3 = p.in[I_E3] + ((size_t)j * NE + e) * D * DFE; const float* w2 = p.in[I_E2] + ((size_t)j * NE + e) * DFE * D;
            if (r < n1) { tr_item(w1, D, DFE, W13, D, 2, e * 2 * DFE, scr, r, lane); continue; } r -= n1;
            if (r < n1) { tr_item(w3, D, DFE, W13, D, 3, e * 2 * DFE, scr, r, lane); continue; } r -= n1;
            tr_item(w2, DFE, D, W2, DFE, 0, e * D, scr, r, lane); }
    }
}

__device__ __forceinline__ void moe_tables(const Params& p, LAS int* tb  ) {
    const int tid = my_tid(); const int* WG = (const int*)(p.ws + WS_WGCNT);
    if (tid < 8) { int tot = 0, mine = 0; for (int w = 0; w < (int)gridDim.x; ++w) { const int c = WG[w * 8 + tid]; if (w < (int)blockIdx.x) mine += c; tot += c; } tb[tid] = tot; tb[16 + tid] = mine; }
    __syncthreads();
    if (tid == 0) { int base = 0; for (int e = 0; e < 8; ++e) { tb[8 + e] = base; base += ((tb[e] + 255) >> 8) << 8; } tb[24] = base; }
    __syncthreads();
}
__device__ __forceinline__ void ph_moe_assign(const Params& p, int l, LAS unsigned char* lds) {
    const int tid = my_tid(), lane = tid & 63, wave = tid >> 6;
    LAS int* tb = (LAS int*)lds; LAS int* rowof = tb + 32;
    moe_tables(p, tb);
    const int rows_per_wg = T / gridDim.x; const int* TOKE = (const int*)(p.ws + WS_TOKE); const float* TOKW = (const float*)(p.ws + WS_TOKW);
    int* ROWTOK = (int*)(p.ws + WS_ROWTOK); float* ROWW = (float*)(p.ws + WS_ROWW);
    if (tid < 8) { int run = tb[8 + tid] + tb[16 + tid];
        for (int rr = 0; rr < rows_per_wg; ++rr) { const int row = blockIdx.x * rows_per_wg + rr;
#pragma unroll
            for (int s = 0; s < 2; ++s) if (TOKE[row * 2 + s] == tid) { ROWTOK[run] = row; ROWW[run] = TOKW[row * 2 + s]; rowof[rr * 2 + s] = run; ++run; } } }
    bf16_t* AG = (bf16_t*)(p.ws + WS_AG);
    if (blockIdx.x < 8) { const int e = blockIdx.x, lo = tb[8 + e] + tb[e], hi = tb[8 + e] + (((tb[e] + 255) >> 8) << 8);
        for (int r = lo + wave; r < hi; r += 8) { if (lane == 0) { ROWTOK[r] = -1; ROWW[r] = 0.f; }
#pragma unroll
            for (int j = 0; j < 2; ++j) *(u32x4*)(AG + (size_t)r * D + 8 * lane + 512 * j) = (u32x4){0u, 0u, 0u, 0u}; } }
    __syncthreads();
    const bf16_t* X1B = (const bf16_t*)(p.ws + WS_X1B);
    for (int pr = wave; pr < rows_per_wg * 2; pr += 8) { const int row = blockIdx.x * rows_per_wg + (pr >> 1), dst = rowof[pr];
#pragma unroll
        for (int j = 0; j < 2; ++j) *(u32x4*)(AG + (size_t)dst * D + 8 * lane + 512 * j) = *(const u32x4*)(X1B + (size_t)row * D + 8 * lane + 512 * j); }
}

struct EpiSwiglu {
    bf16_t* H; int ldh;
    __device__ __forceinline__ void operator()(const AccT& acc, const mg::Unit& u, int wr, int wc, int fr, int fq, int) const {
        const int row0 = u.pm * 256 + wr * 64 + fr, col0 = u.pn * 128 + wc * 32 + 8 * fq;
#pragma unroll
        for (int ai = 0; ai < 2; ++ai)
#pragma unroll
            for (int m = 0; m < 4; ++m) { float hv[8];
#pragma unroll
                for (int n = 0; n < 2; ++n)
#pragma unroll
                    for (int j = 0; j < 4; ++j) { const float a = acc[ai][0][m][n][j], b = acc[ai][1][m][n][j]; hv[4 * n + j] = a * sigm(a) * b; }
                u32x4 w; w.x = pk2(hv[0], hv[1]); w.y = pk2(hv[2], hv[3]); w.z = pk2(hv[4], hv[5]); w.w = pk2(hv[6], hv[7]);
                *(u32x4*)(H + (size_t)(row0 + ai * 128 + m * 16) * ldh + col0) = w; asm volatile("" ::: "memory"); }
    }
};
template <int PERM_, int NN, int K, int BROWS> struct SchedMoe {
    static constexpr int PERM = PERM_;
    const char* A; const char* B; const LAS int* tstart; int G, c;
    __device__ __forceinline__ bool next(int i, mg::Unit& u) const {
        const int L = i * G + c; if (L >= tstart[8] * NN) return false;
        const int rt = L / NN, pn = L % NN; int e = 0;
#pragma unroll
        for (int x = 1; x < 8; ++x) if (rt >= tstart[x]) e = x;
        u.A = A + (size_t)rt * 256 * (K * 2); u.B = B + ((size_t)e * BROWS + (size_t)pn * 256) * (K * 2); u.ld = K * 2; u.nt = K / 64; u.pm = rt; u.pn = pn; u.tag = 0; return true;
    }
};
template <class SM> __device__ __forceinline__ void moe_sched_tiles(const Params& p, LAS unsigned char* lds, SM& S) {
    LAS int* tb = (LAS int*)(lds + LDS_BYTES - 512);
    moe_tables(p, tb);
    { const int t_ = my_tid(); if (t_ < 8) tb[32 + t_] = tb[8 + t_] >> 8; if (t_ == 8) tb[40] = tb[24] >> 8; }
    __syncthreads();
    S.tstart = tb + 32;
}
__device__ __forceinline__ void ph_ffn_up(const Params& p, int l, LAS unsigned char* lds) {
    if ((l & 1) == 0) {
        SchedPlain<1, 2 * DFF / 256, D> S{(const char*)(p.ws + WS_X1B), (const char*)(p.ws + WS_WF13), (int)gridDim.x, (int)blockIdx.x};
        EpiSwiglu E{(bf16_t*)(p.ws + WS_H), DFF};
        mg::gemm_run(lds, S, E);
    } else {
        SchedMoe<1, 2 * DFE / 256, D, 2 * DFE> S; S.A = (const char*)(p.ws + WS_AG); S.B = (const char*)(p.ws + WS_WF13);
        S.G = (int)gridDim.x; S.c = (int)blockIdx.x; moe_sched_tiles(p, lds, S);
        EpiSwiglu E{(bf16_t*)(p.ws + WS_H), DFE};
        mg::gemm_run(lds, S, E);
    }
}

struct EpiAccum {
    float* out;
    __device__ __forceinline__ void operator()(const AccT& acc, const mg::Unit& u, int wr, int wc, int fr, int fq, int) const {
        const int row0 = u.pm * 256 + wr * 64 + fr, col0 = u.pn * 256 + wc * 32 + 4 * fq;
#pragma unroll
        for (int ai = 0; ai < 2; ++ai)
#pragma unroll
            for (int m = 0; m < 4; ++m) { float* rp = out + (size_t)(row0 + ai * 128 + m * 16) * D + col0;
#pragma unroll
                for (int bj = 0; bj < 2; ++bj)
#pragma unroll
                    for (int n = 0; n < 2; ++n) { f32x4* q = (f32x4*)(rp + bj * 128 + n * 16); *q = *q + acc[ai][bj][m][n]; } }
    }
};
struct EpiScatter {
    float* out; const int* rowtok; const float* roww;
    __device__ __forceinline__ void operator()(const AccT& acc, const mg::Unit& u, int wr, int wc, int fr, int fq, int) const {
        const int row0 = u.pm * 256 + wr * 64 + fr, col0 = u.pn * 256 + wc * 32 + 4 * fq;
#pragma unroll
        for (int ai = 0; ai < 2; ++ai)
#pragma unroll
            for (int m = 0; m < 4; ++m) { const int r = row0 + ai * 128 + m * 16; const int tok = rowtok[r]; const float w = roww[r];
                if (tok >= 0) { float* rp = out + (size_t)tok * D + col0;
#pragma unroll
                    for (int bj = 0; bj < 2; ++bj)
#pragma unroll
                        for (int n = 0; n < 2; ++n)
#pragma unroll
                            for (int j = 0; j < 4; ++j) unsafeAtomicAdd(rp + bj * 128 + n * 16 + j, w * acc[ai][bj][m][n][j]); } }
    }
};
__device__ __forceinline__ void ph_ffn_down(const Params& p, int l, LAS unsigned char* lds) {
    if ((l & 1) == 0) {
        SchedPlain<0, 4, DFF> S{(const char*)(p.ws + WS_H), (const char*)(p.ws + WS_WF2_DENSE), (int)gridDim.x, (int)blockIdx.x};
        EpiAccum E{p.out};
        mg::gemm_run(lds, S, E);
    } else {
        SchedMoe<0, 4, DFE, D> S; S.A = (const char*)(p.ws + WS_H); S.B = (const char*)(p.ws + WS_WF2_MOE);
        S.G = (int)gridDim.x; S.c = (int)blockIdx.x; moe_sched_tiles(p, lds, S);
        EpiScatter E{p.out, (const int*)(p.ws + WS_ROWTOK), (const float*)(p.ws + WS_ROWW)};
        mg::gemm_run(lds, S, E);
    }
}

constexpr int PH_PER_LAYER = 12, NPHASE = 2 * PH_PER_LAYER;
template <int K> __device__ __forceinline__ void run_phase(const Params& p, int l, LAS unsigned char* lds) {
    if constexpr (K == 0) ph_conv_mixer(p, l, lds);
    else if constexpr (K == 1) ph_inproj(p, l, lds);
    else if constexpr (K == 2) ph_prep(p, l, lds);
    else if constexpr (K == 3) ph_mixers<-1>(p, l, lds);
    else if constexpr (K == 30) ph_mixers<0>(p, l, lds);
    else if constexpr (K == 31) ph_mixers<1>(p, l, lds);
    else if constexpr (K == 32) ph_mixers<2>(p, l, lds);
    else if constexpr (K == 33) ph_mixers<3>(p, l, lds);
    else if constexpr (K == 4) ph_xb(p, l, lds);
    else if constexpr (K == 5) ph_merge(p, l, lds);
    else if constexpr (K == 6) ph_outproj(p, l, lds);
    else if constexpr (K == 7) ph_ln1(p, l, lds);
    else if constexpr (K == 8) ph_moe_assign(p, l, lds);
    else if constexpr (K == 9) ph_ffn_up(p, l, lds);
    else if constexpr (K == 10) ph_ffn_down(p, l, lds);
    else ln_rows(p, l, 1, lds);
}
template <int K> __global__ void __launch_bounds__(NTHREADS, 2) k_phase(Params p, int l) {
    extern __shared__ __attribute__((aligned(16))) unsigned char lds_raw[];
    run_phase<K>(p, l, (LAS unsigned char*)lds_raw);
}
template <int K> static void launch_phase(const Params& p, int l, hipStream_t stream) {
    static bool attr = false;
    if (!attr) { (void)hipFuncSetAttribute((const void*)k_phase<K>, hipFuncAttributeMaxDynamicSharedMemorySize, LDS_BYTES); attr = true; }
    hipLaunchKernelGGL(k_phase<K>, dim3(256), dim3(NTHREADS), LDS_BYTES, stream, p, l);
}

extern "C" void kernel_launch(void* const* d_in, const int* in_sizes, int n_in, void* d_out, int out_size, void* d_ws, size_t ws_size, hipStream_t stream) {
    if (n_in != 28 || out_size != T * D || ws_size < WS_END) { fprintf(stderr, "kernel_launch: unexpected problem (n_in %d out %d ws %zu)\n", n_in, out_size, ws_size); return; }
    (void)hipMemsetAsync((char*)d_ws + WS_CTL, 0, 4096, stream);
    Params p{};
    for (int i = 0; i < 28; ++i) p.in[i] = (const float*)d_in[i];
    p.out = (float*)d_out; p.ws = (unsigned char*)d_ws;
    for (int l = 0; l < 2; ++l) {
        launch_phase<0>(p, l, stream); launch_phase<1>(p, l, stream); launch_phase<2>(p, l, stream);
        launch_phase<30>(p, l, stream); launch_phase<31>(p, l, stream); launch_phase<32>(p, l, stream); launch_phase<33>(p, l, stream);
        launch_phase<4>(p, l, stream); launch_phase<5>(p, l, stream); launch_phase<6>(p, l, stream); launch_phase<7>(p, l, stream);
        if (l & 1) launch_phase<8>(p, l, stream);
        launch_phase<9>(p, l, stream); launch_phase<10>(p, l, stream); launch_phase<11>(p, l, stream);
    }
}
```

```cpp
#include <hip/hip_runtime.h>
#include <hip/hip_cooperative_groups.h>
#include <cstdio>
#include <cstdint>
namespace cg = cooperative_groups;

#ifndef FUSED
#define FUSED 1
#endif

#define LAS __attribute__((address_space(3)))
typedef unsigned short bf16_t;
typedef short bf16x8 __attribute__((ext_vector_type(8)));
typedef float f32x4 __attribute__((ext_vector_type(4)));
typedef float f32x2 __attribute__((ext_vector_type(2)));
typedef unsigned u32x4 __attribute__((ext_vector_type(4)));
typedef unsigned u32x2 __attribute__((ext_vector_type(2)));

constexpr int T = 16384, D = 1024, SEQ = 2048, NB = 8;
constexpr int NPM = 3328;
constexpr int C_SWA_Q = 0, C_SWA_K = 512, C_SWA_V = 640, C_RW = 768;
constexpr int C_FOX_Q = 1792, C_FOX_K = 2048, C_FOX_V = 2304;
constexpr int C_DSA_Q = 2560, C_DSA_K = 2816, C_DSA_V = 2880, C_DSA_QI = 2944, C_DSA_KI = 3200, C_FLOG = 3264, C_WIDX = 3268;
constexpr int D_IN = 7368, NWIN = 7424;
constexpr int OC = 1280;
constexpr int DFF = 2816, DFE = 1408, NE = 8;
constexpr int MAXROWS = 34816;
constexpr float DN_ALPHA = 1.41421356237f;
constexpr float LN_EPS = 1e-5f;

constexpr size_t MiB = 1u << 20;
constexpr size_t WS_CTL = 0;
constexpr size_t WS_WIN = 1 * MiB, WS_WB = 16 * MiB, WS_WO = 19 * MiB;
constexpr size_t WS_FOXC = 21 * MiB, WS_TOKE = 21 * MiB + 256 * 1024, WS_TOKW = 21 * MiB + 384 * 1024, WS_ROWTOK = 21 * MiB + 512 * 1024,
                 WS_ROWW = 21 * MiB + 768 * 1024, WS_WGCNT = 21 * MiB + 920 * 1024;
constexpr size_t WS_OCAT = 22 * MiB, WS_X1B = 22 * MiB;
constexpr size_t WS_PMIX = 62 * MiB, WS_MERGED = 62 * MiB, WS_MACC = 94 * MiB;
constexpr size_t WS_WF13 = 62 * MiB, WS_WF2_DENSE = 73 * MiB, WS_WF2_MOE = 106 * MiB, WS_H = 128 * MiB;
constexpr size_t WS_RW = 166 * MiB, WS_XB = 166 * MiB, WS_SCORES = 166 * MiB, WS_XB2 = 246 * MiB, WS_GSC = 158 * MiB, WS_AG = 222 * MiB;
constexpr size_t WS_BONUS = 278 * MiB, WS_Y = 279 * MiB;
constexpr size_t WS_END = 295 * MiB;
constexpr size_t RWSZ = 16 * MiB;

constexpr int LDS_BYTES = 155648;
constexpr int NTHREADS = 512;

struct Params { const float* in[28]; float* out; unsigned char* ws; };
typedef const __attribute__((address_space(4))) Params* KP;
__device__ __forceinline__ KP get_params() { KP k = (KP)__builtin_amdgcn_kernarg_segment_ptr(); asm volatile("" : "+s"(k)); return k; }
enum { I_X = 0, I_WIN, I_SINKS, I_MU, I_W0, I_WUP, I_A0, I_AUP, I_GUP, I_KK, I_KA, I_RK, I_GNG, I_GNB, I_FB, I_GB, I_WBR, I_WOUT, I_LNG, I_LNB,
       I_F1, I_F3, I_F2, I_RTW, I_RTB, I_E1, I_E3, I_E2 };

__device__ __forceinline__ float bflo(unsigned u) { return __uint_as_float(u << 16); }
__device__ __forceinline__ float bfhi(unsigned u) { return __uint_as_float(u & 0xffff0000u); }
__device__ __forceinline__ float bf2f(bf16_t b) { return __uint_as_float((unsigned)b << 16); }
__device__ __forceinline__ unsigned f2bf(float f) { unsigned u = __float_as_uint(f); return (u + 0x7fffu + ((u >> 16) & 1u)) >> 16; }
__device__ __forceinline__ unsigned pk2(float lo, float hi) { return f2bf(lo) | (f2bf(hi) << 16); }
__device__ __forceinline__ float wave_sum(float v) {
#pragma unroll
    for (int o = 1; o < 64; o <<= 1) v += __shfl_xor(v, o);
    return v;
}
__device__ __forceinline__ float wave_max(float v) {
#pragma unroll
    for (int o = 1; o < 64; o <<= 1) v = fmaxf(v, __shfl_xor(v, o));
    return v;
}
__device__ __forceinline__ float sigm(float x) { return 1.f / (1.f + __expf(-x)); }
#define LDS_FENCE() asm volatile("s_waitcnt lgkmcnt(0)" ::: "memory")
__device__ __forceinline__ int my_tid() { int t = threadIdx.x; asm volatile("" : "+v"(t)); return t; }
__device__ __forceinline__ void unpack8(const u32x4 v, float* f) {
    f[0] = bflo(v.x); f[1] = bfhi(v.x); f[2] = bflo(v.y); f[3] = bfhi(v.y); f[4] = bflo(v.z); f[5] = bfhi(v.z); f[6] = bflo(v.w); f[7] = bfhi(v.w);
}

namespace mg {
constexpr int BM = 256, BK = 64, HALF = 128, HTB = HALF * BK * 2, STAGE_BYTES = 8 * HTB;
__device__ __forceinline__ int lds_byte(int r, int c) { const int st = (r >> 4) * 2 + (c >> 5), rr = r & 15, cc = c & 31, ob = rr * 64 + cc * 2; return st * 1024 + (ob ^ (((ob >> 9) & 1) << 5)); }
__device__ __forceinline__ void stage_rc(int b, int& R, int& C) { const int st = b / 1024, sb = b % 1024, swz = sb ^ (((sb >> 9) & 1) << 5); R = (st >> 1) * 16 + swz / 64; C = (st & 1) * 32 + (swz % 64) / 2; }
__device__ __forceinline__ int perm32(int rho) { const int n = rho >> 4, i = rho & 15; return 8 * (i >> 2) + 4 * n + (i & 3); }

struct Unit { const char* A; const char* B; unsigned ld; int nt; int pm, pn, tag; };

__device__ __forceinline__ bool static_tile(int i, int G, int c, int nM, int nN, int& pm, int& pn) {
    const int nwg = nM * nN; const long L = (long)i * G + c; if (L >= nwg) return false;
    int wgid = (int)L; { const int q = nwg / 8, r = nwg % 8, xcd = wgid % 8, off = wgid / 8; wgid = (xcd < r ? xcd * (q + 1) : r * (q + 1) + (xcd - r) * q) + off; }
    const int nig = 8 * nN, gid = wgid / nig, fm = gid * 8, gsz = (nM - fm) < 8 ? (nM - fm) : 8;
    pm = fm + ((wgid % nig) % gsz); pn = (wgid % nig) / gsz; return true;
}

template <class Sched, class Epi>
__device__ __forceinline__ void gemm_run(LAS unsigned char* lds, const Sched& S, const Epi& E) {
    const int tid = my_tid(), wid = __builtin_amdgcn_readfirstlane(tid >> 6), lane = tid & 63, wr = wid >> 2, wc = wid & 3, fr = lane & 15, fq = lane >> 4;
    int R0, C0; stage_rc(tid * 16, R0, C0); const unsigned RA = (unsigned)R0, RB = (unsigned)(Sched::PERM ? ((R0 & ~31) + perm32(R0 & 31)) : R0), C02 = (unsigned)C0 * 2u;
    const unsigned ldsw = (unsigned)wid * 1024u;
    const int aoff = lds_byte(wr * 64 + fr, fq * 8), boff = lds_byte(wc * 32 + fr, fq * 8);
#define MG_SA(b, h) (((b) * 2 + (h)) * HTB)
#define MG_SB(b, h) ((4 + (b) * 2 + (h)) * HTB)
#define MG_STAGE(bufoff, gptr, v0, s64) do { \
        __builtin_amdgcn_global_load_lds((const unsigned*)((gptr) + (v0)), (LAS unsigned*)(lds + (bufoff) + ldsw), 16, 0, 0); \
        __builtin_amdgcn_global_load_lds((const unsigned*)((gptr) + (s64) + (v0)), (LAS unsigned*)(lds + (bufoff) + ldsw + 8192), 16, 0, 0); } while (0)
#define MG_LDA(dst, b, h) do { _Pragma("unroll") for (int m = 0; m < 4; ++m) _Pragma("unroll") for (int k = 0; k < 2; ++k) dst[m][k] = *(const LAS bf16x8*)(lds + MG_SA(b, h) + aoff + m * 2048 + k * 1024); } while (0)
#define MG_LDB(dst, b, h) do { _Pragma("unroll") for (int n = 0; n < 2; ++n) _Pragma("unroll") for (int k = 0; k < 2; ++k) dst[n][k] = *(const LAS bf16x8*)(lds + MG_SB(b, h) + boff + n * 2048 + k * 1024); } while (0)
#define MG_MMA(ai, bj, At, Bt) do { __builtin_amdgcn_s_setprio(1); _Pragma("unroll") for (int m = 0; m < 4; ++m) _Pragma("unroll") for (int n = 0; n < 2; ++n) _Pragma("unroll") for (int k = 0; k < 2; ++k) \
        acc[ai][bj][m][n] = __builtin_amdgcn_mfma_f32_16x16x32_bf16(Bt[n][k], At[m][k], acc[ai][bj][m][n], 0, 0, 0); __builtin_amdgcn_s_setprio(0); } while (0)
#define MG_WAIT_V(n) asm volatile("s_waitcnt vmcnt(" #n ")" ::: "memory")
#define MG_WAIT_L(n) asm volatile("s_waitcnt lgkmcnt(" #n ")" ::: "memory")
#define MG_BAR __builtin_amdgcn_s_barrier()
#define MG_SCHED __builtin_amdgcn_sched_barrier(0)
    Unit cur; int ui = 0;
    if (!S.next(0, cur)) return;
    f32x4 acc[2][2][4][2];
#pragma unroll
    for (int a = 0; a < 2; ++a)
#pragma unroll
        for (int b = 0; b < 2; ++b)
#pragma unroll
            for (int m = 0; m < 4; ++m)
#pragma unroll
                for (int n = 0; n < 2; ++n) acc[a][b][m][n] = (f32x4){0.f, 0.f, 0.f, 0.f};
    bf16x8 At[4][2], B0[2][2], B1[2][2];
    const size_t kstep = (size_t)(BK * 2);
    {
        const char* cA = cur.A; const char* cB = cur.B; const unsigned ld = cur.ld, vA = RA * ld + C02, vB = RB * ld + C02, s64 = 64u * ld, sh = 128u * ld;
        MG_STAGE(MG_SB(0, 0), cB, vB, s64); MG_STAGE(MG_SB(0, 1), cB + sh, vB, s64); MG_STAGE(MG_SA(0, 0), cA, vA, s64); MG_STAGE(MG_SA(0, 1), cA + sh, vA, s64);
        if (wr == 1) MG_BAR;
        MG_WAIT_V(2); MG_BAR;
        MG_STAGE(MG_SB(1, 0), cB + kstep, vB, s64); MG_STAGE(MG_SA(1, 0), cA + kstep, vA, s64); MG_STAGE(MG_SB(1, 1), cB + sh + kstep, vB, s64);
        MG_WAIT_V(6); MG_BAR;
    }
    for (;;) {
        const char* cA = cur.A; const char* cB = cur.B; const unsigned cld = cur.ld; const int nt = cur.nt;
        for (int t = 0; t < nt; t += 2) {
            const bool last = (t == nt - 2);
            const char* a1 = cA + (size_t)(t + 1) * kstep;
            const char* a2 = cA + (size_t)(t + 2) * kstep; const char* b2 = cB + (size_t)(t + 2) * kstep; unsigned xld = cld;
            if (last) { Unit n2; if (S.next(ui + 1, n2)) { a2 = n2.A; b2 = n2.B; xld = n2.ld; } else { a2 = cA; b2 = cB; } }
            const char* a3 = a2 + kstep; const char* b3 = b2 + kstep;
            const unsigned cvA = RA * cld + C02, c64 = 64u * cld, ch = 128u * cld;
            const unsigned xvA = RA * xld + C02, xvB = RB * xld + C02, x64 = 64u * xld, xh = 128u * xld;
            MG_LDB(B0, 0, 0); MG_LDB(B1, 0, 1); MG_SCHED; MG_LDA(At, 0, 0); MG_STAGE(MG_SA(1, 1), a1 + ch, cvA, c64);
            MG_WAIT_V(8); MG_WAIT_L(0); MG_BAR; MG_MMA(0, 0, At, B0); MG_MMA(0, 1, At, B1); MG_BAR; MG_SCHED;
            MG_LDA(At, 0, 1); MG_STAGE(MG_SB(0, 0), b2, xvB, x64); MG_STAGE(MG_SB(0, 1), b2 + xh, xvB, x64); MG_STAGE(MG_SA(0, 0), a2, xvA, x64);
            MG_WAIT_V(8); MG_WAIT_L(0); MG_BAR; MG_MMA(1, 0, At, B0); MG_MMA(1, 1, At, B1); MG_BAR; MG_SCHED;
            MG_LDB(B0, 1, 0); MG_LDB(B1, 1, 1); MG_SCHED; MG_LDA(At, 1, 0); MG_STAGE(MG_SA(0, 1), a2 + xh, xvA, x64);
            MG_WAIT_V(8); MG_WAIT_L(0); MG_BAR; MG_MMA(0, 0, At, B0); MG_MMA(0, 1, At, B1); MG_BAR; MG_SCHED;
            MG_LDA(At, 1, 1); MG_STAGE(MG_SB(1, 0), b3, xvB, x64); MG_STAGE(MG_SB(1, 1), b3 + xh, xvB, x64); MG_STAGE(MG_SA(1, 0), a3, xvA, x64);
            MG_WAIT_V(8); MG_WAIT_L(0); MG_BAR; MG_MMA(1, 0, At, B0); MG_MMA(1, 1, At, B1); MG_BAR; MG_SCHED;
        }
        if (wr == 0) MG_BAR;
        { int e_fr = fr, e_fq = fq, e_tid = tid; asm volatile("" : "+v"(e_fr), "+v"(e_fq), "+v"(e_tid));
          E(acc, cur, wr, wc, e_fr, e_fq, e_tid); }
        Unit nxt;
        if (!S.next(ui + 1, nxt)) break;
#pragma unroll
        for (int a = 0; a < 2; ++a)
#pragma unroll
            for (int b = 0; b < 2; ++b)
#pragma unroll
                for (int m = 0; m < 4; ++m)
#pragma unroll
                    for (int n = 0; n < 2; ++n) acc[a][b][m][n] = (f32x4){0.f, 0.f, 0.f, 0.f};
        cur = nxt; ++ui;
        if (wr == 1) MG_BAR;
    }
    MG_WAIT_V(0);
    MG_BAR;
#undef MG_SA
#undef MG_SB
#undef MG_STAGE
#undef MG_LDA
#undef MG_LDB
#undef MG_MMA
#undef MG_WAIT_V
#undef MG_WAIT_L
#undef MG_BAR
#undef MG_SCHED
}
}

typedef f32x4 AccT[2][2][4][2];

__device__ __forceinline__ int rowmap(int mode, int n) {
    if (mode == 0) return n;
    if (mode == 1) { if (n < 2560) return n; if (n < 2564) return 3264 + (n - 2560); if (n < 3268) return n - 4; if (n < 3272) return n; return n + 56; }
    if (mode == 2) return 256 * (n >> 7) + (n & 127);
    return 256 * (n >> 7) + 128 + (n & 127);
}
__device__ __forceinline__ void tr_item(const float* __restrict__ W, int K, int N, bf16_t* WT, int ldt, int mode, int row_off, LAS float* scr, int item, int lane) {
    const int nblk = (N + 31) / 32, kb = item / nblk, nb = item % nblk, k0 = 64 * kb, n0 = 32 * nb;
    const int nl = lane & 31, n = n0 + nl;
#pragma unroll 8
    for (int i = 0; i < 32; ++i) { const int kk = 2 * i + (lane >> 5); scr[kk * 33 + nl] = (n < N) ? W[(size_t)(k0 + kk) * N + n] : 0.f; }
    LDS_FENCE();
    const int c = lane & 7;
#pragma unroll
    for (int j = 0; j < 4; ++j) { const int n2l = (lane >> 3) + 8 * j, n2 = n0 + n2l; const LAS float* s = scr + (8 * c) * 33 + n2l;
        u32x4 o; o.x = pk2(s[0 * 33], s[1 * 33]); o.y = pk2(s[2 * 33], s[3 * 33]); o.z = pk2(s[4 * 33], s[5 * 33]); o.w = pk2(s[6 * 33], s[7 * 33]);
        if (n2 < N) *(u32x4*)(WT + (size_t)(row_off + rowmap(mode, n2)) * ldt + k0 + 8 * c) = o; }
    LDS_FENCE();
}
__device__ __forceinline__ int tr_nitems(int K, int N) { return (K / 64) * ((N + 31) / 32); }

__device__ __forceinline__ void row_to_bf16(const float* xrow, bf16_t* orow, int lane) {
    const f32x4* xr = (const f32x4*)xrow + lane; unsigned long long* o8 = (unsigned long long*)orow + lane;
#pragma unroll
    for (int j = 0; j < 4; ++j) { const f32x4 v = xr[64 * j]; o8[64 * j] = (unsigned long long)pk2(v.x, v.y) | ((unsigned long long)pk2(v.z, v.w) << 32); }
}

__device__ __forceinline__ void ph_conv_mixer(KP p, int l, LAS unsigned char* lds) {
    const int tid_ = my_tid(); const int lane = tid_ & 63, wave = tid_ >> 6, gw = blockIdx.x * 8 + wave, NGW = gridDim.x * 8;
    LAS float* scr = (LAS float*)(lds + wave * 8448);
    const float* win = p->in[I_WIN] + (size_t)l * D * D_IN; const float* wbr = p->in[I_WBR] + (size_t)l * OC * D; const float* wo = p->in[I_WOUT] + (size_t)l * D * D;
    bf16_t* WIN = (bf16_t*)(p->ws + WS_WIN); bf16_t* WB = (bf16_t*)(p->ws + WS_WB); bf16_t* WO = (bf16_t*)(p->ws + WS_WO);
    const int n1 = tr_nitems(D, D_IN), n2 = tr_nitems(OC, D), n3 = tr_nitems(D, D);
    for (int it = gw; it < n1 + n2 + n3; it += NGW) {
        int r = it;
        if (r < n1) { tr_item(win, D, D_IN, WIN, D, 1, 0, scr, r, lane); continue; } r -= n1;
        if (r < n2) { tr_item(wbr, OC, D, WB, OC, 0, 0, scr, r, lane); continue; } r -= n2;
        tr_item(wo, D, D, WO, D, 0, 0, scr, r, lane);
    }
    if (l == 0) { bf16_t* XB = (bf16_t*)(p->ws + WS_XB); for (int m = gw; m < T; m += NGW) row_to_bf16(p->in[I_X] + (size_t)m * D, XB + (size_t)m * D, lane); }
}

struct SchedInproj {
    static constexpr int PERM = 1;
    const char* A; const char* B; int G, c;
    __device__ __forceinline__ bool next(int i, mg::Unit& u) const {
        int pm, pn; if (!mg::static_tile(i, G, c, T / 256, NPM / 256, pm, pn)) return false;
        u.A = A + (size_t)pm * 256 * 2048; u.B = B + (size_t)pn * 256 * 2048; u.ld = 2048; u.nt = 16; u.pm = pm; u.pn = pn; u.tag = 0; return true;
    }
};
struct EpiBf16Store {
    bf16_t* O; int ldo;
    __device__ __forceinline__ void operator()(const AccT& acc, const mg::Unit& u, int wr, int wc, int fr, int fq, int) const {
        const int row0 = u.pm * 256 + wr * 64 + fr, col0 = u.pn * 256 + wc * 32 + 8 * fq;
#pragma unroll
        for (int ai = 0; ai < 2; ++ai)
#pragma unroll
            for (int m = 0; m < 4; ++m) { bf16_t* rowp = O + (size_t)(row0 + ai * 128 + m * 16) * ldo + col0;
#pragma unroll
                for (int bj = 0; bj < 2; ++bj) { const f32x4 v0 = acc[ai][bj][m][0], v1 = acc[ai][bj][m][1];
                    u32x4 w; w.x = pk2(v0[0], v0[1]); w.y = pk2(v0[2], v0[3]); w.z = pk2(v1[0], v1[1]); w.w = pk2(v1[2], v1[3]);
                    *(u32x4*)(rowp + bj * 128) = w; } }
    }
};
__device__ __forceinline__ void ph_inproj(KP p, int l, LAS unsigned char* lds) {
    SchedInproj S{(const char*)(p->ws + WS_XB), (const char*)(p->ws + WS_WIN), (int)gridDim.x, (int)blockIdx.x};
    EpiBf16Store E{(bf16_t*)(p->ws + WS_PMIX), NPM};
    mg::gemm_run(lds, S, E);
}

__device__ __forceinline__ void ph_prep(KP p, int l, LAS unsigned char* lds) {
    const int tid = my_tid(), lane = tid & 63, wave = tid >> 6;
    const bf16_t* P = (const bf16_t*)(p->ws + WS_PMIX);
    if (blockIdx.x < 8 && wave < 4) {
        const int b = blockIdx.x, h = wave; const float fb = p->in[I_FB][l * 4 + h];
        float v[32]; float s = 0.f;
#pragma unroll
        for (int i = 0; i < 32; ++i) { const int t = 32 * lane + i; const float x = bf2f(P[(size_t)(b * SEQ + t) * NPM + C_FLOG + h]) + fb;
            const float ls = fminf(x, 0.f) - log1pf(__expf(-fabsf(x))); s += ls; v[i] = s; }
        float incl = s;
#pragma unroll
        for (int o = 1; o < 64; o <<= 1) { const float n = __shfl_up(incl, o); if (lane >= o) incl += n; }
        const float excl = incl - s; float* C = (float*)(p->ws + WS_FOXC) + (size_t)(b * 4 + h) * SEQ + 32 * lane;
#pragma unroll
        for (int i = 0; i < 32; ++i) C[i] = v[i] + excl;
    }
    LAS float* ps = (LAS float*)lds;
    const float* mu = p->in[I_MU] + l * 1024; const float* w0 = p->in[I_W0] + l * 256; const float* wup = p->in[I_WUP] + (size_t)l * 64 * 256;
    const float* a0 = p->in[I_A0] + l * 256; const float* aup = p->in[I_AUP] + (size_t)l * 64 * 256; const float* gup = p->in[I_GUP] + (size_t)l * 128 * 256;
    const float* kkw = p->in[I_KK] + l * 256; const float* kaw = p->in[I_KA] + l * 256; const float* rk = p->in[I_RK] + l * 256;
    float* RWr = (float*)(p->ws + WS_RW); float* RWw = RWr + (size_t)T * 256; float* RWk = RWw + (size_t)T * 256; float* RWkk = RWk + (size_t)T * 256;
    float* RWkka = RWkk + (size_t)T * 256; float* RWv = RWkka + (size_t)T * 256; float* RWg = RWv + (size_t)T * 256; float* BON = (float*)(p->ws + WS_BONUS);
    for (int it = blockIdx.x; it < T / 16; it += gridDim.x) {
        const int t0 = it * 16;
#pragma unroll
        for (int c4 = 0; c4 < 4; ++c4) { const int id = tid + 512 * c4, tt = id >> 7, ch = (id & 127) * 8, t = t0 + tt;
            const u32x4 cu = *(const u32x4*)(P + (size_t)t * NPM + C_RW + ch);
            u32x4 pv = (u32x4){0u, 0u, 0u, 0u}; if ((t & (SEQ - 1)) != 0) pv = *(const u32x4*)(P + (size_t)(t - 1) * NPM + C_RW + ch);
            float a[8], b[8]; unpack8(cu, a); unpack8(pv, b);
            const f32x4 m0 = *(const f32x4*)(mu + ch), m1 = *(const f32x4*)(mu + ch + 4); const float mm[8] = {m0.x, m0.y, m0.z, m0.w, m1.x, m1.y, m1.z, m1.w};
#pragma unroll
            for (int j = 0; j < 8; ++j) { float x = a[j] + mm[j] * (b[j] - a[j]); if (ch >= 768 && ch < 832) x = tanhf(x); else if (ch >= 896) x = sigm(x); a[j] = x; }
            *(LAS f32x4*)(ps + tt * 1024 + ch) = (f32x4){a[0], a[1], a[2], a[3]}; *(LAS f32x4*)(ps + tt * 1024 + ch + 4) = (f32x4){a[4], a[5], a[6], a[7]}; }
        __syncthreads();
        const int c = tid & 255, half = tid >> 8; const LAS float* pt = ps + (8 * half) * 1024;
        float aw[8], aa[8], ag[8];
#pragma unroll
        for (int i = 0; i < 8; ++i) { aw[i] = 0.f; aa[i] = 0.f; ag[i] = 0.f; }
        for (int j = 0; j < 64; ++j) { const float wu = wup[j * 256 + c], au = aup[j * 256 + c];
#pragma unroll
            for (int i = 0; i < 8; ++i) { aw[i] += pt[i * 1024 + 768 + j] * wu; aa[i] += pt[i * 1024 + 832 + j] * au; } }
        for (int j = 0; j < 128; ++j) { const float gu = gup[j * 256 + c];
#pragma unroll
            for (int i = 0; i < 8; ++i) ag[i] += pt[i * 1024 + 896 + j] * gu; }
        const float w0c = w0[c], a0c = a0[c], kkc = kkw[c], kac = kaw[c], rkc = rk[c];
#pragma unroll
        for (int i = 0; i < 8; ++i) { const int t = t0 + 8 * half + i; const size_t o = (size_t)t * 256 + c;
            const float r = pt[i * 1024 + c], k = pt[i * 1024 + 256 + c], v = pt[i * 1024 + 512 + c];
            const float w = __expf(-sigm(w0c + aw[i]) * 0.60653065971f), a = sigm(a0c + aa[i]);
            float kk = k * kkc; const float ss = wave_sum(kk * kk); kk *= rsqrtf(ss + 1e-12f);
            const float k2 = k * (1.f + (a - 1.f) * kac); const float bon = wave_sum(r * k2 * rkc);
            RWr[o] = r; RWw[o] = w; RWk[o] = k2; RWv[o] = v; RWkk[o] = kk; RWkka[o] = kk * a; RWg[o] = ag[i];
            if (lane == 0) BON[t * 4 + (c >> 6)] = bon; }
        __syncthreads();
    }
}

typedef float f32x16 __attribute__((ext_vector_type(16)));
constexpr int KT_PITCH = 144, VT_PITCH = 136;
constexpr int AT_K_BYTES = 64 * KT_PITCH, AT_V_BYTES = 64 * VT_PITCH, AT_TILE_BYTES = AT_K_BYTES + AT_V_BYTES + 256;
constexpr float LOG2E = 1.4426950408889634f;
constexpr float NEGBIG = -1e30f;
__device__ __forceinline__ int crow(int reg, int h) { return (reg & 3) + 8 * (reg >> 2) + 4 * h; }

__device__ __forceinline__ void at_stage(LAS unsigned char* tile, const bf16_t* Krows, const bf16_t* Vrows, int tid) {
    { const int row = tid >> 3, ch = tid & 7; const u32x4 v = *(const u32x4*)(Krows + (size_t)row * NPM + 8 * ch); *(LAS u32x4*)(tile + row * KT_PITCH + ch * 16) = v; }
    { const int kv = tid & 63, dch = tid >> 6; const u32x4 v = *(const u32x4*)(Vrows + (size_t)kv * NPM + 8 * dch);
      LAS bf16_t* vt = (LAS bf16_t*)(tile + AT_K_BYTES + (8 * dch) * VT_PITCH) + kv; constexpr int P2 = VT_PITCH / 2;
      vt[0 * P2] = (bf16_t)(v.x & 0xffffu); vt[1 * P2] = (bf16_t)(v.x >> 16); vt[2 * P2] = (bf16_t)(v.y & 0xffffu); vt[3 * P2] = (bf16_t)(v.y >> 16);
      vt[4 * P2] = (bf16_t)(v.z & 0xffffu); vt[5 * P2] = (bf16_t)(v.z >> 16); vt[6 * P2] = (bf16_t)(v.w & 0xffffu); vt[7 * P2] = (bf16_t)(v.w >> 16); }
}
__device__ __forceinline__ void at_qk(f32x16& p0, f32x16& p1, const LAS unsigned char* Kt, const bf16x8 (&qr)[4], int r, int h) {
#pragma unroll
    for (int i = 0; i < 16; ++i) { p0[i] = 0.f; p1[i] = 0.f; }
#pragma unroll
    for (int ds = 0; ds < 4; ++ds) {
        const bf16x8 a0 = *(const LAS bf16x8*)(Kt + r * KT_PITCH + (16 * ds + 8 * h) * 2);
        const bf16x8 a1 = *(const LAS bf16x8*)(Kt + (32 + r) * KT_PITCH + (16 * ds + 8 * h) * 2);
        p0 = __builtin_amdgcn_mfma_f32_32x32x16_bf16(a0, qr[ds], p0, 0, 0, 0);
        p1 = __builtin_amdgcn_mfma_f32_32x32x16_bf16(a1, qr[ds], p1, 0, 0, 0);
    }
}
__device__ __forceinline__ void at_pv(f32x16 (&o)[2], const LAS unsigned char* Vt, const bf16x8 (&pk)[4], int r, int h) {
#pragma unroll
    for (int dh = 0; dh < 2; ++dh)
#pragma unroll
        for (int ks = 0; ks < 4; ++ks) { const LAS unsigned char* bp = Vt + (32 * dh + r) * VT_PITCH + (16 * ks + 4 * h) * 2;
            const u32x2 lo = *(const LAS u32x2*)bp, hi = *(const LAS u32x2*)(bp + 16);
            const u32x4 av = (u32x4){lo.x, lo.y, hi.x, hi.y};
            o[dh] = __builtin_amdgcn_mfma_f32_32x32x16_bf16(__builtin_bit_cast(bf16x8, av), pk[ks], o[dh], 0, 0, 0); }
}
template <bool BIAS, bool MASK>
__device__ __forceinline__ void at_softmax(f32x16& p0, f32x16& p1, float& m, float& l, f32x16 (&o)[2], bf16x8 (&pk)[4], float sc2, const LAS float* bias2, int kmax, int h) {
    float mt = NEGBIG;
#pragma unroll
    for (int g = 0; g < 4; ++g) {
        f32x4 b0 = (f32x4){0.f, 0.f, 0.f, 0.f}, b1 = b0;
        if (BIAS) { b0 = *(const LAS f32x4*)(bias2 + 8 * g + 4 * h); b1 = *(const LAS f32x4*)(bias2 + 32 + 8 * g + 4 * h); }
#pragma unroll
        for (int j = 0; j < 4; ++j) { const int reg = 4 * g + j, kv = 8 * g + 4 * h + j;
            float x0 = p0[reg] * sc2 + b0[j], x1 = p1[reg] * sc2 + b1[j];
            if (MASK) { if (kv > kmax) x0 = NEGBIG; if (kv + 32 > kmax) x1 = NEGBIG; }
            p0[reg] = x0; p1[reg] = x1; mt = fmaxf(mt, fmaxf(x0, x1)); }
    }
    mt = fmaxf(mt, __shfl_xor(mt, 32));
    const float mn = fmaxf(m, mt);
    if (__any(mn > m)) { const float al = __builtin_amdgcn_exp2f(m - mn); l *= al;
#pragma unroll
        for (int i = 0; i < 16; ++i) { o[0][i] *= al; o[1][i] *= al; }
        m = mn; }
    float s = 0.f;
#pragma unroll
    for (int i = 0; i < 16; ++i) { const float e0 = (p0[i] > -1e29f) ? __builtin_amdgcn_exp2f(p0[i] - m) : 0.f, e1 = (p1[i] > -1e29f) ? __builtin_amdgcn_exp2f(p1[i] - m) : 0.f; p0[i] = e0; p1[i] = e1; s += e0 + e1; }
    l += s;
#pragma unroll
    for (int ks = 0; ks < 2; ++ks) { u32x4 w0, w1;
        w0.x = pk2(p0[8 * ks + 0], p0[8 * ks + 1]); w0.y = pk2(p0[8 * ks + 2], p0[8 * ks + 3]); w0.z = pk2(p0[8 * ks + 4], p0[8 * ks + 5]); w0.w = pk2(p0[8 * ks + 6], p0[8 * ks + 7]);
        w1.x = pk2(p1[8 * ks + 0], p1[8 * ks + 1]); w1.y = pk2(p1[8 * ks + 2], p1[8 * ks + 3]); w1.z = pk2(p1[8 * ks + 4], p1[8 * ks + 5]); w1.w = pk2(p1[8 * ks + 6], p1[8 * ks + 7]);
        pk[ks] = __builtin_bit_cast(bf16x8, w0); pk[2 + ks] = __builtin_bit_cast(bf16x8, w1); }
}
__device__ __forceinline__ void at_loadq(bf16x8 (&qr)[4], const bf16_t* qrow, int h) {
#pragma unroll
    for (int ds = 0; ds < 4; ++ds) qr[ds] = *(const bf16x8*)(qrow + 16 * ds + 8 * h);
}
__device__ __forceinline__ void at_store(bf16_t* orow, const f32x16 (&o)[2], float inv, int h) {
#pragma unroll
    for (int dh = 0; dh < 2; ++dh)
#pragma unroll
        for (int g = 0; g < 4; ++g) { u32x2 w; w.x = pk2(o[dh][4 * g] * inv, o[dh][4 * g + 1] * inv); w.y = pk2(o[dh][4 * g + 2] * inv, o[dh][4 * g + 3] * inv);
            *(u32x2*)(orow + 32 * dh + 8 * g + 4 * h) = w; }
}

__device__ __forceinline__ void fox_unit(KP p, int bh, int qb, LAS unsigned char* lds) {
    const int tid = my_tid(), lane = tid & 63, wave = tid >> 6, r = lane & 31, h = lane >> 5, wv = wave & 3, g = wave >> 2;
    const int b = bh >> 2, hd = bh & 3;
    const bf16_t* P = (const bf16_t*)(p->ws + WS_PMIX) + (size_t)b * SEQ * NPM; bf16_t* OCT = (bf16_t*)(p->ws + WS_OCAT); const float* FC = (const float*)(p->ws + WS_FOXC) + (size_t)bh * SEQ;
    const int q0 = 128 * qb, qbase = q0 + 32 * wv; const float cref = FC[q0];
    bf16x8 qr[4]; at_loadq(qr, P + (size_t)(qbase + r) * NPM + C_FOX_Q + hd * 64, h);
    f32x16 o[2]; float m = NEGBIG, l = 0.f;
#pragma unroll
    for (int i = 0; i < 16; ++i) { o[0][i] = 0.f; o[1][i] = 0.f; }
#pragma unroll 1
    for (int st = 0; st <= qb; ++st) {
        __syncthreads();
#pragma unroll
        for (int x = 0; x < 2; ++x) { const int k0 = 64 * (2 * st + x); LAS unsigned char* tile = lds + x * AT_TILE_BYTES;
            at_stage(tile, P + (size_t)k0 * NPM + C_FOX_K + hd * 64, P + (size_t)k0 * NPM + C_FOX_V + hd * 64, tid);
            if (tid < 64) ((LAS float*)(tile + AT_K_BYTES + AT_V_BYTES))[tid] = (cref - FC[k0 + tid]) * LOG2E; }
        __syncthreads();
        const int k0 = 64 * (2 * st + g); const LAS unsigned char* tile = lds + g * AT_TILE_BYTES;
        if (k0 <= qbase + 31) {
            f32x16 p0, p1; bf16x8 pk[4];
            at_qk(p0, p1, tile, qr, r, h);
            const LAS float* b2 = (const LAS float*)(tile + AT_K_BYTES + AT_V_BYTES);
            if (k0 + 63 > qbase) at_softmax<true, true>(p0, p1, m, l, o, pk, 0.125f * LOG2E, b2, qbase + r - k0, h);
            else at_softmax<true, false>(p0, p1, m, l, o, pk, 0.125f * LOG2E, b2, 0, h);
            at_pv(o, tile + AT_K_BYTES, pk, r, h);
        }
    }
    __syncthreads();
    LAS float* cb = (LAS float*)lds + (size_t)wv * (34 * 64);
    if (g == 1) { cb[lane] = m; cb[64 + lane] = l;
#pragma unroll
        for (int i = 0; i < 16; ++i) { cb[(2 + i) * 64 + lane] = o[0][i]; cb[(18 + i) * 64 + lane] = o[1][i]; } }
    __syncthreads();
    if (g == 0) { const float mb = cb[lane], lb = cb[64 + lane]; const float M = fmaxf(m, mb), sa = __builtin_amdgcn_exp2f(m - M), sb = __builtin_amdgcn_exp2f(mb - M);
        l = l * sa + lb * sb;
#pragma unroll
        for (int i = 0; i < 16; ++i) { o[0][i] = o[0][i] * sa + cb[(2 + i) * 64 + lane] * sb; o[1][i] = o[1][i] * sa + cb[(18 + i) * 64 + lane] * sb; }
        const float lt = l + __shfl_xor(l, 32);
        at_store(OCT + (size_t)(b * SEQ + qbase + r) * OC + 768 + hd * 64, o, 1.f / lt, h); }
}
__device__ __forceinline__ void swa_unit(KP p, int l_, int item, LAS unsigned char* lds) {
    const int tid = my_tid(), lane = tid & 63, wave = tid >> 6, r = lane & 31, h = lane >> 5;
    const int hk = item & 1, c = (item >> 1) & 31, b = item >> 6, head = hk * 4 + (wave >> 1), qpos = c * 64 + 32 * (wave & 1);
    const bf16_t* P = (const bf16_t*)(p->ws + WS_PMIX) + (size_t)b * SEQ * NPM; bf16_t* OCT = (bf16_t*)(p->ws + WS_OCAT);
    bf16x8 qr[4]; at_loadq(qr, P + (size_t)(qpos + r) * NPM + C_SWA_Q + head * 64, h);
    f32x16 o[2]; float m = p->in[I_SINKS][l_ * 8 + head] * LOG2E, l = (h == 0) ? 1.f : 0.f;
#pragma unroll
    for (int i = 0; i < 16; ++i) { o[0][i] = 0.f; o[1][i] = 0.f; }
    const int nch = (c + 1 < 3) ? (c + 1) : 3;
#pragma unroll 1
    for (int st = 0; st < nch; ++st) {
        const int k0 = 64 * (c - nch + 1 + st);
        __syncthreads();
        at_stage(lds, P + (size_t)k0 * NPM + C_SWA_K + hk * 64, P + (size_t)k0 * NPM + C_SWA_V + hk * 64, tid);
        __syncthreads();
        f32x16 p0, p1; bf16x8 pk[4];
        at_qk(p0, p1, lds, qr, r, h);
        at_softmax<false, false>(p0, p1, m, l, o, pk, 0.125f * LOG2E, nullptr, 0, h);
        at_pv(o, lds + AT_K_BYTES, pk, r, h);
    }
    const float lt = l + __shfl_xor(l, 32);
    at_store(OCT + (size_t)(b * SEQ + qpos + r) * OC + head * 64, o, 1.f / lt, h);
}

__device__ __forceinline__ size_t dsa_chunk_off(int b, int c) { return (size_t)b * (4096 * 528) + (size_t)4096 * (c * (c + 1) / 2); }
__device__ __forceinline__ void dsa_scores(KP p, LAS unsigned char* lds) {
    const int tid = my_tid(), lane = tid & 63, wave = tid >> 6, r = lane & 31, h = lane >> 5;
    const bf16_t* Pm = (const bf16_t*)(p->ws + WS_PMIX); float* SCR = (float*)(p->ws + WS_SCORES);
    LAS float* tb = (LAS float*)(lds + wave * (32 * 36 * 4));
    const int gw = blockIdx.x * 8 + wave, NGW = gridDim.x * 8;
    constexpr int PERB = 1036;
    for (int it = gw; it < NB * PERB; it += NGW) {
        const int b = it / PERB; int rem = it % PERB; const int qh = rem & 1; rem >>= 1;
        int c = 4; { int acc = 0; while (rem >= acc + c + 1) { acc += c + 1; ++c; } rem -= acc; } const int kb = rem;
        const bf16_t* Pb = Pm + (size_t)b * SEQ * NPM; const int qbase = c * 64 + 32 * qh;
        const bf16_t* qrow = Pb + (size_t)(qbase + r) * NPM;
        float wq[4];
#pragma unroll
        for (int hh = 0; hh < 4; ++hh) wq[hh] = bf2f(qrow[C_WIDX + hh]) * 0.0625f;
        float* dst = SCR + dsa_chunk_off(b, c) + (size_t)(32 * qh) * (64 * (c + 1)) + 64 * kb;
#pragma unroll 1
        for (int kh = 0; kh < 2; ++kh) {
            const bf16_t* krow = Pb + (size_t)(64 * kb + 32 * kh + r) * NPM + C_DSA_KI;
            bf16x8 kf[4];
#pragma unroll
            for (int ds = 0; ds < 4; ++ds) kf[ds] = *(const bf16x8*)(krow + 16 * ds + 8 * h);
            f32x16 sc;
#pragma unroll
            for (int i = 0; i < 16; ++i) sc[i] = 0.f;
#pragma unroll
            for (int hh = 0; hh < 4; ++hh) { f32x16 a;
#pragma unroll
                for (int i = 0; i < 16; ++i) a[i] = 0.f;
#pragma unroll
                for (int ds = 0; ds < 4; ++ds) { const bf16x8 qf = *(const bf16x8*)(qrow + C_DSA_QI + hh * 64 + 16 * ds + 8 * h); a = __builtin_amdgcn_mfma_f32_32x32x16_bf16(kf[ds], qf, a, 0, 0, 0); }
#pragma unroll
                for (int i = 0; i < 16; ++i) sc[i] += fmaxf(a[i], 0.f) * wq[hh]; }
#pragma unroll
            for (int g = 0; g < 4; ++g) *(LAS f32x4*)(tb + r * 36 + 8 * g + 4 * h) = (f32x4){sc[4 * g] + 0.f, sc[4 * g + 1] + 0.f, sc[4 * g + 2] + 0.f, sc[4 * g + 3] + 0.f};
            LDS_FENCE();
#pragma unroll
            for (int i = 0; i < 4; ++i) { const int q = 8 * i + (lane >> 3), cc = (lane & 7) * 4; const f32x4 v = *(const LAS f32x4*)(tb + q * 36 + cc);
                *(f32x4*)(dst + (size_t)q * (64 * (c + 1)) + 32 * kh + cc) = v; }
            LDS_FENCE();
        }
    }
}
__device__ __forceinline__ unsigned fkey(float f) { const unsigned u = __float_as_uint(f); return (u & 0x80000000u) ? ~u : (u | 0x80000000u); }
__device__ __forceinline__ void dsa_item(KP p, int l, int item, LAS unsigned char* lds) {
    const int tid = my_tid(), lane0 = tid & 63, wave = tid >> 6; const int chunk = 31 - (item & 31), b = item >> 5;
    const bf16_t* P = (const bf16_t*)(p->ws + WS_PMIX); bf16_t* OCT = (bf16_t*)(p->ws + WS_OCAT);
    LAS float* QA = (LAS float*)(lds + wave * 8192); LAS int* LIST = (LAS int*)(QA + 256); LAS float* PR = QA + 512;
    LAS unsigned* KEY = (LAS unsigned*)(lds + 65536 + wave * 8192);
    const int nadm = 64 * (chunk + 1), nit = chunk + 1;
    const bf16_t* Pb = P + (size_t)b * SEQ * NPM;
    const float* SCRc = (const float*)(p->ws + WS_SCORES) + dsa_chunk_off(b, chunk);
#pragma unroll 1
    for (int qq = 0; qq < 8; ++qq) {
        int lane = lane0; asm volatile("" : "+v"(lane));
        const int ql = wave + 8 * qq, tpos = chunk * 64 + ql; const bf16_t* qrow = Pb + (size_t)tpos * NPM;
        { const u32x2 c = *(const u32x2*)(qrow + C_DSA_Q + 4 * lane); *(LAS f32x4*)(QA + 4 * lane) = (f32x4){bflo(c.x) * 0.125f, bfhi(c.x) * 0.125f, bflo(c.y) * 0.125f, bfhi(c.y) * 0.125f}; }
        int nsel;
        if (nadm <= 256) { nsel = nadm;
#pragma unroll 1
            for (int rr = 0; rr < 4; ++rr) if (lane + 64 * rr < nadm) LIST[lane + 64 * rr] = lane + 64 * rr;
        } else {
            const float* srow = SCRc + (size_t)ql * nadm;
#pragma unroll 4
            for (int i = 0; i < nit; ++i) KEY[64 * i + lane] = fkey(srow[64 * i + lane]);
            LDS_FENCE();
            unsigned Tk = 0u;
#pragma unroll 1
            for (int bit = 31; bit >= 0; --bit) { const unsigned cand = Tk | (1u << bit); int cl = 0;
#pragma unroll 4
                for (int i = 0; i < nit; ++i) cl += (KEY[64 * i + lane] >= cand) ? 1 : 0;
                const int cnt = (int)wave_sum((float)cl);
                if (cnt >= 256) Tk = cand; }
            int cgl = 0;
#pragma unroll 4
            for (int i = 0; i < nit; ++i) cgl += (KEY[64 * i + lane] > Tk) ? 1 : 0;
            const int cgt = (int)wave_sum((float)cgl);
            int quota = 256 - cgt, pos = 0; const unsigned long long ltm = (1ull << lane) - 1ull;
#pragma unroll 1
            for (int i = 0; i < nit; ++i) { const unsigned kq = KEY[64 * i + lane]; const unsigned long long tm = __ballot(kq == Tk); const int tbc = __builtin_popcountll(tm & ltm);
                const bool sel = (kq > Tk) || ((kq == Tk) && tbc < quota);
                const unsigned long long sm = __ballot(sel); if (sel) LIST[pos + __builtin_popcountll(sm & ltm)] = 64 * i + lane;
                pos += __builtin_popcountll(sm); quota -= __builtin_popcountll(tm); if (quota < 0) quota = 0; }
            nsel = pos;
        }
        LDS_FENCE();
        float mx0 = -INFINITY, mx1 = -INFINITY, mx2 = -INFINITY, mx3 = -INFINITY;
#pragma unroll 1
        for (int rr = 0; rr < 4; ++rr) { const int e = lane + 64 * rr; const bool ok = e < nsel; const int kv = ok ? LIST[e] : 0; const bf16_t* kr = Pb + (size_t)kv * NPM + C_DSA_K;
            float a0 = 0.f, a1 = 0.f, a2 = 0.f, a3 = 0.f;
#pragma unroll 2
            for (int c = 0; c < 8; ++c) { float f[8]; unpack8(*(const u32x4*)(kr + 8 * c), f);
#pragma unroll
                for (int hh = 0; hh < 4; ++hh) { const f32x4 qa = *(const LAS f32x4*)(QA + hh * 64 + 8 * c), qb2 = *(const LAS f32x4*)(QA + hh * 64 + 8 * c + 4);
                    const float d = f[0] * qa.x + f[1] * qa.y + f[2] * qa.z + f[3] * qa.w + f[4] * qb2.x + f[5] * qb2.y + f[6] * qb2.z + f[7] * qb2.w;
                    if (hh == 0) a0 += d; else if (hh == 1) a1 += d; else if (hh == 2) a2 += d; else a3 += d; } }
            if (ok) { *(LAS f32x4*)(PR + 4 * e) = (f32x4){a0, a1, a2, a3}; mx0 = fmaxf(mx0, a0); mx1 = fmaxf(mx1, a1); mx2 = fmaxf(mx2, a2); mx3 = fmaxf(mx3, a3); }
            asm volatile("" ::: "memory"); }
        mx0 = wave_max(mx0); mx1 = wave_max(mx1); mx2 = wave_max(mx2); mx3 = wave_max(mx3);
        float ls0 = 0.f, ls1 = 0.f, ls2 = 0.f, ls3 = 0.f;
#pragma unroll 1
        for (int rr = 0; rr < 4; ++rr) { const int e = lane + 64 * rr;
            if (e < nsel) { f32x4 pe = *(const LAS f32x4*)(PR + 4 * e); pe.x = __expf(pe.x - mx0); pe.y = __expf(pe.y - mx1); pe.z = __expf(pe.z - mx2); pe.w = __expf(pe.w - mx3);
                ls0 += pe.x; ls1 += pe.y; ls2 += pe.z; ls3 += pe.w; *(LAS f32x4*)(PR + 4 * e) = pe; } }
        ls0 = wave_sum(ls0); ls1 = wave_sum(ls1); ls2 = wave_sum(ls2); ls3 = wave_sum(ls3);
        LDS_FENCE();
        float o0 = 0.f, o1 = 0.f, o2 = 0.f, o3 = 0.f;
#pragma unroll 1
        for (int e = 0; e < nsel; e += 4) {
#pragma unroll
            for (int u = 0; u < 4; ++u) { const int kv = LIST[e + u]; const f32x4 pe = *(const LAS f32x4*)(PR + 4 * (e + u));
                const float v = bf2f(Pb[(size_t)kv * NPM + C_DSA_V + lane]);
                o0 += pe.x * v; o1 += pe.y * v; o2 += pe.z * v; o3 += pe.w * v; } }
        bf16_t* dst = OCT + (size_t)(b * SEQ + tpos) * OC + 1024 + lane;
        dst[0] = (bf16_t)f2bf(o0 / ls0); dst[64] = (bf16_t)f2bf(o1 / ls1); dst[128] = (bf16_t)f2bf(o2 / ls2); dst[192] = (bf16_t)f2bf(o3 / ls3);
        LDS_FENCE();
    }
}

template <int CTRL, int ROWM, int BANKM> __device__ __forceinline__ float dpp_add(float acc, float src) {
    return acc + __int_as_float(__builtin_amdgcn_update_dpp(0, __float_as_int(src), CTRL, ROWM, BANKM, true));
}
__device__ __forceinline__ float wave_sum_s(float v) {
    float a = v;
    a = dpp_add<0x111, 0xf, 0xf>(a, v); a = dpp_add<0x112, 0xf, 0xf>(a, v); a = dpp_add<0x113, 0xf, 0xf>(a, v);
    a = dpp_add<0x114, 0xf, 0xe>(a, a); a = dpp_add<0x118, 0xf, 0xc>(a, a);
    a = dpp_add<0x142, 0xa, 0xf>(a, a); a = dpp_add<0x143, 0xc, 0xf>(a, a);
    return __int_as_float(__builtin_amdgcn_readlane(__float_as_int(a), 63));
}
__device__ __forceinline__ void rwkv_scan2(KP p, int l, LAS unsigned char* lds) {
    const int tid = my_tid(), lane = tid & 63, wave = tid >> 6; const int bh = blockIdx.x >> 3, b = bh >> 2, h = bh & 3, row = 8 * (blockIdx.x & 7) + wave;
    const float* RW = (const float*)(p->ws + WS_RW);
    const float* RWv = RW + (size_t)5 * T * 256; float* Y = (float*)(p->ws + WS_Y);
    LAS float* L = (LAS float*)lds;
    float S = 0.f;
    const size_t hb = (size_t)b * SEQ * 256 + h * 64;
    f32x2 pre[5];
#pragma unroll
    for (int a = 0; a < 5; ++a) { const int e = 2 * tid; pre[a] = *(const f32x2*)(RW + (size_t)a * T * 256 + hb + (size_t)(e >> 6) * 256 + (e & 63)); }
    float vnext = (lane < 16) ? RWv[hb + (size_t)lane * 256 + row] : 0.f;
#pragma unroll 1
    for (int tb = 0; tb < SEQ; tb += 16) {
        __syncthreads();
#pragma unroll
        for (int a = 0; a < 5; ++a) *(LAS f32x2*)(L + a * 1024 + 2 * tid) = pre[a];
        const float vcur = vnext;
        __syncthreads();
        if (tb + 16 < SEQ) {
#pragma unroll
            for (int a = 0; a < 5; ++a) { const int e = 2 * tid; pre[a] = *(const f32x2*)(RW + (size_t)a * T * 256 + hb + (size_t)(tb + 16 + (e >> 6)) * 256 + (e & 63)); }
            vnext = (lane < 16) ? RWv[hb + (size_t)(tb + 16 + lane) * 256 + row] : 0.f;
        }
        float yv = 0.f;
#pragma unroll
        for (int i = 0; i < 16; ++i) {
            const float r_ = L[0 * 1024 + i * 64 + lane], w_ = L[1 * 1024 + i * 64 + lane], k_ = L[2 * 1024 + i * 64 + lane], kk_ = L[3 * 1024 + i * 64 + lane], ka_ = L[4 * 1024 + i * 64 + lane];
            const float sa = -wave_sum_s(S * kk_);
            const float v_ = __int_as_float(__builtin_amdgcn_readlane(__float_as_int(vcur), i));
            S = S * w_ + sa * ka_ + v_ * k_;
            const float y = wave_sum_s(S * r_);
            yv = (lane == i) ? y : yv;
        }
        if (lane < 16) Y[hb + (size_t)(tb + lane) * 256 + row] = yv;
    }
}
__device__ __forceinline__ void rwkv_post(KP p, int l) {
    const int tid = my_tid(), lane = tid & 63, wave = tid >> 6, gw = blockIdx.x * 8 + wave, NGW = gridDim.x * 8;
    const float* RW = (const float*)(p->ws + WS_RW); const float* RWv = RW + (size_t)5 * T * 256; const float* RWg = RW + (size_t)6 * T * 256;
    const float* Y = (const float*)(p->ws + WS_Y); const float* BON = (const float*)(p->ws + WS_BONUS); bf16_t* OCT = (bf16_t*)(p->ws + WS_OCAT);
    float gng[4], gnb[4];
#pragma unroll
    for (int hh = 0; hh < 4; ++hh) { gng[hh] = p->in[I_GNG][l * 256 + hh * 64 + lane]; gnb[hh] = p->in[I_GNB][l * 256 + hh * 64 + lane]; }
    for (int t = gw; t < T; t += NGW) {
#pragma unroll
        for (int hh = 0; hh < 4; ++hh) { const size_t o = (size_t)t * 256 + hh * 64 + lane; const float yy = Y[o];
            const float mean = wave_sum(yy) * (1.f / 64.f); const float d = yy - mean; const float var = wave_sum(d * d) * (1.f / 64.f);
            const float ov = (d * rsqrtf(var + 64e-5f) * gng[hh] + gnb[hh] + BON[t * 4 + hh] * RWv[o]) * RWg[o];
            OCT[(size_t)t * OC + 512 + hh * 64 + lane] = (bf16_t)f2bf(ov); }
    }
}

__device__ __forceinline__ void ph_scan(KP p, int l, LAS unsigned char* lds) { rwkv_scan2(p, l, lds); }
__device__ __forceinline__ void ph_attn(KP p, int l, LAS unsigned char* lds) {
    {
        const int w = blockIdx.x, bh = w >> 3, s = w & 7;
        fox_unit(p, bh, 15 - s, lds);
        __syncthreads();
        fox_unit(p, bh, s, lds);
        __syncthreads();
    }
    for (int it = blockIdx.x; it < 512; it += gridDim.x) { swa_unit(p, l, it, lds); __syncthreads(); }
    dsa_scores(p, lds);
    rwkv_post(p, l);
}
__device__ __forceinline__ void ph_dsa_xb(KP p, int l, LAS unsigned char* lds) {
    const int tid = my_tid();
    unsigned* ctl = (unsigned*)(p->ws + WS_CTL);
    LAS int* slot = (LAS int*)(lds + LDS_BYTES - 64);
    for (;;) { if (tid == 0) *slot = (int)atomicAdd(ctl + 64 * (l + 1), 1u); __syncthreads(); const int it = *slot; __syncthreads(); if (it >= 256) break; dsa_item(p, l, it, lds); __syncthreads(); }
    const int lane = tid & 63, wave = tid >> 6, gw = blockIdx.x * 8 + wave, NGW = gridDim.x * 8;
    const float* src = (l == 0) ? p->in[I_X] : p->out; bf16_t* XB = (bf16_t*)(p->ws + WS_XB2);
    for (int m = gw; m < T; m += NGW) row_to_bf16(src + (size_t)m * D, XB + (size_t)m * D, lane);
}

struct SchedMerge {
    static constexpr int PERM = 1;
    const char* XB; const char* WIN; const char* OCT; const char* WB; int G, c;
    __device__ __forceinline__ bool next(int i, mg::Unit& u) const {
        int pm, pn; if (!mg::static_tile(i >> 3, G, c, T / 256, 4, pm, pn)) return false;
        const int j = i & 7, br = j >> 1; u.pm = pm; u.pn = pn; u.tag = j;
        if ((j & 1) == 0) { u.A = XB + (size_t)pm * 256 * 2048; u.B = WIN + (size_t)(3328 + 1024 * br + 256 * pn) * 2048; u.ld = 2048; u.nt = 16; }
        else { const int koff = (br == 0) ? 0 : 256 + 256 * br, kk = (br == 0) ? 512 : 256;
            u.A = OCT + (size_t)pm * 256 * (OC * 2) + koff * 2; u.B = WB + (size_t)pn * 256 * (OC * 2) + koff * 2; u.ld = OC * 2; u.nt = kk / 64; }
        return true;
    }
};
struct EpiMerge {
    const float* gbias; f32x4* gsc; f32x4* macc; bf16_t* MB;
    __device__ __forceinline__ void operator()(const AccT& acc, const mg::Unit& u, int wr, int wc, int fr, int fq, int tid) const {
        const int br = u.tag >> 1; const int col0 = u.pn * 256 + wc * 32 + 8 * fq, row0 = u.pm * 256 + wr * 64 + fr;
        if ((u.tag & 1) == 0) {
            f32x4 bv[2][2];
#pragma unroll
            for (int bj = 0; bj < 2; ++bj)
#pragma unroll
                for (int n = 0; n < 2; ++n) bv[bj][n] = *(const f32x4*)(gbias + br * 1024 + col0 + bj * 128 + 4 * n);
#pragma unroll
            for (int ai = 0; ai < 2; ++ai)
#pragma unroll
                for (int m = 0; m < 4; ++m)
#pragma unroll
                    for (int bj = 0; bj < 2; ++bj)
#pragma unroll
                        for (int n = 0; n < 2; ++n) { const f32x4 x = acc[ai][bj][m][n] + bv[bj][n]; f32x4 g;
#pragma unroll
                            for (int j = 0; j < 4; ++j) g[j] = sigm(x[j]);
                            gsc[((((ai * 4 + m) * 2 + bj) * 2 + n) * 512) + tid] = g; asm volatile("" ::: "memory"); }
        } else {
#pragma unroll
            for (int ai = 0; ai < 2; ++ai)
#pragma unroll
                for (int m = 0; m < 4; ++m) { bf16_t* rowp = MB + (size_t)(row0 + ai * 128 + m * 16) * D + col0;
#pragma unroll
                    for (int bj = 0; bj < 2; ++bj) { f32x4 r[2];
#pragma unroll
                        for (int n = 0; n < 2; ++n) { const int idx = ((((ai * 4 + m) * 2 + bj) * 2 + n) * 512) + tid; const f32x4 g = gsc[idx]; f32x4 v = g * acc[ai][bj][m][n];
                            if (br > 0) v += macc[idx]; if (br < 3) macc[idx] = v; r[n] = v; }
                        if (br == 3) { u32x4 w; w.x = pk2(r[0][0], r[0][1]); w.y = pk2(r[0][2], r[0][3]); w.z = pk2(r[1][0], r[1][1]); w.w = pk2(r[1][2], r[1][3]); *(u32x4*)(rowp + bj * 128) = w; }
                        asm volatile("" ::: "memory"); } }
        }
    }
};
__device__ __forceinline__ void ph_merge(KP p, int l, LAS unsigned char* lds) {
    SchedMerge S{(const char*)(p->ws + WS_XB2), (const char*)(p->ws + WS_WIN), (const char*)(p->ws + WS_OCAT), (const char*)(p->ws + WS_WB), (int)gridDim.x, (int)blockIdx.x};
    EpiMerge E{p->in[I_GB] + (size_t)l * 4096, (f32x4*)(p->ws + WS_GSC) + (size_t)blockIdx.x * 16384, (f32x4*)(p->ws + WS_MACC) + (size_t)blockIdx.x * 16384, (bf16_t*)(p->ws + WS_MERGED)};
    mg::gemm_run(lds, S, E);
}

template <int PERM_, int NN, int K> struct SchedPlain {
    static constexpr int PERM = PERM_;
    const char* A; const char* B; int G, c;
    __device__ __forceinline__ bool next(int i, mg::Unit& u) const {
        int pm, pn; if (!mg::static_tile(i, G, c, T / 256, NN, pm, pn)) return false;
        u.A = A + (size_t)pm * 256 * K * 2; u.B = B + (size_t)pn * 256 * K * 2; u.ld = K * 2; u.nt = K / 64; u.pm = pm; u.pn = pn; u.tag = 0; return true;
    }
};
struct EpiResid {
    const float* base; float* out; float alpha;
    __device__ __forceinline__ void operator()(const AccT& acc, const mg::Unit& u, int wr, int wc, int fr, int fq, int) const {
        const int row0 = u.pm * 256 + wr * 64 + fr, col0 = u.pn * 256 + wc * 32 + 4 * fq;
#pragma unroll
        for (int ai = 0; ai < 2; ++ai)
#pragma unroll
            for (int m = 0; m < 4; ++m) { const size_t off = (size_t)(row0 + ai * 128 + m * 16) * D + col0;
#pragma unroll
                for (int bj = 0; bj < 2; ++bj)
#pragma unroll
                    for (int n = 0; n < 2; ++n) { const f32x4 bs = *(const f32x4*)(base + off + bj * 128 + n * 16); *(f32x4*)(out + off + bj * 128 + n * 16) = bs * alpha + acc[ai][bj][m][n]; } }
    }
};
__device__ __forceinline__ void ph_outproj(KP p, int l, LAS unsigned char* lds) {
    SchedPlain<0, 4, D> S{(const char*)(p->ws + WS_MERGED), (const char*)(p->ws + WS_WO), (int)gridDim.x, (int)blockIdx.x};
    EpiResid E{(l == 0) ? p->in[I_X] : p->out, p->out, DN_ALPHA};
    mg::gemm_run(lds, S, E);
}

__device__ __forceinline__ void ln_rows(KP p, int l, int mode, LAS unsigned char* lds) {
    const int tid = my_tid(), lane = tid & 63, wave = tid >> 6;
    const float* g = p->in[I_LNG] + (size_t)(l * 2 + mode) * D; const float* bb = p->in[I_LNB] + (size_t)(l * 2 + mode) * D;
    bf16_t* OB = (bf16_t*)(p->ws + (mode == 0 ? WS_X1B : WS_XB)); const bool wb = (mode == 0) || (l == 0);
    const bool moe = (mode == 0) && (l & 1); const float* rw = p->in[I_RTW] + (size_t)(l >> 1) * D * NE; const float* rb = p->in[I_RTB] + (l >> 1) * NE;
    int* TOKE = (int*)(p->ws + WS_TOKE); float* TOKW = (float*)(p->ws + WS_TOKW);
    f32x4 gv[4], bv[4];
#pragma unroll
    for (int j = 0; j < 4; ++j) { gv[j] = *(const f32x4*)(g + 4 * lane + 256 * j); bv[j] = *(const f32x4*)(bb + 4 * lane + 256 * j); }
    const int rows_per_wg = T / gridDim.x;
    for (int rr = wave; rr < rows_per_wg; rr += 8) {
        const int row = blockIdx.x * rows_per_wg + rr; float* xr = p->out + (size_t)row * D;
        f32x4 v[4]; float s = 0.f;
#pragma unroll
        for (int j = 0; j < 4; ++j) { v[j] = *(const f32x4*)(xr + 4 * lane + 256 * j); s += (v[j].x + v[j].y) + (v[j].z + v[j].w); }
        const float mean = wave_sum(s) * (1.f / D); float s2 = 0.f;
#pragma unroll
        for (int j = 0; j < 4; ++j) { v[j] = v[j] - mean; s2 += (v[j].x * v[j].x + v[j].y * v[j].y) + (v[j].z * v[j].z + v[j].w * v[j].w); }
        const float rstd = rsqrtf(wave_sum(s2) * (1.f / D) + LN_EPS);
        const float osc = (mode == 0) ? DN_ALPHA : 1.f;
#pragma unroll
        for (int j = 0; j < 4; ++j) { v[j] = v[j] * rstd * gv[j] + bv[j]; *(f32x4*)(xr + 4 * lane + 256 * j) = v[j] * osc;
            if (wb) *(unsigned long long*)(OB + (size_t)row * D + 4 * lane + 256 * j) = (unsigned long long)pk2(v[j].x, v[j].y) | ((unsigned long long)pk2(v[j].z, v[j].w) << 32); }
        if (moe) {
            float lg[8];
#pragma unroll
            for (int e = 0; e < 8; ++e) lg[e] = 0.f;
#pragma unroll
            for (int j = 0; j < 4; ++j)
#pragma unroll
                for (int q = 0; q < 4; ++q) { const int c = 4 * lane + 256 * j + q; const f32x4 w0 = *(const f32x4*)(rw + (size_t)c * 8), w1 = *(const f32x4*)(rw + (size_t)c * 8 + 4); const float x = v[j][q];
                    lg[0] += x * w0.x; lg[1] += x * w0.y; lg[2] += x * w0.z; lg[3] += x * w0.w; lg[4] += x * w1.x; lg[5] += x * w1.y; lg[6] += x * w1.z; lg[7] += x * w1.w; }
#pragma unroll
            for (int e = 0; e < 8; ++e) lg[e] = wave_sum(lg[e]) + rb[e];
            int e1 = 0; float v1 = lg[0];
#pragma unroll
            for (int e = 1; e < 8; ++e) if (lg[e] > v1) { v1 = lg[e]; e1 = e; }
            int e2 = -1; float v2 = -INFINITY;
#pragma unroll
            for (int e = 0; e < 8; ++e) if (e != e1 && lg[e] > v2) { v2 = lg[e]; e2 = e; }
            const float w1 = 1.f / (1.f + __expf(v2 - v1));
            if (lane == 0) { TOKE[row * 2] = e1; TOKE[row * 2 + 1] = e2; TOKW[row * 2] = w1; TOKW[row * 2 + 1] = 1.f - w1; }
        }
    }
    if (moe) {
        __syncthreads();
        if (tid < 8) { int cnt = 0; for (int rr = 0; rr < rows_per_wg; ++rr) { const int row = blockIdx.x * rows_per_wg + rr; cnt += (TOKE[row * 2] == tid) + (TOKE[row * 2 + 1] == tid); }
            ((int*)(p->ws + WS_WGCNT))[blockIdx.x * 8 + tid] = cnt; }
    }
}
__device__ __forceinline__ void ph_ln1(KP p, int l, LAS unsigned char* lds) {
    ln_rows(p, l, 0, lds);
    __syncthreads();
    const int tid_ = my_tid(); const int lane = tid_ & 63, wave = tid_ >> 6, gw = blockIdx.x * 8 + wave, NGW = gridDim.x * 8;
    LAS float* scr = (LAS float*)(lds + wave * 8448);
    bf16_t* W13 = (bf16_t*)(p->ws + WS_WF13);
    if ((l & 1) == 0) {
        const int j = l >> 1; const float* w1 = p->in[I_F1] + (size_t)j * D * DFF; const float* w3 = p->in[I_F3] + (size_t)j * D * DFF; const float* w2 = p->in[I_F2] + (size_t)j * DFF * D;
        bf16_t* W2 = (bf16_t*)(p->ws + WS_WF2_DENSE);
        const int n1 = tr_nitems(D, DFF), n2 = tr_nitems(DFF, D);
        for (int it = gw; it < 2 * n1 + n2; it += NGW) { int r = it;
            if (r < n1) { tr_item(w1, D, DFF, W13, D, 2, 0, scr, r, lane); continue; } r -= n1;
            if (r < n1) { tr_item(w3, D, DFF, W13, D, 3, 0, scr, r, lane); continue; } r -= n1;
            tr_item(w2, DFF, D, W2, DFF, 0, 0, scr, r, lane); }
    } else {
        const int j = l >> 1; bf16_t* W2 = (bf16_t*)(p->ws + WS_WF2_MOE);
        const int n1 = tr_nitems(D, DFE), n2 = tr_nitems(DFE, D), per = 2 * n1 + n2;
        for (int it = gw; it < NE * per; it += NGW) { const int e = it / per; int r = it % per;
            const float* w1 = p->in[I_E1] + ((size_t)j * NE + e) * D * DFE; const float* w3 = p->in[I_E3] + ((size_t)j * NE + e) * D * DFE; const float* w2 = p->in[I_E2] + ((size_t)j * NE + e) * DFE * D;
            if (r < n1) { tr_item(w1, D, DFE, W13, D, 2, e * 2 * DFE, scr, r, lane); continue; } r -= n1;
            if (r < n1) { tr_item(w3, D, DFE, W13, D, 3, e * 2 * DFE, scr, r, lane); continue; } r -= n1;
            tr_item(w2, DFE, D, W2, DFE, 0, e * D, scr, r, lane); }
    }
}

__device__ __forceinline__ void moe_tables(KP p, LAS int* tb  ) {
    const int tid = my_tid(); const int* WG = (const int*)(p->ws + WS_WGCNT);
    if (tid < 8) { int tot = 0, mine = 0; for (int w = 0; w < (int)gridDim.x; ++w) { const int c = WG[w * 8 + tid]; if (w < (int)blockIdx.x) mine += c; tot += c; } tb[tid] = tot; tb[16 + tid] = mine; }
    __syncthreads();
    if (tid == 0) { int base = 0; for (int e = 0; e < 8; ++e) { tb[8 + e] = base; base += ((tb[e] + 255) >> 8) << 8; } tb[24] = base; }
    __syncthreads();
}
__device__ __forceinline__ void ph_moe_assign(KP p, int l, LAS unsigned char* lds) {
    const int tid = my_tid(), lane = tid & 63, wave = tid >> 6;
    LAS int* tb = (LAS int*)lds; LAS int* rowof = tb + 32;
    moe_tables(p, tb);
    const int rows_per_wg = T / gridDim.x; const int* TOKE = (const int*)(p->ws + WS_TOKE); const float* TOKW = (const float*)(p->ws + WS_TOKW);
    int* ROWTOK = (int*)(p->ws + WS_ROWTOK); float* ROWW = (float*)(p->ws + WS_ROWW);
    if (tid < 8) { int run = tb[8 + tid] + tb[16 + tid];
        for (int rr = 0; rr < rows_per_wg; ++rr) { const int row = blockIdx.x * rows_per_wg + rr;
#pragma unroll
            for (int s = 0; s < 2; ++s) if (TOKE[row * 2 + s] == tid) { ROWTOK[run] = row; ROWW[run] = TOKW[row * 2 + s]; rowof[rr * 2 + s] = run; ++run; } } }
    bf16_t* AG = (bf16_t*)(p->ws + WS_AG);
    if (blockIdx.x < 8) { const int e = blockIdx.x, lo = tb[8 + e] + tb[e], hi = tb[8 + e] + (((tb[e] + 255) >> 8) << 8);
        for (int r = lo + wave; r < hi; r += 8) { if (lane == 0) { ROWTOK[r] = -1; ROWW[r] = 0.f; }
#pragma unroll
            for (int j = 0; j < 2; ++j) *(u32x4*)(AG + (size_t)r * D + 8 * lane + 512 * j) = (u32x4){0u, 0u, 0u, 0u}; } }
    __syncthreads();
    const bf16_t* X1B = (const bf16_t*)(p->ws + WS_X1B);
    for (int pr = wave; pr < rows_per_wg * 2; pr += 8) { const int row = blockIdx.x * rows_per_wg + (pr >> 1), dst = rowof[pr];
#pragma unroll
        for (int j = 0; j < 2; ++j) *(u32x4*)(AG + (size_t)dst * D + 8 * lane + 512 * j) = *(const u32x4*)(X1B + (size_t)row * D + 8 * lane + 512 * j); }
}

struct EpiSwiglu {
    bf16_t* H; int ldh;
    __device__ __forceinline__ void operator()(const AccT& acc, const mg::Unit& u, int wr, int wc, int fr, int fq, int) const {
        const int row0 = u.pm * 256 + wr * 64 + fr, col0 = u.pn * 128 + wc * 32 + 8 * fq;
#pragma unroll
        for (int ai = 0; ai < 2; ++ai)
#pragma unroll
            for (int m = 0; m < 4; ++m) { float hv[8];
#pragma unroll
                for (int n = 0; n < 2; ++n)
#pragma unroll
                    for (int j = 0; j < 4; ++j) { const float a = acc[ai][0][m][n][j], b = acc[ai][1][m][n][j]; hv[4 * n + j] = a * sigm(a) * b; }
                u32x4 w; w.x = pk2(hv[0], hv[1]); w.y = pk2(hv[2], hv[3]); w.z = pk2(hv[4], hv[5]); w.w = pk2(hv[6], hv[7]);
                *(u32x4*)(H + (size_t)(row0 + ai * 128 + m * 16) * ldh + col0) = w; asm volatile("" ::: "memory"); }
    }
};
template <int PERM_, int NN, int K, int BROWS> struct SchedMoe {
    static constexpr int PERM = PERM_;
    const char* A; const char* B; const LAS int* tstart; int G, c;
    __device__ __forceinline__ bool next(int i, mg::Unit& u) const {
        const int L = i * G + c; if (L >= tstart[8] * NN) return false;
        const int rt = L / NN, pn = L % NN; int e = 0;
#pragma unroll
        for (int x = 1; x < 8; ++x) if (rt >= tstart[x]) e = x;
        u.A = A + (size_t)rt * 256 * (K * 2); u.B = B + ((size_t)e * BROWS + (size_t)pn * 256) * (K * 2); u.ld = K * 2; u.nt = K / 64; u.pm = rt; u.pn = pn; u.tag = 0; return true;
    }
};
template <class SM> __device__ __forceinline__ void moe_sched_tiles(KP p, LAS unsigned char* lds, SM& S) {
    LAS int* tb = (LAS int*)(lds + LDS_BYTES - 512);
    moe_tables(p, tb);
    { const int t_ = my_tid(); if (t_ < 8) tb[32 + t_] = tb[8 + t_] >> 8; if (t_ == 8) tb[40] = tb[24] >> 8; }
    __syncthreads();
    S.tstart = tb + 32;
}
__device__ __forceinline__ void ph_ffn_up(KP p, int l, LAS unsigned char* lds) {
    if ((l & 1) == 0) {
        SchedPlain<1, 2 * DFF / 256, D> S{(const char*)(p->ws + WS_X1B), (const char*)(p->ws + WS_WF13), (int)gridDim.x, (int)blockIdx.x};
        EpiSwiglu E{(bf16_t*)(p->ws + WS_H), DFF};
        mg::gemm_run(lds, S, E);
    } else {
        SchedMoe<1, 2 * DFE / 256, D, 2 * DFE> S; S.A = (const char*)(p->ws + WS_AG); S.B = (const char*)(p->ws + WS_WF13);
        S.G = (int)gridDim.x; S.c = (int)blockIdx.x; moe_sched_tiles(p, lds, S);
        EpiSwiglu E{(bf16_t*)(p->ws + WS_H), DFE};
        mg::gemm_run(lds, S, E);
    }
}

struct EpiAccum {
    float* out;
    __device__ __forceinline__ void operator()(const AccT& acc, const mg::Unit& u, int wr, int wc, int fr, int fq, int) const {
        const int row0 = u.pm * 256 + wr * 64 + fr, col0 = u.pn * 256 + wc * 32 + 4 * fq;
#pragma unroll
        for (int ai = 0; ai < 2; ++ai)
#pragma unroll
            for (int m = 0; m < 4; ++m) { float* rp = out + (size_t)(row0 + ai * 128 + m * 16) * D + col0;
#pragma unroll
                for (int bj = 0; bj < 2; ++bj)
#pragma unroll
                    for (int n = 0; n < 2; ++n) { f32x4* q = (f32x4*)(rp + bj * 128 + n * 16); *q = *q + acc[ai][bj][m][n]; } }
    }
};
struct EpiScatter {
    float* out; const int* rowtok; const float* roww;
    __device__ __forceinline__ void operator()(const AccT& acc, const mg::Unit& u, int wr, int wc, int fr, int fq, int) const {
        const int row0 = u.pm * 256 + wr * 64 + fr, col0 = u.pn * 256 + wc * 32 + 4 * fq;
#pragma unroll
        for (int ai = 0; ai < 2; ++ai)
#pragma unroll
            for (int m = 0; m < 4; ++m) { const int r = row0 + ai * 128 + m * 16; const int tok = rowtok[r]; const float w = roww[r];
                if (tok >= 0) { float* rp = out + (size_t)tok * D + col0;
#pragma unroll
                    for (int bj = 0; bj < 2; ++bj)
#pragma unroll
                        for (int n = 0; n < 2; ++n)
#pragma unroll
                            for (int j = 0; j < 4; ++j) unsafeAtomicAdd(rp + bj * 128 + n * 16 + j, w * acc[ai][bj][m][n][j]); } }
    }
};
__device__ __forceinline__ void ph_ffn_down(KP p, int l, LAS unsigned char* lds) {
    if ((l & 1) == 0) {
        SchedPlain<0, 4, DFF> S{(const char*)(p->ws + WS_H), (const char*)(p->ws + WS_WF2_DENSE), (int)gridDim.x, (int)blockIdx.x};
        EpiAccum E{p->out};
        mg::gemm_run(lds, S, E);
    } else {
        SchedMoe<0, 4, DFE, D> S; S.A = (const char*)(p->ws + WS_H); S.B = (const char*)(p->ws + WS_WF2_MOE);
        S.G = (int)gridDim.x; S.c = (int)blockIdx.x; moe_sched_tiles(p, lds, S);
        EpiScatter E{p->out, (const int*)(p->ws + WS_ROWTOK), (const float*)(p->ws + WS_ROWW)};
        mg::gemm_run(lds, S, E);
    }
}

constexpr int PH_PER_LAYER = 12, NPHASE = 2 * PH_PER_LAYER;
template <int K> __device__ __forceinline__ void run_phase(KP p, int l, LAS unsigned char* lds) {
    asm volatile("" : "+s"(lds));
    if constexpr (K == 0) ph_conv_mixer(p, l, lds);
    else if constexpr (K == 1) ph_inproj(p, l, lds);
    else if constexpr (K == 2) ph_prep(p, l, lds);
    else if constexpr (K == 30) ph_scan(p, l, lds);
    else if constexpr (K == 31) ph_attn(p, l, lds);
    else if constexpr (K == 4) ph_dsa_xb(p, l, lds);
    else if constexpr (K == 5) ph_merge(p, l, lds);
    else if constexpr (K == 6) ph_outproj(p, l, lds);
    else if constexpr (K == 7) ph_ln1(p, l, lds);
    else if constexpr (K == 8) ph_moe_assign(p, l, lds);
    else if constexpr (K == 9) ph_ffn_up(p, l, lds);
    else if constexpr (K == 10) ph_ffn_down(p, l, lds);
    else ln_rows(p, l, 1, lds);
}
template <int K> __global__ void __launch_bounds__(NTHREADS, 2) k_phase(Params, int l) {
    extern __shared__ __attribute__((aligned(16))) unsigned char lds_raw[];
    run_phase<K>(get_params(), l, (LAS unsigned char*)lds_raw);
}
#if FUSED
#define PH(K, L) do { run_phase<K>(get_params(), L, lds); __syncthreads(); } while (0)
#define SYNC() grid.sync()
__global__ void __launch_bounds__(NTHREADS, 2) k_fused(Params) {
    extern __shared__ __attribute__((aligned(16))) unsigned char lds_raw[];
    LAS unsigned char* lds = (LAS unsigned char*)lds_raw;
    cg::grid_group grid = cg::this_grid();
    PH(0, 0); SYNC(); PH(1, 0); SYNC(); PH(2, 0); SYNC(); PH(30, 0); SYNC(); PH(31, 0); SYNC(); PH(4, 0); SYNC(); PH(5, 0); SYNC(); PH(6, 0); SYNC(); PH(7, 0); SYNC();
    PH(9, 0); SYNC(); PH(10, 0); SYNC(); PH(11, 0); SYNC();
    PH(0, 1); SYNC(); PH(1, 1); SYNC(); PH(2, 1); SYNC(); PH(30, 1); SYNC(); PH(31, 1); SYNC(); PH(4, 1); SYNC(); PH(5, 1); SYNC(); PH(6, 1); SYNC(); PH(7, 1); SYNC();
    PH(8, 1); SYNC(); PH(9, 1); SYNC(); PH(10, 1); SYNC(); PH(11, 1);
}
#undef PH
#undef SYNC
#endif
template <int K> static void launch_phase(const Params& p, int l, hipStream_t stream) {
    static bool attr = false;
    if (!attr) { (void)hipFuncSetAttribute((const void*)k_phase<K>, hipFuncAttributeMaxDynamicSharedMemorySize, LDS_BYTES); attr = true; }
    hipLaunchKernelGGL(k_phase<K>, dim3(256), dim3(NTHREADS), LDS_BYTES, stream, p, l);
}

extern "C" void kernel_launch(void* const* d_in, const int* in_sizes, int n_in, void* d_out, int out_size, void* d_ws, size_t ws_size, hipStream_t stream) {
    if (n_in != 28 || out_size != T * D || ws_size < WS_END) { fprintf(stderr, "kernel_launch: unexpected problem (n_in %d out %d ws %zu)\n", n_in, out_size, ws_size); return; }
    (void)hipMemsetAsync((char*)d_ws + WS_CTL, 0, 4096, stream);
    Params p{};
    for (int i = 0; i < 28; ++i) p.in[i] = (const float*)d_in[i];
    p.out = (float*)d_out; p.ws = (unsigned char*)d_ws;
#if FUSED
    static bool attr = false;
    if (!attr) { (void)hipFuncSetAttribute((const void*)k_fused, hipFuncAttributeMaxDynamicSharedMemorySize, LDS_BYTES); attr = true; }
    void* args[] = {&p};
    hipError_t e = hipLaunchCooperativeKernel((const void*)k_fused, dim3(256), dim3(NTHREADS), args, LDS_BYTES, stream);
    if (e != hipSuccess) fprintf(stderr, "cooperative launch failed: %s\n", hipGetErrorString(e));
    return;
#endif
    for (int l = 0; l < 2; ++l) {
        launch_phase<0>(p, l, stream); launch_phase<1>(p, l, stream); launch_phase<2>(p, l, stream);
        launch_phase<30>(p, l, stream); launch_phase<31>(p, l, stream);
        launch_phase<4>(p, l, stream); launch_phase<5>(p, l, stream); launch_phase<6>(p, l, stream); launch_phase<7>(p, l, stream);
        if (l & 1) launch_phase<8>(p, l, stream);
        launch_phase<9>(p, l, stream); launch_phase<10>(p, l, stream); launch_phase<11>(p, l, stream);
    }
}
```

```cpp
#include <hip/hip_runtime.h>
#include <hip/hip_cooperative_groups.h>
#include <cstdio>
#include <cstdint>
namespace cg = cooperative_groups;

#ifndef FUSED
#define FUSED 1
#endif

#define LAS __attribute__((address_space(3)))
typedef unsigned short bf16_t;
typedef short bf16x8 __attribute__((ext_vector_type(8)));
typedef float f32x4 __attribute__((ext_vector_type(4)));
typedef float f32x2 __attribute__((ext_vector_type(2)));
typedef unsigned u32x4 __attribute__((ext_vector_type(4)));
typedef unsigned u32x2 __attribute__((ext_vector_type(2)));

constexpr int T = 16384, D = 1024, SEQ = 2048, NB = 8;
constexpr int NPM = 3328;
constexpr int C_SWA_Q = 0, C_SWA_K = 512, C_SWA_V = 640, C_RW = 768;
constexpr int C_FOX_Q = 1792, C_FOX_K = 2048, C_FOX_V = 2304;
constexpr int C_DSA_Q = 2560, C_DSA_K = 2816, C_DSA_V = 2880, C_DSA_QI = 2944, C_DSA_KI = 3200, C_FLOG = 3264, C_WIDX = 3268;
constexpr int D_IN = 7368, NWIN = 7424;
constexpr int OC = 1280;
constexpr int DFF = 2816, DFE = 1408, NE = 8;
constexpr int MAXROWS = 34816;
constexpr float DN_ALPHA = 1.41421356237f;
constexpr float LN_EPS = 1e-5f;

constexpr size_t MiB = 1u << 20;
constexpr size_t WS_CTL = 0;
constexpr size_t WS_WIN = 1 * MiB, WS_WB = 16 * MiB, WS_WO = 19 * MiB;
constexpr size_t WS_THR = 21 * MiB + 256 * 1024  , WS_ROWOF = 21 * MiB  , WS_FOXC = 21 * MiB, WS_TOKE = 21 * MiB + 256 * 1024, WS_TOKW = 21 * MiB + 384 * 1024, WS_ROWTOK = 21 * MiB + 512 * 1024,
                 WS_ROWW = 21 * MiB + 768 * 1024, WS_WGCNT = 21 * MiB + 920 * 1024;
constexpr size_t WS_OCAT = 22 * MiB, WS_X1B = 22 * MiB;
constexpr size_t WS_PMIX = 62 * MiB, WS_MERGED = 62 * MiB, WS_MACC = 94 * MiB;
constexpr size_t WS_WF13 = 62 * MiB, WS_WF2_DENSE = 73 * MiB, WS_WF2_MOE = 106 * MiB, WS_H = 128 * MiB;
constexpr size_t WS_RW = 166 * MiB, WS_XB = 166 * MiB, WS_SCORES = 166 * MiB, WS_XB2 = 246 * MiB, WS_GSC = 158 * MiB, WS_AG = 222 * MiB;
constexpr size_t WS_BONUS = 278 * MiB, WS_Y = 279 * MiB;
constexpr size_t WS_END = 295 * MiB;
constexpr size_t RWSZ = 16 * MiB;

constexpr int LDS_BYTES = 155648;
constexpr int NTHREADS = 512;

struct Params { const float* in[28]; float* out; unsigned char* ws; };
typedef const __attribute__((address_space(4))) Params* KP;
__device__ __forceinline__ KP get_params() { KP k = (KP)__builtin_amdgcn_kernarg_segment_ptr(); asm volatile("" : "+s"(k)); return k; }
enum { I_X = 0, I_WIN, I_SINKS, I_MU, I_W0, I_WUP, I_A0, I_AUP, I_GUP, I_KK, I_KA, I_RK, I_GNG, I_GNB, I_FB, I_GB, I_WBR, I_WOUT, I_LNG, I_LNB,
       I_F1, I_F3, I_F2, I_RTW, I_RTB, I_E1, I_E3, I_E2 };

__device__ __forceinline__ float bflo(unsigned u) { return __uint_as_float(u << 16); }
__device__ __forceinline__ float bfhi(unsigned u) { return __uint_as_float(u & 0xffff0000u); }
__device__ __forceinline__ float bf2f(bf16_t b) { return __uint_as_float((unsigned)b << 16); }
__device__ __forceinline__ unsigned f2bf(float f) { unsigned u = __float_as_uint(f); return (u + 0x7fffu + ((u >> 16) & 1u)) >> 16; }
__device__ __forceinline__ unsigned pk2(float lo, float hi) { return f2bf(lo) | (f2bf(hi) << 16); }
__device__ __forceinline__ float wave_sum(float v) {
#pragma unroll
    for (int o = 1; o < 64; o <<= 1) v += __shfl_xor(v, o);
    return v;
}
__device__ __forceinline__ float wave_max(float v) {
#pragma unroll
    for (int o = 1; o < 64; o <<= 1) v = fmaxf(v, __shfl_xor(v, o));
    return v;
}
__device__ __forceinline__ float sigm(float x) { return 1.f / (1.f + __expf(-x)); }
#define LDS_FENCE() asm volatile("s_waitcnt lgkmcnt(0)" ::: "memory")
__device__ __forceinline__ int my_tid() { int t = threadIdx.x; asm volatile("" : "+v"(t)); return t; }
__device__ __forceinline__ void unpack8(const u32x4 v, float* f) {
    f[0] = bflo(v.x); f[1] = bfhi(v.x); f[2] = bflo(v.y); f[3] = bfhi(v.y); f[4] = bflo(v.z); f[5] = bfhi(v.z); f[6] = bflo(v.w); f[7] = bfhi(v.w);
}

namespace mg {
constexpr int BM = 256, BK = 64, HALF = 128, HTB = HALF * BK * 2, STAGE_BYTES = 8 * HTB;
__device__ __forceinline__ int lds_byte(int r, int c) { const int st = (r >> 4) * 2 + (c >> 5), rr = r & 15, cc = c & 31, ob = rr * 64 + cc * 2; return st * 1024 + (ob ^ (((ob >> 9) & 1) << 5)); }
__device__ __forceinline__ void stage_rc(int b, int& R, int& C) { const int st = b / 1024, sb = b % 1024, swz = sb ^ (((sb >> 9) & 1) << 5); R = (st >> 1) * 16 + swz / 64; C = (st & 1) * 32 + (swz % 64) / 2; }
__device__ __forceinline__ int perm32(int rho) { const int n = rho >> 4, i = rho & 15; return 8 * (i >> 2) + 4 * n + (i & 3); }

struct Unit { const char* A; const char* B; unsigned ld; int nt; int pm, pn, tag; };

__device__ __forceinline__ bool static_tile(int i, int G, int c, int nM, int nN, int& pm, int& pn) {
    const int nwg = nM * nN; const long L = (long)i * G + c; if (L >= nwg) return false;
    int wgid = (int)L; { const int q = nwg / 8, r = nwg % 8, xcd = wgid % 8, off = wgid / 8; wgid = (xcd < r ? xcd * (q + 1) : r * (q + 1) + (xcd - r) * q) + off; }
    const int nig = 8 * nN, gid = wgid / nig, fm = gid * 8, gsz = (nM - fm) < 8 ? (nM - fm) : 8;
    pm = fm + ((wgid % nig) % gsz); pn = (wgid % nig) / gsz; return true;
}

template <class Sched, class Epi>
__device__ __forceinline__ void gemm_run(LAS unsigned char* lds, const Sched& S, const Epi& E) {
    const int tid = my_tid(), wid = __builtin_amdgcn_readfirstlane(tid >> 6), lane = tid & 63, wr = wid >> 2, wc = wid & 3, fr = lane & 15, fq = lane >> 4;
    int R0, C0; stage_rc(tid * 16, R0, C0); const unsigned RA = (unsigned)R0, RB = (unsigned)(Sched::PERM ? ((R0 & ~31) + perm32(R0 & 31)) : R0), C02 = (unsigned)C0 * 2u;
    const unsigned ldsw = (unsigned)wid * 1024u;
    const int aoff = lds_byte(wr * 64 + fr, fq * 8), boff = lds_byte(wc * 32 + fr, fq * 8);
#define MG_SA(b, h) (((b) * 2 + (h)) * HTB)
#define MG_SB(b, h) ((4 + (b) * 2 + (h)) * HTB)
#define MG_STAGE(bufoff, gptr, v0, s64) do { \
        __builtin_amdgcn_global_load_lds((const unsigned*)((gptr) + (v0)), (LAS unsigned*)(lds + (bufoff) + ldsw), 16, 0, 0); \
        __builtin_amdgcn_global_load_lds((const unsigned*)((gptr) + (s64) + (v0)), (LAS unsigned*)(lds + (bufoff) + ldsw + 8192), 16, 0, 0); } while (0)
#define MG_LDA(dst, b, h) do { _Pragma("unroll") for (int m = 0; m < 4; ++m) _Pragma("unroll") for (int k = 0; k < 2; ++k) dst[m][k] = *(const LAS bf16x8*)(lds + MG_SA(b, h) + aoff + m * 2048 + k * 1024); } while (0)
#define MG_LDB(dst, b, h) do { _Pragma("unroll") for (int n = 0; n < 2; ++n) _Pragma("unroll") for (int k = 0; k < 2; ++k) dst[n][k] = *(const LAS bf16x8*)(lds + MG_SB(b, h) + boff + n * 2048 + k * 1024); } while (0)
#define MG_MMA(ai, bj, At, Bt) do { __builtin_amdgcn_s_setprio(1); _Pragma("unroll") for (int m = 0; m < 4; ++m) _Pragma("unroll") for (int n = 0; n < 2; ++n) _Pragma("unroll") for (int k = 0; k < 2; ++k) \
        acc[ai][bj][m][n] = __builtin_amdgcn_mfma_f32_16x16x32_bf16(Bt[n][k], At[m][k], acc[ai][bj][m][n], 0, 0, 0); __builtin_amdgcn_s_setprio(0); } while (0)
#define MG_WAIT_V(n) asm volatile("s_waitcnt vmcnt(" #n ")" ::: "memory")
#define MG_WAIT_L(n) asm volatile("s_waitcnt lgkmcnt(" #n ")" ::: "memory")
#define MG_BAR __builtin_amdgcn_s_barrier()
#define MG_SCHED __builtin_amdgcn_sched_barrier(0)
    Unit cur; int ui = 0;
    if (!S.next(0, cur)) return;
    f32x4 acc[2][2][4][2];
#pragma unroll
    for (int a = 0; a < 2; ++a)
#pragma unroll
        for (int b = 0; b < 2; ++b)
#pragma unroll
            for (int m = 0; m < 4; ++m)
#pragma unroll
                for (int n = 0; n < 2; ++n) acc[a][b][m][n] = (f32x4){0.f, 0.f, 0.f, 0.f};
    bf16x8 At[4][2], B0[2][2], B1[2][2];
    const size_t kstep = (size_t)(BK * 2);
    {
        const char* cA = cur.A; const char* cB = cur.B; const unsigned ld = cur.ld, vA = RA * ld + C02, vB = RB * ld + C02, s64 = 64u * ld, sh = 128u * ld;
        MG_STAGE(MG_SB(0, 0), cB, vB, s64); MG_STAGE(MG_SB(0, 1), cB + sh, vB, s64); MG_STAGE(MG_SA(0, 0), cA, vA, s64); MG_STAGE(MG_SA(0, 1), cA + sh, vA, s64);
        if (wr == 1) MG_BAR;
        MG_WAIT_V(2); MG_BAR;
        MG_STAGE(MG_SB(1, 0), cB + kstep, vB, s64); MG_STAGE(MG_SA(1, 0), cA + kstep, vA, s64); MG_STAGE(MG_SB(1, 1), cB + sh + kstep, vB, s64);
        MG_WAIT_V(6); MG_BAR;
    }
    for (;;) {
        const char* cA = cur.A; const char* cB = cur.B; const unsigned cld = cur.ld; const int nt = cur.nt;
        for (int t = 0; t < nt; t += 2) {
            const bool last = (t == nt - 2);
            const char* a1 = cA + (size_t)(t + 1) * kstep;
            const char* a2 = cA + (size_t)(t + 2) * kstep; const char* b2 = cB + (size_t)(t + 2) * kstep; unsigned xld = cld;
            if (last) { Unit n2; if (S.next(ui + 1, n2)) { a2 = n2.A; b2 = n2.B; xld = n2.ld; } else { a2 = cA; b2 = cB; } }
            const char* a3 = a2 + kstep; const char* b3 = b2 + kstep;
            const unsigned cvA = RA * cld + C02, c64 = 64u * cld, ch = 128u * cld;
            const unsigned xvA = RA * xld + C02, xvB = RB * xld + C02, x64 = 64u * xld, xh = 128u * xld;
            MG_LDB(B0, 0, 0); MG_LDB(B1, 0, 1); MG_SCHED; MG_LDA(At, 0, 0); MG_STAGE(MG_SA(1, 1), a1 + ch, cvA, c64);
            MG_WAIT_V(8); MG_WAIT_L(0); MG_BAR; MG_MMA(0, 0, At, B0); MG_MMA(0, 1, At, B1); MG_BAR; MG_SCHED;
            MG_LDA(At, 0, 1); MG_STAGE(MG_SB(0, 0), b2, xvB, x64); MG_STAGE(MG_SB(0, 1), b2 + xh, xvB, x64); MG_STAGE(MG_SA(0, 0), a2, xvA, x64);
            MG_WAIT_V(8); MG_WAIT_L(0); MG_BAR; MG_MMA(1, 0, At, B0); MG_MMA(1, 1, At, B1); MG_BAR; MG_SCHED;
            MG_LDB(B0, 1, 0); MG_LDB(B1, 1, 1); MG_SCHED; MG_LDA(At, 1, 0); MG_STAGE(MG_SA(0, 1), a2 + xh, xvA, x64);
            MG_WAIT_V(8); MG_WAIT_L(0); MG_BAR; MG_MMA(0, 0, At, B0); MG_MMA(0, 1, At, B1); MG_BAR; MG_SCHED;
            MG_LDA(At, 1, 1); MG_STAGE(MG_SB(1, 0), b3, xvB, x64); MG_STAGE(MG_SB(1, 1), b3 + xh, xvB, x64); MG_STAGE(MG_SA(1, 0), a3, xvA, x64);
            MG_WAIT_V(8); MG_WAIT_L(0); MG_BAR; MG_MMA(1, 0, At, B0); MG_MMA(1, 1, At, B1); MG_BAR; MG_SCHED;
        }
        if (wr == 0) MG_BAR;
        { int e_fr = fr, e_fq = fq, e_tid = tid; asm volatile("" : "+v"(e_fr), "+v"(e_fq), "+v"(e_tid));
          E(acc, cur, wr, wc, e_fr, e_fq, e_tid); }
        Unit nxt;
        if (!S.next(ui + 1, nxt)) break;
#pragma unroll
        for (int a = 0; a < 2; ++a)
#pragma unroll
            for (int b = 0; b < 2; ++b)
#pragma unroll
                for (int m = 0; m < 4; ++m)
#pragma unroll
                    for (int n = 0; n < 2; ++n) acc[a][b][m][n] = (f32x4){0.f, 0.f, 0.f, 0.f};
        cur = nxt; ++ui;
        if (wr == 1) MG_BAR;
    }
    MG_WAIT_V(0);
    MG_BAR;
#undef MG_SA
#undef MG_SB
#undef MG_STAGE
#undef MG_LDA
#undef MG_LDB
#undef MG_MMA
#undef MG_WAIT_V
#undef MG_WAIT_L
#undef MG_BAR
#undef MG_SCHED
}
}

typedef f32x4 AccT[2][2][4][2];

__device__ __forceinline__ int rowmap(int mode, int n) {
    if (mode == 0) return n;
    if (mode == 1) { if (n < 2560) return n; if (n < 2564) return 3264 + (n - 2560); if (n < 3268) return n - 4; if (n < 3272) return n; return n + 56; }
    if (mode == 2) return 256 * (n >> 7) + (n & 127);
    return 256 * (n >> 7) + 128 + (n & 127);
}
__device__ __forceinline__ void tr_item(const float* __restrict__ W, int K, int N, bf16_t* WT, int ldt, int mode, int row_off, LAS float* scr, int item, int lane) {
    const int nblk = (N + 31) / 32, kb = item / nblk, nb = item % nblk, k0 = 64 * kb, n0 = 32 * nb;
    const int nl = lane & 31, n = n0 + nl;
#pragma unroll 8
    for (int i = 0; i < 32; ++i) { const int kk = 2 * i + (lane >> 5); scr[kk * 33 + nl] = (n < N) ? W[(size_t)(k0 + kk) * N + n] : 0.f; }
    LDS_FENCE();
    const int c = lane & 7;
#pragma unroll
    for (int j = 0; j < 4; ++j) { const int n2l = (lane >> 3) + 8 * j, n2 = n0 + n2l; const LAS float* s = scr + (8 * c) * 33 + n2l;
        u32x4 o; o.x = pk2(s[0 * 33], s[1 * 33]); o.y = pk2(s[2 * 33], s[3 * 33]); o.z = pk2(s[4 * 33], s[5 * 33]); o.w = pk2(s[6 * 33], s[7 * 33]);
        if (n2 < N) *(u32x4*)(WT + (size_t)(row_off + rowmap(mode, n2)) * ldt + k0 + 8 * c) = o; }
    LDS_FENCE();
}
__device__ __forceinline__ int tr_nitems(int K, int N) { return (K / 64) * ((N + 31) / 32); }

__device__ __forceinline__ void row_to_bf16(const float* xrow, bf16_t* orow, int lane) {
    const f32x4* xr = (const f32x4*)xrow + lane; unsigned long long* o8 = (unsigned long long*)orow + lane;
#pragma unroll
    for (int j = 0; j < 4; ++j) { const f32x4 v = xr[64 * j]; o8[64 * j] = (unsigned long long)pk2(v.x, v.y) | ((unsigned long long)pk2(v.z, v.w) << 32); }
}

__device__ __forceinline__ void ph_conv_mixer(KP p, int l, LAS unsigned char* lds) {
    const int tid_ = my_tid(); const int lane = tid_ & 63, wave = tid_ >> 6, gw = blockIdx.x * 8 + wave, NGW = gridDim.x * 8;
    LAS float* scr = (LAS float*)(lds + wave * 8448);
    const float* win = p->in[I_WIN] + (size_t)l * D * D_IN; const float* wbr = p->in[I_WBR] + (size_t)l * OC * D; const float* wo = p->in[I_WOUT] + (size_t)l * D * D;
    bf16_t* WIN = (bf16_t*)(p->ws + WS_WIN); bf16_t* WB = (bf16_t*)(p->ws + WS_WB); bf16_t* WO = (bf16_t*)(p->ws + WS_WO);
    const int n1 = tr_nitems(D, D_IN), n2 = tr_nitems(OC, D), n3 = tr_nitems(D, D);
    for (int it = gw; it < n1 + n2 + n3; it += NGW) {
        int r = it;
        if (r < n1) { tr_item(win, D, D_IN, WIN, D, 1, 0, scr, r, lane); continue; } r -= n1;
        if (r < n2) { tr_item(wbr, OC, D, WB, OC, 0, 0, scr, r, lane); continue; } r -= n2;
        tr_item(wo, D, D, WO, D, 0, 0, scr, r, lane);
    }
    if (l == 0) { bf16_t* XB = (bf16_t*)(p->ws + WS_XB); for (int m = gw; m < T; m += NGW) row_to_bf16(p->in[I_X] + (size_t)m * D, XB + (size_t)m * D, lane); }
}

struct SchedInproj {
    static constexpr int PERM = 1;
    const char* A; const char* B; int G, c;
    __device__ __forceinline__ bool next(int i, mg::Unit& u) const {
        int pm, pn; if (!mg::static_tile(i, G, c, T / 256, NPM / 256, pm, pn)) return false;
        u.A = A + (size_t)pm * 256 * 2048; u.B = B + (size_t)pn * 256 * 2048; u.ld = 2048; u.nt = 16; u.pm = pm; u.pn = pn; u.tag = 0; return true;
    }
};
struct EpiBf16Store {
    bf16_t* O; int ldo;
    __device__ __forceinline__ void operator()(const AccT& acc, const mg::Unit& u, int wr, int wc, int fr, int fq, int) const {
        const int row0 = u.pm * 256 + wr * 64 + fr, col0 = u.pn * 256 + wc * 32 + 8 * fq;
#pragma unroll
        for (int ai = 0; ai < 2; ++ai)
#pragma unroll
            for (int m = 0; m < 4; ++m) { bf16_t* rowp = O + (size_t)(row0 + ai * 128 + m * 16) * ldo + col0;
#pragma unroll
                for (int bj = 0; bj < 2; ++bj) { const f32x4 v0 = acc[ai][bj][m][0], v1 = acc[ai][bj][m][1];
                    u32x4 w; w.x = pk2(v0[0], v0[1]); w.y = pk2(v0[2], v0[3]); w.z = pk2(v1[0], v1[1]); w.w = pk2(v1[2], v1[3]);
                    *(u32x4*)(rowp + bj * 128) = w; } }
    }
};
__device__ __forceinline__ void ph_inproj(KP p, int l, LAS unsigned char* lds) {
    SchedInproj S{(const char*)(p->ws + WS_XB), (const char*)(p->ws + WS_WIN), (int)gridDim.x, (int)blockIdx.x};
    EpiBf16Store E{(bf16_t*)(p->ws + WS_PMIX), NPM};
    mg::gemm_run(lds, S, E);
}

__device__ __forceinline__ void ph_prep(KP p, int l, LAS unsigned char* lds) {
    const int tid = my_tid(), lane = tid & 63, wave = tid >> 6;
    const bf16_t* P = (const bf16_t*)(p->ws + WS_PMIX);
    if (blockIdx.x < 8 && wave < 4) {
        const int b = blockIdx.x, h = wave; const float fb = p->in[I_FB][l * 4 + h];
        float v[32]; float s = 0.f;
#pragma unroll
        for (int i = 0; i < 32; ++i) { const int t = 32 * lane + i; const float x = bf2f(P[(size_t)(b * SEQ + t) * NPM + C_FLOG + h]) + fb;
            const float ls = fminf(x, 0.f) - log1pf(__expf(-fabsf(x))); s += ls; v[i] = s; }
        float incl = s;
#pragma unroll
        for (int o = 1; o < 64; o <<= 1) { const float n = __shfl_up(incl, o); if (lane >= o) incl += n; }
        const float excl = incl - s; float* C = (float*)(p->ws + WS_FOXC) + (size_t)(b * 4 + h) * SEQ + 32 * lane;
#pragma unroll
        for (int i = 0; i < 32; ++i) C[i] = v[i] + excl;
    }
    LAS float* ps = (LAS float*)lds;
    const float* mu = p->in[I_MU] + l * 1024; const float* w0 = p->in[I_W0] + l * 256; const float* wup = p->in[I_WUP] + (size_t)l * 64 * 256;
    const float* a0 = p->in[I_A0] + l * 256; const float* aup = p->in[I_AUP] + (size_t)l * 64 * 256; const float* gup = p->in[I_GUP] + (size_t)l * 128 * 256;
    const float* kkw = p->in[I_KK] + l * 256; const float* kaw = p->in[I_KA] + l * 256; const float* rk = p->in[I_RK] + l * 256;
    float* RWr = (float*)(p->ws + WS_RW); float* RWw = RWr + (size_t)T * 256; float* RWk = RWw + (size_t)T * 256; float* RWkk = RWk + (size_t)T * 256;
    float* RWkka = RWkk + (size_t)T * 256; float* RWv = RWkka + (size_t)T * 256; float* RWg = RWv + (size_t)T * 256; float* BON = (float*)(p->ws + WS_BONUS);
    for (int it = blockIdx.x; it < T / 16; it += gridDim.x) {
        const int t0 = it * 16;
#pragma unroll
        for (int c4 = 0; c4 < 4; ++c4) { const int id = tid + 512 * c4, tt = id >> 7, ch = (id & 127) * 8, t = t0 + tt;
            const u32x4 cu = *(const u32x4*)(P + (size_t)t * NPM + C_RW + ch);
            u32x4 pv = (u32x4){0u, 0u, 0u, 0u}; if ((t & (SEQ - 1)) != 0) pv = *(const u32x4*)(P + (size_t)(t - 1) * NPM + C_RW + ch);
            float a[8], b[8]; unpack8(cu, a); unpack8(pv, b);
            const f32x4 m0 = *(const f32x4*)(mu + ch), m1 = *(const f32x4*)(mu + ch + 4); const float mm[8] = {m0.x, m0.y, m0.z, m0.w, m1.x, m1.y, m1.z, m1.w};
#pragma unroll
            for (int j = 0; j < 8; ++j) { float x = a[j] + mm[j] * (b[j] - a[j]); if (ch >= 768 && ch < 832) x = tanhf(x); else if (ch >= 896) x = sigm(x); a[j] = x; }
            *(LAS f32x4*)(ps + tt * 1024 + ch) = (f32x4){a[0], a[1], a[2], a[3]}; *(LAS f32x4*)(ps + tt * 1024 + ch + 4) = (f32x4){a[4], a[5], a[6], a[7]}; }
        __syncthreads();
        const int c = tid & 255, half = tid >> 8; const LAS float* pt = ps + (8 * half) * 1024;
        float aw[8], aa[8], ag[8];
#pragma unroll
        for (int i = 0; i < 8; ++i) { aw[i] = 0.f; aa[i] = 0.f; ag[i] = 0.f; }
#pragma unroll 8
        for (int j = 0; j < 64; ++j) { const float wu = wup[j * 256 + c], au = aup[j * 256 + c];
#pragma unroll
            for (int i = 0; i < 8; ++i) { aw[i] += pt[i * 1024 + 768 + j] * wu; aa[i] += pt[i * 1024 + 832 + j] * au; } }
#pragma unroll 8
        for (int j = 0; j < 128; ++j) { const float gu = gup[j * 256 + c];
#pragma unroll
            for (int i = 0; i < 8; ++i) ag[i] += pt[i * 1024 + 896 + j] * gu; }
        const float w0c = w0[c], a0c = a0[c], kkc = kkw[c], kac = kaw[c], rkc = rk[c];
#pragma unroll
        for (int i = 0; i < 8; ++i) { const int t = t0 + 8 * half + i; const size_t o = (size_t)t * 256 + c;
            const float r = pt[i * 1024 + c], k = pt[i * 1024 + 256 + c], v = pt[i * 1024 + 512 + c];
            const float w = __expf(-sigm(w0c + aw[i]) * 0.60653065971f), a = sigm(a0c + aa[i]);
            float kk = k * kkc; const float ss = wave_sum(kk * kk); kk *= rsqrtf(ss + 1e-12f);
            const float k2 = k * (1.f + (a - 1.f) * kac); const float bon = wave_sum(r * k2 * rkc);
            RWr[o] = r; RWw[o] = w; RWk[o] = k2; RWv[o] = v; RWkk[o] = kk; RWkka[o] = kk * a; RWg[o] = ag[i];
            if (lane == 0) BON[t * 4 + (c >> 6)] = bon; }
        __syncthreads();
    }
}

template <int CTRL, int ROWM, int BANKM> __device__ __forceinline__ float dpp_add(float acc, float src) {
    return acc + __int_as_float(__builtin_amdgcn_update_dpp(0, __float_as_int(src), CTRL, ROWM, BANKM, true));
}
__device__ __forceinline__ float wave_sum_s(float v) {
    float a = v;
    a = dpp_add<0x111, 0xf, 0xf>(a, v); a = dpp_add<0x112, 0xf, 0xf>(a, v); a = dpp_add<0x113, 0xf, 0xf>(a, v);
    a = dpp_add<0x114, 0xf, 0xe>(a, a); a = dpp_add<0x118, 0xf, 0xc>(a, a);
    a = dpp_add<0x142, 0xa, 0xf>(a, a); a = dpp_add<0x143, 0xc, 0xf>(a, a);
    return __int_as_float(__builtin_amdgcn_readlane(__float_as_int(a), 63));
}
typedef float f32x16 __attribute__((ext_vector_type(16)));
constexpr int KT_PITCH = 144, VT_PITCH = 136;
constexpr int AT_K_BYTES = 64 * KT_PITCH, AT_V_BYTES = 64 * VT_PITCH, AT_TILE_BYTES = AT_K_BYTES + AT_V_BYTES + 256;
constexpr float LOG2E = 1.4426950408889634f;
constexpr float NEGBIG = -1e30f;
__device__ __forceinline__ int crow(int reg, int h) { return (reg & 3) + 8 * (reg >> 2) + 4 * h; }
__device__ __forceinline__ unsigned fkey(float f) { const unsigned u = __float_as_uint(f); return (u & 0x80000000u) ? ~u : (u | 0x80000000u); }

__device__ __forceinline__ void at_stage(LAS unsigned char* tile, const bf16_t* Krows, const bf16_t* Vrows, int tid) {
    { const int row = tid >> 3, ch = tid & 7; const u32x4 v = *(const u32x4*)(Krows + (size_t)row * NPM + 8 * ch); *(LAS u32x4*)(tile + row * KT_PITCH + ch * 16) = v; }
    { const int kv = tid & 63, dch = tid >> 6; const u32x4 v = *(const u32x4*)(Vrows + (size_t)kv * NPM + 8 * dch);
      LAS bf16_t* vt = (LAS bf16_t*)(tile + AT_K_BYTES + (8 * dch) * VT_PITCH) + kv; constexpr int P2 = VT_PITCH / 2;
      vt[0 * P2] = (bf16_t)(v.x & 0xffffu); vt[1 * P2] = (bf16_t)(v.x >> 16); vt[2 * P2] = (bf16_t)(v.y & 0xffffu); vt[3 * P2] = (bf16_t)(v.y >> 16);
      vt[4 * P2] = (bf16_t)(v.z & 0xffffu); vt[5 * P2] = (bf16_t)(v.z >> 16); vt[6 * P2] = (bf16_t)(v.w & 0xffffu); vt[7 * P2] = (bf16_t)(v.w >> 16); }
}
__device__ __forceinline__ void at_qk(f32x16& p0, f32x16& p1, const LAS unsigned char* Kt, const bf16x8 (&qr)[4], int r, int h) {
#pragma unroll
    for (int i = 0; i < 16; ++i) { p0[i] = 0.f; p1[i] = 0.f; }
#pragma unroll
    for (int ds = 0; ds < 4; ++ds) {
        const bf16x8 a0 = *(const LAS bf16x8*)(Kt + r * KT_PITCH + (16 * ds + 8 * h) * 2);
        const bf16x8 a1 = *(const LAS bf16x8*)(Kt + (32 + r) * KT_PITCH + (16 * ds + 8 * h) * 2);
        p0 = __builtin_amdgcn_mfma_f32_32x32x16_bf16(a0, qr[ds], p0, 0, 0, 0);
        p1 = __builtin_amdgcn_mfma_f32_32x32x16_bf16(a1, qr[ds], p1, 0, 0, 0);
    }
}
__device__ __forceinline__ void at_pv(f32x16 (&o)[2], const LAS unsigned char* Vt, const bf16x8 (&pk)[4], int r, int h) {
#pragma unroll
    for (int dh = 0; dh < 2; ++dh)
#pragma unroll
        for (int ks = 0; ks < 4; ++ks) { const LAS unsigned char* bp = Vt + (32 * dh + r) * VT_PITCH + (16 * ks + 4 * h) * 2;
            const u32x2 lo = *(const LAS u32x2*)bp, hi = *(const LAS u32x2*)(bp + 16);
            const u32x4 av = (u32x4){lo.x, lo.y, hi.x, hi.y};
            o[dh] = __builtin_amdgcn_mfma_f32_32x32x16_bf16(__builtin_bit_cast(bf16x8, av), pk[ks], o[dh], 0, 0, 0); }
}
template <bool BIAS, bool MASK, bool DSAM = false>
__device__ __forceinline__ void at_softmax(f32x16& p0, f32x16& p1, float& m, float& l, f32x16 (&o)[2], bf16x8 (&pk)[4], float sc2, const LAS float* bias2, int kmax, int h, unsigned mb = 0u) {
    float mt = NEGBIG;
#pragma unroll
    for (int g = 0; g < 4; ++g) {
        f32x4 b0 = (f32x4){0.f, 0.f, 0.f, 0.f}, b1 = b0;
        if (BIAS) { b0 = *(const LAS f32x4*)(bias2 + 8 * g + 4 * h); b1 = *(const LAS f32x4*)(bias2 + 32 + 8 * g + 4 * h); }
#pragma unroll
        for (int j = 0; j < 4; ++j) { const int reg = 4 * g + j, kv = 8 * g + 4 * h + j;
            float x0 = p0[reg] * sc2 + b0[j], x1 = p1[reg] * sc2 + b1[j];
            if (MASK) { if (kv > kmax) x0 = NEGBIG; if (kv + 32 > kmax) x1 = NEGBIG; }
            if (DSAM) { if (!((mb >> reg) & 1u)) x0 = NEGBIG; if (!((mb >> (16 + reg)) & 1u)) x1 = NEGBIG; }
            p0[reg] = x0; p1[reg] = x1; mt = fmaxf(mt, fmaxf(x0, x1)); }
    }
    mt = fmaxf(mt, __shfl_xor(mt, 32));
    const float mn = fmaxf(m, mt);
    if (__any(mn > m)) { const float al = __builtin_amdgcn_exp2f(m - mn); l *= al;
#pragma unroll
        for (int i = 0; i < 16; ++i) { o[0][i] *= al; o[1][i] *= al; }
        m = mn; }
    float s = 0.f;
#pragma unroll
    for (int i = 0; i < 16; ++i) { const float e0 = (p0[i] > -1e29f) ? __builtin_amdgcn_exp2f(p0[i] - m) : 0.f, e1 = (p1[i] > -1e29f) ? __builtin_amdgcn_exp2f(p1[i] - m) : 0.f; p0[i] = e0; p1[i] = e1; s += e0 + e1; }
    l += s;
#pragma unroll
    for (int ks = 0; ks < 2; ++ks) { u32x4 w0, w1;
        w0.x = pk2(p0[8 * ks + 0], p0[8 * ks + 1]); w0.y = pk2(p0[8 * ks + 2], p0[8 * ks + 3]); w0.z = pk2(p0[8 * ks + 4], p0[8 * ks + 5]); w0.w = pk2(p0[8 * ks + 6], p0[8 * ks + 7]);
        w1.x = pk2(p1[8 * ks + 0], p1[8 * ks + 1]); w1.y = pk2(p1[8 * ks + 2], p1[8 * ks + 3]); w1.z = pk2(p1[8 * ks + 4], p1[8 * ks + 5]); w1.w = pk2(p1[8 * ks + 6], p1[8 * ks + 7]);
        pk[ks] = __builtin_bit_cast(bf16x8, w0); pk[2 + ks] = __builtin_bit_cast(bf16x8, w1); }
}
__device__ __forceinline__ void at_loadq(bf16x8 (&qr)[4], const bf16_t* qrow, int h) {
#pragma unroll
    for (int ds = 0; ds < 4; ++ds) qr[ds] = *(const bf16x8*)(qrow + 16 * ds + 8 * h);
}
__device__ __forceinline__ void at_store(bf16_t* orow, const f32x16 (&o)[2], float inv, int h) {
#pragma unroll
    for (int dh = 0; dh < 2; ++dh)
#pragma unroll
        for (int g = 0; g < 4; ++g) { u32x2 w; w.x = pk2(o[dh][4 * g] * inv, o[dh][4 * g + 1] * inv); w.y = pk2(o[dh][4 * g + 2] * inv, o[dh][4 * g + 3] * inv);
            *(u32x2*)(orow + 32 * dh + 8 * g + 4 * h) = w; }
}

__device__ __forceinline__ void fox_unit(KP p, int bh, int qb, LAS unsigned char* lds) {
    const int tid = my_tid(), lane = tid & 63, wave = tid >> 6, r = lane & 31, h = lane >> 5, wv = wave & 3, g = wave >> 2;
    const int b = bh >> 2, hd = bh & 3;
    const bf16_t* P = (const bf16_t*)(p->ws + WS_PMIX) + (size_t)b * SEQ * NPM; bf16_t* OCT = (bf16_t*)(p->ws + WS_OCAT); const float* FC = (const float*)(p->ws + WS_FOXC) + (size_t)bh * SEQ;
    const int q0 = 128 * qb, qbase = q0 + 32 * wv; const float cref = FC[q0];
    bf16x8 qr[4]; at_loadq(qr, P + (size_t)(qbase + r) * NPM + C_FOX_Q + hd * 64, h);
    f32x16 o[2]; float m = NEGBIG, l = 0.f;
#pragma unroll
    for (int i = 0; i < 16; ++i) { o[0][i] = 0.f; o[1][i] = 0.f; }
#pragma unroll 1
    for (int st = 0; st <= qb; ++st) {
        __syncthreads();
#pragma unroll
        for (int x = 0; x < 2; ++x) { const int k0 = 64 * (2 * st + x); LAS unsigned char* tile = lds + x * AT_TILE_BYTES;
            at_stage(tile, P + (size_t)k0 * NPM + C_FOX_K + hd * 64, P + (size_t)k0 * NPM + C_FOX_V + hd * 64, tid);
            if (tid < 64) ((LAS float*)(tile + AT_K_BYTES + AT_V_BYTES))[tid] = (cref - FC[k0 + tid]) * LOG2E; }
        __syncthreads();
        const int k0 = 64 * (2 * st + g); const LAS unsigned char* tile = lds + g * AT_TILE_BYTES;
        if (k0 <= qbase + 31) {
            f32x16 p0, p1; bf16x8 pk[4];
            at_qk(p0, p1, tile, qr, r, h);
            const LAS float* b2 = (const LAS float*)(tile + AT_K_BYTES + AT_V_BYTES);
            if (k0 + 63 > qbase) at_softmax<true, true>(p0, p1, m, l, o, pk, 0.125f * LOG2E, b2, qbase + r - k0, h);
            else at_softmax<true, false>(p0, p1, m, l, o, pk, 0.125f * LOG2E, b2, 0, h);
            at_pv(o, tile + AT_K_BYTES, pk, r, h);
        }
    }
    __syncthreads();
    LAS float* cb = (LAS float*)lds + (size_t)wv * (34 * 64);
    if (g == 1) { cb[lane] = m; cb[64 + lane] = l;
#pragma unroll
        for (int i = 0; i < 16; ++i) { cb[(2 + i) * 64 + lane] = o[0][i]; cb[(18 + i) * 64 + lane] = o[1][i]; } }
    __syncthreads();
    if (g == 0) { const float mb = cb[lane], lb = cb[64 + lane]; const float M = fmaxf(m, mb), sa = __builtin_amdgcn_exp2f(m - M), sb = __builtin_amdgcn_exp2f(mb - M);
        l = l * sa + lb * sb;
#pragma unroll
        for (int i = 0; i < 16; ++i) { o[0][i] = o[0][i] * sa + cb[(2 + i) * 64 + lane] * sb; o[1][i] = o[1][i] * sa + cb[(18 + i) * 64 + lane] * sb; }
        const float lt = l + __shfl_xor(l, 32);
        at_store(OCT + (size_t)(b * SEQ + qbase + r) * OC + 768 + hd * 64, o, 1.f / lt, h); }
}
__device__ __forceinline__ void swa_unit(KP p, int l_, int item, LAS unsigned char* lds) {
    const int tid = my_tid(), lane = tid & 63, wave = tid >> 6, r = lane & 31, h = lane >> 5;
    const int hk = item & 1, c = (item >> 1) & 31, b = item >> 6, head = hk * 4 + (wave >> 1), qpos = c * 64 + 32 * (wave & 1);
    const bf16_t* P = (const bf16_t*)(p->ws + WS_PMIX) + (size_t)b * SEQ * NPM; bf16_t* OCT = (bf16_t*)(p->ws + WS_OCAT);
    bf16x8 qr[4]; at_loadq(qr, P + (size_t)(qpos + r) * NPM + C_SWA_Q + head * 64, h);
    f32x16 o[2]; float m = p->in[I_SINKS][l_ * 8 + head] * LOG2E, l = (h == 0) ? 1.f : 0.f;
#pragma unroll
    for (int i = 0; i < 16; ++i) { o[0][i] = 0.f; o[1][i] = 0.f; }
    const int nch = (c + 1 < 3) ? (c + 1) : 3;
#pragma unroll 1
    for (int st = 0; st < nch; ++st) {
        const int k0 = 64 * (c - nch + 1 + st);
        __syncthreads();
        at_stage(lds, P + (size_t)k0 * NPM + C_SWA_K + hk * 64, P + (size_t)k0 * NPM + C_SWA_V + hk * 64, tid);
        __syncthreads();
        f32x16 p0, p1; bf16x8 pk[4];
        at_qk(p0, p1, lds, qr, r, h);
        at_softmax<false, false>(p0, p1, m, l, o, pk, 0.125f * LOG2E, nullptr, 0, h);
        at_pv(o, lds + AT_K_BYTES, pk, r, h);
    }
    const float lt = l + __shfl_xor(l, 32);
    at_store(OCT + (size_t)(b * SEQ + qpos + r) * OC + head * 64, o, 1.f / lt, h);
}

__device__ __forceinline__ size_t dsa_chunk_off(int b, int c) { return (size_t)b * (4096 * 528) + (size_t)4096 * (c * (c + 1) / 2); }
__device__ __forceinline__ void dsa_scores(KP p, LAS unsigned char* lds) {
    const int tid = my_tid(), lane = tid & 63, wave = tid >> 6, r = lane & 31, h = lane >> 5;
    const bf16_t* Pm = (const bf16_t*)(p->ws + WS_PMIX); float* SCR = (float*)(p->ws + WS_SCORES);
    LAS float* tb = (LAS float*)(lds + wave * (32 * 36 * 4));
    const int gw = blockIdx.x * 8 + wave, NGW = gridDim.x * 8;
    constexpr int PERB = 1036;
    for (int it = gw; it < NB * PERB; it += NGW) {
        const int b = it / PERB; int rem = it % PERB; const int qh = rem & 1; rem >>= 1;
        int c = 4; { int acc = 0; while (rem >= acc + c + 1) { acc += c + 1; ++c; } rem -= acc; } const int kb = rem;
        const bf16_t* Pb = Pm + (size_t)b * SEQ * NPM; const int qbase = c * 64 + 32 * qh;
        const bf16_t* qrow = Pb + (size_t)(qbase + r) * NPM;
        float wq[4];
#pragma unroll
        for (int hh = 0; hh < 4; ++hh) wq[hh] = bf2f(qrow[C_WIDX + hh]) * 0.0625f;
        float* dst = SCR + dsa_chunk_off(b, c) + (size_t)(32 * qh) * (64 * (c + 1)) + 64 * kb;
#pragma unroll 1
        for (int kh = 0; kh < 2; ++kh) {
            const bf16_t* krow = Pb + (size_t)(64 * kb + 32 * kh + r) * NPM + C_DSA_KI;
            bf16x8 kf[4];
#pragma unroll
            for (int ds = 0; ds < 4; ++ds) kf[ds] = *(const bf16x8*)(krow + 16 * ds + 8 * h);
            f32x16 sc;
#pragma unroll
            for (int i = 0; i < 16; ++i) sc[i] = 0.f;
#pragma unroll
            for (int hh = 0; hh < 4; ++hh) { f32x16 a;
#pragma unroll
                for (int i = 0; i < 16; ++i) a[i] = 0.f;
#pragma unroll
                for (int ds = 0; ds < 4; ++ds) { const bf16x8 qf = *(const bf16x8*)(qrow + C_DSA_QI + hh * 64 + 16 * ds + 8 * h); a = __builtin_amdgcn_mfma_f32_32x32x16_bf16(kf[ds], qf, a, 0, 0, 0); }
#pragma unroll
                for (int i = 0; i < 16; ++i) sc[i] += fmaxf(a[i], 0.f) * wq[hh]; }
#pragma unroll
            for (int g = 0; g < 4; ++g) *(LAS f32x4*)(tb + r * 36 + 8 * g + 4 * h) = (f32x4){sc[4 * g] + 0.f, sc[4 * g + 1] + 0.f, sc[4 * g + 2] + 0.f, sc[4 * g + 3] + 0.f};
            LDS_FENCE();
#pragma unroll
            for (int i = 0; i < 4; ++i) { const int q = 8 * i + (lane >> 3), cc = (lane & 7) * 4; const f32x4 v = *(const LAS f32x4*)(tb + q * 36 + cc);
                *(f32x4*)(dst + (size_t)q * (64 * (c + 1)) + 32 * kh + cc) = v; }
            LDS_FENCE();
        }
    }
}
__device__ __forceinline__ void dsa_select(KP p) {
    const int tid = my_tid(), lane0 = tid & 63, wave = tid >> 6, gw = blockIdx.x * 8 + wave, NGW = gridDim.x * 8;
    unsigned* THRG = (unsigned*)(p->ws + WS_THR); int* CUTG = (int*)(p->ws + WS_THR) + T;
#pragma unroll 1
    for (int it = gw; it < NB * 28 * 64; it += NGW) {
        int lane = lane0; asm volatile("" : "+v"(lane));
        const int b = it / (28 * 64), rem = it % (28 * 64), c = 4 + (rem >> 6), ql = rem & 63, nadm = 64 * (c + 1);
        const float* srow = (const float*)(p->ws + WS_SCORES) + dsa_chunk_off(b, c) + (size_t)ql * nadm;
        unsigned key[32];
#pragma unroll
        for (int i = 0; i < 32; ++i) { const int kv = 64 * i + lane; const float sv = (kv < nadm) ? srow[kv] : 0.f; key[i] = (kv < nadm) ? fkey(sv + 0.f) : 0u; }
        unsigned Tk = 0u;
#pragma unroll 1
        for (int bit = 31; bit >= 0; --bit) { const unsigned cand = Tk | (1u << bit); int cl = 0;
#pragma unroll
            for (int i = 0; i < 32; ++i) cl += (key[i] >= cand) ? 1 : 0;
            const int cnt = (int)wave_sum_s((float)cl);
            if (cnt >= 256) Tk = cand; }
        int cgl = 0, ntl = 0, mxl = -1;
#pragma unroll
        for (int i = 0; i < 32; ++i) { cgl += (key[i] > Tk) ? 1 : 0; if (key[i] == Tk) { ++ntl; mxl = 64 * i + lane; } }
        const int quota = 256 - (int)wave_sum_s((float)cgl), nt = (int)wave_sum_s((float)ntl);
        int cut = (int)wave_max((float)mxl);
        if (nt > quota) {
            int ck = 0;
#pragma unroll 1
            for (int bit = 10; bit >= 0; --bit) { const int cand = ck | (1 << bit); int cl = 0;
#pragma unroll
                for (int i = 0; i < 32; ++i) cl += (key[i] == Tk && 64 * i + lane < cand) ? 1 : 0;
                if ((int)wave_sum_s((float)cl) < quota) ck = cand; }
            cut = ck;
        }
        if (lane == 0) { THRG[b * SEQ + c * 64 + ql] = Tk; CUTG[b * SEQ + c * 64 + ql] = cut; }
    }
}
__device__ __forceinline__ void dsa_unit(KP p, int b, int c, int hp, LAS unsigned char* lds) {
    const int tid = my_tid(), lane = tid & 63, wave = tid >> 6, r = lane & 31, h = lane >> 5, wv = wave & 3, g = wave >> 2;
    const bf16_t* P = (const bf16_t*)(p->ws + WS_PMIX) + (size_t)b * SEQ * NPM; bf16_t* OCT = (bf16_t*)(p->ws + WS_OCAT);
    const int nadm = 64 * (c + 1);
    const float* SCRc = (const float*)(p->ws + WS_SCORES) + dsa_chunk_off(b, c);
    const bool sel = nadm > 256;
    const int head = 2 * hp + (wv >> 1), ql = 32 * (wv & 1) + r, qbase = 64 * c + 32 * (wv & 1);
    const unsigned thr = sel ? ((const unsigned*)(p->ws + WS_THR))[b * SEQ + c * 64 + ql] : 0u; const int cut = sel ? ((const int*)(p->ws + WS_THR))[T + b * SEQ + c * 64 + ql] : 0;
    const float* srow = SCRc + (size_t)ql * nadm;
    bf16x8 qr[4]; at_loadq(qr, P + (size_t)(qbase + r) * NPM + C_DSA_Q + head * 64, h);
    f32x16 o[2]; float m = NEGBIG, l = 0.f;
#pragma unroll
    for (int i = 0; i < 16; ++i) { o[0][i] = 0.f; o[1][i] = 0.f; }
    const int nst = (c + 2) >> 1;
#pragma unroll 1
    for (int st = 0; st < nst; ++st) {
        __syncthreads();
#pragma unroll
        for (int x = 0; x < 2; ++x) { const int jt = 2 * st + x; if (jt <= c) at_stage(lds + x * AT_TILE_BYTES, P + (size_t)(64 * jt) * NPM + C_DSA_K, P + (size_t)(64 * jt) * NPM + C_DSA_V, tid); }
        __syncthreads();
        const int jt = 2 * st + g; const LAS unsigned char* tile = lds + g * AT_TILE_BYTES;
        if (jt <= c) {
            unsigned mb = 0u;
            if (sel) { const int cutrel = cut - 64 * jt;
#pragma unroll
                for (int kvh = 0; kvh < 2; ++kvh)
#pragma unroll
                    for (int gg = 0; gg < 4; ++gg) { const f32x4 sv = *(const f32x4*)(srow + 64 * jt + 32 * kvh + 8 * gg + 4 * h);
#pragma unroll
                        for (int j = 0; j < 4; ++j) { const unsigned kq = fkey(sv[j] + 0.f); const int kv = 32 * kvh + 8 * gg + 4 * h + j;
                            if ((kq > thr) || (kq == thr && kv <= cutrel)) mb |= 1u << (16 * kvh + 4 * gg + j); } }
            }
            f32x16 p0, p1; bf16x8 pk[4];
            at_qk(p0, p1, tile, qr, r, h);
            if (sel) at_softmax<false, false, true>(p0, p1, m, l, o, pk, 0.125f * LOG2E, nullptr, 0, h, mb);
            else at_softmax<false, false>(p0, p1, m, l, o, pk, 0.125f * LOG2E, nullptr, 0, h);
            at_pv(o, tile + AT_K_BYTES, pk, r, h);
        }
    }
    __syncthreads();
    LAS float* cb = (LAS float*)lds + (size_t)wv * (34 * 64);
    if (g == 1) { cb[lane] = m; cb[64 + lane] = l;
#pragma unroll
        for (int i = 0; i < 16; ++i) { cb[(2 + i) * 64 + lane] = o[0][i]; cb[(18 + i) * 64 + lane] = o[1][i]; } }
    __syncthreads();
    if (g == 0) { const float mb = cb[lane], lb = cb[64 + lane]; const float M = fmaxf(m, mb), sa = __builtin_amdgcn_exp2f(m - M), sb = __builtin_amdgcn_exp2f(mb - M);
        l = l * sa + lb * sb;
#pragma unroll
        for (int i = 0; i < 16; ++i) { o[0][i] = o[0][i] * sa + cb[(2 + i) * 64 + lane] * sb; o[1][i] = o[1][i] * sa + cb[(18 + i) * 64 + lane] * sb; }
        const float lt = l + __shfl_xor(l, 32);
        at_store(OCT + (size_t)(b * SEQ + qbase + r) * OC + 1024 + head * 64, o, 1.f / lt, h); }
}

template <int N> __device__ __forceinline__ float dpp_ror(float x) { return __int_as_float(__builtin_amdgcn_update_dpp(0, __float_as_int(x), 0x120 + N, 0xf, 0xf, false)); }
__device__ __forceinline__ void row16_sum2(float& a, float& b) {
    a += dpp_ror<8>(a); b += dpp_ror<8>(b); a += dpp_ror<4>(a); b += dpp_ror<4>(b); a += dpp_ror<2>(a); b += dpp_ror<2>(b); a += dpp_ror<1>(a); b += dpp_ror<1>(b);
}
__device__ __forceinline__ float row16_sum(float x) { x += dpp_ror<8>(x); x += dpp_ror<4>(x); x += dpp_ror<2>(x); x += dpp_ror<1>(x); return x; }
__device__ __forceinline__ void rwkv_scan2(KP p, int l, LAS unsigned char* lds) {
    const int tid = my_tid(), lane = tid & 63, wave = tid >> 6; const int bh = blockIdx.x >> 3, b = bh >> 2, h = bh & 3, rowbase = 8 * (blockIdx.x & 7);
    const int rl = lane >> 4, c = lane & 15, r8 = 4 * (wave & 1) + rl;
    const float* RW = (const float*)(p->ws + WS_RW);
    const float* RWv = RW + (size_t)5 * T * 256; float* Y = (float*)(p->ws + WS_Y);
    LAS float* L = (LAS float*)lds;
    LAS float* Lv = L + 5 * 1024; LAS float* Ly = Lv + 128;
    f32x4 S = (f32x4){0.f, 0.f, 0.f, 0.f}, rprev = (f32x4){0.f, 0.f, 0.f, 0.f};
    const size_t hb = (size_t)b * SEQ * 256 + h * 64;
    f32x2 pre[5]; float vpre = 0.f;
#pragma unroll
    for (int a = 0; a < 5; ++a) { const int e = 2 * tid; pre[a] = *(const f32x2*)(RW + (size_t)a * T * 256 + hb + (size_t)(e >> 6) * 256 + (e & 63)); }
    if (tid < 128) vpre = RWv[hb + (size_t)(tid >> 3) * 256 + rowbase + (tid & 7)];
#pragma unroll 1
    for (int tb = 0; tb < SEQ; tb += 16) {
        __syncthreads();
        if (tb > 0 && tid < 128) { const int st = tb - 17 + (tid >> 3); if (st >= 0) Y[hb + (size_t)st * 256 + rowbase + (tid & 7)] = Ly[tid]; }
#pragma unroll
        for (int a = 0; a < 5; ++a) *(LAS f32x2*)(L + a * 1024 + 2 * tid) = pre[a];
        if (tid < 128) Lv[tid] = vpre;
        __syncthreads();
        if (tb + 16 < SEQ) {
#pragma unroll
            for (int a = 0; a < 5; ++a) { const int e = 2 * tid; pre[a] = *(const f32x2*)(RW + (size_t)a * T * 256 + hb + (size_t)(tb + 16 + (e >> 6)) * 256 + (e & 63)); }
            if (tid < 128) vpre = RWv[hb + (size_t)(tb + 16 + (tid >> 3)) * 256 + rowbase + (tid & 7)];
        }
        if (wave < 2) {
            f32x4 r_ = *(const LAS f32x4*)(L + 0 * 1024 + 4 * c), w_ = *(const LAS f32x4*)(L + 1 * 1024 + 4 * c), k_ = *(const LAS f32x4*)(L + 2 * 1024 + 4 * c);
            f32x4 kk_ = *(const LAS f32x4*)(L + 3 * 1024 + 4 * c), ka_ = *(const LAS f32x4*)(L + 4 * 1024 + 4 * c); float v_ = Lv[r8];
#pragma unroll
            for (int i = 0; i < 16; ++i) {
                f32x4 rn = r_, wn = w_, kn = k_, kkn = kk_, kan = ka_; float vn = v_;
                if (i < 15) { rn = *(const LAS f32x4*)(L + 0 * 1024 + (i + 1) * 64 + 4 * c); wn = *(const LAS f32x4*)(L + 1 * 1024 + (i + 1) * 64 + 4 * c); kn = *(const LAS f32x4*)(L + 2 * 1024 + (i + 1) * 64 + 4 * c);
                    kkn = *(const LAS f32x4*)(L + 3 * 1024 + (i + 1) * 64 + 4 * c); kan = *(const LAS f32x4*)(L + 4 * 1024 + (i + 1) * 64 + 4 * c); vn = Lv[(i + 1) * 8 + r8]; }
                float pa = (S.x * kk_.x + S.y * kk_.y) + (S.z * kk_.z + S.w * kk_.w);
                float py = (S.x * rprev.x + S.y * rprev.y) + (S.z * rprev.z + S.w * rprev.w);
                row16_sum2(pa, py);
                Ly[i * 8 + r8] = py;
                S = S * w_ - ka_ * pa + k_ * v_;
                rprev = r_;
                r_ = rn; w_ = wn; k_ = kn; kk_ = kkn; ka_ = kan; v_ = vn;
            }
        }
    }
    __syncthreads();
    if (tid < 128) { const int st = SEQ - 17 + (tid >> 3); Y[hb + (size_t)st * 256 + rowbase + (tid & 7)] = Ly[tid]; }
    if (wave < 2) { const float py = row16_sum((S.x * rprev.x + S.y * rprev.y) + (S.z * rprev.z + S.w * rprev.w)); if (c == 0) Y[hb + (size_t)(SEQ - 1) * 256 + rowbase + r8] = py; }
}
__device__ __forceinline__ void rwkv_post(KP p, int l) {
    const int tid = my_tid(), lane = tid & 63, wave = tid >> 6, gw = blockIdx.x * 8 + wave, NGW = gridDim.x * 8;
    const float* RW = (const float*)(p->ws + WS_RW); const float* RWv = RW + (size_t)5 * T * 256; const float* RWg = RW + (size_t)6 * T * 256;
    const float* Y = (const float*)(p->ws + WS_Y); const float* BON = (const float*)(p->ws + WS_BONUS); bf16_t* OCT = (bf16_t*)(p->ws + WS_OCAT);
    float gng[4], gnb[4];
#pragma unroll
    for (int hh = 0; hh < 4; ++hh) { gng[hh] = p->in[I_GNG][l * 256 + hh * 64 + lane]; gnb[hh] = p->in[I_GNB][l * 256 + hh * 64 + lane]; }
    for (int t = gw; t < T; t += NGW) {
#pragma unroll
        for (int hh = 0; hh < 4; ++hh) { const size_t o = (size_t)t * 256 + hh * 64 + lane; const float yy = Y[o];
            const float mean = wave_sum(yy) * (1.f / 64.f); const float d = yy - mean; const float var = wave_sum(d * d) * (1.f / 64.f);
            const float ov = (d * rsqrtf(var + 64e-5f) * gng[hh] + gnb[hh] + BON[t * 4 + hh] * RWv[o]) * RWg[o];
            OCT[(size_t)t * OC + 512 + hh * 64 + lane] = (bf16_t)f2bf(ov); }
    }
}

__device__ __forceinline__ void ph_scan(KP p, int l, LAS unsigned char* lds) { rwkv_scan2(p, l, lds); }
__device__ __forceinline__ void ph_attn(KP p, int l, LAS unsigned char* lds) {
    {
        const int w = blockIdx.x, bh = w >> 3, s = w & 7;
        fox_unit(p, bh, 15 - s, lds);
        __syncthreads();
        fox_unit(p, bh, s, lds);
        __syncthreads();
    }
    for (int it = blockIdx.x; it < 512; it += gridDim.x) { swa_unit(p, l, it, lds); __syncthreads(); }
    dsa_scores(p, lds);
    rwkv_post(p, l);
}
__device__ __forceinline__ void ph_dsa_xb(KP p, int l, LAS unsigned char* lds) {
    {
        const int w = blockIdx.x, b = w >> 5, s = (w >> 1) & 15, hp = w & 1;
        dsa_unit(p, b, 31 - s, hp, lds);
        __syncthreads();
        dsa_unit(p, b, s, hp, lds);
        __syncthreads();
    }
    const int tid = my_tid(), lane = tid & 63, wave = tid >> 6, gw = blockIdx.x * 8 + wave, NGW = gridDim.x * 8;
    const float* src = (l == 0) ? p->in[I_X] : p->out; bf16_t* XB = (bf16_t*)(p->ws + WS_XB2);
    for (int m = gw; m < T; m += NGW) row_to_bf16(src + (size_t)m * D, XB + (size_t)m * D, lane);
}

struct SchedMerge {
    static constexpr int PERM = 1;
    const char* XB; const char* WIN; const char* OCT; const char* WB; int G, c;
    __device__ __forceinline__ bool next(int i, mg::Unit& u) const {
        int pm, pn; if (!mg::static_tile(i >> 3, G, c, T / 256, 4, pm, pn)) return false;
        const int j = i & 7, br = j >> 1; u.pm = pm; u.pn = pn; u.tag = j;
        if ((j & 1) == 0) { u.A = XB + (size_t)pm * 256 * 2048; u.B = WIN + (size_t)(3328 + 1024 * br + 256 * pn) * 2048; u.ld = 2048; u.nt = 16; }
        else { const int koff = (br == 0) ? 0 : 256 + 256 * br, kk = (br == 0) ? 512 : 256;
            u.A = OCT + (size_t)pm * 256 * (OC * 2) + koff * 2; u.B = WB + (size_t)pn * 256 * (OC * 2) + koff * 2; u.ld = OC * 2; u.nt = kk / 64; }
        return true;
    }
};
struct EpiMerge {
    const float* gbias; f32x4* gsc; f32x4* macc; bf16_t* MB;
    __device__ __forceinline__ void operator()(const AccT& acc, const mg::Unit& u, int wr, int wc, int fr, int fq, int tid) const {
        const int br = u.tag >> 1; const int col0 = u.pn * 256 + wc * 32 + 8 * fq, row0 = u.pm * 256 + wr * 64 + fr;
        if ((u.tag & 1) == 0) {
            f32x4 bv[2][2];
#pragma unroll
            for (int bj = 0; bj < 2; ++bj)
#pragma unroll
                for (int n = 0; n < 2; ++n) bv[bj][n] = *(const f32x4*)(gbias + br * 1024 + col0 + bj * 128 + 4 * n);
#pragma unroll
            for (int ai = 0; ai < 2; ++ai)
#pragma unroll
                for (int m = 0; m < 4; ++m)
#pragma unroll
                    for (int bj = 0; bj < 2; ++bj)
#pragma unroll
                        for (int n = 0; n < 2; ++n) { const f32x4 x = acc[ai][bj][m][n] + bv[bj][n]; f32x4 g;
#pragma unroll
                            for (int j = 0; j < 4; ++j) g[j] = sigm(x[j]);
                            gsc[((((ai * 4 + m) * 2 + bj) * 2 + n) * 512) + tid] = g; asm volatile("" ::: "memory"); }
        } else {
#pragma unroll
            for (int ai = 0; ai < 2; ++ai)
#pragma unroll
                for (int m = 0; m < 4; ++m) { bf16_t* rowp = MB + (size_t)(row0 + ai * 128 + m * 16) * D + col0;
#pragma unroll
                    for (int bj = 0; bj < 2; ++bj) { f32x4 r[2];
#pragma unroll
                        for (int n = 0; n < 2; ++n) { const int idx = ((((ai * 4 + m) * 2 + bj) * 2 + n) * 512) + tid; const f32x4 g = gsc[idx]; f32x4 v = g * acc[ai][bj][m][n];
                            if (br > 0) v += macc[idx]; if (br < 3) macc[idx] = v; r[n] = v; }
                        if (br == 3) { u32x4 w; w.x = pk2(r[0][0], r[0][1]); w.y = pk2(r[0][2], r[0][3]); w.z = pk2(r[1][0], r[1][1]); w.w = pk2(r[1][2], r[1][3]); *(u32x4*)(rowp + bj * 128) = w; }
                        asm volatile("" ::: "memory"); } }
        }
    }
};
__device__ __forceinline__ void ph_merge(KP p, int l, LAS unsigned char* lds) {
    SchedMerge S{(const char*)(p->ws + WS_XB2), (const char*)(p->ws + WS_WIN), (const char*)(p->ws + WS_OCAT), (const char*)(p->ws + WS_WB), (int)gridDim.x, (int)blockIdx.x};
    EpiMerge E{p->in[I_GB] + (size_t)l * 4096, (f32x4*)(p->ws + WS_GSC) + (size_t)blockIdx.x * 16384, (f32x4*)(p->ws + WS_MACC) + (size_t)blockIdx.x * 16384, (bf16_t*)(p->ws + WS_MERGED)};
    mg::gemm_run(lds, S, E);
}

template <int PERM_, int NN, int K> struct SchedPlain {
    static constexpr int PERM = PERM_;
    const char* A; const char* B; int G, c;
    __device__ __forceinline__ bool next(int i, mg::Unit& u) const {
        int pm, pn; if (!mg::static_tile(i, G, c, T / 256, NN, pm, pn)) return false;
        u.A = A + (size_t)pm * 256 * K * 2; u.B = B + (size_t)pn * 256 * K * 2; u.ld = K * 2; u.nt = K / 64; u.pm = pm; u.pn = pn; u.tag = 0; return true;
    }
};
struct EpiResid {
    const float* base; float* out; float alpha;
    __device__ __forceinline__ void operator()(const AccT& acc, const mg::Unit& u, int wr, int wc, int fr, int fq, int) const {
        const int row0 = u.pm * 256 + wr * 64 + fr, col0 = u.pn * 256 + wc * 32 + 4 * fq;
#pragma unroll
        for (int ai = 0; ai < 2; ++ai)
#pragma unroll
            for (int m = 0; m < 4; ++m) { const size_t off = (size_t)(row0 + ai * 128 + m * 16) * D + col0;
#pragma unroll
                for (int bj = 0; bj < 2; ++bj)
#pragma unroll
                    for (int n = 0; n < 2; ++n) { const f32x4 bs = *(const f32x4*)(base + off + bj * 128 + n * 16); *(f32x4*)(out + off + bj * 128 + n * 16) = bs * alpha + acc[ai][bj][m][n]; } }
    }
};
__device__ __forceinline__ void ph_outproj(KP p, int l, LAS unsigned char* lds) {
    SchedPlain<0, 4, D> S{(const char*)(p->ws + WS_MERGED), (const char*)(p->ws + WS_WO), (int)gridDim.x, (int)blockIdx.x};
    EpiResid E{(l == 0) ? p->in[I_X] : p->out, p->out, DN_ALPHA};
    mg::gemm_run(lds, S, E);
}

__device__ __forceinline__ void ln_rows(KP p, int l, int mode, LAS unsigned char* lds) {
    const int tid = my_tid(), lane = tid & 63, wave = tid >> 6;
    const float* g = p->in[I_LNG] + (size_t)(l * 2 + mode) * D; const float* bb = p->in[I_LNB] + (size_t)(l * 2 + mode) * D;
    bf16_t* OB = (bf16_t*)(p->ws + (mode == 0 ? WS_X1B : WS_XB)); const bool wb = (mode == 0) || (l == 0);
    const bool moe = (mode == 0) && (l & 1); const float* rw = p->in[I_RTW] + (size_t)(l >> 1) * D * NE; const float* rb = p->in[I_RTB] + (l >> 1) * NE;
    int* TOKE = (int*)(p->ws + WS_TOKE); float* TOKW = (float*)(p->ws + WS_TOKW);
    f32x4 gv[4], bv[4];
#pragma unroll
    for (int j = 0; j < 4; ++j) { gv[j] = *(const f32x4*)(g + 4 * lane + 256 * j); bv[j] = *(const f32x4*)(bb + 4 * lane + 256 * j); }
    const int rows_per_wg = T / gridDim.x;
    for (int rr = wave; rr < rows_per_wg; rr += 8) {
        const int row = blockIdx.x * rows_per_wg + rr; float* xr = p->out + (size_t)row * D;
        f32x4 v[4]; float s = 0.f;
#pragma unroll
        for (int j = 0; j < 4; ++j) v[j] = *(const f32x4*)(xr + 4 * lane + 256 * j);
        if (mode == 1 && (l & 1)) {
            const int* RO = (const int*)(p->ws + WS_ROWOF); const bf16_t* YB = (const bf16_t*)(p->ws + WS_AG);
#pragma unroll
            for (int sl = 0; sl < 2; ++sl) { const int yr = RO[row * 2 + sl]; const float w = TOKW[row * 2 + sl];
#pragma unroll
                for (int j = 0; j < 4; ++j) { const u32x2 y = *(const u32x2*)(YB + (size_t)yr * D + 4 * lane + 256 * j);
                    v[j].x += w * bflo(y.x); v[j].y += w * bfhi(y.x); v[j].z += w * bflo(y.y); v[j].w += w * bfhi(y.y); } } }
#pragma unroll
        for (int j = 0; j < 4; ++j) s += (v[j].x + v[j].y) + (v[j].z + v[j].w);
        const float mean = wave_sum(s) * (1.f / D); float s2 = 0.f;
#pragma unroll
        for (int j = 0; j < 4; ++j) { v[j] = v[j] - mean; s2 += (v[j].x * v[j].x + v[j].y * v[j].y) + (v[j].z * v[j].z + v[j].w * v[j].w); }
        const float rstd = rsqrtf(wave_sum(s2) * (1.f / D) + LN_EPS);
        const float osc = (mode == 0) ? DN_ALPHA : 1.f;
#pragma unroll
        for (int j = 0; j < 4; ++j) { v[j] = v[j] * rstd * gv[j] + bv[j]; *(f32x4*)(xr + 4 * lane + 256 * j) = v[j] * osc;
            if (wb) *(unsigned long long*)(OB + (size_t)row * D + 4 * lane + 256 * j) = (unsigned long long)pk2(v[j].x, v[j].y) | ((unsigned long long)pk2(v[j].z, v[j].w) << 32); }
        if (moe) {
            float lg[8];
#pragma unroll
            for (int e = 0; e < 8; ++e) lg[e] = 0.f;
#pragma unroll
            for (int j = 0; j < 4; ++j)
#pragma unroll
                for (int q = 0; q < 4; ++q) { const int c = 4 * lane + 256 * j + q; const f32x4 w0 = *(const f32x4*)(rw + (size_t)c * 8), w1 = *(const f32x4*)(rw + (size_t)c * 8 + 4); const float x = v[j][q];
                    lg[0] += x * w0.x; lg[1] += x * w0.y; lg[2] += x * w0.z; lg[3] += x * w0.w; lg[4] += x * w1.x; lg[5] += x * w1.y; lg[6] += x * w1.z; lg[7] += x * w1.w; }
#pragma unroll
            for (int e = 0; e < 8; ++e) lg[e] = wave_sum(lg[e]) + rb[e];
            int e1 = 0; float v1 = lg[0];
#pragma unroll
            for (int e = 1; e < 8; ++e) if (lg[e] > v1) { v1 = lg[e]; e1 = e; }
            int e2 = -1; float v2 = -INFINITY;
#pragma unroll
            for (int e = 0; e < 8; ++e) if (e != e1 && lg[e] > v2) { v2 = lg[e]; e2 = e; }
            const float w1 = 1.f / (1.f + __expf(v2 - v1));
            if (lane == 0) { TOKE[row * 2] = e1; TOKE[row * 2 + 1] = e2; TOKW[row * 2] = w1; TOKW[row * 2 + 1] = 1.f - w1; }
        }
    }
    if (moe) {
        __syncthreads();
        if (tid < 8) { int cnt = 0; for (int rr = 0; rr < rows_per_wg; ++rr) { const int row = blockIdx.x * rows_per_wg + rr; cnt += (TOKE[row * 2] == tid) + (TOKE[row * 2 + 1] == tid); }
            ((int*)(p->ws + WS_WGCNT))[blockIdx.x * 8 + tid] = cnt; }
    }
}
__device__ __forceinline__ void ph_ln1(KP p, int l, LAS unsigned char* lds) {
    ln_rows(p, l, 0, lds);
    __syncthreads();
    const int tid_ = my_tid(); const int lane = tid_ & 63, wave = tid_ >> 6, gw = blockIdx.x * 8 + wave, NGW = gridDim.x * 8;
    LAS float* scr = (LAS float*)(lds + wave * 8448);
    bf16_t* W13 = (bf16_t*)(p->ws + WS_WF13);
    if ((l & 1) == 0) {
        const int j = l >> 1; const float* w1 = p->in[I_F1] + (size_t)j * D * DFF; const float* w3 = p->in[I_F3] + (size_t)j * D * DFF; const float* w2 = p->in[I_F2] + (size_t)j * DFF * D;
        bf16_t* W2 = (bf16_t*)(p->ws + WS_WF2_DENSE);
        const int n1 = tr_nitems(D, DFF), n2 = tr_nitems(DFF, D);
        for (int it = gw; it < 2 * n1 + n2; it += NGW) { int r = it;
            if (r < n1) { tr_item(w1, D, DFF, W13, D, 2, 0, scr, r, lane); continue; } r -= n1;
            if (r < n1) { tr_item(w3, D, DFF, W13, D, 3, 0, scr, r, lane); continue; } r -= n1;
            tr_item(w2, DFF, D, W2, DFF, 0, 0, scr, r, lane); }
    } else {
        const int j = l >> 1; bf16_t* W2 = (bf16_t*)(p->ws + WS_WF2_MOE);
        const int n1 = tr_nitems(D, DFE), n2 = tr_nitems(DFE, D), per = 2 * n1 + n2;
        for (int it = gw; it < NE * per; it += NGW) { const int e = it / per; int r = it % per;
            const float* w1 = p->in[I_E1] + ((size_t)j * NE + e) * D * DFE; const float* w3 = p->in[I_E3] + ((size_t)j * NE + e) * D * DFE; const float* w2 = p->in[I_E2] + ((size_t)j * NE + e) * DFE * D;
            if (r < n1) { tr_item(w1, D, DFE, W13, D, 2, e * 2 * DFE, scr, r, lane); continue; } r -= n1;
            if (r < n1) { tr_item(w3, D, DFE, W13, D, 3, e * 2 * DFE, scr, r, lane); continue; } r -= n1;
            tr_item(w2, DFE, D, W2, DFE, 0, e * D, scr, r, lane); }
    }
}

__device__ __forceinline__ void moe_tables(KP p, LAS int* tb  ) {
    const int tid = my_tid(); const int* WG = (const int*)(p->ws + WS_WGCNT);
    if (tid < 8) { int tot = 0, mine = 0; for (int w = 0; w < (int)gridDim.x; ++w) { const int c = WG[w * 8 + tid]; if (w < (int)blockIdx.x) mine += c; tot += c; } tb[tid] = tot; tb[16 + tid] = mine; }
    __syncthreads();
    if (tid == 0) { int base = 0; for (int e = 0; e < 8; ++e) { tb[8 + e] = base; base += ((tb[e] + 255) >> 8) << 8; } tb[24] = base; }
    __syncthreads();
}
__device__ __forceinline__ void ph_moe_assign(KP p, int l, LAS unsigned char* lds) {
    const int tid = my_tid(), lane = tid & 63, wave = tid >> 6;
    LAS int* tb = (LAS int*)lds; LAS int* rowof = tb + 32;
    moe_tables(p, tb);
    const int rows_per_wg = T / gridDim.x; const int* TOKE = (const int*)(p->ws + WS_TOKE); const float* TOKW = (const float*)(p->ws + WS_TOKW);
    int* ROWTOK = (int*)(p->ws + WS_ROWTOK); float* ROWW = (float*)(p->ws + WS_ROWW);
    if (tid < 8) { int run = tb[8 + tid] + tb[16 + tid];
        for (int rr = 0; rr < rows_per_wg; ++rr) { const int row = blockIdx.x * rows_per_wg + rr;
#pragma unroll
            for (int s = 0; s < 2; ++s) if (TOKE[row * 2 + s] == tid) { ROWTOK[run] = row; ROWW[run] = TOKW[row * 2 + s]; rowof[rr * 2 + s] = run; ((int*)(p->ws + WS_ROWOF))[row * 2 + s] = run; ++run; } } }
    bf16_t* AG = (bf16_t*)(p->ws + WS_AG);
    if (blockIdx.x < 8) { const int e = blockIdx.x, lo = tb[8 + e] + tb[e], hi = tb[8 + e] + (((tb[e] + 255) >> 8) << 8);
        for (int r = lo + wave; r < hi; r += 8) { if (lane == 0) { ROWTOK[r] = -1; ROWW[r] = 0.f; }
#pragma unroll
            for (int j = 0; j < 2; ++j) *(u32x4*)(AG + (size_t)r * D + 8 * lane + 512 * j) = (u32x4){0u, 0u, 0u, 0u}; } }
    __syncthreads();
    const bf16_t* X1B = (const bf16_t*)(p->ws + WS_X1B);
    for (int pr = wave; pr < rows_per_wg * 2; pr += 8) { const int row = blockIdx.x * rows_per_wg + (pr >> 1), dst = rowof[pr];
#pragma unroll
        for (int j = 0; j < 2; ++j) *(u32x4*)(AG + (size_t)dst * D + 8 * lane + 512 * j) = *(const u32x4*)(X1B + (size_t)row * D + 8 * lane + 512 * j); }
}

struct EpiSwiglu {
    bf16_t* H; int ldh;
    __device__ __forceinline__ void operator()(const AccT& acc, const mg::Unit& u, int wr, int wc, int fr, int fq, int) const {
        const int row0 = u.pm * 256 + wr * 64 + fr, col0 = u.pn * 128 + wc * 32 + 8 * fq;
#pragma unroll
        for (int ai = 0; ai < 2; ++ai)
#pragma unroll
            for (int m = 0; m < 4; ++m) { float hv[8];
#pragma unroll
                for (int n = 0; n < 2; ++n)
#pragma unroll
                    for (int j = 0; j < 4; ++j) { const float a = acc[ai][0][m][n][j], b = acc[ai][1][m][n][j]; hv[4 * n + j] = a * sigm(a) * b; }
                u32x4 w; w.x = pk2(hv[0], hv[1]); w.y = pk2(hv[2], hv[3]); w.z = pk2(hv[4], hv[5]); w.w = pk2(hv[6], hv[7]);
                *(u32x4*)(H + (size_t)(row0 + ai * 128 + m * 16) * ldh + col0) = w; asm volatile("" ::: "memory"); }
    }
};
template <int PERM_, int NN, int K, int BROWS> struct SchedMoe {
    static constexpr int PERM = PERM_;
    const char* A; const char* B; const LAS int* tstart; int G, c;
    __device__ __forceinline__ bool next(int i, mg::Unit& u) const {
        const int L = i * G + c; if (L >= tstart[8] * NN) return false;
        const int rt = L / NN, pn = L % NN; int e = 0;
#pragma unroll
        for (int x = 1; x < 8; ++x) if (rt >= tstart[x]) e = x;
        u.A = A + (size_t)rt * 256 * (K * 2); u.B = B + ((size_t)e * BROWS + (size_t)pn * 256) * (K * 2); u.ld = K * 2; u.nt = K / 64; u.pm = rt; u.pn = pn; u.tag = 0; return true;
    }
};
template <class SM> __device__ __forceinline__ void moe_sched_tiles(KP p, LAS unsigned char* lds, SM& S) {
    LAS int* tb = (LAS int*)(lds + LDS_BYTES - 512);
    moe_tables(p, tb);
    { const int t_ = my_tid(); if (t_ < 8) tb[32 + t_] = tb[8 + t_] >> 8; if (t_ == 8) tb[40] = tb[24] >> 8; }
    __syncthreads();
    S.tstart = tb + 32;
}
__device__ __forceinline__ void ph_ffn_up(KP p, int l, LAS unsigned char* lds) {
    if ((l & 1) == 0) {
        SchedPlain<1, 2 * DFF / 256, D> S{(const char*)(p->ws + WS_X1B), (const char*)(p->ws + WS_WF13), (int)gridDim.x, (int)blockIdx.x};
        EpiSwiglu E{(bf16_t*)(p->ws + WS_H), DFF};
        mg::gemm_run(lds, S, E);
    } else {
        SchedMoe<1, 2 * DFE / 256, D, 2 * DFE> S; S.A = (const char*)(p->ws + WS_AG); S.B = (const char*)(p->ws + WS_WF13);
        S.G = (int)gridDim.x; S.c = (int)blockIdx.x; moe_sched_tiles(p, lds, S);
        EpiSwiglu E{(bf16_t*)(p->ws + WS_H), DFE};
        mg::gemm_run(lds, S, E);
    }
}

struct EpiAccum {
    float* out;
    __device__ __forceinline__ void operator()(const AccT& acc, const mg::Unit& u, int wr, int wc, int fr, int fq, int) const {
        const int row0 = u.pm * 256 + wr * 64 + fr, col0 = u.pn * 256 + wc * 32 + 4 * fq;
#pragma unroll
        for (int ai = 0; ai < 2; ++ai)
#pragma unroll
            for (int m = 0; m < 4; ++m) { float* rp = out + (size_t)(row0 + ai * 128 + m * 16) * D + col0;
#pragma unroll
                for (int bj = 0; bj < 2; ++bj)
#pragma unroll
                    for (int n = 0; n < 2; ++n) { f32x4* q = (f32x4*)(rp + bj * 128 + n * 16); *q = *q + acc[ai][bj][m][n]; } }
    }
};
struct EpiScatter {
    float* out; const int* rowtok; const float* roww;
    __device__ __forceinline__ void operator()(const AccT& acc, const mg::Unit& u, int wr, int wc, int fr, int fq, int) const {
        const int row0 = u.pm * 256 + wr * 64 + fr, col0 = u.pn * 256 + wc * 32 + 4 * fq;
#pragma unroll
        for (int ai = 0; ai < 2; ++ai)
#pragma unroll
            for (int m = 0; m < 4; ++m) { const int r = row0 + ai * 128 + m * 16; const int tok = rowtok[r]; const float w = roww[r];
                if (tok >= 0) { float* rp = out + (size_t)tok * D + col0;
#pragma unroll
                    for (int bj = 0; bj < 2; ++bj)
#pragma unroll
                        for (int n = 0; n < 2; ++n)
#pragma unroll
                            for (int j = 0; j < 4; ++j) unsafeAtomicAdd(rp + bj * 128 + n * 16 + j, w * acc[ai][bj][m][n][j]); } }
    }
};
__device__ __forceinline__ void ph_ffn_down(KP p, int l, LAS unsigned char* lds) {
    if ((l & 1) == 0) {
        SchedPlain<0, 4, DFF> S{(const char*)(p->ws + WS_H), (const char*)(p->ws + WS_WF2_DENSE), (int)gridDim.x, (int)blockIdx.x};
        EpiAccum E{p->out};
        mg::gemm_run(lds, S, E);
    } else {
        SchedMoe<1, 4, DFE, D> S; S.A = (const char*)(p->ws + WS_H); S.B = (const char*)(p->ws + WS_WF2_MOE);
        S.G = (int)gridDim.x; S.c = (int)blockIdx.x; moe_sched_tiles(p, lds, S);
        EpiBf16Store E{(bf16_t*)(p->ws + WS_AG), D};
        mg::gemm_run(lds, S, E);
    }
}


#define XB_TMO      128
#define XB_XCNT(j)  (256  + 64 * (j))
#define XB_XSUB(j)  (1280 + 64 * (j))
#define XB_XGEN(j)  (2304 + 64 * (j))
#define XB_TOP      3328
#define XB_TOPGEN   3392
#define XCD_BAR_WORDS 3456
#define XB_SPIN_CAP (1u << 18)
__device__ __forceinline__ unsigned xb_ld(unsigned* p)              { return __hip_atomic_load(p, __ATOMIC_RELAXED, __HIP_MEMORY_SCOPE_AGENT); }
__device__ __forceinline__ unsigned xb_add(unsigned* p, unsigned v) { return __hip_atomic_fetch_add(p, v, __ATOMIC_RELAXED, __HIP_MEMORY_SCOPE_AGENT); }
__device__ __forceinline__ unsigned xb_xcc_id() { return (unsigned)__builtin_amdgcn_s_getreg((3 << 11) | 20) & 0xFu; }
#define XB_SPIN(cond, bar) do { unsigned _sp = 0; while (cond) { __builtin_amdgcn_s_sleep(1); \
    if ((++_sp & 255u) == 0u) { if (xb_ld(&(bar)[XB_TMO])) break; if (_sp > XB_SPIN_CAP) { atomicAdd(&(bar)[XB_TMO], 1u); break; } } } } while (0)
struct XcdBarrier { unsigned* bar; unsigned x; volatile LAS unsigned* st; };
__device__ __forceinline__ XcdBarrier xcd_barrier_post(unsigned* bar, volatile LAS unsigned* st) {
    XcdBarrier b; b.bar = bar; b.x = xb_xcc_id(); b.st = st;
    if (threadIdx.x == 0) (void)xb_add(&bar[XB_XCNT(b.x)], 1u);
    return b;
}
__device__ __forceinline__ void xcd_barrier_complete(unsigned* bar, unsigned x, unsigned& nloc, unsigned& nx) {
    const unsigned G = gridDim.x * gridDim.y * gridDim.z;
    unsigned sum, cnt, mine, sp = 0u;
    for (;;) {
        sum = 0u; cnt = 0u; mine = 0u;
#pragma unroll
        for (unsigned j = 0; j < 16; ++j) { const unsigned c = xb_ld(&bar[XB_XCNT(j)]); sum += c; cnt += (c > 0u) ? 1u : 0u; mine = (j == x) ? c : mine; }
        if (sum == G) break;
        __builtin_amdgcn_s_sleep(1);
        if ((++sp & 255u) == 0u) { if (xb_ld(&bar[XB_TMO])) break; if (sp > XB_SPIN_CAP) { atomicAdd(&bar[XB_TMO], 1u); break; } }
    }
    nloc = mine > 0u ? mine : 1u; nx = cnt > 0u ? cnt : 1u;
}
__device__ __forceinline__ void xcd_barrier(const XcdBarrier& b) {
    asm volatile("s_waitcnt vmcnt(0)" ::: "memory");
    __syncthreads();
    if (threadIdx.x == 0) {
        unsigned* bar = b.bar;
        __builtin_amdgcn_s_waitcnt(0);
        unsigned nloc = b.st[0], nx = b.st[1];
        if (nloc == 0u) { xcd_barrier_complete(bar, b.x, nloc, nx); b.st[0] = nloc; b.st[1] = nx; }
        const unsigned old = xb_add(&bar[XB_XSUB(b.x)], 1u);
        const unsigned gen = old / nloc;
        if (old + 1u == (gen + 1u) * nloc) {
            __builtin_amdgcn_fence(__ATOMIC_RELEASE, "agent");
            asm volatile("s_waitcnt vmcnt(0)" ::: "memory");
            const unsigned og = xb_add(&bar[XB_TOP], 1u);
            const unsigned tg = og / nx;
            if (og + 1u == (tg + 1u) * nx) xb_add(&bar[XB_TOPGEN], 1u);
            else XB_SPIN(xb_ld(&bar[XB_TOPGEN]) == tg, bar);
            __builtin_amdgcn_fence(__ATOMIC_ACQUIRE, "agent");
            xb_add(&bar[XB_XGEN(b.x)], 1u);
            asm volatile("s_waitcnt vmcnt(0)" ::: "memory");
        } else {
            XB_SPIN(xb_ld(&bar[XB_XGEN(b.x)]) == gen, bar);
            __builtin_amdgcn_fence(__ATOMIC_ACQUIRE, "agent");
            asm volatile("s_waitcnt vmcnt(0)" ::: "memory");
        }
    }
    __syncthreads();
}

constexpr int PH_PER_LAYER = 12, NPHASE = 2 * PH_PER_LAYER;
template <int K> __device__ __forceinline__ void run_phase(KP p, int l, LAS unsigned char* lds) {
    asm volatile("" : "+s"(lds));
    if constexpr (K == 0) ph_conv_mixer(p, l, lds);
    else if constexpr (K == 1) ph_inproj(p, l, lds);
    else if constexpr (K == 2) ph_prep(p, l, lds);
    else if constexpr (K == 30) ph_scan(p, l, lds);
    else if constexpr (K == 31) ph_attn(p, l, lds);
    else if constexpr (K == 32) dsa_select(p);
    else if constexpr (K == 4) ph_dsa_xb(p, l, lds);
    else if constexpr (K == 5) ph_merge(p, l, lds);
    else if constexpr (K == 6) ph_outproj(p, l, lds);
    else if constexpr (K == 7) ph_ln1(p, l, lds);
    else if constexpr (K == 8) ph_moe_assign(p, l, lds);
    else if constexpr (K == 9) ph_ffn_up(p, l, lds);
    else if constexpr (K == 10) ph_ffn_down(p, l, lds);
    else ln_rows(p, l, 1, lds);
}
template <int K> __global__ void __launch_bounds__(NTHREADS, 2) k_phase(Params, int l) {
    extern __shared__ __attribute__((aligned(16))) unsigned char lds_raw[];
    run_phase<K>(get_params(), l, (LAS unsigned char*)lds_raw);
}
#if FUSED
#define PH(K, L) do { run_phase<K>(get_params(), L, lds); __syncthreads(); } while (0)
#define SYNC() xcd_barrier(xbar)
__global__ void __launch_bounds__(NTHREADS, 2) k_fused(Params) {
    extern __shared__ __attribute__((aligned(16))) unsigned char lds_raw[];
    LAS unsigned char* lds = (LAS unsigned char*)lds_raw;
    cg::grid_group grid = cg::this_grid();
    volatile LAS unsigned* bst = (volatile LAS unsigned*)(lds + LDS_BYTES - 128);
    if (threadIdx.x < 2) bst[threadIdx.x] = 0u;
    __syncthreads();
    const XcdBarrier xbar = xcd_barrier_post((unsigned*)(get_params()->ws + WS_CTL) + 1024, bst);
    PH(0, 0); grid.sync();
    PH(1, 0); SYNC(); PH(2, 0); SYNC(); PH(30, 0); SYNC(); PH(31, 0); SYNC(); PH(32, 0); SYNC(); PH(4, 0); SYNC(); PH(5, 0); SYNC(); PH(6, 0); SYNC(); PH(7, 0); SYNC();
    PH(9, 0); SYNC(); PH(10, 0); SYNC(); PH(11, 0); SYNC();
    PH(0, 1); SYNC(); PH(1, 1); SYNC(); PH(2, 1); SYNC(); PH(30, 1); SYNC(); PH(31, 1); SYNC(); PH(32, 1); SYNC(); PH(4, 1); SYNC(); PH(5, 1); SYNC(); PH(6, 1); SYNC(); PH(7, 1); SYNC();
    PH(8, 1); SYNC(); PH(9, 1); SYNC(); PH(10, 1); SYNC(); PH(11, 1);
}
#undef PH
#undef SYNC
#endif
template <int K> static void launch_phase(const Params& p, int l, hipStream_t stream) {
    static bool attr = false;
    if (!attr) { (void)hipFuncSetAttribute((const void*)k_phase<K>, hipFuncAttributeMaxDynamicSharedMemorySize, LDS_BYTES); attr = true; }
    hipLaunchKernelGGL(k_phase<K>, dim3(256), dim3(NTHREADS), LDS_BYTES, stream, p, l);
}

extern "C" void kernel_launch(void* const* d_in, const int* in_sizes, int n_in, void* d_out, int out_size, void* d_ws, size_t ws_size, hipStream_t stream) {
    if (n_in != 28 || out_size != T * D || ws_size < WS_END) { fprintf(stderr, "kernel_launch: unexpected problem (n_in %d out %d ws %zu)\n", n_in, out_size, ws_size); return; }
    (void)hipMemsetAsync((char*)d_ws + WS_CTL, 0, 32768, stream);
    Params p{};
    for (int i = 0; i < 28; ++i) p.in[i] = (const float*)d_in[i];
    p.out = (float*)d_out; p.ws = (unsigned char*)d_ws;
#if FUSED
    static bool attr = false;
    if (!attr) { (void)hipFuncSetAttribute((const void*)k_fused, hipFuncAttributeMaxDynamicSharedMemorySize, LDS_BYTES); attr = true; }
    void* args[] = {&p};
    hipError_t e = hipLaunchCooperativeKernel((const void*)k_fused, dim3(256), dim3(NTHREADS), args, LDS_BYTES, stream);
    if (e != hipSuccess) fprintf(stderr, "cooperative launch failed: %s\n", hipGetErrorString(e));
    return;
#endif
    for (int l = 0; l < 2; ++l) {
        launch_phase<0>(p, l, stream); launch_phase<1>(p, l, stream); launch_phase<2>(p, l, stream);
        launch_phase<30>(p, l, stream); launch_phase<31>(p, l, stream); launch_phase<32>(p, l, stream);
        launch_phase<4>(p, l, stream); launch_phase<5>(p, l, stream); launch_phase<6>(p, l, stream); launch_phase<7>(p, l, stream);
        if (l & 1) launch_phase<8>(p, l, stream);
        launch_phase<9>(p, l, stream); launch_phase<10>(p, l, stream); launch_phase<11>(p, l, stream);
    }
}
```

```cpp
#include <hip/hip_runtime.h>
#include <hip/hip_cooperative_groups.h>
#include <cstdio>
#include <cstdint>
namespace cg = cooperative_groups;

#ifndef FUSED
#define FUSED 1
#endif

#define LAS __attribute__((address_space(3)))
typedef unsigned short bf16_t;
typedef short bf16x8 __attribute__((ext_vector_type(8)));
typedef float f32x4 __attribute__((ext_vector_type(4)));
typedef float f32x2 __attribute__((ext_vector_type(2)));
typedef unsigned u32x4 __attribute__((ext_vector_type(4)));
typedef unsigned u32x2 __attribute__((ext_vector_type(2)));

constexpr int T = 16384, D = 1024, SEQ = 2048, NB = 8;
constexpr int NPM = 3328;
constexpr int C_SWA_Q = 0, C_SWA_K = 512, C_SWA_V = 640, C_RW = 768;
constexpr int C_FOX_Q = 1792, C_FOX_K = 2048, C_FOX_V = 2304;
constexpr int C_DSA_Q = 2560, C_DSA_K = 2816, C_DSA_V = 2880, C_DSA_QI = 2944, C_DSA_KI = 3200, C_FLOG = 3264, C_WIDX = 3268;
constexpr int D_IN = 7368, NWIN = 7424;
constexpr int OC = 1280;
constexpr int DFF = 2816, DFE = 1408, NE = 8;
constexpr int MAXROWS = 34816;
constexpr float DN_ALPHA = 1.41421356237f;
constexpr float LN_EPS = 1e-5f;

constexpr size_t MiB = 1u << 20;
constexpr size_t WS_CTL = 0;
constexpr size_t WS_WIN = 1 * MiB, WS_WB = 16 * MiB, WS_WO = 19 * MiB;
constexpr size_t WS_THR = 21 * MiB + 256 * 1024  , WS_ROWOF = 21 * MiB  , WS_FOXC = 21 * MiB, WS_TOKE = 21 * MiB + 256 * 1024, WS_TOKW = 21 * MiB + 384 * 1024, WS_ROWTOK = 21 * MiB + 512 * 1024,
                 WS_ROWW = 21 * MiB + 768 * 1024, WS_WGCNT = 21 * MiB + 920 * 1024;
constexpr size_t WS_OCAT = 22 * MiB, WS_X1B = 22 * MiB;
constexpr size_t WS_PMIX = 62 * MiB, WS_MERGED = 62 * MiB, WS_MACC = 94 * MiB;
constexpr size_t WS_WF13 = 62 * MiB, WS_WF2_DENSE = 73 * MiB, WS_WF2_MOE = 106 * MiB, WS_H = 128 * MiB;
constexpr size_t WS_RW = 166 * MiB, WS_XB = 166 * MiB, WS_SCORES = 166 * MiB, WS_XB2 = 246 * MiB, WS_GSC = 158 * MiB, WS_AG = 222 * MiB;
constexpr size_t WS_BONUS = 278 * MiB, WS_Y = 279 * MiB, WS_LORA_A = 279 * MiB  ;
constexpr size_t WS_WLORA = 15 * MiB + 512 * 1024;
constexpr size_t WS_END = 295 * MiB;
constexpr size_t RWSZ = 16 * MiB;

constexpr int LDS_BYTES = 155648;
constexpr int NTHREADS = 512;

struct Params { const float* in[28]; float* out; unsigned char* ws; };
typedef const __attribute__((address_space(4))) Params* KP;
__device__ __forceinline__ KP get_params() { KP k = (KP)__builtin_amdgcn_kernarg_segment_ptr(); asm volatile("" : "+s"(k)); return k; }
enum { I_X = 0, I_WIN, I_SINKS, I_MU, I_W0, I_WUP, I_A0, I_AUP, I_GUP, I_KK, I_KA, I_RK, I_GNG, I_GNB, I_FB, I_GB, I_WBR, I_WOUT, I_LNG, I_LNB,
       I_F1, I_F3, I_F2, I_RTW, I_RTB, I_E1, I_E3, I_E2 };

__device__ __forceinline__ float bflo(unsigned u) { return __uint_as_float(u << 16); }
__device__ __forceinline__ float bfhi(unsigned u) { return __uint_as_float(u & 0xffff0000u); }
__device__ __forceinline__ float bf2f(bf16_t b) { return __uint_as_float((unsigned)b << 16); }
__device__ __forceinline__ unsigned f2bf(float f) { unsigned u = __float_as_uint(f); return (u + 0x7fffu + ((u >> 16) & 1u)) >> 16; }
__device__ __forceinline__ unsigned pk2(float lo, float hi) { return f2bf(lo) | (f2bf(hi) << 16); }
__device__ __forceinline__ float wave_sum(float v) {
#pragma unroll
    for (int o = 1; o < 64; o <<= 1) v += __shfl_xor(v, o);
    return v;
}
__device__ __forceinline__ float wave_max(float v) {
#pragma unroll
    for (int o = 1; o < 64; o <<= 1) v = fmaxf(v, __shfl_xor(v, o));
    return v;
}
__device__ __forceinline__ float sigm(float x) { return 1.f / (1.f + __expf(-x)); }
#define LDS_FENCE() asm volatile("s_waitcnt lgkmcnt(0)" ::: "memory")
__device__ __forceinline__ int my_tid() { int t = threadIdx.x; asm volatile("" : "+v"(t)); return t; }
__device__ __forceinline__ void unpack8(const u32x4 v, float* f) {
    f[0] = bflo(v.x); f[1] = bfhi(v.x); f[2] = bflo(v.y); f[3] = bfhi(v.y); f[4] = bflo(v.z); f[5] = bfhi(v.z); f[6] = bflo(v.w); f[7] = bfhi(v.w);
}

namespace mg {
constexpr int BM = 256, BK = 64, HALF = 128, HTB = HALF * BK * 2, STAGE_BYTES = 8 * HTB;
__device__ __forceinline__ int lds_byte(int r, int c) { const int st = (r >> 4) * 2 + (c >> 5), rr = r & 15, cc = c & 31, ob = rr * 64 + cc * 2; return st * 1024 + (ob ^ (((ob >> 9) & 1) << 5)); }
__device__ __forceinline__ void stage_rc(int b, int& R, int& C) { const int st = b / 1024, sb = b % 1024, swz = sb ^ (((sb >> 9) & 1) << 5); R = (st >> 1) * 16 + swz / 64; C = (st & 1) * 32 + (swz % 64) / 2; }
__device__ __forceinline__ int perm32(int rho) { const int n = rho >> 4, i = rho & 15; return 8 * (i >> 2) + 4 * n + (i & 3); }

struct Unit { const char* A; const char* B; unsigned ld; int nt; int pm, pn, tag; };

__device__ __forceinline__ bool static_tile(int i, int G, int c, int nM, int nN, int& pm, int& pn) {
    const int nwg = nM * nN; const long L = (long)i * G + c; if (L >= nwg) return false;
    int wgid = (int)L; { const int q = nwg / 8, r = nwg % 8, xcd = wgid % 8, off = wgid / 8; wgid = (xcd < r ? xcd * (q + 1) : r * (q + 1) + (xcd - r) * q) + off; }
    const int nig = 8 * nN, gid = wgid / nig, fm = gid * 8, gsz = (nM - fm) < 8 ? (nM - fm) : 8;
    pm = fm + ((wgid % nig) % gsz); pn = (wgid % nig) / gsz; return true;
}

template <class Sched, class Epi>
__device__ __forceinline__ void gemm_run(LAS unsigned char* lds, const Sched& S, const Epi& E) {
    const int tid = my_tid(), wid = __builtin_amdgcn_readfirstlane(tid >> 6), lane = tid & 63, wr = wid >> 2, wc = wid & 3, fr = lane & 15, fq = lane >> 4;
    int R0, C0; stage_rc(tid * 16, R0, C0); const unsigned RA = (unsigned)R0, RB = (unsigned)(Sched::PERM ? ((R0 & ~31) + perm32(R0 & 31)) : R0), C02 = (unsigned)C0 * 2u;
    const unsigned ldsw = (unsigned)wid * 1024u;
    const int aoff = lds_byte(wr * 64 + fr, fq * 8), boff = lds_byte(wc * 32 + fr, fq * 8);
#define MG_SA(b, h) (((b) * 2 + (h)) * HTB)
#define MG_SB(b, h) ((4 + (b) * 2 + (h)) * HTB)
#define MG_STAGE(bufoff, gptr, v0, s64) do { \
        __builtin_amdgcn_global_load_lds((const unsigned*)((gptr) + (v0)), (LAS unsigned*)(lds + (bufoff) + ldsw), 16, 0, 0); \
        __builtin_amdgcn_global_load_lds((const unsigned*)((gptr) + (s64) + (v0)), (LAS unsigned*)(lds + (bufoff) + ldsw + 8192), 16, 0, 0); } while (0)
#define MG_LDA(dst, b, h) do { _Pragma("unroll") for (int m = 0; m < 4; ++m) _Pragma("unroll") for (int k = 0; k < 2; ++k) dst[m][k] = *(const LAS bf16x8*)(lds + MG_SA(b, h) + aoff + m * 2048 + k * 1024); } while (0)
#define MG_LDB(dst, b, h) do { _Pragma("unroll") for (int n = 0; n < 2; ++n) _Pragma("unroll") for (int k = 0; k < 2; ++k) dst[n][k] = *(const LAS bf16x8*)(lds + MG_SB(b, h) + boff + n * 2048 + k * 1024); } while (0)
#define MG_MMA(ai, bj, At, Bt) do { __builtin_amdgcn_s_setprio(1); _Pragma("unroll") for (int m = 0; m < 4; ++m) _Pragma("unroll") for (int n = 0; n < 2; ++n) _Pragma("unroll") for (int k = 0; k < 2; ++k) \
        acc[ai][bj][m][n] = __builtin_amdgcn_mfma_f32_16x16x32_bf16(Bt[n][k], At[m][k], acc[ai][bj][m][n], 0, 0, 0); __builtin_amdgcn_s_setprio(0); } while (0)
#define MG_WAIT_V(n) asm volatile("s_waitcnt vmcnt(" #n ")" ::: "memory")
#define MG_WAIT_L(n) asm volatile("s_waitcnt lgkmcnt(" #n ")" ::: "memory")
#define MG_BAR __builtin_amdgcn_s_barrier()
#define MG_SCHED __builtin_amdgcn_sched_barrier(0)
    Unit cur; int ui = 0;
    if (!S.next(0, cur)) return;
    f32x4 acc[2][2][4][2];
#pragma unroll
    for (int a = 0; a < 2; ++a)
#pragma unroll
        for (int b = 0; b < 2; ++b)
#pragma unroll
            for (int m = 0; m < 4; ++m)
#pragma unroll
                for (int n = 0; n < 2; ++n) acc[a][b][m][n] = (f32x4){0.f, 0.f, 0.f, 0.f};
    bf16x8 At[4][2], B0[2][2], B1[2][2];
    const size_t kstep = (size_t)(BK * 2);
    {
        const char* cA = cur.A; const char* cB = cur.B; const unsigned ld = cur.ld, vA = RA * ld + C02, vB = RB * ld + C02, s64 = 64u * ld, sh = 128u * ld;
        MG_STAGE(MG_SB(0, 0), cB, vB, s64); MG_STAGE(MG_SB(0, 1), cB + sh, vB, s64); MG_STAGE(MG_SA(0, 0), cA, vA, s64); MG_STAGE(MG_SA(0, 1), cA + sh, vA, s64);
        if (wr == 1) MG_BAR;
        MG_WAIT_V(2); MG_BAR;
        MG_STAGE(MG_SB(1, 0), cB + kstep, vB, s64); MG_STAGE(MG_SA(1, 0), cA + kstep, vA, s64); MG_STAGE(MG_SB(1, 1), cB + sh + kstep, vB, s64);
        MG_WAIT_V(6); MG_BAR;
    }
    for (;;) {
        const char* cA = cur.A; const char* cB = cur.B; const unsigned cld = cur.ld; const int nt = cur.nt;
        for (int t = 0; t < nt; t += 2) {
            const bool last = (t == nt - 2);
            const char* a1 = cA + (size_t)(t + 1) * kstep;
            const char* a2 = cA + (size_t)(t + 2) * kstep; const char* b2 = cB + (size_t)(t + 2) * kstep; unsigned xld = cld;
            if (last) { Unit n2; if (S.next(ui + 1, n2)) { a2 = n2.A; b2 = n2.B; xld = n2.ld; } else { a2 = cA; b2 = cB; } }
            const char* a3 = a2 + kstep; const char* b3 = b2 + kstep;
            const unsigned cvA = RA * cld + C02, c64 = 64u * cld, ch = 128u * cld;
            const unsigned xvA = RA * xld + C02, xvB = RB * xld + C02, x64 = 64u * xld, xh = 128u * xld;
            MG_LDB(B0, 0, 0); MG_LDB(B1, 0, 1); MG_SCHED; MG_LDA(At, 0, 0); MG_STAGE(MG_SA(1, 1), a1 + ch, cvA, c64);
            MG_WAIT_V(8); MG_WAIT_L(0); MG_BAR; MG_MMA(0, 0, At, B0); MG_MMA(0, 1, At, B1); MG_BAR; MG_SCHED;
            MG_LDA(At, 0, 1); MG_STAGE(MG_SB(0, 0), b2, xvB, x64); MG_STAGE(MG_SB(0, 1), b2 + xh, xvB, x64); MG_STAGE(MG_SA(0, 0), a2, xvA, x64);
            MG_WAIT_V(8); MG_WAIT_L(0); MG_BAR; MG_MMA(1, 0, At, B0); MG_MMA(1, 1, At, B1); MG_BAR; MG_SCHED;
            MG_LDB(B0, 1, 0); MG_LDB(B1, 1, 1); MG_SCHED; MG_LDA(At, 1, 0); MG_STAGE(MG_SA(0, 1), a2 + xh, xvA, x64);
            MG_WAIT_V(8); MG_WAIT_L(0); MG_BAR; MG_MMA(0, 0, At, B0); MG_MMA(0, 1, At, B1); MG_BAR; MG_SCHED;
            MG_LDA(At, 1, 1); MG_STAGE(MG_SB(1, 0), b3, xvB, x64); MG_STAGE(MG_SB(1, 1), b3 + xh, xvB, x64); MG_STAGE(MG_SA(1, 0), a3, xvA, x64);
            MG_WAIT_V(8); MG_WAIT_L(0); MG_BAR; MG_MMA(1, 0, At, B0); MG_MMA(1, 1, At, B1); MG_BAR; MG_SCHED;
        }
        if (wr == 0) MG_BAR;
        { int e_fr = fr, e_fq = fq, e_tid = tid; asm volatile("" : "+v"(e_fr), "+v"(e_fq), "+v"(e_tid));
          E(acc, cur, wr, wc, e_fr, e_fq, e_tid); }
        Unit nxt;
        if (!S.next(ui + 1, nxt)) break;
#pragma unroll
        for (int a = 0; a < 2; ++a)
#pragma unroll
            for (int b = 0; b < 2; ++b)
#pragma unroll
                for (int m = 0; m < 4; ++m)
#pragma unroll
                    for (int n = 0; n < 2; ++n) acc[a][b][m][n] = (f32x4){0.f, 0.f, 0.f, 0.f};
        cur = nxt; ++ui;
        if (wr == 1) MG_BAR;
    }
    MG_WAIT_V(0);
    MG_BAR;
#undef MG_SA
#undef MG_SB
#undef MG_STAGE
#undef MG_LDA
#undef MG_LDB
#undef MG_MMA
#undef MG_WAIT_V
#undef MG_WAIT_L
#undef MG_BAR
#undef MG_SCHED
}
}

typedef f32x4 AccT[2][2][4][2];

__device__ __forceinline__ int rowmap(int mode, int n) {
    if (mode == 0) return n;
    if (mode == 1) { if (n < 2560) return n; if (n < 2564) return 3264 + (n - 2560); if (n < 3268) return n - 4; if (n < 3272) return n; return n + 56; }
    if (mode == 2) return 256 * (n >> 7) + (n & 127);
    return 256 * (n >> 7) + 128 + (n & 127);
}
__device__ __forceinline__ void tr_item(const float* __restrict__ W, int K, int N, bf16_t* WT, int ldt, int mode, int row_off, LAS float* scr, int item, int lane) {
    const int nblk = (N + 31) / 32, kb = item / nblk, nb = item % nblk, k0 = 64 * kb, n0 = 32 * nb;
    const int nl = lane & 31, n = n0 + nl;
    float tv[32];
    const int nc = (n < N) ? n : N - 1;
#pragma unroll
    for (int i = 0; i < 32; ++i) { const int kk = 2 * i + (lane >> 5); tv[i] = W[(size_t)(k0 + kk) * N + nc]; }
#pragma unroll
    for (int i = 0; i < 32; ++i) { const int kk = 2 * i + (lane >> 5); scr[kk * 33 + nl] = (n < N) ? tv[i] : 0.f; }
    LDS_FENCE();
    const int c = lane & 7;
#pragma unroll
    for (int j = 0; j < 4; ++j) { const int n2l = (lane >> 3) + 8 * j, n2 = n0 + n2l; const LAS float* s = scr + (8 * c) * 33 + n2l;
        u32x4 o; o.x = pk2(s[0 * 33], s[1 * 33]); o.y = pk2(s[2 * 33], s[3 * 33]); o.z = pk2(s[4 * 33], s[5 * 33]); o.w = pk2(s[6 * 33], s[7 * 33]);
        if (n2 < N) *(u32x4*)(WT + (size_t)(row_off + rowmap(mode, n2)) * ldt + k0 + 8 * c) = o; }
    LDS_FENCE();
}
__device__ __forceinline__ int tr_nitems(int K, int N) { return (K / 64) * ((N + 31) / 32); }

__device__ __forceinline__ void row_to_bf16(const float* xrow, bf16_t* orow, int lane) {
    const f32x4* xr = (const f32x4*)xrow + lane; unsigned long long* o8 = (unsigned long long*)orow + lane;
#pragma unroll
    for (int j = 0; j < 4; ++j) { const f32x4 v = xr[64 * j]; o8[64 * j] = (unsigned long long)pk2(v.x, v.y) | ((unsigned long long)pk2(v.z, v.w) << 32); }
}

__device__ __forceinline__ void ph_conv_mixer(KP p, int l, LAS unsigned char* lds) {
    const int tid_ = my_tid(); const int lane = tid_ & 63, wave = tid_ >> 6, gw = blockIdx.x * 8 + wave, NGW = gridDim.x * 8;
    LAS float* scr = (LAS float*)(lds + wave * 8448);
    const float* win = p->in[I_WIN] + (size_t)l * D * D_IN; const float* wbr = p->in[I_WBR] + (size_t)l * OC * D; const float* wo = p->in[I_WOUT] + (size_t)l * D * D;
    bf16_t* WIN = (bf16_t*)(p->ws + WS_WIN); bf16_t* WB = (bf16_t*)(p->ws + WS_WB); bf16_t* WO = (bf16_t*)(p->ws + WS_WO);
    const int n1 = tr_nitems(D, D_IN), n2 = tr_nitems(OC, D), n3 = tr_nitems(D, D);
    for (int it = gw; it < n1 + n2 + n3; it += NGW) {
        int r = it;
        if (r < n1) { tr_item(win, D, D_IN, WIN, D, 1, 0, scr, r, lane); continue; } r -= n1;
        if (r < n2) { tr_item(wbr, OC, D, WB, OC, 0, 0, scr, r, lane); continue; } r -= n2;
        tr_item(wo, D, D, WO, D, 0, 0, scr, r, lane);
    }
    {
        bf16_t* WL = (bf16_t*)(p->ws + WS_WLORA);
        const float* wup = p->in[I_WUP] + (size_t)l * 64 * 256; const float* aup = p->in[I_AUP] + (size_t)l * 64 * 256; const float* gup = p->in[I_GUP] + (size_t)l * 128 * 256;
        const int m1 = tr_nitems(64, 256), m2 = tr_nitems(128, 256);
        for (int it = gw; it < 2 * m1 + m2; it += NGW) { int r = it;
            if (r < m1) { tr_item(wup, 64, 256, WL, 256, 0, 0, scr, r, lane); continue; } r -= m1;
            if (r < m1) { tr_item(aup, 64, 256, WL + 64, 256, 0, 256, scr, r, lane); continue; } r -= m1;
            tr_item(gup, 128, 256, WL + 128, 256, 0, 512, scr, r, lane); }
        for (int ch = gw * 64 + lane; ch < 768 * 32; ch += NGW * 64) { const int row = ch >> 5, k8 = (ch & 31) * 8, blk = row >> 8;
            const bool used = (blk == 0) ? (k8 < 64) : ((blk == 1) ? (k8 >= 64 && k8 < 128) : (k8 >= 128));
            if (!used) *(u32x4*)(WL + (size_t)row * 256 + k8) = (u32x4){0u, 0u, 0u, 0u}; }
    }
    if (l == 0) { bf16_t* XB = (bf16_t*)(p->ws + WS_XB); for (int m = gw; m < T; m += NGW) row_to_bf16(p->in[I_X] + (size_t)m * D, XB + (size_t)m * D, lane); }
}

struct SchedInproj {
    static constexpr int PERM = 1;
    const char* A; const char* B; int G, c;
    __device__ __forceinline__ bool next(int i, mg::Unit& u) const {
        int pm, pn; if (!mg::static_tile(i, G, c, T / 256, NPM / 256, pm, pn)) return false;
        u.A = A + (size_t)pm * 256 * 2048; u.B = B + (size_t)pn * 256 * 2048; u.ld = 2048; u.nt = 16; u.pm = pm; u.pn = pn; u.tag = 0; return true;
    }
};
template <int PERM_, int NN, int K> struct SchedPlain {
    static constexpr int PERM = PERM_;
    const char* A; const char* B; int G, c;
    __device__ __forceinline__ bool next(int i, mg::Unit& u) const {
        int pm, pn; if (!mg::static_tile(i, G, c, T / 256, NN, pm, pn)) return false;
        u.A = A + (size_t)pm * 256 * K * 2; u.B = B + (size_t)pn * 256 * K * 2; u.ld = K * 2; u.nt = K / 64; u.pm = pm; u.pn = pn; u.tag = 0; return true;
    }
};
struct EpiBf16Store {
    bf16_t* O; int ldo;
    __device__ __forceinline__ void operator()(const AccT& acc, const mg::Unit& u, int wr, int wc, int fr, int fq, int) const {
        const int row0 = u.pm * 256 + wr * 64 + fr, col0 = u.pn * 256 + wc * 32 + 8 * fq;
#pragma unroll
        for (int ai = 0; ai < 2; ++ai)
#pragma unroll
            for (int m = 0; m < 4; ++m) { bf16_t* rowp = O + (size_t)(row0 + ai * 128 + m * 16) * ldo + col0;
#pragma unroll
                for (int bj = 0; bj < 2; ++bj) { const f32x4 v0 = acc[ai][bj][m][0], v1 = acc[ai][bj][m][1];
                    u32x4 w; w.x = pk2(v0[0], v0[1]); w.y = pk2(v0[2], v0[3]); w.z = pk2(v1[0], v1[1]); w.w = pk2(v1[2], v1[3]);
                    *(u32x4*)(rowp + bj * 128) = w; } }
    }
};
__device__ __forceinline__ void ph_inproj(KP p, int l, LAS unsigned char* lds) {
    SchedInproj S{(const char*)(p->ws + WS_XB), (const char*)(p->ws + WS_WIN), (int)gridDim.x, (int)blockIdx.x};
    EpiBf16Store E{(bf16_t*)(p->ws + WS_PMIX), NPM};
    mg::gemm_run(lds, S, E);
}

__device__ __forceinline__ void ph_prep(KP p, int l, LAS unsigned char* lds) {
    const int tid = my_tid(), lane = tid & 63, wave = tid >> 6;
    const bf16_t* P = (const bf16_t*)(p->ws + WS_PMIX);
    if (blockIdx.x < 8 && wave < 4) {
        const int b = blockIdx.x, h = wave; const float fb = p->in[I_FB][l * 4 + h];
        float v[32]; float s = 0.f;
#pragma unroll
        for (int i = 0; i < 32; ++i) { const int t = 32 * lane + i; const float x = bf2f(P[(size_t)(b * SEQ + t) * NPM + C_FLOG + h]) + fb;
            const float ls = fminf(x, 0.f) - log1pf(__expf(-fabsf(x))); s += ls; v[i] = s; }
        float incl = s;
#pragma unroll
        for (int o = 1; o < 64; o <<= 1) { const float n = __shfl_up(incl, o); if (lane >= o) incl += n; }
        const float excl = incl - s; float* C = (float*)(p->ws + WS_FOXC) + (size_t)(b * 4 + h) * SEQ + 32 * lane;
#pragma unroll
        for (int i = 0; i < 32; ++i) C[i] = v[i] + excl;
    }
    const float* mu = p->in[I_MU] + l * 1024; const float* kkw = p->in[I_KK] + l * 256;
    float* RWr = (float*)(p->ws + WS_RW); float* RWk = RWr + (size_t)2 * T * 256; float* RWkk = RWr + (size_t)3 * T * 256; float* RWv = RWr + (size_t)5 * T * 256;
    bf16_t* LA = (bf16_t*)(p->ws + WS_LORA_A);
    const int gw = blockIdx.x * 8 + wave, NGW = gridDim.x * 8;
    float m0[8], m1[8], kkc[8];
    { const f32x4 a = *(const f32x4*)(mu + 8 * lane), b = *(const f32x4*)(mu + 8 * lane + 4), c = *(const f32x4*)(mu + 512 + 8 * lane), d = *(const f32x4*)(mu + 512 + 8 * lane + 4);
      m0[0] = a.x; m0[1] = a.y; m0[2] = a.z; m0[3] = a.w; m0[4] = b.x; m0[5] = b.y; m0[6] = b.z; m0[7] = b.w; m1[0] = c.x; m1[1] = c.y; m1[2] = c.z; m1[3] = c.w; m1[4] = d.x; m1[5] = d.y; m1[6] = d.z; m1[7] = d.w;
      const f32x4 e = *(const f32x4*)(kkw + 8 * (lane & 31)), f = *(const f32x4*)(kkw + 8 * (lane & 31) + 4); kkc[0] = e.x; kkc[1] = e.y; kkc[2] = e.z; kkc[3] = e.w; kkc[4] = f.x; kkc[5] = f.y; kkc[6] = f.z; kkc[7] = f.w; }
#pragma unroll 2
    for (int t = gw; t < T; t += NGW) {
        const bf16_t* pr = P + (size_t)t * NPM + C_RW; const bool first = (t & (SEQ - 1)) == 0; const bf16_t* pp = first ? pr : pr - NPM;
        float x0[8], x1[8], y0[8], y1[8];
        unpack8(*(const u32x4*)(pr + 8 * lane), x0); unpack8(*(const u32x4*)(pr + 512 + 8 * lane), x1);
        unpack8(*(const u32x4*)(pp + 8 * lane), y0); unpack8(*(const u32x4*)(pp + 512 + 8 * lane), y1);
#pragma unroll
        for (int j = 0; j < 8; ++j) { const float q0 = first ? 0.f : y0[j], q1 = first ? 0.f : y1[j]; x0[j] += m0[j] * (q0 - x0[j]); x1[j] += m1[j] * (q1 - x1[j]); }
        const size_t o = (size_t)t * 256 + 8 * (lane & 31);
        if (lane < 32) {
            *(f32x4*)(RWr + o) = (f32x4){x0[0], x0[1], x0[2], x0[3]}; *(f32x4*)(RWr + o + 4) = (f32x4){x0[4], x0[5], x0[6], x0[7]};
            *(f32x4*)(RWv + o) = (f32x4){x1[0], x1[1], x1[2], x1[3]}; *(f32x4*)(RWv + o + 4) = (f32x4){x1[4], x1[5], x1[6], x1[7]};
        }
        float kk[8], ss = 0.f;
#pragma unroll
        for (int j = 0; j < 8; ++j) { kk[j] = x0[j] * kkc[j]; ss += kk[j] * kk[j]; }
        ss += __shfl_xor(ss, 1); ss += __shfl_xor(ss, 2); ss += __shfl_xor(ss, 4);
        const float rn = rsqrtf(ss + 1e-12f);
        if (lane >= 32) {
            *(f32x4*)(RWk + o) = (f32x4){x0[0], x0[1], x0[2], x0[3]}; *(f32x4*)(RWk + o + 4) = (f32x4){x0[4], x0[5], x0[6], x0[7]};
            *(f32x4*)(RWkk + o) = (f32x4){kk[0] * rn, kk[1] * rn, kk[2] * rn, kk[3] * rn}; *(f32x4*)(RWkk + o + 4) = (f32x4){kk[4] * rn, kk[5] * rn, kk[6] * rn, kk[7] * rn};
            float a[8];
#pragma unroll
            for (int j = 0; j < 8; ++j) a[j] = (lane < 40) ? tanhf(x1[j]) : ((lane < 48) ? x1[j] : sigm(x1[j]));
            u32x4 w; w.x = pk2(a[0], a[1]); w.y = pk2(a[2], a[3]); w.z = pk2(a[4], a[5]); w.w = pk2(a[6], a[7]);
            *(u32x4*)(LA + (size_t)t * 256 + 8 * (lane - 32)) = w;
        }
    }
}
struct EpiLora {
    const float* w0; const float* a0; const float* ka; float* RW;
    __device__ __forceinline__ void operator()(const AccT& acc, const mg::Unit& u, int wr, int wc, int fr, int fq, int) const {
        const int row0 = u.pm * 256 + wr * 64 + fr, col0 = wc * 32 + 4 * fq;
        float* RWw = RW + (size_t)1 * T * 256; float* RWk = RW + (size_t)2 * T * 256; float* RWkk = RW + (size_t)3 * T * 256; float* RWkka = RW + (size_t)4 * T * 256; float* RWg = RW + (size_t)6 * T * 256;
#pragma unroll
        for (int bj = 0; bj < 2; ++bj)
#pragma unroll
            for (int n = 0; n < 2; ++n) { const int c = col0 + bj * 128 + n * 16;
                f32x4 c0 = (f32x4){0.f, 0.f, 0.f, 0.f}, c1 = c0;
                if (u.pn == 0) c0 = *(const f32x4*)(w0 + c); else if (u.pn == 1) { c0 = *(const f32x4*)(a0 + c); c1 = *(const f32x4*)(ka + c); }
#pragma unroll
                for (int ai = 0; ai < 2; ++ai)
#pragma unroll
                    for (int m = 0; m < 4; ++m) { const size_t o = (size_t)(row0 + ai * 128 + m * 16) * 256 + c; const f32x4 x = acc[ai][bj][m][n];
                        if (u.pn == 0) { f32x4 w;
#pragma unroll
                            for (int j = 0; j < 4; ++j) w[j] = __expf(-sigm(c0[j] + x[j]) * 0.60653065971f);
                            *(f32x4*)(RWw + o) = w; }
                        else if (u.pn == 1) { const f32x4 k = *(const f32x4*)(RWk + o), kk = *(const f32x4*)(RWkk + o); f32x4 k2, kka;
#pragma unroll
                            for (int j = 0; j < 4; ++j) { const float a = sigm(c0[j] + x[j]); k2[j] = k[j] * (1.f + (a - 1.f) * c1[j]); kka[j] = kk[j] * a; }
                            *(f32x4*)(RWk + o) = k2; *(f32x4*)(RWkka + o) = kka; }
                        else *(f32x4*)(RWg + o) = x;
                        asm volatile("" ::: "memory"); } }
    }
};
__device__ __forceinline__ void ph_lora(KP p, int l, LAS unsigned char* lds) {
    SchedPlain<0, 3, 256> S{(const char*)(p->ws + WS_LORA_A), (const char*)(p->ws + WS_WLORA), (int)gridDim.x, (int)blockIdx.x};
    EpiLora E{p->in[I_W0] + l * 256, p->in[I_A0] + l * 256, p->in[I_KA] + l * 256, (float*)(p->ws + WS_RW)};
    mg::gemm_run(lds, S, E);
}

template <int CTRL, int ROWM, int BANKM> __device__ __forceinline__ float dpp_add(float acc, float src) {
    return acc + __int_as_float(__builtin_amdgcn_update_dpp(0, __float_as_int(src), CTRL, ROWM, BANKM, true));
}
__device__ __forceinline__ float wave_sum_s(float v) {
    float a = v;
    a = dpp_add<0x111, 0xf, 0xf>(a, v); a = dpp_add<0x112, 0xf, 0xf>(a, v); a = dpp_add<0x113, 0xf, 0xf>(a, v);
    a = dpp_add<0x114, 0xf, 0xe>(a, a); a = dpp_add<0x118, 0xf, 0xc>(a, a);
    a = dpp_add<0x142, 0xa, 0xf>(a, a); a = dpp_add<0x143, 0xc, 0xf>(a, a);
    return __int_as_float(__builtin_amdgcn_readlane(__float_as_int(a), 63));
}
typedef float f32x16 __attribute__((ext_vector_type(16)));
constexpr int KT_PITCH = 144, VT_PITCH = 136;
constexpr int AT_K_BYTES = 64 * KT_PITCH, AT_V_BYTES = 64 * VT_PITCH, AT_TILE_BYTES = AT_K_BYTES + AT_V_BYTES + 256;
constexpr float LOG2E = 1.4426950408889634f;
constexpr float NEGBIG = -1e30f;
__device__ __forceinline__ int crow(int reg, int h) { return (reg & 3) + 8 * (reg >> 2) + 4 * h; }
__device__ __forceinline__ unsigned fkey(float f) { const unsigned u = __float_as_uint(f); return (u & 0x80000000u) ? ~u : (u | 0x80000000u); }

__device__ __forceinline__ void at_stage(LAS unsigned char* tile, const bf16_t* Krows, const bf16_t* Vrows, int tid) {
    { const int row = tid >> 3, ch = tid & 7; const u32x4 v = *(const u32x4*)(Krows + (size_t)row * NPM + 8 * ch); *(LAS u32x4*)(tile + row * KT_PITCH + ch * 16) = v; }
    { const int kv = tid & 63, dch = tid >> 6; const u32x4 v = *(const u32x4*)(Vrows + (size_t)kv * NPM + 8 * dch);
      LAS bf16_t* vt = (LAS bf16_t*)(tile + AT_K_BYTES + (8 * dch) * VT_PITCH) + kv; constexpr int P2 = VT_PITCH / 2;
      vt[0 * P2] = (bf16_t)(v.x & 0xffffu); vt[1 * P2] = (bf16_t)(v.x >> 16); vt[2 * P2] = (bf16_t)(v.y & 0xffffu); vt[3 * P2] = (bf16_t)(v.y >> 16);
      vt[4 * P2] = (bf16_t)(v.z & 0xffffu); vt[5 * P2] = (bf16_t)(v.z >> 16); vt[6 * P2] = (bf16_t)(v.w & 0xffffu); vt[7 * P2] = (bf16_t)(v.w >> 16); }
}
struct AtRegs { u32x4 k, v; };
__device__ __forceinline__ AtRegs at_gload(const bf16_t* Krows, const bf16_t* Vrows, int tid) {
    AtRegs a; a.k = *(const u32x4*)(Krows + (size_t)(tid >> 3) * NPM + 8 * (tid & 7)); a.v = *(const u32x4*)(Vrows + (size_t)(tid & 63) * NPM + 8 * (tid >> 6)); return a;
}
__device__ __forceinline__ void at_sstore(LAS unsigned char* tile, const AtRegs& a, int tid) {
    *(LAS u32x4*)(tile + (tid >> 3) * KT_PITCH + (tid & 7) * 16) = a.k;
    const u32x4 v = a.v; LAS bf16_t* vt = (LAS bf16_t*)(tile + AT_K_BYTES + (8 * (tid >> 6)) * VT_PITCH) + (tid & 63); constexpr int P2 = VT_PITCH / 2;
    vt[0 * P2] = (bf16_t)(v.x & 0xffffu); vt[1 * P2] = (bf16_t)(v.x >> 16); vt[2 * P2] = (bf16_t)(v.y & 0xffffu); vt[3 * P2] = (bf16_t)(v.y >> 16);
    vt[4 * P2] = (bf16_t)(v.z & 0xffffu); vt[5 * P2] = (bf16_t)(v.z >> 16); vt[6 * P2] = (bf16_t)(v.w & 0xffffu); vt[7 * P2] = (bf16_t)(v.w >> 16);
}
__device__ __forceinline__ void at_qk(f32x16& p0, f32x16& p1, const LAS unsigned char* Kt, const bf16x8 (&qr)[4], int r, int h) {
#pragma unroll
    for (int i = 0; i < 16; ++i) { p0[i] = 0.f; p1[i] = 0.f; }
#pragma unroll
    for (int ds = 0; ds < 4; ++ds) {
        const bf16x8 a0 = *(const LAS bf16x8*)(Kt + r * KT_PITCH + (16 * ds + 8 * h) * 2);
        const bf16x8 a1 = *(const LAS bf16x8*)(Kt + (32 + r) * KT_PITCH + (16 * ds + 8 * h) * 2);
        p0 = __builtin_amdgcn_mfma_f32_32x32x16_bf16(a0, qr[ds], p0, 0, 0, 0);
        p1 = __builtin_amdgcn_mfma_f32_32x32x16_bf16(a1, qr[ds], p1, 0, 0, 0);
    }
}
__device__ __forceinline__ void at_pv(f32x16 (&o)[2], const LAS unsigned char* Vt, const bf16x8 (&pk)[4], int r, int h) {
#pragma unroll
    for (int dh = 0; dh < 2; ++dh)
#pragma unroll
        for (int ks = 0; ks < 4; ++ks) { const LAS unsigned char* bp = Vt + (32 * dh + r) * VT_PITCH + (16 * ks + 4 * h) * 2;
            const u32x2 lo = *(const LAS u32x2*)bp, hi = *(const LAS u32x2*)(bp + 16);
            const u32x4 av = (u32x4){lo.x, lo.y, hi.x, hi.y};
            o[dh] = __builtin_amdgcn_mfma_f32_32x32x16_bf16(__builtin_bit_cast(bf16x8, av), pk[ks], o[dh], 0, 0, 0); }
}
template <bool BIAS, bool MASK, bool DSAM = false>
__device__ __forceinline__ void at_softmax(f32x16& p0, f32x16& p1, float& m, float& l, f32x16 (&o)[2], bf16x8 (&pk)[4], float sc2, const LAS float* bias2, int kmax, int h, unsigned mb = 0u) {
    float mt = NEGBIG;
#pragma unroll
    for (int g = 0; g < 4; ++g) {
        f32x4 b0 = (f32x4){0.f, 0.f, 0.f, 0.f}, b1 = b0;
        if (BIAS) { b0 = *(const LAS f32x4*)(bias2 + 8 * g + 4 * h); b1 = *(const LAS f32x4*)(bias2 + 32 + 8 * g + 4 * h); }
#pragma unroll
        for (int j = 0; j < 4; ++j) { const int reg = 4 * g + j, kv = 8 * g + 4 * h + j;
            float x0 = p0[reg] * sc2 + b0[j], x1 = p1[reg] * sc2 + b1[j];
            if (MASK) { if (kv > kmax) x0 = NEGBIG; if (kv + 32 > kmax) x1 = NEGBIG; }
            if (DSAM) { if (!((mb >> reg) & 1u)) x0 = NEGBIG; if (!((mb >> (16 + reg)) & 1u)) x1 = NEGBIG; }
            p0[reg] = x0; p1[reg] = x1; mt = fmaxf(mt, fmaxf(x0, x1)); }
    }
    mt = fmaxf(mt, __shfl_xor(mt, 32));
    const float mn = fmaxf(m, mt);
    if (__any(mn > m)) { const float al = __builtin_amdgcn_exp2f(m - mn); l *= al;
#pragma unroll
        for (int i = 0; i < 16; ++i) { o[0][i] *= al; o[1][i] *= al; }
        m = mn; }
    float s = 0.f;
#pragma unroll
    for (int i = 0; i < 16; ++i) { const float e0 = (p0[i] > -1e29f) ? __builtin_amdgcn_exp2f(p0[i] - m) : 0.f, e1 = (p1[i] > -1e29f) ? __builtin_amdgcn_exp2f(p1[i] - m) : 0.f; p0[i] = e0; p1[i] = e1; s += e0 + e1; }
    l += s;
#pragma unroll
    for (int ks = 0; ks < 2; ++ks) { u32x4 w0, w1;
        w0.x = pk2(p0[8 * ks + 0], p0[8 * ks + 1]); w0.y = pk2(p0[8 * ks + 2], p0[8 * ks + 3]); w0.z = pk2(p0[8 * ks + 4], p0[8 * ks + 5]); w0.w = pk2(p0[8 * ks + 6], p0[8 * ks + 7]);
        w1.x = pk2(p1[8 * ks + 0], p1[8 * ks + 1]); w1.y = pk2(p1[8 * ks + 2], p1[8 * ks + 3]); w1.z = pk2(p1[8 * ks + 4], p1[8 * ks + 5]); w1.w = pk2(p1[8 * ks + 6], p1[8 * ks + 7]);
        pk[ks] = __builtin_bit_cast(bf16x8, w0); pk[2 + ks] = __builtin_bit_cast(bf16x8, w1); }
}
__device__ __forceinline__ void at_loadq(bf16x8 (&qr)[4], const bf16_t* qrow, int h) {
#pragma unroll
    for (int ds = 0; ds < 4; ++ds) qr[ds] = *(const bf16x8*)(qrow + 16 * ds + 8 * h);
}
__device__ __forceinline__ void at_store(bf16_t* orow, const f32x16 (&o)[2], float inv, int h) {
#pragma unroll
    for (int dh = 0; dh < 2; ++dh)
#pragma unroll
        for (int g = 0; g < 4; ++g) { u32x2 w; w.x = pk2(o[dh][4 * g] * inv, o[dh][4 * g + 1] * inv); w.y = pk2(o[dh][4 * g + 2] * inv, o[dh][4 * g + 3] * inv);
            *(u32x2*)(orow + 32 * dh + 8 * g + 4 * h) = w; }
}

__device__ __forceinline__ void fox_unit(KP p, int bh, int qb, LAS unsigned char* lds) {
    const int tid = my_tid(), lane = tid & 63, wave = tid >> 6, r = lane & 31, h = lane >> 5, wv = wave & 3, g = wave >> 2;
    const int b = bh >> 2, hd = bh & 3;
    const bf16_t* P = (const bf16_t*)(p->ws + WS_PMIX) + (size_t)b * SEQ * NPM; bf16_t* OCT = (bf16_t*)(p->ws + WS_OCAT); const float* FC = (const float*)(p->ws + WS_FOXC) + (size_t)bh * SEQ;
    const int q0 = 128 * qb, qbase = q0 + 32 * wv; const float cref = FC[q0];
    bf16x8 qr[4]; at_loadq(qr, P + (size_t)(qbase + r) * NPM + C_FOX_Q + hd * 64, h);
    f32x16 o[2]; float m = NEGBIG, l = 0.f;
#pragma unroll
    for (int i = 0; i < 16; ++i) { o[0][i] = 0.f; o[1][i] = 0.f; }
    const bf16_t* Kc = P + C_FOX_K + hd * 64; const bf16_t* Vc = P + C_FOX_V + hd * 64;
    AtRegs pre0 = at_gload(Kc, Vc, tid), pre1 = at_gload(Kc + (size_t)64 * NPM, Vc + (size_t)64 * NPM, tid);
    float bpre = (tid < 128) ? FC[tid] : 0.f;
#pragma unroll 1
    for (int st = 0; st <= qb; ++st) {
        __syncthreads();
        at_sstore(lds, pre0, tid); at_sstore(lds + AT_TILE_BYTES, pre1, tid);
        if (tid < 128) ((LAS float*)(lds + (tid >> 6) * AT_TILE_BYTES + AT_K_BYTES + AT_V_BYTES))[tid & 63] = (cref - bpre) * LOG2E;
        __syncthreads();
        if (st < qb) { const size_t ko = (size_t)(128 * (st + 1)) * NPM; pre0 = at_gload(Kc + ko, Vc + ko, tid); pre1 = at_gload(Kc + ko + (size_t)64 * NPM, Vc + ko + (size_t)64 * NPM, tid);
            if (tid < 128) bpre = FC[128 * (st + 1) + tid]; }
        const int k0 = 64 * (2 * st + g); const LAS unsigned char* tile = lds + g * AT_TILE_BYTES;
        if (k0 <= qbase + 31) {
            f32x16 p0, p1; bf16x8 pk[4];
            at_qk(p0, p1, tile, qr, r, h);
            const LAS float* b2 = (const LAS float*)(tile + AT_K_BYTES + AT_V_BYTES);
            if (k0 + 63 > qbase) at_softmax<true, true>(p0, p1, m, l, o, pk, 0.125f * LOG2E, b2, qbase + r - k0, h);
            else at_softmax<true, false>(p0, p1, m, l, o, pk, 0.125f * LOG2E, b2, 0, h);
            at_pv(o, tile + AT_K_BYTES, pk, r, h);
        }
    }
    __syncthreads();
    LAS float* cb = (LAS float*)lds + (size_t)wv * (34 * 64);
    if (g == 1) { cb[lane] = m; cb[64 + lane] = l;
#pragma unroll
        for (int i = 0; i < 16; ++i) { cb[(2 + i) * 64 + lane] = o[0][i]; cb[(18 + i) * 64 + lane] = o[1][i]; } }
    __syncthreads();
    if (g == 0) { const float mb = cb[lane], lb = cb[64 + lane]; const float M = fmaxf(m, mb), sa = __builtin_amdgcn_exp2f(m - M), sb = __builtin_amdgcn_exp2f(mb - M);
        l = l * sa + lb * sb;
#pragma unroll
        for (int i = 0; i < 16; ++i) { o[0][i] = o[0][i] * sa + cb[(2 + i) * 64 + lane] * sb; o[1][i] = o[1][i] * sa + cb[(18 + i) * 64 + lane] * sb; }
        const float lt = l + __shfl_xor(l, 32);
        at_store(OCT + (size_t)(b * SEQ + qbase + r) * OC + 768 + hd * 64, o, 1.f / lt, h); }
}
__device__ __forceinline__ void swa_unit(KP p, int l_, int item, LAS unsigned char* lds) {
    const int tid = my_tid(), lane = tid & 63, wave = tid >> 6, r = lane & 31, h = lane >> 5;
    const int hk = item & 1, c = (item >> 1) & 31, b = item >> 6, head = hk * 4 + (wave >> 1), qpos = c * 64 + 32 * (wave & 1);
    const bf16_t* P = (const bf16_t*)(p->ws + WS_PMIX) + (size_t)b * SEQ * NPM; bf16_t* OCT = (bf16_t*)(p->ws + WS_OCAT);
    bf16x8 qr[4]; at_loadq(qr, P + (size_t)(qpos + r) * NPM + C_SWA_Q + head * 64, h);
    f32x16 o[2]; float m = p->in[I_SINKS][l_ * 8 + head] * LOG2E, l = (h == 0) ? 1.f : 0.f;
#pragma unroll
    for (int i = 0; i < 16; ++i) { o[0][i] = 0.f; o[1][i] = 0.f; }
    const int nch = (c + 1 < 3) ? (c + 1) : 3;
    const bf16_t* Kc = P + (size_t)(64 * (c - nch + 1)) * NPM + C_SWA_K + hk * 64; const bf16_t* Vc = P + (size_t)(64 * (c - nch + 1)) * NPM + C_SWA_V + hk * 64;
    AtRegs pre = at_gload(Kc, Vc, tid);
#pragma unroll 1
    for (int st = 0; st < nch; ++st) {
        __syncthreads();
        at_sstore(lds, pre, tid);
        __syncthreads();
        if (st + 1 < nch) pre = at_gload(Kc + (size_t)(64 * (st + 1)) * NPM, Vc + (size_t)(64 * (st + 1)) * NPM, tid);
        f32x16 p0, p1; bf16x8 pk[4];
        at_qk(p0, p1, lds, qr, r, h);
        at_softmax<false, false>(p0, p1, m, l, o, pk, 0.125f * LOG2E, nullptr, 0, h);
        at_pv(o, lds + AT_K_BYTES, pk, r, h);
    }
    const float lt = l + __shfl_xor(l, 32);
    at_store(OCT + (size_t)(b * SEQ + qpos + r) * OC + head * 64, o, 1.f / lt, h);
}

__device__ __forceinline__ size_t dsa_chunk_off(int b, int c) { return (size_t)b * (4096 * 528) + (size_t)4096 * (c * (c + 1) / 2); }
__device__ __forceinline__ void dsa_scores(KP p, LAS unsigned char* lds) {
    const int tid = my_tid(), lane = tid & 63, wave = tid >> 6, r = lane & 31, h = lane >> 5;
    const bf16_t* Pm = (const bf16_t*)(p->ws + WS_PMIX); float* SCR = (float*)(p->ws + WS_SCORES);
    LAS float* tb = (LAS float*)(lds + wave * (32 * 36 * 4));
    const int gw = blockIdx.x * 8 + wave, NGW = gridDim.x * 8;
    constexpr int PERB = 1036;
    for (int it = gw; it < NB * PERB; it += NGW) {
        const int b = it / PERB; int rem = it % PERB; const int qh = rem & 1; rem >>= 1;
        int c = 4; { int acc = 0; while (rem >= acc + c + 1) { acc += c + 1; ++c; } rem -= acc; } const int kb = rem;
        const bf16_t* Pb = Pm + (size_t)b * SEQ * NPM; const int qbase = c * 64 + 32 * qh;
        const bf16_t* qrow = Pb + (size_t)(qbase + r) * NPM;
        float wq[4];
#pragma unroll
        for (int hh = 0; hh < 4; ++hh) wq[hh] = bf2f(qrow[C_WIDX + hh]) * 0.0625f;
        float* dst = SCR + dsa_chunk_off(b, c) + (size_t)(32 * qh) * (64 * (c + 1)) + 64 * kb;
#pragma unroll 1
        for (int kh = 0; kh < 2; ++kh) {
            const bf16_t* krow = Pb + (size_t)(64 * kb + 32 * kh + r) * NPM + C_DSA_KI;
            bf16x8 kf[4];
#pragma unroll
            for (int ds = 0; ds < 4; ++ds) kf[ds] = *(const bf16x8*)(krow + 16 * ds + 8 * h);
            f32x16 sc;
#pragma unroll
            for (int i = 0; i < 16; ++i) sc[i] = 0.f;
#pragma unroll
            for (int hh = 0; hh < 4; ++hh) { f32x16 a;
#pragma unroll
                for (int i = 0; i < 16; ++i) a[i] = 0.f;
#pragma unroll
                for (int ds = 0; ds < 4; ++ds) { const bf16x8 qf = *(const bf16x8*)(qrow + C_DSA_QI + hh * 64 + 16 * ds + 8 * h); a = __builtin_amdgcn_mfma_f32_32x32x16_bf16(kf[ds], qf, a, 0, 0, 0); }
#pragma unroll
                for (int i = 0; i < 16; ++i) sc[i] += fmaxf(a[i], 0.f) * wq[hh]; }
#pragma unroll
            for (int g = 0; g < 4; ++g) *(LAS f32x4*)(tb + r * 36 + 8 * g + 4 * h) = (f32x4){sc[4 * g] + 0.f, sc[4 * g + 1] + 0.f, sc[4 * g + 2] + 0.f, sc[4 * g + 3] + 0.f};
            LDS_FENCE();
#pragma unroll
            for (int i = 0; i < 4; ++i) { const int q = 8 * i + (lane >> 3), cc = (lane & 7) * 4; const f32x4 v = *(const LAS f32x4*)(tb + q * 36 + cc);
                *(f32x4*)(dst + (size_t)q * (64 * (c + 1)) + 32 * kh + cc) = v; }
            LDS_FENCE();
        }
    }
}
__device__ __forceinline__ int count_ge8(int cnt, unsigned cand, unsigned k0, unsigned k1, unsigned k2, unsigned k3, unsigned k4, unsigned k5, unsigned k6, unsigned k7) {
    int t; unsigned long long m0, m1, m2, m3;
    asm volatile("v_cmp_ge_u32_e64 %2, %7, %6\n\tv_cmp_ge_u32_e64 %3, %8, %6\n\tv_cmp_ge_u32_e64 %4, %9, %6\n\tv_cmp_ge_u32_e64 %5, %10, %6\n\t"
                 "s_bcnt1_i32_b64 %1, %2\n\ts_add_i32 %0, %0, %1\n\tv_cmp_ge_u32_e64 %2, %11, %6\n\t"
                 "s_bcnt1_i32_b64 %1, %3\n\ts_add_i32 %0, %0, %1\n\tv_cmp_ge_u32_e64 %3, %12, %6\n\t"
                 "s_bcnt1_i32_b64 %1, %4\n\ts_add_i32 %0, %0, %1\n\tv_cmp_ge_u32_e64 %4, %13, %6\n\t"
                 "s_bcnt1_i32_b64 %1, %5\n\ts_add_i32 %0, %0, %1\n\tv_cmp_ge_u32_e64 %5, %14, %6\n\t"
                 "s_bcnt1_i32_b64 %1, %2\n\ts_add_i32 %0, %0, %1\n\t"
                 "s_bcnt1_i32_b64 %1, %3\n\ts_add_i32 %0, %0, %1\n\t"
                 "s_bcnt1_i32_b64 %1, %4\n\ts_add_i32 %0, %0, %1\n\t"
                 "s_bcnt1_i32_b64 %1, %5\n\ts_add_i32 %0, %0, %1"
                 : "+s"(cnt), "=&s"(t), "=&s"(m0), "=&s"(m1), "=&s"(m2), "=&s"(m3)
                 : "v"(cand), "v"(k0), "v"(k1), "v"(k2), "v"(k3), "v"(k4), "v"(k5), "v"(k6), "v"(k7) : "scc");
    return cnt;
}
__device__ __forceinline__ int count_lane4(int cnt, unsigned cand, unsigned k0, unsigned k1, unsigned k2, unsigned k3) {
    asm volatile("v_cmp_ge_u32_e32 vcc, %2, %1\n\tv_addc_co_u32_e32 %0, vcc, 0, %0, vcc\n\t"
                 "v_cmp_ge_u32_e32 vcc, %3, %1\n\tv_addc_co_u32_e32 %0, vcc, 0, %0, vcc\n\t"
                 "v_cmp_ge_u32_e32 vcc, %4, %1\n\tv_addc_co_u32_e32 %0, vcc, 0, %0, vcc\n\t"
                 "v_cmp_ge_u32_e32 vcc, %5, %1\n\tv_addc_co_u32_e32 %0, vcc, 0, %0, vcc"
                 : "+v"(cnt) : "v"(cand), "v"(k0), "v"(k1), "v"(k2), "v"(k3) : "vcc");
    return cnt;
}
__device__ __forceinline__ int count_ge32(const unsigned (&key)[32], unsigned cand) {
    int cnt = 0;
#pragma unroll
    for (int i = 0; i < 32; i += 8) cnt = count_ge8(cnt, cand, key[i], key[i + 1], key[i + 2], key[i + 3], key[i + 4], key[i + 5], key[i + 6], key[i + 7]);
    return cnt;
}
__device__ __forceinline__ void dsa_select(KP p, LAS unsigned char* lds) {
    const int tid = my_tid(), lane0 = tid & 63, wave = tid >> 6, gw = blockIdx.x * 8 + wave, NGW = gridDim.x * 8;
    unsigned* THRG = (unsigned*)(p->ws + WS_THR); int* CUTG = (int*)(p->ws + WS_THR) + T;
#pragma unroll 1
    for (int it = gw; it < NB * 28 * 64; it += NGW) {
        int lane = lane0; asm volatile("" : "+v"(lane));
        const int b = it / (28 * 64), rem = it % (28 * 64), c = 4 + (rem >> 6), ql = rem & 63, nadm = 64 * (c + 1);
        const float* srow = (const float*)(p->ws + WS_SCORES) + dsa_chunk_off(b, c) + (size_t)ql * nadm;
        unsigned key[32];
#pragma unroll
        for (int i = 0; i < 32; ++i) { const int kv = 64 * i + lane; key[i] = __float_as_uint(srow[kv < nadm ? kv : nadm - 1]); }
#pragma unroll
        for (int i = 0; i < 32; ++i) asm volatile("" : "+v"(key[i]));
#pragma unroll
        for (int i = 0; i < 32; ++i) { const int kv = 64 * i + lane; key[i] = (kv < nadm) ? fkey(__uint_as_float(key[i]) + 0.f) : 0u; }
        unsigned Tk = 0u;
#pragma unroll 1
        for (int bit = 31; bit >= 0; --bit) { const unsigned cand = Tk | (1u << bit); int cl = 0;
            cl = count_lane4(cl, cand, key[0], key[1], key[2], key[3]); cl = count_lane4(cl, cand, key[4], key[5], key[6], key[7]); cl = count_lane4(cl, cand, key[8], key[9], key[10], key[11]);
            int cnt = count_ge8(0, cand, key[12], key[13], key[14], key[15], key[16], key[17], key[18], key[19]);
            cnt = count_ge8(cnt, cand, key[20], key[21], key[22], key[23], key[24], key[25], key[26], key[27]);
            cl = count_lane4(cl, cand, key[28], key[29], key[30], key[31]);
            cnt += (int)wave_sum_s((float)cl);
            if (cnt >= 256) Tk = cand; }
        const int cge = count_ge32(key, Tk), cgt = count_ge32(key, Tk + 1u), quota = 256 - cgt, nt = cge - cgt;
        int mxl = -1;
#pragma unroll
        for (int i = 0; i < 32; ++i) if (key[i] == Tk) mxl = 64 * i + lane;
        int cut = (int)wave_max((float)mxl);
        if (nt > quota) {
            int ck = 0;
#pragma unroll 1
            for (int bit = 10; bit >= 0; --bit) { const int cand = ck | (1 << bit); int cl = 0;
#pragma unroll
                for (int i = 0; i < 32; ++i) cl += (key[i] == Tk && 64 * i + lane < cand) ? 1 : 0;
                if ((int)wave_sum_s((float)cl) < quota) ck = cand; }
            cut = ck;
        }
        if (lane == 0) { THRG[b * SEQ + c * 64 + ql] = Tk; CUTG[b * SEQ + c * 64 + ql] = cut; }
    }
}
__device__ __forceinline__ void dsa_unit(KP p, int b, int c, int hp, LAS unsigned char* lds) {
    const int tid = my_tid(), lane = tid & 63, wave = tid >> 6, r = lane & 31, h = lane >> 5, wv = wave & 3, g = wave >> 2;
    const bf16_t* P = (const bf16_t*)(p->ws + WS_PMIX) + (size_t)b * SEQ * NPM; bf16_t* OCT = (bf16_t*)(p->ws + WS_OCAT);
    const int nadm = 64 * (c + 1);
    const float* SCRc = (const float*)(p->ws + WS_SCORES) + dsa_chunk_off(b, c);
    const bool sel = nadm > 256;
    const int head = 2 * hp + (wv >> 1), ql = 32 * (wv & 1) + r, qbase = 64 * c + 32 * (wv & 1);
    const unsigned thr = sel ? ((const unsigned*)(p->ws + WS_THR))[b * SEQ + c * 64 + ql] : 0u; const int cut = sel ? ((const int*)(p->ws + WS_THR))[T + b * SEQ + c * 64 + ql] : 0;
    const float* srow = SCRc + (size_t)ql * nadm;
    bf16x8 qr[4]; at_loadq(qr, P + (size_t)(qbase + r) * NPM + C_DSA_Q + head * 64, h);
    f32x16 o[2]; float m = NEGBIG, l = 0.f;
#pragma unroll
    for (int i = 0; i < 16; ++i) { o[0][i] = 0.f; o[1][i] = 0.f; }
    const int nst = (c + 2) >> 1;
    const bf16_t* Kc = P + C_DSA_K; const bf16_t* Vc = P + C_DSA_V;
    AtRegs pre0 = at_gload(Kc, Vc, tid), pre1 = at_gload(Kc + (size_t)((c >= 1) ? 64 : 0) * NPM, Vc + (size_t)((c >= 1) ? 64 : 0) * NPM, tid);
#pragma unroll 1
    for (int st = 0; st < nst; ++st) {
        __syncthreads();
        at_sstore(lds, pre0, tid); at_sstore(lds + AT_TILE_BYTES, pre1, tid);
        __syncthreads();
        if (st + 1 < nst) { const int j0 = 2 * st + 2, j1 = (j0 + 1 <= c) ? j0 + 1 : j0; pre0 = at_gload(Kc + (size_t)(64 * j0) * NPM, Vc + (size_t)(64 * j0) * NPM, tid); pre1 = at_gload(Kc + (size_t)(64 * j1) * NPM, Vc + (size_t)(64 * j1) * NPM, tid); }
        const int jt = 2 * st + g; const LAS unsigned char* tile = lds + g * AT_TILE_BYTES;
        if (jt <= c) {
            unsigned mb = 0u;
            if (sel) { const int cutrel = cut - 64 * jt;
#pragma unroll
                for (int kvh = 0; kvh < 2; ++kvh)
#pragma unroll
                    for (int gg = 0; gg < 4; ++gg) { const f32x4 sv = *(const f32x4*)(srow + 64 * jt + 32 * kvh + 8 * gg + 4 * h);
#pragma unroll
                        for (int j = 0; j < 4; ++j) { const unsigned kq = fkey(sv[j] + 0.f); const int kv = 32 * kvh + 8 * gg + 4 * h + j;
                            if ((kq > thr) || (kq == thr && kv <= cutrel)) mb |= 1u << (16 * kvh + 4 * gg + j); } }
            }
            f32x16 p0, p1; bf16x8 pk[4];
            at_qk(p0, p1, tile, qr, r, h);
            if (sel) at_softmax<false, false, true>(p0, p1, m, l, o, pk, 0.125f * LOG2E, nullptr, 0, h, mb);
            else at_softmax<false, false>(p0, p1, m, l, o, pk, 0.125f * LOG2E, nullptr, 0, h);
            at_pv(o, tile + AT_K_BYTES, pk, r, h);
        }
    }
    __syncthreads();
    LAS float* cb = (LAS float*)lds + (size_t)wv * (34 * 64);
    if (g == 1) { cb[lane] = m; cb[64 + lane] = l;
#pragma unroll
        for (int i = 0; i < 16; ++i) { cb[(2 + i) * 64 + lane] = o[0][i]; cb[(18 + i) * 64 + lane] = o[1][i]; } }
    __syncthreads();
    if (g == 0) { const float mb = cb[lane], lb = cb[64 + lane]; const float M = fmaxf(m, mb), sa = __builtin_amdgcn_exp2f(m - M), sb = __builtin_amdgcn_exp2f(mb - M);
        l = l * sa + lb * sb;
#pragma unroll
        for (int i = 0; i < 16; ++i) { o[0][i] = o[0][i] * sa + cb[(2 + i) * 64 + lane] * sb; o[1][i] = o[1][i] * sa + cb[(18 + i) * 64 + lane] * sb; }
        const float lt = l + __shfl_xor(l, 32);
        at_store(OCT + (size_t)(b * SEQ + qbase + r) * OC + 1024 + head * 64, o, 1.f / lt, h); }
}

template <int N> __device__ __forceinline__ float dpp_ror(float x) { return __int_as_float(__builtin_amdgcn_update_dpp(0, __float_as_int(x), 0x120 + N, 0xf, 0xf, false)); }
__device__ __forceinline__ void row16_sum2(float& a, float& b) {
    a += dpp_ror<8>(a); b += dpp_ror<8>(b); a += dpp_ror<4>(a); b += dpp_ror<4>(b); a += dpp_ror<2>(a); b += dpp_ror<2>(b); a += dpp_ror<1>(a); b += dpp_ror<1>(b);
}
__device__ __forceinline__ float row16_sum(float x) { x += dpp_ror<8>(x); x += dpp_ror<4>(x); x += dpp_ror<2>(x); x += dpp_ror<1>(x); return x; }
__device__ __forceinline__ void rwkv_scan2(KP p, int l, int sw, LAS unsigned char* lds) {
    const int tid = my_tid(), lane = tid & 63, wave = tid >> 6; const int bh = sw >> 2, b = bh >> 2, h = bh & 3, rowbase = 16 * (sw & 3);
    const int rl = lane >> 4, c = lane & 15, r16 = 4 * (wave & 3) + rl;
    const float* RW = (const float*)(p->ws + WS_RW);
    const float* RWv = RW + (size_t)5 * T * 256; float* Y = (float*)(p->ws + WS_Y); float* BONW = (float*)(p->ws + WS_BONUS); const float rkl = p->in[I_RK][l * 256 + h * 64 + lane];
    LAS float* L = (LAS float*)lds;
    LAS float* Lv = L + 5 * 1024; LAS float* Ly = Lv + 256;
    f32x4 S = (f32x4){0.f, 0.f, 0.f, 0.f}, rprev = (f32x4){0.f, 0.f, 0.f, 0.f};
    const size_t hb = (size_t)b * SEQ * 256 + h * 64;
    f32x2 pre[5]; float vpre = 0.f;
#pragma unroll
    for (int a = 0; a < 5; ++a) { const int e = 2 * tid; pre[a] = *(const f32x2*)(RW + (size_t)a * T * 256 + hb + (size_t)(e >> 6) * 256 + (e & 63)); }
    if (tid < 256) vpre = RWv[hb + (size_t)(tid >> 4) * 256 + rowbase + (tid & 15)];
#pragma unroll 1
    for (int tb = 0; tb < SEQ; tb += 16) {
        __syncthreads();
        if (tb > 0 && tid < 256) { const int st = tb - 17 + (tid >> 4); if (st >= 0) Y[hb + (size_t)st * 256 + rowbase + (tid & 15)] = Ly[tid]; }
#pragma unroll
        for (int a = 0; a < 5; ++a) *(LAS f32x2*)(L + a * 1024 + 2 * tid) = pre[a];
        if (tid < 256) Lv[tid] = vpre;
        __syncthreads();
        if (tb + 16 < SEQ) {
#pragma unroll
            for (int a = 0; a < 5; ++a) { const int e = 2 * tid; pre[a] = *(const f32x2*)(RW + (size_t)a * T * 256 + hb + (size_t)(tb + 16 + (e >> 6)) * 256 + (e & 63)); }
            if (tid < 256) vpre = RWv[hb + (size_t)(tb + 16 + (tid >> 4)) * 256 + rowbase + (tid & 15)];
        }
        if ((sw & 3) == 0 && wave >= 4) {
#pragma unroll
            for (int i4 = 0; i4 < 4; ++i4) { const int i = 4 * (wave - 4) + i4; const float s = wave_sum(L[0 * 1024 + i * 64 + lane] * L[2 * 1024 + i * 64 + lane] * rkl);
                if (lane == 0) BONW[(size_t)(b * SEQ + tb + i) * 4 + h] = s; }
        }
        if (wave < 4) {
            f32x4 r_ = *(const LAS f32x4*)(L + 0 * 1024 + 4 * c), w_ = *(const LAS f32x4*)(L + 1 * 1024 + 4 * c), k_ = *(const LAS f32x4*)(L + 2 * 1024 + 4 * c);
            f32x4 kk_ = *(const LAS f32x4*)(L + 3 * 1024 + 4 * c), ka_ = *(const LAS f32x4*)(L + 4 * 1024 + 4 * c); float v_ = Lv[r16];
#pragma unroll
            for (int i = 0; i < 16; ++i) {
                f32x4 rn = r_, wn = w_, kn = k_, kkn = kk_, kan = ka_; float vn = v_;
                if (i < 15) { rn = *(const LAS f32x4*)(L + 0 * 1024 + (i + 1) * 64 + 4 * c); wn = *(const LAS f32x4*)(L + 1 * 1024 + (i + 1) * 64 + 4 * c); kn = *(const LAS f32x4*)(L + 2 * 1024 + (i + 1) * 64 + 4 * c);
                    kkn = *(const LAS f32x4*)(L + 3 * 1024 + (i + 1) * 64 + 4 * c); kan = *(const LAS f32x4*)(L + 4 * 1024 + (i + 1) * 64 + 4 * c); vn = Lv[(i + 1) * 16 + r16]; }
                float pa = (S.x * kk_.x + S.y * kk_.y) + (S.z * kk_.z + S.w * kk_.w);
                float py = (S.x * rprev.x + S.y * rprev.y) + (S.z * rprev.z + S.w * rprev.w);
                row16_sum2(pa, py);
                Ly[i * 16 + r16] = py;
                S = S * w_ - ka_ * pa + k_ * v_;
                rprev = r_;
                r_ = rn; w_ = wn; k_ = kn; kk_ = kkn; ka_ = kan; v_ = vn;
            }
        }
    }
    __syncthreads();
    if (tid < 256) { const int st = SEQ - 17 + (tid >> 4); Y[hb + (size_t)st * 256 + rowbase + (tid & 15)] = Ly[tid]; }
    if (wave < 4) { const float py = row16_sum((S.x * rprev.x + S.y * rprev.y) + (S.z * rprev.z + S.w * rprev.w)); if (c == 0) Y[hb + (size_t)(SEQ - 1) * 256 + rowbase + r16] = py; }
}
__device__ __forceinline__ void rwkv_post(KP p, int l) {
    const int tid = my_tid(), lane = tid & 63, wave = tid >> 6, gw = blockIdx.x * 8 + wave, NGW = gridDim.x * 8;
    const float* RW = (const float*)(p->ws + WS_RW); const float* RWv = RW + (size_t)5 * T * 256; const float* RWg = RW + (size_t)6 * T * 256;
    const float* Y = (const float*)(p->ws + WS_Y); const float* BON = (const float*)(p->ws + WS_BONUS); bf16_t* OCT = (bf16_t*)(p->ws + WS_OCAT);
    float gng[4], gnb[4];
#pragma unroll
    for (int hh = 0; hh < 4; ++hh) { gng[hh] = p->in[I_GNG][l * 256 + hh * 64 + lane]; gnb[hh] = p->in[I_GNB][l * 256 + hh * 64 + lane]; }
    for (int t = gw; t < T; t += NGW) {
#pragma unroll
        for (int hh = 0; hh < 4; ++hh) { const size_t o = (size_t)t * 256 + hh * 64 + lane; const float yy = Y[o];
            const float mean = wave_sum(yy) * (1.f / 64.f); const float d = yy - mean; const float var = wave_sum(d * d) * (1.f / 64.f);
            const float ov = (d * rsqrtf(var + 64e-5f) * gng[hh] + gnb[hh] + BON[t * 4 + hh] * RWv[o]) * RWg[o];
            OCT[(size_t)t * OC + 512 + hh * 64 + lane] = (bf16_t)f2bf(ov); }
    }
}

__device__ __forceinline__ void ph_scan(KP p, int l, LAS unsigned char* lds) {
    if (blockIdx.x < 128) { rwkv_scan2(p, l, blockIdx.x, lds); return; }
    const int tid = my_tid(); unsigned* ctl = (unsigned*)(p->ws + WS_CTL) + 512 + 64 * l; LAS int* slot = (LAS int*)(lds + LDS_BYTES - 256);
    for (;;) { if (tid == 0) *slot = (int)atomicAdd(ctl, 1u); __syncthreads(); const int it = *slot; __syncthreads(); if (it >= 512) break; fox_unit(p, it & 31, 15 - (it >> 5), lds); __syncthreads(); }
    for (;;) { if (tid == 0) *slot = (int)atomicAdd(ctl + 16, 1u); __syncthreads(); const int it = *slot; __syncthreads(); if (it >= 512) break; swa_unit(p, l, it, lds); __syncthreads(); }
}
__device__ __forceinline__ void ph_attn(KP p, int l, LAS unsigned char* lds) {
    dsa_scores(p, lds);
    rwkv_post(p, l);
}
__device__ __forceinline__ void ph_dsa_xb(KP p, int l, LAS unsigned char* lds) {
    {
        const int w = blockIdx.x, b = w >> 5, s = (w >> 1) & 15, hp = w & 1;
        dsa_unit(p, b, 31 - s, hp, lds);
        __syncthreads();
        dsa_unit(p, b, s, hp, lds);
        __syncthreads();
    }
    const int tid = my_tid(), lane = tid & 63, wave = tid >> 6, gw = blockIdx.x * 8 + wave, NGW = gridDim.x * 8;
    const float* src = (l == 0) ? p->in[I_X] : p->out; bf16_t* XB = (bf16_t*)(p->ws + WS_XB2);
    for (int m = gw; m < T; m += NGW) row_to_bf16(src + (size_t)m * D, XB + (size_t)m * D, lane);
}

struct SchedMerge {
    static constexpr int PERM = 1;
    const char* XB; const char* WIN; const char* OCT; const char* WB; int G, c;
    __device__ __forceinline__ bool next(int i, mg::Unit& u) const {
        int pm, pn; if (!mg::static_tile(i >> 3, G, c, T / 256, 4, pm, pn)) return false;
        const int j = i & 7, br = j >> 1; u.pm = pm; u.pn = pn; u.tag = j;
        if ((j & 1) == 0) { u.A = XB + (size_t)pm * 256 * 2048; u.B = WIN + (size_t)(3328 + 1024 * br + 256 * pn) * 2048; u.ld = 2048; u.nt = 16; }
        else { const int koff = (br == 0) ? 0 : 256 + 256 * br, kk = (br == 0) ? 512 : 256;
            u.A = OCT + (size_t)pm * 256 * (OC * 2) + koff * 2; u.B = WB + (size_t)pn * 256 * (OC * 2) + koff * 2; u.ld = OC * 2; u.nt = kk / 64; }
        return true;
    }
};
struct EpiMerge {
    const float* gbias; u32x4* gsc; u32x4* macc; bf16_t* MB;
    __device__ __forceinline__ void operator()(const AccT& acc, const mg::Unit& u, int wr, int wc, int fr, int fq, int tid) const {
        const int br = u.tag >> 1; const int col0 = u.pn * 256 + wc * 32 + 8 * fq, row0 = u.pm * 256 + wr * 64 + fr;
        if ((u.tag & 1) == 0) {
            f32x4 bv[2][2];
#pragma unroll
            for (int bj = 0; bj < 2; ++bj)
#pragma unroll
                for (int n = 0; n < 2; ++n) bv[bj][n] = *(const f32x4*)(gbias + br * 1024 + col0 + bj * 128 + 4 * n);
#pragma unroll
            for (int ai = 0; ai < 2; ++ai)
#pragma unroll
                for (int m = 0; m < 4; ++m)
#pragma unroll
                    for (int bj = 0; bj < 2; ++bj) { f32x4 g[2];
#pragma unroll
                        for (int n = 0; n < 2; ++n) { const f32x4 x = acc[ai][bj][m][n] + bv[bj][n];
#pragma unroll
                            for (int j = 0; j < 4; ++j) g[n][j] = sigm(x[j]); }
                        u32x4 w; w.x = pk2(g[0][0], g[0][1]); w.y = pk2(g[0][2], g[0][3]); w.z = pk2(g[1][0], g[1][1]); w.w = pk2(g[1][2], g[1][3]);
                        gsc[(((ai * 4 + m) * 2 + bj) * 512) + tid] = w; asm volatile("" ::: "memory"); }
        } else {
#pragma unroll
            for (int ai = 0; ai < 2; ++ai)
#pragma unroll
                for (int m = 0; m < 4; ++m) { bf16_t* rowp = MB + (size_t)(row0 + ai * 128 + m * 16) * D + col0;
#pragma unroll
                    for (int bj = 0; bj < 2; ++bj) { const int idx = (((ai * 4 + m) * 2 + bj) * 512) + tid; float g[8], r[8]; unpack8(gsc[idx], g);
#pragma unroll
                        for (int n = 0; n < 2; ++n)
#pragma unroll
                            for (int j = 0; j < 4; ++j) r[4 * n + j] = g[4 * n + j] * acc[ai][bj][m][n][j];
                        if (br > 0) { float pm[8]; unpack8(macc[idx], pm);
#pragma unroll
                            for (int j = 0; j < 8; ++j) r[j] += pm[j]; }
                        u32x4 w; w.x = pk2(r[0], r[1]); w.y = pk2(r[2], r[3]); w.z = pk2(r[4], r[5]); w.w = pk2(r[6], r[7]);
                        if (br < 3) macc[idx] = w; else *(u32x4*)(rowp + bj * 128) = w;
                        asm volatile("" ::: "memory"); } }
        }
    }
};
__device__ __forceinline__ void ph_merge(KP p, int l, LAS unsigned char* lds) {
    SchedMerge S{(const char*)(p->ws + WS_XB2), (const char*)(p->ws + WS_WIN), (const char*)(p->ws + WS_OCAT), (const char*)(p->ws + WS_WB), (int)gridDim.x, (int)blockIdx.x};
    EpiMerge E{p->in[I_GB] + (size_t)l * 4096, (u32x4*)(p->ws + WS_GSC) + (size_t)blockIdx.x * 8192, (u32x4*)(p->ws + WS_MACC) + (size_t)blockIdx.x * 8192, (bf16_t*)(p->ws + WS_MERGED)};
    mg::gemm_run(lds, S, E);
}

struct EpiResid {
    const float* base; float* out; float alpha;
    __device__ __forceinline__ void operator()(const AccT& acc, const mg::Unit& u, int wr, int wc, int fr, int fq, int) const {
        const int row0 = u.pm * 256 + wr * 64 + fr, col0 = u.pn * 256 + wc * 32 + 4 * fq;
#pragma unroll
        for (int ai = 0; ai < 2; ++ai)
#pragma unroll
            for (int m = 0; m < 4; ++m) { const size_t off = (size_t)(row0 + ai * 128 + m * 16) * D + col0;
#pragma unroll
                for (int bj = 0; bj < 2; ++bj)
#pragma unroll
                    for (int n = 0; n < 2; ++n) { const f32x4 bs = *(const f32x4*)(base + off + bj * 128 + n * 16); *(f32x4*)(out + off + bj * 128 + n * 16) = bs * alpha + acc[ai][bj][m][n]; } }
    }
};
__device__ __forceinline__ void ph_outproj(KP p, int l, LAS unsigned char* lds) {
    SchedPlain<0, 4, D> S{(const char*)(p->ws + WS_MERGED), (const char*)(p->ws + WS_WO), (int)gridDim.x, (int)blockIdx.x};
    EpiResid E{(l == 0) ? p->in[I_X] : p->out, p->out, DN_ALPHA};
    mg::gemm_run(lds, S, E);
}

__device__ __forceinline__ void ln_rows(KP p, int l, int mode, LAS unsigned char* lds) {
    const int tid = my_tid(), lane = tid & 63, wave = tid >> 6;
    const float* g = p->in[I_LNG] + (size_t)(l * 2 + mode) * D; const float* bb = p->in[I_LNB] + (size_t)(l * 2 + mode) * D;
    bf16_t* OB = (bf16_t*)(p->ws + (mode == 0 ? WS_X1B : WS_XB)); const bool wb = (mode == 0) || (l == 0);
    const bool moe = (mode == 0) && (l & 1); const float* rw = p->in[I_RTW] + (size_t)(l >> 1) * D * NE; const float* rb = p->in[I_RTB] + (l >> 1) * NE;
    int* TOKE = (int*)(p->ws + WS_TOKE); float* TOKW = (float*)(p->ws + WS_TOKW);
    f32x4 gv[4], bv[4];
#pragma unroll
    for (int j = 0; j < 4; ++j) { gv[j] = *(const f32x4*)(g + 4 * lane + 256 * j); bv[j] = *(const f32x4*)(bb + 4 * lane + 256 * j); }
    const int rows_per_wg = T / gridDim.x;
#pragma unroll 2
    for (int rr = wave; rr < rows_per_wg; rr += 8) {
        const int row = blockIdx.x * rows_per_wg + rr; float* xr = p->out + (size_t)row * D;
        f32x4 v[4]; float s = 0.f;
#pragma unroll
        for (int j = 0; j < 4; ++j) v[j] = *(const f32x4*)(xr + 4 * lane + 256 * j);
        if (mode == 1 && (l & 1)) {
            const int* RO = (const int*)(p->ws + WS_ROWOF); const bf16_t* YB = (const bf16_t*)(p->ws + WS_AG);
#pragma unroll
            for (int sl = 0; sl < 2; ++sl) { const int yr = RO[row * 2 + sl]; const float w = TOKW[row * 2 + sl];
#pragma unroll
                for (int j = 0; j < 4; ++j) { const u32x2 y = *(const u32x2*)(YB + (size_t)yr * D + 4 * lane + 256 * j);
                    v[j].x += w * bflo(y.x); v[j].y += w * bfhi(y.x); v[j].z += w * bflo(y.y); v[j].w += w * bfhi(y.y); } } }
#pragma unroll
        for (int j = 0; j < 4; ++j) s += (v[j].x + v[j].y) + (v[j].z + v[j].w);
        const float mean = wave_sum(s) * (1.f / D); float s2 = 0.f;
#pragma unroll
        for (int j = 0; j < 4; ++j) { v[j] = v[j] - mean; s2 += (v[j].x * v[j].x + v[j].y * v[j].y) + (v[j].z * v[j].z + v[j].w * v[j].w); }
        const float rstd = rsqrtf(wave_sum(s2) * (1.f / D) + LN_EPS);
        const float osc = (mode == 0) ? DN_ALPHA : 1.f;
#pragma unroll
        for (int j = 0; j < 4; ++j) { v[j] = v[j] * rstd * gv[j] + bv[j]; *(f32x4*)(xr + 4 * lane + 256 * j) = v[j] * osc;
            if (wb) *(unsigned long long*)(OB + (size_t)row * D + 4 * lane + 256 * j) = (unsigned long long)pk2(v[j].x, v[j].y) | ((unsigned long long)pk2(v[j].z, v[j].w) << 32); }
        if (moe) {
            float lg[8];
#pragma unroll
            for (int e = 0; e < 8; ++e) lg[e] = 0.f;
#pragma unroll
            for (int j = 0; j < 4; ++j)
#pragma unroll
                for (int q = 0; q < 4; ++q) { const int c = 4 * lane + 256 * j + q; const f32x4 w0 = *(const f32x4*)(rw + (size_t)c * 8), w1 = *(const f32x4*)(rw + (size_t)c * 8 + 4); const float x = v[j][q];
                    lg[0] += x * w0.x; lg[1] += x * w0.y; lg[2] += x * w0.z; lg[3] += x * w0.w; lg[4] += x * w1.x; lg[5] += x * w1.y; lg[6] += x * w1.z; lg[7] += x * w1.w; }
#pragma unroll
            for (int e = 0; e < 8; ++e) lg[e] = wave_sum(lg[e]) + rb[e];
            int e1 = 0; float v1 = lg[0];
#pragma unroll
            for (int e = 1; e < 8; ++e) if (lg[e] > v1) { v1 = lg[e]; e1 = e; }
            int e2 = -1; float v2 = -INFINITY;
#pragma unroll
            for (int e = 0; e < 8; ++e) if (e != e1 && lg[e] > v2) { v2 = lg[e]; e2 = e; }
            const float w1 = 1.f / (1.f + __expf(v2 - v1));
            if (lane == 0) { TOKE[row * 2] = e1; TOKE[row * 2 + 1] = e2; TOKW[row * 2] = w1; TOKW[row * 2 + 1] = 1.f - w1; }
        }
    }
    if (moe) {
        __syncthreads();
        if (tid < 8) { int cnt = 0; for (int rr = 0; rr < rows_per_wg; ++rr) { const int row = blockIdx.x * rows_per_wg + rr; cnt += (TOKE[row * 2] == tid) + (TOKE[row * 2 + 1] == tid); }
            ((int*)(p->ws + WS_WGCNT))[blockIdx.x * 8 + tid] = cnt; }
    }
}
__device__ __forceinline__ void ph_ln1(KP p, int l, LAS unsigned char* lds) {
    ln_rows(p, l, 0, lds);
    __syncthreads();
    const int tid_ = my_tid(); const int lane = tid_ & 63, wave = tid_ >> 6, gw = blockIdx.x * 8 + wave, NGW = gridDim.x * 8;
    LAS float* scr = (LAS float*)(lds + wave * 8448);
    bf16_t* W13 = (bf16_t*)(p->ws + WS_WF13);
    if ((l & 1) == 0) {
        const int j = l >> 1; const float* w1 = p->in[I_F1] + (size_t)j * D * DFF; const float* w3 = p->in[I_F3] + (size_t)j * D * DFF; const float* w2 = p->in[I_F2] + (size_t)j * DFF * D;
        bf16_t* W2 = (bf16_t*)(p->ws + WS_WF2_DENSE);
        const int n1 = tr_nitems(D, DFF), n2 = tr_nitems(DFF, D);
        for (int it = gw; it < 2 * n1 + n2; it += NGW) { int r = it;
            if (r < n1) { tr_item(w1, D, DFF, W13, D, 2, 0, scr, r, lane); continue; } r -= n1;
            if (r < n1) { tr_item(w3, D, DFF, W13, D, 3, 0, scr, r, lane); continue; } r -= n1;
            tr_item(w2, DFF, D, W2, DFF, 0, 0, scr, r, lane); }
    } else {
        const int j = l >> 1; bf16_t* W2 = (bf16_t*)(p->ws + WS_WF2_MOE);
        const int n1 = tr_nitems(D, DFE), n2 = tr_nitems(DFE, D), per = 2 * n1 + n2;
        for (int it = gw; it < NE * per; it += NGW) { const int e = it / per; int r = it % per;
            const float* w1 = p->in[I_E1] + ((size_t)j * NE + e) * D * DFE; const float* w3 = p->in[I_E3] + ((size_t)j * NE + e) * D * DFE; const float* w2 = p->in[I_E2] + ((size_t)j * NE + e) * DFE * D;
            if (r < n1) { tr_item(w1, D, DFE, W13, D, 2, e * 2 * DFE, scr, r, lane); continue; } r -= n1;
            if (r < n1) { tr_item(w3, D, DFE, W13, D, 3, e * 2 * DFE, scr, r, lane); continue; } r -= n1;
            tr_item(w2, DFE, D, W2, DFE, 0, e * D, scr, r, lane); }
    }
}

__device__ __forceinline__ void moe_tables(KP p, LAS int* tb  ) {
    const int tid = my_tid(); const int* WG = (const int*)(p->ws + WS_WGCNT);
    if (tid < 8) { int tot = 0, mine = 0; for (int w = 0; w < (int)gridDim.x; ++w) { const int c = WG[w * 8 + tid]; if (w < (int)blockIdx.x) mine += c; tot += c; } tb[tid] = tot; tb[16 + tid] = mine; }
    __syncthreads();
    if (tid == 0) { int base = 0; for (int e = 0; e < 8; ++e) { tb[8 + e] = base; base += ((tb[e] + 255) >> 8) << 8; } tb[24] = base; }
    __syncthreads();
}
__device__ __forceinline__ void ph_moe_assign(KP p, int l, LAS unsigned char* lds) {
    const int tid = my_tid(), lane = tid & 63, wave = tid >> 6;
    LAS int* tb = (LAS int*)lds; LAS int* rowof = tb + 32;
    moe_tables(p, tb);
    const int rows_per_wg = T / gridDim.x; const int* TOKE = (const int*)(p->ws + WS_TOKE); const float* TOKW = (const float*)(p->ws + WS_TOKW);
    int* ROWTOK = (int*)(p->ws + WS_ROWTOK); float* ROWW = (float*)(p->ws + WS_ROWW);
    if (tid < 8) { int run = tb[8 + tid] + tb[16 + tid];
        for (int rr = 0; rr < rows_per_wg; ++rr) { const int row = blockIdx.x * rows_per_wg + rr;
#pragma unroll
            for (int s = 0; s < 2; ++s) if (TOKE[row * 2 + s] == tid) { ROWTOK[run] = row; ROWW[run] = TOKW[row * 2 + s]; rowof[rr * 2 + s] = run; ((int*)(p->ws + WS_ROWOF))[row * 2 + s] = run; ++run; } } }
    bf16_t* AG = (bf16_t*)(p->ws + WS_AG);
    if (blockIdx.x < 8) { const int e = blockIdx.x, lo = tb[8 + e] + tb[e], hi = tb[8 + e] + (((tb[e] + 255) >> 8) << 8);
        for (int r = lo + wave; r < hi; r += 8) { if (lane == 0) { ROWTOK[r] = -1; ROWW[r] = 0.f; }
#pragma unroll
            for (int j = 0; j < 2; ++j) *(u32x4*)(AG + (size_t)r * D + 8 * lane + 512 * j) = (u32x4){0u, 0u, 0u, 0u}; } }
    __syncthreads();
    const bf16_t* X1B = (const bf16_t*)(p->ws + WS_X1B);
    for (int pr = wave; pr < rows_per_wg * 2; pr += 8) { const int row = blockIdx.x * rows_per_wg + (pr >> 1), dst = rowof[pr];
#pragma unroll
        for (int j = 0; j < 2; ++j) *(u32x4*)(AG + (size_t)dst * D + 8 * lane + 512 * j) = *(const u32x4*)(X1B + (size_t)row * D + 8 * lane + 512 * j); }
}

struct EpiSwiglu {
    bf16_t* H; int ldh;
    __device__ __forceinline__ void operator()(const AccT& acc, const mg::Unit& u, int wr, int wc, int fr, int fq, int) const {
        const int row0 = u.pm * 256 + wr * 64 + fr, col0 = u.pn * 128 + wc * 32 + 8 * fq;
#pragma unroll
        for (int ai = 0; ai < 2; ++ai)
#pragma unroll
            for (int m = 0; m < 4; ++m) { float hv[8];
#pragma unroll
                for (int n = 0; n < 2; ++n)
#pragma unroll
                    for (int j = 0; j < 4; ++j) { const float a = acc[ai][0][m][n][j], b = acc[ai][1][m][n][j]; hv[4 * n + j] = a * sigm(a) * b; }
                u32x4 w; w.x = pk2(hv[0], hv[1]); w.y = pk2(hv[2], hv[3]); w.z = pk2(hv[4], hv[5]); w.w = pk2(hv[6], hv[7]);
                *(u32x4*)(H + (size_t)(row0 + ai * 128 + m * 16) * ldh + col0) = w; asm volatile("" ::: "memory"); }
    }
};
template <int PERM_, int NN, int K, int BROWS> struct SchedMoe {
    static constexpr int PERM = PERM_;
    const char* A; const char* B; const LAS int* tstart; int G, c;
    __device__ __forceinline__ bool next(int i, mg::Unit& u) const {
        const int L = i * G + c; if (L >= tstart[8] * NN) return false;
        const int rt = L / NN, pn = L % NN; int e = 0;
#pragma unroll
        for (int x = 1; x < 8; ++x) if (rt >= tstart[x]) e = x;
        u.A = A + (size_t)rt * 256 * (K * 2); u.B = B + ((size_t)e * BROWS + (size_t)pn * 256) * (K * 2); u.ld = K * 2; u.nt = K / 64; u.pm = rt; u.pn = pn; u.tag = 0; return true;
    }
};
template <class SM> __device__ __forceinline__ void moe_sched_tiles(KP p, LAS unsigned char* lds, SM& S) {
    LAS int* tb = (LAS int*)(lds + LDS_BYTES - 512);
    moe_tables(p, tb);
    { const int t_ = my_tid(); if (t_ < 8) tb[32 + t_] = tb[8 + t_] >> 8; if (t_ == 8) tb[40] = tb[24] >> 8; }
    __syncthreads();
    S.tstart = tb + 32;
}
__device__ __forceinline__ void ph_ffn_up(KP p, int l, LAS unsigned char* lds) {
    if ((l & 1) == 0) {
        SchedPlain<1, 2 * DFF / 256, D> S{(const char*)(p->ws + WS_X1B), (const char*)(p->ws + WS_WF13), (int)gridDim.x, (int)blockIdx.x};
        EpiSwiglu E{(bf16_t*)(p->ws + WS_H), DFF};
        mg::gemm_run(lds, S, E);
    } else {
        SchedMoe<1, 2 * DFE / 256, D, 2 * DFE> S; S.A = (const char*)(p->ws + WS_AG); S.B = (const char*)(p->ws + WS_WF13);
        S.G = (int)gridDim.x; S.c = (int)blockIdx.x; moe_sched_tiles(p, lds, S);
        EpiSwiglu E{(bf16_t*)(p->ws + WS_H), DFE};
        mg::gemm_run(lds, S, E);
    }
}

struct EpiAccum {
    float* out;
    __device__ __forceinline__ void operator()(const AccT& acc, const mg::Unit& u, int wr, int wc, int fr, int fq, int) const {
        const int row0 = u.pm * 256 + wr * 64 + fr, col0 = u.pn * 256 + wc * 32 + 4 * fq;
#pragma unroll
        for (int ai = 0; ai < 2; ++ai)
#pragma unroll
            for (int m = 0; m < 4; ++m) { float* rp = out + (size_t)(row0 + ai * 128 + m * 16) * D + col0;
#pragma unroll
                for (int bj = 0; bj < 2; ++bj)
#pragma unroll
                    for (int n = 0; n < 2; ++n) { f32x4* q = (f32x4*)(rp + bj * 128 + n * 16); *q = *q + acc[ai][bj][m][n]; } }
    }
};
struct EpiScatter {
    float* out; const int* rowtok; const float* roww;
    __device__ __forceinline__ void operator()(const AccT& acc, const mg::Unit& u, int wr, int wc, int fr, int fq, int) const {
        const int row0 = u.pm * 256 + wr * 64 + fr, col0 = u.pn * 256 + wc * 32 + 4 * fq;
#pragma unroll
        for (int ai = 0; ai < 2; ++ai)
#pragma unroll
            for (int m = 0; m < 4; ++m) { const int r = row0 + ai * 128 + m * 16; const int tok = rowtok[r]; const float w = roww[r];
                if (tok >= 0) { float* rp = out + (size_t)tok * D + col0;
#pragma unroll
                    for (int bj = 0; bj < 2; ++bj)
#pragma unroll
                        for (int n = 0; n < 2; ++n)
#pragma unroll
                            for (int j = 0; j < 4; ++j) unsafeAtomicAdd(rp + bj * 128 + n * 16 + j, w * acc[ai][bj][m][n][j]); } }
    }
};
__device__ __forceinline__ void ph_ffn_down(KP p, int l, LAS unsigned char* lds) {
    if ((l & 1) == 0) {
        SchedPlain<0, 4, DFF> S{(const char*)(p->ws + WS_H), (const char*)(p->ws + WS_WF2_DENSE), (int)gridDim.x, (int)blockIdx.x};
        EpiAccum E{p->out};
        mg::gemm_run(lds, S, E);
    } else {
        SchedMoe<1, 4, DFE, D> S; S.A = (const char*)(p->ws + WS_H); S.B = (const char*)(p->ws + WS_WF2_MOE);
        S.G = (int)gridDim.x; S.c = (int)blockIdx.x; moe_sched_tiles(p, lds, S);
        EpiBf16Store E{(bf16_t*)(p->ws + WS_AG), D};
        mg::gemm_run(lds, S, E);
    }
}


#define XB_TMO      128
#define XB_XCNT(j)  (256  + 64 * (j))
#define XB_XSUB(j)  (1280 + 64 * (j))
#define XB_XGEN(j)  (2304 + 64 * (j))
#define XB_TOP      3328
#define XB_TOPGEN   3392
#define XCD_BAR_WORDS 3456
#define XB_SPIN_CAP (1u << 18)
__device__ __forceinline__ unsigned xb_ld(unsigned* p)              { return __hip_atomic_load(p, __ATOMIC_RELAXED, __HIP_MEMORY_SCOPE_AGENT); }
__device__ __forceinline__ unsigned xb_add(unsigned* p, unsigned v) { return __hip_atomic_fetch_add(p, v, __ATOMIC_RELAXED, __HIP_MEMORY_SCOPE_AGENT); }
__device__ __forceinline__ unsigned xb_xcc_id() { return (unsigned)__builtin_amdgcn_s_getreg((3 << 11) | 20) & 0xFu; }
#define XB_SPIN(cond, bar) do { unsigned _sp = 0; while (cond) { __builtin_amdgcn_s_sleep(1); \
    if ((++_sp & 255u) == 0u) { if (xb_ld(&(bar)[XB_TMO])) break; if (_sp > XB_SPIN_CAP) { atomicAdd(&(bar)[XB_TMO], 1u); break; } } } } while (0)
struct XcdBarrier { unsigned* bar; unsigned x; volatile LAS unsigned* st; };
__device__ __forceinline__ XcdBarrier xcd_barrier_post(unsigned* bar, volatile LAS unsigned* st) {
    XcdBarrier b; b.bar = bar; b.x = xb_xcc_id(); b.st = st;
    if (threadIdx.x == 0) (void)xb_add(&bar[XB_XCNT(b.x)], 1u);
    return b;
}
__device__ __forceinline__ void xcd_barrier_complete(unsigned* bar, unsigned x, unsigned& nloc, unsigned& nx) {
    const unsigned G = gridDim.x * gridDim.y * gridDim.z;
    unsigned sum, cnt, mine, sp = 0u;
    for (;;) {
        sum = 0u; cnt = 0u; mine = 0u;
#pragma unroll
        for (unsigned j = 0; j < 16; ++j) { const unsigned c = xb_ld(&bar[XB_XCNT(j)]); sum += c; cnt += (c > 0u) ? 1u : 0u; mine = (j == x) ? c : mine; }
        if (sum == G) break;
        __builtin_amdgcn_s_sleep(1);
        if ((++sp & 255u) == 0u) { if (xb_ld(&bar[XB_TMO])) break; if (sp > XB_SPIN_CAP) { atomicAdd(&bar[XB_TMO], 1u); break; } }
    }
    nloc = mine > 0u ? mine : 1u; nx = cnt > 0u ? cnt : 1u;
}
__device__ __forceinline__ void xcd_barrier(const XcdBarrier& b) {
    asm volatile("s_waitcnt vmcnt(0)" ::: "memory");
    __syncthreads();
    if (threadIdx.x == 0) {
        unsigned* bar = b.bar;
        __builtin_amdgcn_s_waitcnt(0);
        unsigned nloc = b.st[0], nx = b.st[1];
        if (nloc == 0u) { xcd_barrier_complete(bar, b.x, nloc, nx); b.st[0] = nloc; b.st[1] = nx; }
        const unsigned old = xb_add(&bar[XB_XSUB(b.x)], 1u);
        const unsigned gen = old / nloc;
        if (old + 1u == (gen + 1u) * nloc) {
            __builtin_amdgcn_fence(__ATOMIC_RELEASE, "agent");
            asm volatile("s_waitcnt vmcnt(0)" ::: "memory");
            const unsigned og = xb_add(&bar[XB_TOP], 1u);
            const unsigned tg = og / nx;
            if (og + 1u == (tg + 1u) * nx) xb_add(&bar[XB_TOPGEN], 1u);
            else XB_SPIN(xb_ld(&bar[XB_TOPGEN]) == tg, bar);
            __builtin_amdgcn_fence(__ATOMIC_ACQUIRE, "agent");
            xb_add(&bar[XB_XGEN(b.x)], 1u);
            asm volatile("s_waitcnt vmcnt(0)" ::: "memory");
        } else {
            XB_SPIN(xb_ld(&bar[XB_XGEN(b.x)]) == gen, bar);
            __builtin_amdgcn_fence(__ATOMIC_ACQUIRE, "agent");
            asm volatile("s_waitcnt vmcnt(0)" ::: "memory");
        }
    }
    __syncthreads();
}

constexpr int PH_PER_LAYER = 12, NPHASE = 2 * PH_PER_LAYER;
template <int K> __device__ __forceinline__ void run_phase(KP p, int l, LAS unsigned char* lds) {
    asm volatile("" : "+s"(lds));
    if constexpr (K == 0) ph_conv_mixer(p, l, lds);
    else if constexpr (K == 1) ph_inproj(p, l, lds);
    else if constexpr (K == 2) ph_prep(p, l, lds);
    else if constexpr (K == 21) ph_lora(p, l, lds);
    else if constexpr (K == 30) ph_scan(p, l, lds);
    else if constexpr (K == 31) ph_attn(p, l, lds);
    else if constexpr (K == 32) dsa_select(p, lds);
    else if constexpr (K == 4) ph_dsa_xb(p, l, lds);
    else if constexpr (K == 5) ph_merge(p, l, lds);
    else if constexpr (K == 6) ph_outproj(p, l, lds);
    else if constexpr (K == 7) ph_ln1(p, l, lds);
    else if constexpr (K == 8) ph_moe_assign(p, l, lds);
    else if constexpr (K == 9) ph_ffn_up(p, l, lds);
    else if constexpr (K == 10) ph_ffn_down(p, l, lds);
    else ln_rows(p, l, 1, lds);
}
template <int K> __global__ void __launch_bounds__(NTHREADS, 2) k_phase(Params, int l) {
    extern __shared__ __attribute__((aligned(16))) unsigned char lds_raw[];
    run_phase<K>(get_params(), l, (LAS unsigned char*)lds_raw);
}
#if FUSED
#define PH(K, L) do { run_phase<K>(get_params(), L, lds); __syncthreads(); } while (0)
#define SYNC() xcd_barrier(xbar)
__global__ void __launch_bounds__(NTHREADS, 2) k_fused(Params) {
    extern __shared__ __attribute__((aligned(16))) unsigned char lds_raw[];
    LAS unsigned char* lds = (LAS unsigned char*)lds_raw;
    cg::grid_group grid = cg::this_grid();
    volatile LAS unsigned* bst = (volatile LAS unsigned*)(lds + LDS_BYTES - 128);
    if (threadIdx.x < 2) bst[threadIdx.x] = 0u;
    __syncthreads();
    const XcdBarrier xbar = xcd_barrier_post((unsigned*)(get_params()->ws + WS_CTL) + 1024, bst);
    PH(0, 0); grid.sync();
    PH(1, 0); SYNC(); PH(2, 0); SYNC(); PH(21, 0); SYNC(); PH(30, 0); SYNC(); PH(31, 0); SYNC(); PH(32, 0); SYNC(); PH(4, 0); SYNC(); PH(5, 0); SYNC(); PH(6, 0); SYNC(); PH(7, 0); SYNC();
    PH(9, 0); SYNC(); PH(10, 0); SYNC(); PH(11, 0); SYNC();
    PH(0, 1); SYNC(); PH(1, 1); SYNC(); PH(2, 1); SYNC(); PH(21, 1); SYNC(); PH(30, 1); SYNC(); PH(31, 1); SYNC(); PH(32, 1); SYNC(); PH(4, 1); SYNC(); PH(5, 1); SYNC(); PH(6, 1); SYNC(); PH(7, 1); SYNC();
    PH(8, 1); SYNC(); PH(9, 1); SYNC(); PH(10, 1); SYNC(); PH(11, 1);
}
#undef PH
#undef SYNC
#endif
template <int K> static void launch_phase(const Params& p, int l, hipStream_t stream) {
    static bool attr = false;
    if (!attr) { (void)hipFuncSetAttribute((const void*)k_phase<K>, hipFuncAttributeMaxDynamicSharedMemorySize, LDS_BYTES); attr = true; }
    hipLaunchKernelGGL(k_phase<K>, dim3(256), dim3(NTHREADS), LDS_BYTES, stream, p, l);
}

extern "C" void kernel_launch(void* const* d_in, const int* in_sizes, int n_in, void* d_out, int out_size, void* d_ws, size_t ws_size, hipStream_t stream) {
    if (n_in != 28 || out_size != T * D || ws_size < WS_END) { fprintf(stderr, "kernel_launch: unexpected problem (n_in %d out %d ws %zu)\n", n_in, out_size, ws_size); return; }
    (void)hipMemsetAsync((char*)d_ws + WS_CTL, 0, 32768, stream);
    Params p{};
    for (int i = 0; i < 28; ++i) p.in[i] = (const float*)d_in[i];
    p.out = (float*)d_out; p.ws = (unsigned char*)d_ws;
#if FUSED
    static bool attr = false;
    if (!attr) { (void)hipFuncSetAttribute((const void*)k_fused, hipFuncAttributeMaxDynamicSharedMemorySize, LDS_BYTES); attr = true; }
    void* args[] = {&p};
    hipError_t e = hipLaunchCooperativeKernel((const void*)k_fused, dim3(256), dim3(NTHREADS), args, LDS_BYTES, stream);
    if (e != hipSuccess) fprintf(stderr, "cooperative launch failed: %s\n", hipGetErrorString(e));
    return;
#endif
    for (int l = 0; l < 2; ++l) {
        launch_phase<0>(p, l, stream); launch_phase<1>(p, l, stream); launch_phase<2>(p, l, stream); launch_phase<21>(p, l, stream);
        launch_phase<30>(p, l, stream); launch_phase<31>(p, l, stream); launch_phase<32>(p, l, stream);
        launch_phase<4>(p, l, stream); launch_phase<5>(p, l, stream); launch_phase<6>(p, l, stream); launch_phase<7>(p, l, stream);
        if (l & 1) launch_phase<8>(p, l, stream);
        launch_phase<9>(p, l, stream); launch_phase<10>(p, l, stream); launch_phase<11>(p, l, stream);
    }
}
```

```cpp
#include <hip/hip_runtime.h>
#include <hip/hip_cooperative_groups.h>
#include <cstdio>
#include <cstdint>
namespace cg = cooperative_groups;

#ifndef FUSED
#define FUSED 1
#endif

#define LAS __attribute__((address_space(3)))
typedef unsigned short bf16_t;
typedef short bf16x8 __attribute__((ext_vector_type(8)));
typedef float f32x4 __attribute__((ext_vector_type(4)));
typedef float f32x2 __attribute__((ext_vector_type(2)));
typedef unsigned u32x4 __attribute__((ext_vector_type(4)));
typedef unsigned u32x2 __attribute__((ext_vector_type(2)));

constexpr int T = 16384, D = 1024, SEQ = 2048, NB = 8;
constexpr int NPM = 3328;
constexpr int C_SWA_Q = 0, C_SWA_K = 512, C_SWA_V = 640, C_RW = 768;
constexpr int C_FOX_Q = 1792, C_FOX_K = 2048, C_FOX_V = 2304;
constexpr int C_DSA_Q = 2560, C_DSA_K = 2816, C_DSA_V = 2880, C_DSA_QI = 2944, C_DSA_KI = 3200, C_FLOG = 3264, C_WIDX = 3268;
constexpr int D_IN = 7368, NWIN = 7424;
constexpr int OC = 1280;
constexpr int DFF = 2816, DFE = 1408, NE = 8;
constexpr int MAXROWS = 34816;
constexpr float DN_ALPHA = 1.41421356237f;
constexpr float LN_EPS = 1e-5f;

constexpr size_t MiB = 1u << 20;
constexpr size_t WS_CTL = 0;
constexpr size_t WS_WIN = 1 * MiB, WS_WB = 16 * MiB, WS_WO = 19 * MiB;
constexpr size_t WS_THR = 21 * MiB + 256 * 1024  , WS_ROWOF = 21 * MiB  , WS_FOXC = 21 * MiB, WS_TOKE = 21 * MiB + 256 * 1024, WS_TOKW = 21 * MiB + 384 * 1024, WS_ROWTOK = 21 * MiB + 512 * 1024,
                 WS_ROWW = 21 * MiB + 768 * 1024, WS_WGCNT = 21 * MiB + 920 * 1024;
constexpr size_t WS_OCAT = 22 * MiB, WS_X1B = 22 * MiB;
constexpr size_t WS_PMIX = 62 * MiB, WS_MERGED = 62 * MiB, WS_MACC = 94 * MiB;
constexpr size_t WS_WF13 = 62 * MiB, WS_WF2_DENSE = 73 * MiB, WS_WF2_MOE = 106 * MiB, WS_H = 128 * MiB;
constexpr size_t WS_RW = 166 * MiB, WS_XB = 166 * MiB, WS_SCORES = 166 * MiB, WS_XB2 = 246 * MiB, WS_GSC = 158 * MiB, WS_AG = 222 * MiB;
constexpr size_t WS_BONUS = 278 * MiB, WS_Y = 279 * MiB, WS_LORA_A = 279 * MiB  ;
constexpr size_t WS_WLORA = 15 * MiB + 512 * 1024;
constexpr size_t WS_MASKB = 295 * MiB;
constexpr size_t WS_END = 299 * MiB;
constexpr size_t RWSZ = 16 * MiB;

constexpr int LDS_BYTES = 155648;
constexpr int NTHREADS = 512;

struct Params { const float* in[28]; float* out; unsigned char* ws; };
typedef const __attribute__((address_space(4))) Params* KP;
__device__ __forceinline__ KP get_params() { KP k = (KP)__builtin_amdgcn_kernarg_segment_ptr(); asm volatile("" : "+s"(k)); return k; }
enum { I_X = 0, I_WIN, I_SINKS, I_MU, I_W0, I_WUP, I_A0, I_AUP, I_GUP, I_KK, I_KA, I_RK, I_GNG, I_GNB, I_FB, I_GB, I_WBR, I_WOUT, I_LNG, I_LNB,
       I_F1, I_F3, I_F2, I_RTW, I_RTB, I_E1, I_E3, I_E2 };

__device__ __forceinline__ float bflo(unsigned u) { return __uint_as_float(u << 16); }
__device__ __forceinline__ float bfhi(unsigned u) { return __uint_as_float(u & 0xffff0000u); }
__device__ __forceinline__ float bf2f(bf16_t b) { return __uint_as_float((unsigned)b << 16); }
__device__ __forceinline__ unsigned f2bf(float f) { unsigned u = __float_as_uint(f); return (u + 0x7fffu + ((u >> 16) & 1u)) >> 16; }
__device__ __forceinline__ unsigned pk2(float lo, float hi) { unsigned r; asm("v_cvt_pk_bf16_f32 %0, %1, %2" : "=v"(r) : "v"(lo), "v"(hi)); return r; }
__device__ __forceinline__ float wave_sum(float v) {
#pragma unroll
    for (int o = 1; o < 64; o <<= 1) v += __shfl_xor(v, o);
    return v;
}
__device__ __forceinline__ float wave_max(float v) {
#pragma unroll
    for (int o = 1; o < 64; o <<= 1) v = fmaxf(v, __shfl_xor(v, o));
    return v;
}
__device__ __forceinline__ float sigm(float x) { return 1.f / (1.f + __expf(-x)); }
#define LDS_FENCE() asm volatile("s_waitcnt lgkmcnt(0)" ::: "memory")
__device__ __forceinline__ int my_tid() { int t = threadIdx.x; asm volatile("" : "+v"(t)); return t; }
__device__ __forceinline__ void unpack8(const u32x4 v, float* f) {
    f[0] = bflo(v.x); f[1] = bfhi(v.x); f[2] = bflo(v.y); f[3] = bfhi(v.y); f[4] = bflo(v.z); f[5] = bfhi(v.z); f[6] = bflo(v.w); f[7] = bfhi(v.w);
}

namespace mg {
constexpr int BM = 256, BK = 64, HALF = 128, HTB = HALF * BK * 2, STAGE_BYTES = 8 * HTB;
__device__ __forceinline__ int lds_byte(int r, int c) { const int st = (r >> 4) * 2 + (c >> 5), rr = r & 15, cc = c & 31, ob = rr * 64 + cc * 2; return st * 1024 + (ob ^ (((ob >> 9) & 1) << 5)); }
__device__ __forceinline__ void stage_rc(int b, int& R, int& C) { const int st = b / 1024, sb = b % 1024, swz = sb ^ (((sb >> 9) & 1) << 5); R = (st >> 1) * 16 + swz / 64; C = (st & 1) * 32 + (swz % 64) / 2; }
__device__ __forceinline__ int perm32(int rho) { const int n = rho >> 4, i = rho & 15; return 8 * (i >> 2) + 4 * n + (i & 3); }

struct Unit { const char* A; const char* B; unsigned ld; int nt; int pm, pn, tag; };

__device__ __forceinline__ bool static_tile(int i, int G, int c, int nM, int nN, int& pm, int& pn) {
    const int nwg = nM * nN; const long L = (long)i * G + c; if (L >= nwg) return false;
    int wgid = (int)L; { const int q = nwg / 8, r = nwg % 8, xcd = wgid % 8, off = wgid / 8; wgid = (xcd < r ? xcd * (q + 1) : r * (q + 1) + (xcd - r) * q) + off; }
    const int nig = 8 * nN, gid = wgid / nig, fm = gid * 8, gsz = (nM - fm) < 8 ? (nM - fm) : 8;
    pm = fm + ((wgid % nig) % gsz); pn = (wgid % nig) / gsz; return true;
}

template <class Sched, class Epi>
__device__ __forceinline__ void gemm_run(LAS unsigned char* lds, const Sched& S, const Epi& E) {
    const int tid = my_tid(), wid = __builtin_amdgcn_readfirstlane(tid >> 6), lane = tid & 63, wr = wid >> 2, wc = wid & 3, fr = lane & 15, fq = lane >> 4;
    int R0, C0; stage_rc(tid * 16, R0, C0); const unsigned RA = (unsigned)R0, RB = (unsigned)(Sched::PERM ? ((R0 & ~31) + perm32(R0 & 31)) : R0), C02 = (unsigned)C0 * 2u;
    const unsigned ldsw = (unsigned)wid * 1024u;
    const int aoff = lds_byte(wr * 64 + fr, fq * 8), boff = lds_byte(wc * 32 + fr, fq * 8);
#define MG_SA(b, h) (((b) * 2 + (h)) * HTB)
#define MG_SB(b, h) ((4 + (b) * 2 + (h)) * HTB)
#define MG_STAGE(bufoff, gptr, v0, s64) do { \
        __builtin_amdgcn_global_load_lds((const unsigned*)((gptr) + (v0)), (LAS unsigned*)(lds + (bufoff) + ldsw), 16, 0, 0); \
        __builtin_amdgcn_global_load_lds((const unsigned*)((gptr) + (s64) + (v0)), (LAS unsigned*)(lds + (bufoff) + ldsw + 8192), 16, 0, 0); } while (0)
#define MG_LDA(dst, b, h) do { _Pragma("unroll") for (int m = 0; m < 4; ++m) _Pragma("unroll") for (int k = 0; k < 2; ++k) dst[m][k] = *(const LAS bf16x8*)(lds + MG_SA(b, h) + aoff + m * 2048 + k * 1024); } while (0)
#define MG_LDB(dst, b, h) do { _Pragma("unroll") for (int n = 0; n < 2; ++n) _Pragma("unroll") for (int k = 0; k < 2; ++k) dst[n][k] = *(const LAS bf16x8*)(lds + MG_SB(b, h) + boff + n * 2048 + k * 1024); } while (0)
#define MG_MMA(ai, bj, At, Bt) do { __builtin_amdgcn_s_setprio(1); _Pragma("unroll") for (int m = 0; m < 4; ++m) _Pragma("unroll") for (int n = 0; n < 2; ++n) _Pragma("unroll") for (int k = 0; k < 2; ++k) \
        acc[ai][bj][m][n] = __builtin_amdgcn_mfma_f32_16x16x32_bf16(Bt[n][k], At[m][k], acc[ai][bj][m][n], 0, 0, 0); __builtin_amdgcn_s_setprio(0); } while (0)
#define MG_WAIT_V(n) asm volatile("s_waitcnt vmcnt(" #n ")" ::: "memory")
#define MG_WAIT_L(n) asm volatile("s_waitcnt lgkmcnt(" #n ")" ::: "memory")
#define MG_BAR __builtin_amdgcn_s_barrier()
#define MG_SCHED __builtin_amdgcn_sched_barrier(0)
    Unit cur; int ui = 0;
    if (!S.next(0, cur)) return;
    f32x4 acc[2][2][4][2];
#pragma unroll
    for (int a = 0; a < 2; ++a)
#pragma unroll
        for (int b = 0; b < 2; ++b)
#pragma unroll
            for (int m = 0; m < 4; ++m)
#pragma unroll
                for (int n = 0; n < 2; ++n) acc[a][b][m][n] = (f32x4){0.f, 0.f, 0.f, 0.f};
    bf16x8 At[4][2], B0[2][2], B1[2][2];
    const size_t kstep = (size_t)(BK * 2);
    {
        const char* cA = cur.A; const char* cB = cur.B; const unsigned ld = cur.ld, vA = RA * ld + C02, vB = RB * ld + C02, s64 = 64u * ld, sh = 128u * ld;
        MG_STAGE(MG_SB(0, 0), cB, vB, s64); MG_STAGE(MG_SB(0, 1), cB + sh, vB, s64); MG_STAGE(MG_SA(0, 0), cA, vA, s64); MG_STAGE(MG_SA(0, 1), cA + sh, vA, s64);
        if (wr == 1) MG_BAR;
        MG_WAIT_V(2); MG_BAR;
        MG_STAGE(MG_SB(1, 0), cB + kstep, vB, s64); MG_STAGE(MG_SA(1, 0), cA + kstep, vA, s64); MG_STAGE(MG_SB(1, 1), cB + sh + kstep, vB, s64);
        MG_WAIT_V(6); MG_BAR;
    }
    for (;;) {
        const char* cA = cur.A; const char* cB = cur.B; const unsigned cld = cur.ld; const int nt = cur.nt;
        for (int t = 0; t < nt; t += 2) {
            const bool last = (t == nt - 2);
            const char* a1 = cA + (size_t)(t + 1) * kstep;
            const char* a2 = cA + (size_t)(t + 2) * kstep; const char* b2 = cB + (size_t)(t + 2) * kstep; unsigned xld = cld;
            if (last) { Unit n2; if (S.next(ui + 1, n2)) { a2 = n2.A; b2 = n2.B; xld = n2.ld; } else { a2 = cA; b2 = cB; } }
            const char* a3 = a2 + kstep; const char* b3 = b2 + kstep;
            const unsigned cvA = RA * cld + C02, c64 = 64u * cld, ch = 128u * cld;
            const unsigned xvA = RA * xld + C02, xvB = RB * xld + C02, x64 = 64u * xld, xh = 128u * xld;
            MG_LDB(B0, 0, 0); MG_LDB(B1, 0, 1); MG_SCHED; MG_LDA(At, 0, 0); MG_STAGE(MG_SA(1, 1), a1 + ch, cvA, c64);
            MG_WAIT_V(8); MG_WAIT_L(0); MG_BAR; MG_MMA(0, 0, At, B0); MG_MMA(0, 1, At, B1); MG_BAR; MG_SCHED;
            MG_LDA(At, 0, 1); MG_STAGE(MG_SB(0, 0), b2, xvB, x64); MG_STAGE(MG_SB(0, 1), b2 + xh, xvB, x64); MG_STAGE(MG_SA(0, 0), a2, xvA, x64);
            MG_WAIT_V(8); MG_WAIT_L(0); MG_BAR; MG_MMA(1, 0, At, B0); MG_MMA(1, 1, At, B1); MG_BAR; MG_SCHED;
            MG_LDB(B0, 1, 0); MG_LDB(B1, 1, 1); MG_SCHED; MG_LDA(At, 1, 0); MG_STAGE(MG_SA(0, 1), a2 + xh, xvA, x64);
            MG_WAIT_V(8); MG_WAIT_L(0); MG_BAR; MG_MMA(0, 0, At, B0); MG_MMA(0, 1, At, B1); MG_BAR; MG_SCHED;
            MG_LDA(At, 1, 1); MG_STAGE(MG_SB(1, 0), b3, xvB, x64); MG_STAGE(MG_SB(1, 1), b3 + xh, xvB, x64); MG_STAGE(MG_SA(1, 0), a3, xvA, x64);
            MG_WAIT_V(8); MG_WAIT_L(0); MG_BAR; MG_MMA(1, 0, At, B0); MG_MMA(1, 1, At, B1); MG_BAR; MG_SCHED;
        }
        if (wr == 0) MG_BAR;
        { int e_fr = fr, e_fq = fq, e_tid = tid; asm volatile("" : "+v"(e_fr), "+v"(e_fq), "+v"(e_tid));
          E(acc, cur, wr, wc, e_fr, e_fq, e_tid); }
        Unit nxt;
        if (!S.next(ui + 1, nxt)) break;
#pragma unroll
        for (int a = 0; a < 2; ++a)
#pragma unroll
            for (int b = 0; b < 2; ++b)
#pragma unroll
                for (int m = 0; m < 4; ++m)
#pragma unroll
                    for (int n = 0; n < 2; ++n) acc[a][b][m][n] = (f32x4){0.f, 0.f, 0.f, 0.f};
        cur = nxt; ++ui;
        if (wr == 1) MG_BAR;
    }
    MG_WAIT_V(0);
    MG_BAR;
#undef MG_SA
#undef MG_SB
#undef MG_STAGE
#undef MG_LDA
#undef MG_LDB
#undef MG_MMA
#undef MG_WAIT_V
#undef MG_WAIT_L
#undef MG_BAR
#undef MG_SCHED
}
}

typedef f32x4 AccT[2][2][4][2];

__device__ __forceinline__ int rowmap(int mode, int n) {
    if (mode == 0) return n;
    if (mode == 1) { if (n < 2560) return n; if (n < 2564) return 3264 + (n - 2560); if (n < 3268) return n - 4; if (n < 3272) return n; return n + 56; }
    if (mode == 2) return 256 * (n >> 7) + (n & 127);
    return 256 * (n >> 7) + 128 + (n & 127);
}
__device__ __forceinline__ void tr_item(const float* __restrict__ W, int K, int N, bf16_t* WT, int ldt, int mode, int row_off, LAS float* scr, int item, int lane) {
    const int nblk = (N + 31) / 32, kb = item / nblk, nb = item % nblk, k0 = 64 * kb, n0 = 32 * nb;
    const int nl = lane & 31, n = n0 + nl;
    float tv[32];
    const int nc = (n < N) ? n : N - 1;
#pragma unroll
    for (int i = 0; i < 32; ++i) { const int kk = 2 * i + (lane >> 5); tv[i] = W[(size_t)(k0 + kk) * N + nc]; }
#pragma unroll
    for (int i = 0; i < 32; ++i) { const int kk = 2 * i + (lane >> 5); scr[kk * 33 + nl] = (n < N) ? tv[i] : 0.f; }
    LDS_FENCE();
    const int c = lane & 7;
#pragma unroll
    for (int j = 0; j < 4; ++j) { const int n2l = (lane >> 3) + 8 * j, n2 = n0 + n2l; const LAS float* s = scr + (8 * c) * 33 + n2l;
        u32x4 o; o.x = pk2(s[0 * 33], s[1 * 33]); o.y = pk2(s[2 * 33], s[3 * 33]); o.z = pk2(s[4 * 33], s[5 * 33]); o.w = pk2(s[6 * 33], s[7 * 33]);
        if (n2 < N) *(u32x4*)(WT + (size_t)(row_off + rowmap(mode, n2)) * ldt + k0 + 8 * c) = o; }
    LDS_FENCE();
}
__device__ __forceinline__ int tr_nitems(int K, int N) { return (K / 64) * ((N + 31) / 32); }

__device__ __forceinline__ void row_to_bf16(const float* xrow, bf16_t* orow, int lane) {
    const f32x4* xr = (const f32x4*)xrow + lane; unsigned long long* o8 = (unsigned long long*)orow + lane;
#pragma unroll
    for (int j = 0; j < 4; ++j) { const f32x4 v = xr[64 * j]; o8[64 * j] = (unsigned long long)pk2(v.x, v.y) | ((unsigned long long)pk2(v.z, v.w) << 32); }
}

__device__ __forceinline__ void ph_conv_mixer(KP p, int l, LAS unsigned char* lds) {
    const int tid_ = my_tid(); const int lane = tid_ & 63, wave = tid_ >> 6, gw = blockIdx.x * 8 + wave, NGW = gridDim.x * 8;
    LAS float* scr = (LAS float*)(lds + wave * 8448);
    const float* win = p->in[I_WIN] + (size_t)l * D * D_IN; const float* wbr = p->in[I_WBR] + (size_t)l * OC * D; const float* wo = p->in[I_WOUT] + (size_t)l * D * D;
    bf16_t* WIN = (bf16_t*)(p->ws + WS_WIN); bf16_t* WB = (bf16_t*)(p->ws + WS_WB); bf16_t* WO = (bf16_t*)(p->ws + WS_WO);
    const int n1 = tr_nitems(D, D_IN), n2 = tr_nitems(OC, D), n3 = tr_nitems(D, D);
    for (int it = gw; it < n1 + n2 + n3; it += NGW) {
        int r = it;
        if (r < n1) { tr_item(win, D, D_IN, WIN, D, 1, 0, scr, r, lane); continue; } r -= n1;
        if (r < n2) { tr_item(wbr, OC, D, WB, OC, 0, 0, scr, r, lane); continue; } r -= n2;
        tr_item(wo, D, D, WO, D, 0, 0, scr, r, lane);
    }
    {
        bf16_t* WL = (bf16_t*)(p->ws + WS_WLORA);
        const float* wup = p->in[I_WUP] + (size_t)l * 64 * 256; const float* aup = p->in[I_AUP] + (size_t)l * 64 * 256; const float* gup = p->in[I_GUP] + (size_t)l * 128 * 256;
        const int m1 = tr_nitems(64, 256), m2 = tr_nitems(128, 256);
        for (int it = gw; it < 2 * m1 + m2; it += NGW) { int r = it;
            if (r < m1) { tr_item(wup, 64, 256, WL, 256, 0, 0, scr, r, lane); continue; } r -= m1;
            if (r < m1) { tr_item(aup, 64, 256, WL + 64, 256, 0, 256, scr, r, lane); continue; } r -= m1;
            tr_item(gup, 128, 256, WL + 128, 256, 0, 512, scr, r, lane); }
        for (int ch = gw * 64 + lane; ch < 768 * 32; ch += NGW * 64) { const int row = ch >> 5, k8 = (ch & 31) * 8, blk = row >> 8;
            const bool used = (blk == 0) ? (k8 < 64) : ((blk == 1) ? (k8 >= 64 && k8 < 128) : (k8 >= 128));
            if (!used) *(u32x4*)(WL + (size_t)row * 256 + k8) = (u32x4){0u, 0u, 0u, 0u}; }
    }
    if (l == 0) { bf16_t* XB = (bf16_t*)(p->ws + WS_XB); for (int m = gw; m < T; m += NGW) row_to_bf16(p->in[I_X] + (size_t)m * D, XB + (size_t)m * D, lane); }
}

struct SchedInproj {
    static constexpr int PERM = 1;
    const char* A; const char* B; int G, c;
    __device__ __forceinline__ bool next(int i, mg::Unit& u) const {
        int pm, pn; if (!mg::static_tile(i, G, c, T / 256, NPM / 256, pm, pn)) return false;
        u.A = A + (size_t)pm * 256 * 2048; u.B = B + (size_t)pn * 256 * 2048; u.ld = 2048; u.nt = 16; u.pm = pm; u.pn = pn; u.tag = 0; return true;
    }
};
template <int PERM_, int NN, int K> struct SchedPlain {
    static constexpr int PERM = PERM_;
    const char* A; const char* B; int G, c;
    __device__ __forceinline__ bool next(int i, mg::Unit& u) const {
        int pm, pn; if (!mg::static_tile(i, G, c, T / 256, NN, pm, pn)) return false;
        u.A = A + (size_t)pm * 256 * K * 2; u.B = B + (size_t)pn * 256 * K * 2; u.ld = K * 2; u.nt = K / 64; u.pm = pm; u.pn = pn; u.tag = 0; return true;
    }
};
struct EpiBf16Store {
    bf16_t* O; int ldo;
    __device__ __forceinline__ void operator()(const AccT& acc, const mg::Unit& u, int wr, int wc, int fr, int fq, int) const {
        const int row0 = u.pm * 256 + wr * 64 + fr, col0 = u.pn * 256 + wc * 32 + 8 * fq;
#pragma unroll
        for (int ai = 0; ai < 2; ++ai)
#pragma unroll
            for (int m = 0; m < 4; ++m) { bf16_t* rowp = O + (size_t)(row0 + ai * 128 + m * 16) * ldo + col0;
#pragma unroll
                for (int bj = 0; bj < 2; ++bj) { const f32x4 v0 = acc[ai][bj][m][0], v1 = acc[ai][bj][m][1];
                    u32x4 w; w.x = pk2(v0[0], v0[1]); w.y = pk2(v0[2], v0[3]); w.z = pk2(v1[0], v1[1]); w.w = pk2(v1[2], v1[3]);
                    *(u32x4*)(rowp + bj * 128) = w; } }
    }
};
__device__ __forceinline__ void ph_inproj(KP p, int l, LAS unsigned char* lds) {
    SchedInproj S{(const char*)(p->ws + WS_XB), (const char*)(p->ws + WS_WIN), (int)gridDim.x, (int)blockIdx.x};
    EpiBf16Store E{(bf16_t*)(p->ws + WS_PMIX), NPM};
    mg::gemm_run(lds, S, E);
}

__device__ __forceinline__ void ph_prep(KP p, int l, LAS unsigned char* lds) {
    const int tid = my_tid(), lane = tid & 63, wave = tid >> 6;
    const bf16_t* P = (const bf16_t*)(p->ws + WS_PMIX);
    if (blockIdx.x < 8 && wave < 4) {
        const int b = blockIdx.x, h = wave; const float fb = p->in[I_FB][l * 4 + h];
        float v[32]; float s = 0.f;
#pragma unroll
        for (int i = 0; i < 32; ++i) { const int t = 32 * lane + i; const float x = bf2f(P[(size_t)(b * SEQ + t) * NPM + C_FLOG + h]) + fb;
            const float ls = fminf(x, 0.f) - log1pf(__expf(-fabsf(x))); s += ls; v[i] = s; }
        float incl = s;
#pragma unroll
        for (int o = 1; o < 64; o <<= 1) { const float n = __shfl_up(incl, o); if (lane >= o) incl += n; }
        const float excl = incl - s; float* C = (float*)(p->ws + WS_FOXC) + (size_t)(b * 4 + h) * SEQ + 32 * lane;
#pragma unroll
        for (int i = 0; i < 32; ++i) C[i] = v[i] + excl;
    }
    const float* mu = p->in[I_MU] + l * 1024; const float* kkw = p->in[I_KK] + l * 256;
    float* RWr = (float*)(p->ws + WS_RW); float* RWk = RWr + (size_t)2 * T * 256; float* RWkk = RWr + (size_t)3 * T * 256; float* RWv = RWr + (size_t)5 * T * 256;
    bf16_t* LA = (bf16_t*)(p->ws + WS_LORA_A);
    const int gw = blockIdx.x * 8 + wave, NGW = gridDim.x * 8;
    float m0[8], m1[8], kkc[8];
    { const f32x4 a = *(const f32x4*)(mu + 8 * lane), b = *(const f32x4*)(mu + 8 * lane + 4), c = *(const f32x4*)(mu + 512 + 8 * lane), d = *(const f32x4*)(mu + 512 + 8 * lane + 4);
      m0[0] = a.x; m0[1] = a.y; m0[2] = a.z; m0[3] = a.w; m0[4] = b.x; m0[5] = b.y; m0[6] = b.z; m0[7] = b.w; m1[0] = c.x; m1[1] = c.y; m1[2] = c.z; m1[3] = c.w; m1[4] = d.x; m1[5] = d.y; m1[6] = d.z; m1[7] = d.w;
      const f32x4 e = *(const f32x4*)(kkw + 8 * (lane & 31)), f = *(const f32x4*)(kkw + 8 * (lane & 31) + 4); kkc[0] = e.x; kkc[1] = e.y; kkc[2] = e.z; kkc[3] = e.w; kkc[4] = f.x; kkc[5] = f.y; kkc[6] = f.z; kkc[7] = f.w; }
#pragma unroll 2
    for (int t = gw; t < T; t += NGW) {
        const bf16_t* pr = P + (size_t)t * NPM + C_RW; const bool first = (t & (SEQ - 1)) == 0; const bf16_t* pp = first ? pr : pr - NPM;
        float x0[8], x1[8], y0[8], y1[8];
        unpack8(*(const u32x4*)(pr + 8 * lane), x0); unpack8(*(const u32x4*)(pr + 512 + 8 * lane), x1);
        unpack8(*(const u32x4*)(pp + 8 * lane), y0); unpack8(*(const u32x4*)(pp + 512 + 8 * lane), y1);
#pragma unroll
        for (int j = 0; j < 8; ++j) { const float q0 = first ? 0.f : y0[j], q1 = first ? 0.f : y1[j]; x0[j] += m0[j] * (q0 - x0[j]); x1[j] += m1[j] * (q1 - x1[j]); }
        const size_t o = (size_t)t * 256 + 8 * (lane & 31);
        if (lane < 32) {
            *(f32x4*)(RWr + o) = (f32x4){x0[0], x0[1], x0[2], x0[3]}; *(f32x4*)(RWr + o + 4) = (f32x4){x0[4], x0[5], x0[6], x0[7]};
            *(f32x4*)(RWv + o) = (f32x4){x1[0], x1[1], x1[2], x1[3]}; *(f32x4*)(RWv + o + 4) = (f32x4){x1[4], x1[5], x1[6], x1[7]};
        }
        float kk[8], ss = 0.f;
#pragma unroll
        for (int j = 0; j < 8; ++j) { kk[j] = x0[j] * kkc[j]; ss += kk[j] * kk[j]; }
        ss += __shfl_xor(ss, 1); ss += __shfl_xor(ss, 2); ss += __shfl_xor(ss, 4);
        const float rn = rsqrtf(ss + 1e-12f);
        if (lane >= 32) {
            *(f32x4*)(RWk + o) = (f32x4){x0[0], x0[1], x0[2], x0[3]}; *(f32x4*)(RWk + o + 4) = (f32x4){x0[4], x0[5], x0[6], x0[7]};
            *(f32x4*)(RWkk + o) = (f32x4){kk[0] * rn, kk[1] * rn, kk[2] * rn, kk[3] * rn}; *(f32x4*)(RWkk + o + 4) = (f32x4){kk[4] * rn, kk[5] * rn, kk[6] * rn, kk[7] * rn};
            float a[8];
#pragma unroll
            for (int j = 0; j < 8; ++j) a[j] = (lane < 40) ? tanhf(x1[j]) : ((lane < 48) ? x1[j] : sigm(x1[j]));
            u32x4 w; w.x = pk2(a[0], a[1]); w.y = pk2(a[2], a[3]); w.z = pk2(a[4], a[5]); w.w = pk2(a[6], a[7]);
            *(u32x4*)(LA + (size_t)t * 256 + 8 * (lane - 32)) = w;
        }
    }
}
struct EpiLora {
    const float* w0; const float* a0; const float* ka; float* RW;
    __device__ __forceinline__ void operator()(const AccT& acc, const mg::Unit& u, int wr, int wc, int fr, int fq, int) const {
        const int row0 = u.pm * 256 + wr * 64 + fr, col0 = wc * 32 + 4 * fq;
        float* RWw = RW + (size_t)1 * T * 256; float* RWk = RW + (size_t)2 * T * 256; float* RWkk = RW + (size_t)3 * T * 256; float* RWkka = RW + (size_t)4 * T * 256; float* RWg = RW + (size_t)6 * T * 256;
#pragma unroll
        for (int bj = 0; bj < 2; ++bj)
#pragma unroll
            for (int n = 0; n < 2; ++n) { const int c = col0 + bj * 128 + n * 16;
                f32x4 c0 = (f32x4){0.f, 0.f, 0.f, 0.f}, c1 = c0;
                if (u.pn == 0) c0 = *(const f32x4*)(w0 + c); else if (u.pn == 1) { c0 = *(const f32x4*)(a0 + c); c1 = *(const f32x4*)(ka + c); }
#pragma unroll
                for (int ai = 0; ai < 2; ++ai)
#pragma unroll
                    for (int m = 0; m < 4; ++m) { const size_t o = (size_t)(row0 + ai * 128 + m * 16) * 256 + c; const f32x4 x = acc[ai][bj][m][n];
                        if (u.pn == 0) { f32x4 w;
#pragma unroll
                            for (int j = 0; j < 4; ++j) w[j] = __expf(-sigm(c0[j] + x[j]) * 0.60653065971f);
                            *(f32x4*)(RWw + o) = w; }
                        else if (u.pn == 1) { const f32x4 k = *(const f32x4*)(RWk + o), kk = *(const f32x4*)(RWkk + o); f32x4 k2, kka;
#pragma unroll
                            for (int j = 0; j < 4; ++j) { const float a = sigm(c0[j] + x[j]); k2[j] = k[j] * (1.f + (a - 1.f) * c1[j]); kka[j] = kk[j] * a; }
                            *(f32x4*)(RWk + o) = k2; *(f32x4*)(RWkka + o) = kka; }
                        else *(f32x4*)(RWg + o) = x;
                        asm volatile("" ::: "memory"); } }
    }
};
__device__ __forceinline__ void ph_lora(KP p, int l, LAS unsigned char* lds) {
    SchedPlain<0, 3, 256> S{(const char*)(p->ws + WS_LORA_A), (const char*)(p->ws + WS_WLORA), (int)gridDim.x, (int)blockIdx.x};
    EpiLora E{p->in[I_W0] + l * 256, p->in[I_A0] + l * 256, p->in[I_KA] + l * 256, (float*)(p->ws + WS_RW)};
    mg::gemm_run(lds, S, E);
}

template <int CTRL, int ROWM, int BANKM> __device__ __forceinline__ float dpp_add(float acc, float src) {
    return acc + __int_as_float(__builtin_amdgcn_update_dpp(0, __float_as_int(src), CTRL, ROWM, BANKM, true));
}
__device__ __forceinline__ float wave_sum_s(float v) {
    float a = v;
    a = dpp_add<0x111, 0xf, 0xf>(a, v); a = dpp_add<0x112, 0xf, 0xf>(a, v); a = dpp_add<0x113, 0xf, 0xf>(a, v);
    a = dpp_add<0x114, 0xf, 0xe>(a, a); a = dpp_add<0x118, 0xf, 0xc>(a, a);
    a = dpp_add<0x142, 0xa, 0xf>(a, a); a = dpp_add<0x143, 0xc, 0xf>(a, a);
    return __int_as_float(__builtin_amdgcn_readlane(__float_as_int(a), 63));
}
typedef float f32x16 __attribute__((ext_vector_type(16)));
constexpr int KT_PITCH = 144, VT_PITCH = 136;
constexpr int AT_K_BYTES = 64 * KT_PITCH, AT_V_BYTES = 64 * VT_PITCH, AT_TILE_BYTES = AT_K_BYTES + AT_V_BYTES + 256;
constexpr float LOG2E = 1.4426950408889634f;
constexpr float NEGBIG = -1e30f;
__device__ __forceinline__ int crow(int reg, int h) { return (reg & 3) + 8 * (reg >> 2) + 4 * h; }
__device__ __forceinline__ unsigned fkey(float f) { const unsigned u = __float_as_uint(f); return (u & 0x80000000u) ? ~u : (u | 0x80000000u); }

__device__ __forceinline__ void at_stage(LAS unsigned char* tile, const bf16_t* Krows, const bf16_t* Vrows, int tid) {
    { const int row = tid >> 3, ch = tid & 7; const u32x4 v = *(const u32x4*)(Krows + (size_t)row * NPM + 8 * ch); *(LAS u32x4*)(tile + row * KT_PITCH + ch * 16) = v; }
    { const int kv = tid & 63, dch = tid >> 6; const u32x4 v = *(const u32x4*)(Vrows + (size_t)kv * NPM + 8 * dch);
      LAS bf16_t* vt = (LAS bf16_t*)(tile + AT_K_BYTES + (8 * dch) * VT_PITCH) + kv; constexpr int P2 = VT_PITCH / 2;
      vt[0 * P2] = (bf16_t)(v.x & 0xffffu); vt[1 * P2] = (bf16_t)(v.x >> 16); vt[2 * P2] = (bf16_t)(v.y & 0xffffu); vt[3 * P2] = (bf16_t)(v.y >> 16);
      vt[4 * P2] = (bf16_t)(v.z & 0xffffu); vt[5 * P2] = (bf16_t)(v.z >> 16); vt[6 * P2] = (bf16_t)(v.w & 0xffffu); vt[7 * P2] = (bf16_t)(v.w >> 16); }
}
struct AtRegs { u32x4 k, v; };
__device__ __forceinline__ AtRegs at_gload(const bf16_t* Krows, const bf16_t* Vrows, int tid) {
    AtRegs a; a.k = *(const u32x4*)(Krows + (size_t)(tid >> 3) * NPM + 8 * (tid & 7)); a.v = *(const u32x4*)(Vrows + (size_t)(tid & 63) * NPM + 8 * (tid >> 6)); return a;
}
__device__ __forceinline__ void at_sstore(LAS unsigned char* tile, const AtRegs& a, int tid) {
    *(LAS u32x4*)(tile + (tid >> 3) * KT_PITCH + (tid & 7) * 16) = a.k;
    const u32x4 v = a.v; LAS bf16_t* vt = (LAS bf16_t*)(tile + AT_K_BYTES + (8 * (tid >> 6)) * VT_PITCH) + (tid & 63); constexpr int P2 = VT_PITCH / 2;
    vt[0 * P2] = (bf16_t)(v.x & 0xffffu); vt[1 * P2] = (bf16_t)(v.x >> 16); vt[2 * P2] = (bf16_t)(v.y & 0xffffu); vt[3 * P2] = (bf16_t)(v.y >> 16);
    vt[4 * P2] = (bf16_t)(v.z & 0xffffu); vt[5 * P2] = (bf16_t)(v.z >> 16); vt[6 * P2] = (bf16_t)(v.w & 0xffffu); vt[7 * P2] = (bf16_t)(v.w >> 16);
}
__device__ __forceinline__ void at_qk(f32x16& p0, f32x16& p1, const LAS unsigned char* Kt, const bf16x8 (&qr)[4], int r, int h) {
#pragma unroll
    for (int i = 0; i < 16; ++i) { p0[i] = 0.f; p1[i] = 0.f; }
#pragma unroll
    for (int ds = 0; ds < 4; ++ds) {
        const bf16x8 a0 = *(const LAS bf16x8*)(Kt + r * KT_PITCH + (16 * ds + 8 * h) * 2);
        const bf16x8 a1 = *(const LAS bf16x8*)(Kt + (32 + r) * KT_PITCH + (16 * ds + 8 * h) * 2);
        p0 = __builtin_amdgcn_mfma_f32_32x32x16_bf16(a0, qr[ds], p0, 0, 0, 0);
        p1 = __builtin_amdgcn_mfma_f32_32x32x16_bf16(a1, qr[ds], p1, 0, 0, 0);
    }
}
__device__ __forceinline__ void at_pv(f32x16 (&o)[2], const LAS unsigned char* Vt, const bf16x8 (&pk)[4], int r, int h) {
#pragma unroll
    for (int dh = 0; dh < 2; ++dh)
#pragma unroll
        for (int ks = 0; ks < 4; ++ks) { const LAS unsigned char* bp = Vt + (32 * dh + r) * VT_PITCH + (16 * ks + 4 * h) * 2;
            const u32x2 lo = *(const LAS u32x2*)bp, hi = *(const LAS u32x2*)(bp + 16);
            const u32x4 av = (u32x4){lo.x, lo.y, hi.x, hi.y};
            o[dh] = __builtin_amdgcn_mfma_f32_32x32x16_bf16(__builtin_bit_cast(bf16x8, av), pk[ks], o[dh], 0, 0, 0); }
}
template <bool BIAS, bool MASK, bool DSAM = false>
__device__ __forceinline__ void at_softmax(f32x16& p0, f32x16& p1, float& m, float& l, f32x16 (&o)[2], bf16x8 (&pk)[4], float sc2, const LAS float* bias2, int kmax, int h, unsigned mb = 0u) {
    float mt = NEGBIG;
#pragma unroll
    for (int g = 0; g < 4; ++g) {
        f32x4 b0 = (f32x4){0.f, 0.f, 0.f, 0.f}, b1 = b0;
        if (BIAS) { b0 = *(const LAS f32x4*)(bias2 + 8 * g + 4 * h); b1 = *(const LAS f32x4*)(bias2 + 32 + 8 * g + 4 * h); }
#pragma unroll
        for (int j = 0; j < 4; ++j) { const int reg = 4 * g + j, kv = 8 * g + 4 * h + j;
            float x0 = p0[reg] * sc2 + b0[j], x1 = p1[reg] * sc2 + b1[j];
            if (MASK) { if (kv > kmax) x0 = NEGBIG; if (kv + 32 > kmax) x1 = NEGBIG; }
            if (DSAM) { if (!((mb >> reg) & 1u)) x0 = NEGBIG; if (!((mb >> (16 + reg)) & 1u)) x1 = NEGBIG; }
            p0[reg] = x0; p1[reg] = x1; mt = fmaxf(mt, fmaxf(x0, x1)); }
    }
    mt = fmaxf(mt, __shfl_xor(mt, 32));
    const float mn = fmaxf(m, mt);
    if (__any(mn > m)) { const float al = __builtin_amdgcn_exp2f(m - mn); l *= al;
#pragma unroll
        for (int i = 0; i < 16; ++i) { o[0][i] *= al; o[1][i] *= al; }
        m = mn; }
    float s = 0.f;
#pragma unroll
    for (int i = 0; i < 16; ++i) { const float e0 = (p0[i] > -1e29f) ? __builtin_amdgcn_exp2f(p0[i] - m) : 0.f, e1 = (p1[i] > -1e29f) ? __builtin_amdgcn_exp2f(p1[i] - m) : 0.f; p0[i] = e0; p1[i] = e1; s += e0 + e1; }
    l += s;
#pragma unroll
    for (int ks = 0; ks < 2; ++ks) { u32x4 w0, w1;
        w0.x = pk2(p0[8 * ks + 0], p0[8 * ks + 1]); w0.y = pk2(p0[8 * ks + 2], p0[8 * ks + 3]); w0.z = pk2(p0[8 * ks + 4], p0[8 * ks + 5]); w0.w = pk2(p0[8 * ks + 6], p0[8 * ks + 7]);
        w1.x = pk2(p1[8 * ks + 0], p1[8 * ks + 1]); w1.y = pk2(p1[8 * ks + 2], p1[8 * ks + 3]); w1.z = pk2(p1[8 * ks + 4], p1[8 * ks + 5]); w1.w = pk2(p1[8 * ks + 6], p1[8 * ks + 7]);
        pk[ks] = __builtin_bit_cast(bf16x8, w0); pk[2 + ks] = __builtin_bit_cast(bf16x8, w1); }
}
__device__ __forceinline__ void at_loadq(bf16x8 (&qr)[4], const bf16_t* qrow, int h) {
#pragma unroll
    for (int ds = 0; ds < 4; ++ds) qr[ds] = *(const bf16x8*)(qrow + 16 * ds + 8 * h);
}
__device__ __forceinline__ void at_store(bf16_t* orow, const f32x16 (&o)[2], float inv, int h) {
#pragma unroll
    for (int dh = 0; dh < 2; ++dh)
#pragma unroll
        for (int g = 0; g < 4; ++g) { u32x2 w; w.x = pk2(o[dh][4 * g] * inv, o[dh][4 * g + 1] * inv); w.y = pk2(o[dh][4 * g + 2] * inv, o[dh][4 * g + 3] * inv);
            *(u32x2*)(orow + 32 * dh + 8 * g + 4 * h) = w; }
}

__device__ __forceinline__ void fox_unit(KP p, int bh, int qb, LAS unsigned char* lds) {
    const int tid = my_tid(), lane = tid & 63, wave = tid >> 6, r = lane & 31, h = lane >> 5, wv = wave & 3, g = wave >> 2;
    const int b = bh >> 2, hd = bh & 3;
    const bf16_t* P = (const bf16_t*)(p->ws + WS_PMIX) + (size_t)b * SEQ * NPM; bf16_t* OCT = (bf16_t*)(p->ws + WS_OCAT); const float* FC = (const float*)(p->ws + WS_FOXC) + (size_t)bh * SEQ;
    const int q0 = 128 * qb, qbase = q0 + 32 * wv; const float cref = FC[q0];
    bf16x8 qr[4]; at_loadq(qr, P + (size_t)(qbase + r) * NPM + C_FOX_Q + hd * 64, h);
    f32x16 o[2]; float m = NEGBIG, l = 0.f;
#pragma unroll
    for (int i = 0; i < 16; ++i) { o[0][i] = 0.f; o[1][i] = 0.f; }
    const bf16_t* Kc = P + C_FOX_K + hd * 64; const bf16_t* Vc = P + C_FOX_V + hd * 64;
    AtRegs pre0 = at_gload(Kc, Vc, tid), pre1 = at_gload(Kc + (size_t)64 * NPM, Vc + (size_t)64 * NPM, tid);
    float bpre = (tid < 128) ? FC[tid] : 0.f;
#pragma unroll 1
    for (int st = 0; st <= qb; ++st) {
        __syncthreads();
        at_sstore(lds, pre0, tid); at_sstore(lds + AT_TILE_BYTES, pre1, tid);
        if (tid < 128) ((LAS float*)(lds + (tid >> 6) * AT_TILE_BYTES + AT_K_BYTES + AT_V_BYTES))[tid & 63] = (cref - bpre) * LOG2E;
        __syncthreads();
        if (st < qb) { const size_t ko = (size_t)(128 * (st + 1)) * NPM; pre0 = at_gload(Kc + ko, Vc + ko, tid); pre1 = at_gload(Kc + ko + (size_t)64 * NPM, Vc + ko + (size_t)64 * NPM, tid);
            if (tid < 128) bpre = FC[128 * (st + 1) + tid]; }
        const int k0 = 64 * (2 * st + g); const LAS unsigned char* tile = lds + g * AT_TILE_BYTES;
        if (k0 <= qbase + 31) {
            f32x16 p0, p1; bf16x8 pk[4];
            at_qk(p0, p1, tile, qr, r, h);
            const LAS float* b2 = (const LAS float*)(tile + AT_K_BYTES + AT_V_BYTES);
            if (k0 + 63 > qbase) at_softmax<true, true>(p0, p1, m, l, o, pk, 0.125f * LOG2E, b2, qbase + r - k0, h);
            else at_softmax<true, false>(p0, p1, m, l, o, pk, 0.125f * LOG2E, b2, 0, h);
            at_pv(o, tile + AT_K_BYTES, pk, r, h);
        }
    }
    __syncthreads();
    LAS float* cb = (LAS float*)lds + (size_t)wv * (34 * 64);
    if (g == 1) { cb[lane] = m; cb[64 + lane] = l;
#pragma unroll
        for (int i = 0; i < 16; ++i) { cb[(2 + i) * 64 + lane] = o[0][i]; cb[(18 + i) * 64 + lane] = o[1][i]; } }
    __syncthreads();
    if (g == 0) { const float mb = cb[lane], lb = cb[64 + lane]; const float M = fmaxf(m, mb), sa = __builtin_amdgcn_exp2f(m - M), sb = __builtin_amdgcn_exp2f(mb - M);
        l = l * sa + lb * sb;
#pragma unroll
        for (int i = 0; i < 16; ++i) { o[0][i] = o[0][i] * sa + cb[(2 + i) * 64 + lane] * sb; o[1][i] = o[1][i] * sa + cb[(18 + i) * 64 + lane] * sb; }
        const float lt = l + __shfl_xor(l, 32);
        at_store(OCT + (size_t)(b * SEQ + qbase + r) * OC + 768 + hd * 64, o, 1.f / lt, h); }
}
__device__ __forceinline__ void swa_unit(KP p, int l_, int item, LAS unsigned char* lds) {
    const int tid = my_tid(), lane = tid & 63, wave = tid >> 6, r = lane & 31, h = lane >> 5;
    const int hk = item & 1, c = (item >> 1) & 31, b = item >> 6, head = hk * 4 + (wave >> 1), qpos = c * 64 + 32 * (wave & 1);
    const bf16_t* P = (const bf16_t*)(p->ws + WS_PMIX) + (size_t)b * SEQ * NPM; bf16_t* OCT = (bf16_t*)(p->ws + WS_OCAT);
    bf16x8 qr[4]; at_loadq(qr, P + (size_t)(qpos + r) * NPM + C_SWA_Q + head * 64, h);
    f32x16 o[2]; float m = p->in[I_SINKS][l_ * 8 + head] * LOG2E, l = (h == 0) ? 1.f : 0.f;
#pragma unroll
    for (int i = 0; i < 16; ++i) { o[0][i] = 0.f; o[1][i] = 0.f; }
    const int nch = (c + 1 < 3) ? (c + 1) : 3;
    const bf16_t* Kc = P + (size_t)(64 * (c - nch + 1)) * NPM + C_SWA_K + hk * 64; const bf16_t* Vc = P + (size_t)(64 * (c - nch + 1)) * NPM + C_SWA_V + hk * 64;
    AtRegs pre = at_gload(Kc, Vc, tid);
#pragma unroll 1
    for (int st = 0; st < nch; ++st) {
        __syncthreads();
        at_sstore(lds, pre, tid);
        __syncthreads();
        if (st + 1 < nch) pre = at_gload(Kc + (size_t)(64 * (st + 1)) * NPM, Vc + (size_t)(64 * (st + 1)) * NPM, tid);
        f32x16 p0, p1; bf16x8 pk[4];
        at_qk(p0, p1, lds, qr, r, h);
        at_softmax<false, false>(p0, p1, m, l, o, pk, 0.125f * LOG2E, nullptr, 0, h);
        at_pv(o, lds + AT_K_BYTES, pk, r, h);
    }
    const float lt = l + __shfl_xor(l, 32);
    at_store(OCT + (size_t)(b * SEQ + qpos + r) * OC + head * 64, o, 1.f / lt, h);
}

__device__ __forceinline__ size_t dsa_chunk_off(int b, int c) { return (size_t)b * (4096 * 528) + (size_t)4096 * (c * (c + 1) / 2); }
__device__ __forceinline__ void dsa_scores(KP p, LAS unsigned char* lds) {
    const int tid = my_tid(), lane = tid & 63, wave = tid >> 6, r = lane & 31, h = lane >> 5;
    const bf16_t* Pm = (const bf16_t*)(p->ws + WS_PMIX); float* SCR = (float*)(p->ws + WS_SCORES);
    LAS float* tb = (LAS float*)(lds + wave * (32 * 36 * 4));
    const int gw = blockIdx.x * 8 + wave, NGW = gridDim.x * 8;
    constexpr int PERB = 1036;
    for (int it = gw; it < NB * PERB; it += NGW) {
        const int b = it / PERB; int rem = it % PERB; const int qh = rem & 1; rem >>= 1;
        int c = 4; { int acc = 0; while (rem >= acc + c + 1) { acc += c + 1; ++c; } rem -= acc; } const int kb = rem;
        const bf16_t* Pb = Pm + (size_t)b * SEQ * NPM; const int qbase = c * 64 + 32 * qh;
        const bf16_t* qrow = Pb + (size_t)(qbase + r) * NPM;
        float wq[4];
#pragma unroll
        for (int hh = 0; hh < 4; ++hh) wq[hh] = bf2f(qrow[C_WIDX + hh]) * 0.0625f;
        float* dst = SCR + dsa_chunk_off(b, c) + (size_t)(32 * qh) * (64 * (c + 1)) + 64 * kb;
#pragma unroll 1
        for (int kh = 0; kh < 2; ++kh) {
            const bf16_t* krow = Pb + (size_t)(64 * kb + 32 * kh + r) * NPM + C_DSA_KI;
            bf16x8 kf[4];
#pragma unroll
            for (int ds = 0; ds < 4; ++ds) kf[ds] = *(const bf16x8*)(krow + 16 * ds + 8 * h);
            f32x16 sc;
#pragma unroll
            for (int i = 0; i < 16; ++i) sc[i] = 0.f;
#pragma unroll
            for (int hh = 0; hh < 4; ++hh) { f32x16 a;
#pragma unroll
                for (int i = 0; i < 16; ++i) a[i] = 0.f;
#pragma unroll
                for (int ds = 0; ds < 4; ++ds) { const bf16x8 qf = *(const bf16x8*)(qrow + C_DSA_QI + hh * 64 + 16 * ds + 8 * h); a = __builtin_amdgcn_mfma_f32_32x32x16_bf16(kf[ds], qf, a, 0, 0, 0); }
#pragma unroll
                for (int i = 0; i < 16; ++i) sc[i] += fmaxf(a[i], 0.f) * wq[hh]; }
#pragma unroll
            for (int g = 0; g < 4; ++g) *(LAS f32x4*)(tb + r * 36 + 8 * g + 4 * h) = (f32x4){sc[4 * g] + 0.f, sc[4 * g + 1] + 0.f, sc[4 * g + 2] + 0.f, sc[4 * g + 3] + 0.f};
            LDS_FENCE();
#pragma unroll
            for (int i = 0; i < 4; ++i) { const int q = 8 * i + (lane >> 3), cc = (lane & 7) * 4; const f32x4 v = *(const LAS f32x4*)(tb + q * 36 + cc);
                *(f32x4*)(dst + (size_t)q * (64 * (c + 1)) + 32 * kh + cc) = v; }
            LDS_FENCE();
        }
    }
}
__device__ __forceinline__ int count_ge8(int cnt, unsigned cand, unsigned k0, unsigned k1, unsigned k2, unsigned k3, unsigned k4, unsigned k5, unsigned k6, unsigned k7) {
    int t; unsigned long long m0, m1, m2, m3;
    asm volatile("v_cmp_ge_u32_e64 %2, %7, %6\n\tv_cmp_ge_u32_e64 %3, %8, %6\n\tv_cmp_ge_u32_e64 %4, %9, %6\n\tv_cmp_ge_u32_e64 %5, %10, %6\n\t"
                 "s_bcnt1_i32_b64 %1, %2\n\ts_add_i32 %0, %0, %1\n\tv_cmp_ge_u32_e64 %2, %11, %6\n\t"
                 "s_bcnt1_i32_b64 %1, %3\n\ts_add_i32 %0, %0, %1\n\tv_cmp_ge_u32_e64 %3, %12, %6\n\t"
                 "s_bcnt1_i32_b64 %1, %4\n\ts_add_i32 %0, %0, %1\n\tv_cmp_ge_u32_e64 %4, %13, %6\n\t"
                 "s_bcnt1_i32_b64 %1, %5\n\ts_add_i32 %0, %0, %1\n\tv_cmp_ge_u32_e64 %5, %14, %6\n\t"
                 "s_bcnt1_i32_b64 %1, %2\n\ts_add_i32 %0, %0, %1\n\t"
                 "s_bcnt1_i32_b64 %1, %3\n\ts_add_i32 %0, %0, %1\n\t"
                 "s_bcnt1_i32_b64 %1, %4\n\ts_add_i32 %0, %0, %1\n\t"
                 "s_bcnt1_i32_b64 %1, %5\n\ts_add_i32 %0, %0, %1"
                 : "+s"(cnt), "=&s"(t), "=&s"(m0), "=&s"(m1), "=&s"(m2), "=&s"(m3)
                 : "v"(cand), "v"(k0), "v"(k1), "v"(k2), "v"(k3), "v"(k4), "v"(k5), "v"(k6), "v"(k7) : "scc");
    return cnt;
}
__device__ __forceinline__ int count_lane4(int cnt, unsigned cand, unsigned k0, unsigned k1, unsigned k2, unsigned k3) {
    asm volatile("v_cmp_ge_u32_e32 vcc, %2, %1\n\tv_addc_co_u32_e32 %0, vcc, 0, %0, vcc\n\t"
                 "v_cmp_ge_u32_e32 vcc, %3, %1\n\tv_addc_co_u32_e32 %0, vcc, 0, %0, vcc\n\t"
                 "v_cmp_ge_u32_e32 vcc, %4, %1\n\tv_addc_co_u32_e32 %0, vcc, 0, %0, vcc\n\t"
                 "v_cmp_ge_u32_e32 vcc, %5, %1\n\tv_addc_co_u32_e32 %0, vcc, 0, %0, vcc"
                 : "+v"(cnt) : "v"(cand), "v"(k0), "v"(k1), "v"(k2), "v"(k3) : "vcc");
    return cnt;
}
__device__ __forceinline__ int count_ge32(const unsigned (&key)[32], unsigned cand) {
    int cnt = 0;
#pragma unroll
    for (int i = 0; i < 32; i += 8) cnt = count_ge8(cnt, cand, key[i], key[i + 1], key[i + 2], key[i + 3], key[i + 4], key[i + 5], key[i + 6], key[i + 7]);
    return cnt;
}
__device__ __forceinline__ void dsa_select(KP p, LAS unsigned char* lds) {
    const int tid = my_tid(), lane0 = tid & 63, wave = tid >> 6, gw = blockIdx.x * 8 + wave, NGW = gridDim.x * 8;
#pragma unroll 1
    for (int it = gw; it < NB * 28 * 64; it += NGW) {
        int lane = lane0; asm volatile("" : "+v"(lane));
        const int b = it / (28 * 64), rem = it % (28 * 64), c = 4 + (rem >> 6), ql = rem & 63, nadm = 64 * (c + 1);
        const float* srow = (const float*)(p->ws + WS_SCORES) + dsa_chunk_off(b, c) + (size_t)ql * nadm;
        unsigned key[32];
#pragma unroll
        for (int i = 0; i < 32; ++i) { const int kv = 64 * i + lane; key[i] = __float_as_uint(srow[kv < nadm ? kv : nadm - 1]); }
#pragma unroll
        for (int i = 0; i < 32; ++i) asm volatile("" : "+v"(key[i]));
#pragma unroll
        for (int i = 0; i < 32; ++i) { const int kv = 64 * i + lane; key[i] = (kv < nadm) ? fkey(__uint_as_float(key[i]) + 0.f) : 0u; }
        unsigned Tk = 0u;
#pragma unroll 1
        for (int bit = 31; bit >= 0; --bit) { const unsigned cand = Tk | (1u << bit); int cl = 0;
            cl = count_lane4(cl, cand, key[0], key[1], key[2], key[3]);
            int cnt = count_ge8(0, cand, key[4], key[5], key[6], key[7], key[8], key[9], key[10], key[11]);
            if (c >= 12) { cl = count_lane4(cl, cand, key[12], key[13], key[14], key[15]);
                if (c >= 16) { cnt = count_ge8(cnt, cand, key[16], key[17], key[18], key[19], key[20], key[21], key[22], key[23]);
                    if (c >= 24) { cl = count_lane4(cl, cand, key[24], key[25], key[26], key[27]); if (c >= 28) cl = count_lane4(cl, cand, key[28], key[29], key[30], key[31]); } } }
            cnt += (int)wave_sum_s((float)cl);
            if (cnt >= 256) Tk = cand; }
        const int cge = count_ge32(key, Tk), cgt = count_ge32(key, Tk + 1u), quota = 256 - cgt, nt = cge - cgt;
        int cut = -1, acc = 0; const unsigned long long ltm = (1ull << lane) - 1ull;
#pragma unroll
        for (int i = 0; i < 32; ++i) { const unsigned long long tm = __ballot(key[i] == Tk); const int n = __builtin_popcountll(tm);
            if (acc < quota && acc + n >= quota) { const unsigned long long hit = __ballot(key[i] == Tk && __builtin_popcountll(tm & ltm) == quota - acc - 1); cut = 64 * i + (int)__builtin_ctzll(hit); }
            acc += n; }
        (void)nt;
        unsigned long long mine = 0ull;
#pragma unroll
        for (int i = 0; i < 32; ++i) { const unsigned long long sm = __ballot((key[i] > Tk) || (key[i] == Tk && 64 * i + lane <= cut)); mine = (lane == i) ? sm : mine; }
        if (lane < 32) ((unsigned long long*)(p->ws + WS_MASKB))[(size_t)(b * SEQ + c * 64 + ql) * 32 + lane] = mine;
    }
}
__device__ __forceinline__ void dsa_unit(KP p, int b, int c, int hp, LAS unsigned char* lds) {
    const int tid = my_tid(), lane = tid & 63, wave = tid >> 6, r = lane & 31, h = lane >> 5, wv = wave & 3, g = wave >> 2;
    const bf16_t* P = (const bf16_t*)(p->ws + WS_PMIX) + (size_t)b * SEQ * NPM; bf16_t* OCT = (bf16_t*)(p->ws + WS_OCAT);
    const int nadm = 64 * (c + 1);
    const float* SCRc = (const float*)(p->ws + WS_SCORES) + dsa_chunk_off(b, c);
    const bool sel = nadm > 256;
    const int head = 2 * hp + (wv >> 1), ql = 32 * (wv & 1) + r, qbase = 64 * c + 32 * (wv & 1);
    const unsigned long long* mrow = (const unsigned long long*)(p->ws + WS_MASKB) + (size_t)(b * SEQ + c * 64 + ql) * 32;
    bf16x8 qr[4]; at_loadq(qr, P + (size_t)(qbase + r) * NPM + C_DSA_Q + head * 64, h);
    f32x16 o[2]; float m = NEGBIG, l = 0.f;
#pragma unroll
    for (int i = 0; i < 16; ++i) { o[0][i] = 0.f; o[1][i] = 0.f; }
    const int nst = (c + 2) >> 1;
    const bf16_t* Kc = P + C_DSA_K; const bf16_t* Vc = P + C_DSA_V;
    AtRegs pre0 = at_gload(Kc, Vc, tid), pre1 = at_gload(Kc + (size_t)((c >= 1) ? 64 : 0) * NPM, Vc + (size_t)((c >= 1) ? 64 : 0) * NPM, tid);
#pragma unroll 1
    for (int st = 0; st < nst; ++st) {
        __syncthreads();
        at_sstore(lds, pre0, tid); at_sstore(lds + AT_TILE_BYTES, pre1, tid);
        __syncthreads();
        if (st + 1 < nst) { const int j0 = 2 * st + 2, j1 = (j0 + 1 <= c) ? j0 + 1 : j0; pre0 = at_gload(Kc + (size_t)(64 * j0) * NPM, Vc + (size_t)(64 * j0) * NPM, tid); pre1 = at_gload(Kc + (size_t)(64 * j1) * NPM, Vc + (size_t)(64 * j1) * NPM, tid); }
        const int jt = 2 * st + g; const LAS unsigned char* tile = lds + g * AT_TILE_BYTES;
        if (jt <= c) {
            unsigned mb = 0u;
            if (sel) { const unsigned long long m64 = mrow[jt] >> (4 * h);
#pragma unroll
                for (int kvh = 0; kvh < 2; ++kvh)
#pragma unroll
                    for (int reg = 0; reg < 16; ++reg) mb |= (unsigned)((m64 >> (32 * kvh + (reg & 3) + 8 * (reg >> 2))) & 1ull) << (16 * kvh + reg); }
            f32x16 p0, p1; bf16x8 pk[4];
            at_qk(p0, p1, tile, qr, r, h);
            if (sel) at_softmax<false, false, true>(p0, p1, m, l, o, pk, 0.125f * LOG2E, nullptr, 0, h, mb);
            else at_softmax<false, false>(p0, p1, m, l, o, pk, 0.125f * LOG2E, nullptr, 0, h);
            at_pv(o, tile + AT_K_BYTES, pk, r, h);
        }
    }
    __syncthreads();
    LAS float* cb = (LAS float*)lds + (size_t)wv * (34 * 64);
    if (g == 1) { cb[lane] = m; cb[64 + lane] = l;
#pragma unroll
        for (int i = 0; i < 16; ++i) { cb[(2 + i) * 64 + lane] = o[0][i]; cb[(18 + i) * 64 + lane] = o[1][i]; } }
    __syncthreads();
    if (g == 0) { const float mb = cb[lane], lb = cb[64 + lane]; const float M = fmaxf(m, mb), sa = __builtin_amdgcn_exp2f(m - M), sb = __builtin_amdgcn_exp2f(mb - M);
        l = l * sa + lb * sb;
#pragma unroll
        for (int i = 0; i < 16; ++i) { o[0][i] = o[0][i] * sa + cb[(2 + i) * 64 + lane] * sb; o[1][i] = o[1][i] * sa + cb[(18 + i) * 64 + lane] * sb; }
        const float lt = l + __shfl_xor(l, 32);
        at_store(OCT + (size_t)(b * SEQ + qbase + r) * OC + 1024 + head * 64, o, 1.f / lt, h); }
}

template <int N> __device__ __forceinline__ float dpp_ror(float x) { return __int_as_float(__builtin_amdgcn_update_dpp(0, __float_as_int(x), 0x120 + N, 0xf, 0xf, false)); }
__device__ __forceinline__ void row16_sum2(float& a, float& b) {
    a += dpp_ror<8>(a); b += dpp_ror<8>(b); a += dpp_ror<4>(a); b += dpp_ror<4>(b); a += dpp_ror<2>(a); b += dpp_ror<2>(b); a += dpp_ror<1>(a); b += dpp_ror<1>(b);
}
__device__ __forceinline__ float row16_sum(float x) { x += dpp_ror<8>(x); x += dpp_ror<4>(x); x += dpp_ror<2>(x); x += dpp_ror<1>(x); return x; }
__device__ __forceinline__ void rwkv_scan2(KP p, int l, int sw, LAS unsigned char* lds) {
    const int tid = my_tid(), lane = tid & 63, wave = tid >> 6; const int bh = sw >> 2, b = bh >> 2, h = bh & 3, rowbase = 16 * (sw & 3);
    const int rl = lane >> 4, c = lane & 15, r16 = 4 * (wave & 3) + rl;
    const float* RW = (const float*)(p->ws + WS_RW);
    const float* RWv = RW + (size_t)5 * T * 256; float* Y = (float*)(p->ws + WS_Y); float* BONW = (float*)(p->ws + WS_BONUS); const float rkl = p->in[I_RK][l * 256 + h * 64 + lane];
    LAS float* L = (LAS float*)lds;
    LAS float* Lv = L + 5 * 1024; LAS float* Ly = Lv + 256;
    f32x4 S = (f32x4){0.f, 0.f, 0.f, 0.f}, rprev = (f32x4){0.f, 0.f, 0.f, 0.f};
    const size_t hb = (size_t)b * SEQ * 256 + h * 64;
    f32x2 pre[5]; float vpre = 0.f;
#pragma unroll
    for (int a = 0; a < 5; ++a) { const int e = 2 * tid; pre[a] = *(const f32x2*)(RW + (size_t)a * T * 256 + hb + (size_t)(e >> 6) * 256 + (e & 63)); }
    if (tid < 256) vpre = RWv[hb + (size_t)(tid >> 4) * 256 + rowbase + (tid & 15)];
#pragma unroll 1
    for (int tb = 0; tb < SEQ; tb += 16) {
        __syncthreads();
        if (tb > 0 && tid < 256) { const int st = tb - 17 + (tid >> 4); if (st >= 0) Y[hb + (size_t)st * 256 + rowbase + (tid & 15)] = Ly[tid]; }
#pragma unroll
        for (int a = 0; a < 5; ++a) *(LAS f32x2*)(L + a * 1024 + 2 * tid) = pre[a];
        if (tid < 256) Lv[tid] = vpre;
        __syncthreads();
        if (tb + 16 < SEQ) {
#pragma unroll
            for (int a = 0; a < 5; ++a) { const int e = 2 * tid; pre[a] = *(const f32x2*)(RW + (size_t)a * T * 256 + hb + (size_t)(tb + 16 + (e >> 6)) * 256 + (e & 63)); }
            if (tid < 256) vpre = RWv[hb + (size_t)(tb + 16 + (tid >> 4)) * 256 + rowbase + (tid & 15)];
        }
        if ((sw & 3) == 0 && wave >= 4) {
#pragma unroll
            for (int i4 = 0; i4 < 4; ++i4) { const int i = 4 * (wave - 4) + i4; const float s = wave_sum(L[0 * 1024 + i * 64 + lane] * L[2 * 1024 + i * 64 + lane] * rkl);
                if (lane == 0) BONW[(size_t)(b * SEQ + tb + i) * 4 + h] = s; }
        }
        if (wave < 4) {
            f32x4 r_ = *(const LAS f32x4*)(L + 0 * 1024 + 4 * c), w_ = *(const LAS f32x4*)(L + 1 * 1024 + 4 * c), k_ = *(const LAS f32x4*)(L + 2 * 1024 + 4 * c);
            f32x4 kk_ = *(const LAS f32x4*)(L + 3 * 1024 + 4 * c), ka_ = *(const LAS f32x4*)(L + 4 * 1024 + 4 * c); float v_ = Lv[r16];
#pragma unroll
            for (int i = 0; i < 16; ++i) {
                f32x4 rn = r_, wn = w_, kn = k_, kkn = kk_, kan = ka_; float vn = v_;
                if (i < 15) { rn = *(const LAS f32x4*)(L + 0 * 1024 + (i + 1) * 64 + 4 * c); wn = *(const LAS f32x4*)(L + 1 * 1024 + (i + 1) * 64 + 4 * c); kn = *(const LAS f32x4*)(L + 2 * 1024 + (i + 1) * 64 + 4 * c);
                    kkn = *(const LAS f32x4*)(L + 3 * 1024 + (i + 1) * 64 + 4 * c); kan = *(const LAS f32x4*)(L + 4 * 1024 + (i + 1) * 64 + 4 * c); vn = Lv[(i + 1) * 16 + r16]; }
                float pa = (S.x * kk_.x + S.y * kk_.y) + (S.z * kk_.z + S.w * kk_.w);
                float py = (S.x * rprev.x + S.y * rprev.y) + (S.z * rprev.z + S.w * rprev.w);
                row16_sum2(pa, py);
                Ly[i * 16 + r16] = py;
                S = S * w_ - ka_ * pa + k_ * v_;
                rprev = r_;
                r_ = rn; w_ = wn; k_ = kn; kk_ = kkn; ka_ = kan; v_ = vn;
            }
        }
    }
    __syncthreads();
    if (tid < 256) { const int st = SEQ - 17 + (tid >> 4); Y[hb + (size_t)st * 256 + rowbase + (tid & 15)] = Ly[tid]; }
    if (wave < 4) { const float py = row16_sum((S.x * rprev.x + S.y * rprev.y) + (S.z * rprev.z + S.w * rprev.w)); if (c == 0) Y[hb + (size_t)(SEQ - 1) * 256 + rowbase + r16] = py; }
}
__device__ __forceinline__ void rwkv_post(KP p, int l) {
    const int tid = my_tid(), lane = tid & 63, wave = tid >> 6, gw = blockIdx.x * 8 + wave, NGW = gridDim.x * 8;
    const float* RW = (const float*)(p->ws + WS_RW); const float* RWv = RW + (size_t)5 * T * 256; const float* RWg = RW + (size_t)6 * T * 256;
    const float* Y = (const float*)(p->ws + WS_Y); const float* BON = (const float*)(p->ws + WS_BONUS); bf16_t* OCT = (bf16_t*)(p->ws + WS_OCAT);
    float gng[4], gnb[4];
#pragma unroll
    for (int hh = 0; hh < 4; ++hh) { gng[hh] = p->in[I_GNG][l * 256 + hh * 64 + lane]; gnb[hh] = p->in[I_GNB][l * 256 + hh * 64 + lane]; }
    for (int t = gw; t < T; t += NGW) {
#pragma unroll
        for (int hh = 0; hh < 4; ++hh) { const size_t o = (size_t)t * 256 + hh * 64 + lane; const float yy = Y[o];
            const float mean = wave_sum(yy) * (1.f / 64.f); const float d = yy - mean; const float var = wave_sum(d * d) * (1.f / 64.f);
            const float ov = (d * rsqrtf(var + 64e-5f) * gng[hh] + gnb[hh] + BON[t * 4 + hh] * RWv[o]) * RWg[o];
            OCT[(size_t)t * OC + 512 + hh * 64 + lane] = (bf16_t)f2bf(ov); }
    }
}

__device__ __forceinline__ void ph_scan(KP p, int l, LAS unsigned char* lds) {
    if (blockIdx.x < 128) { rwkv_scan2(p, l, blockIdx.x, lds); return; }
    const int tid = my_tid(); unsigned* ctl = (unsigned*)(p->ws + WS_CTL) + 512 + 64 * l; LAS int* slot = (LAS int*)(lds + LDS_BYTES - 256);
    for (;;) { if (tid == 0) *slot = (int)atomicAdd(ctl, 1u); __syncthreads(); const int it = *slot; __syncthreads(); if (it >= 512) break; fox_unit(p, it & 31, 15 - (it >> 5), lds); __syncthreads(); }
    for (;;) { if (tid == 0) *slot = (int)atomicAdd(ctl + 16, 1u); __syncthreads(); const int it = *slot; __syncthreads(); if (it >= 512) break; swa_unit(p, l, it, lds); __syncthreads(); }
}
__device__ __forceinline__ void ph_attn(KP p, int l, LAS unsigned char* lds) {
    dsa_scores(p, lds);
    rwkv_post(p, l);
}
__device__ __forceinline__ void ph_dsa_xb(KP p, int l, LAS unsigned char* lds) {
    {
        const int w = blockIdx.x, b = w >> 5, s = (w >> 1) & 15, hp = w & 1;
        dsa_unit(p, b, 31 - s, hp, lds);
        __syncthreads();
        dsa_unit(p, b, s, hp, lds);
        __syncthreads();
    }
    const int tid = my_tid(), lane = tid & 63, wave = tid >> 6, gw = blockIdx.x * 8 + wave, NGW = gridDim.x * 8;
    const float* src = (l == 0) ? p->in[I_X] : p->out; bf16_t* XB = (bf16_t*)(p->ws + WS_XB2);
    for (int m = gw; m < T; m += NGW) row_to_bf16(src + (size_t)m * D, XB + (size_t)m * D, lane);
}

struct SchedMerge {
    static constexpr int PERM = 1;
    const char* XB; const char* WIN; const char* OCT; const char* WB; int G, c;
    __device__ __forceinline__ bool next(int i, mg::Unit& u) const {
        int pm, pn; if (!mg::static_tile(i >> 3, G, c, T / 256, 4, pm, pn)) return false;
        const int j = i & 7, br = j >> 1; u.pm = pm; u.pn = pn; u.tag = j;
        if ((j & 1) == 0) { u.A = XB + (size_t)pm * 256 * 2048; u.B = WIN + (size_t)(3328 + 1024 * br + 256 * pn) * 2048; u.ld = 2048; u.nt = 16; }
        else { const int koff = (br == 0) ? 0 : 256 + 256 * br, kk = (br == 0) ? 512 : 256;
            u.A = OCT + (size_t)pm * 256 * (OC * 2) + koff * 2; u.B = WB + (size_t)pn * 256 * (OC * 2) + koff * 2; u.ld = OC * 2; u.nt = kk / 64; }
        return true;
    }
};
struct EpiMerge {
    const float* gbias; u32x4* gsc; u32x4* macc; bf16_t* MB;
    __device__ __forceinline__ void operator()(const AccT& acc, const mg::Unit& u, int wr, int wc, int fr, int fq, int tid) const {
        const int br = u.tag >> 1; const int col0 = u.pn * 256 + wc * 32 + 8 * fq, row0 = u.pm * 256 + wr * 64 + fr;
        if ((u.tag & 1) == 0) {
            f32x4 bv[2][2];
#pragma unroll
            for (int bj = 0; bj < 2; ++bj)
#pragma unroll
                for (int n = 0; n < 2; ++n) bv[bj][n] = *(const f32x4*)(gbias + br * 1024 + col0 + bj * 128 + 4 * n);
#pragma unroll
            for (int ai = 0; ai < 2; ++ai)
#pragma unroll
                for (int m = 0; m < 4; ++m)
#pragma unroll
                    for (int bj = 0; bj < 2; ++bj) { f32x4 g[2];
#pragma unroll
                        for (int n = 0; n < 2; ++n) { const f32x4 x = acc[ai][bj][m][n] + bv[bj][n];
#pragma unroll
                            for (int j = 0; j < 4; ++j) g[n][j] = sigm(x[j]); }
                        u32x4 w; w.x = pk2(g[0][0], g[0][1]); w.y = pk2(g[0][2], g[0][3]); w.z = pk2(g[1][0], g[1][1]); w.w = pk2(g[1][2], g[1][3]);
                        gsc[(((ai * 4 + m) * 2 + bj) * 512) + tid] = w; asm volatile("" ::: "memory"); }
        } else {
#pragma unroll
            for (int ai = 0; ai < 2; ++ai)
#pragma unroll
                for (int m = 0; m < 4; ++m) { bf16_t* rowp = MB + (size_t)(row0 + ai * 128 + m * 16) * D + col0;
#pragma unroll
                    for (int bj = 0; bj < 2; ++bj) { const int idx = (((ai * 4 + m) * 2 + bj) * 512) + tid; float g[8], r[8]; unpack8(gsc[idx], g);
#pragma unroll
                        for (int n = 0; n < 2; ++n)
#pragma unroll
                            for (int j = 0; j < 4; ++j) r[4 * n + j] = g[4 * n + j] * acc[ai][bj][m][n][j];
                        if (br > 0) { float pm[8]; unpack8(macc[idx], pm);
#pragma unroll
                            for (int j = 0; j < 8; ++j) r[j] += pm[j]; }
                        u32x4 w; w.x = pk2(r[0], r[1]); w.y = pk2(r[2], r[3]); w.z = pk2(r[4], r[5]); w.w = pk2(r[6], r[7]);
                        if (br < 3) macc[idx] = w; else *(u32x4*)(rowp + bj * 128) = w;
                        asm volatile("" ::: "memory"); } }
        }
    }
};
__device__ __forceinline__ void ph_merge(KP p, int l, LAS unsigned char* lds) {
    SchedMerge S{(const char*)(p->ws + WS_XB2), (const char*)(p->ws + WS_WIN), (const char*)(p->ws + WS_OCAT), (const char*)(p->ws + WS_WB), (int)gridDim.x, (int)blockIdx.x};
    EpiMerge E{p->in[I_GB] + (size_t)l * 4096, (u32x4*)(p->ws + WS_GSC) + (size_t)blockIdx.x * 8192, (u32x4*)(p->ws + WS_MACC) + (size_t)blockIdx.x * 8192, (bf16_t*)(p->ws + WS_MERGED)};
    mg::gemm_run(lds, S, E);
}

struct EpiResid {
    const float* base; float* out; float alpha;
    __device__ __forceinline__ void operator()(const AccT& acc, const mg::Unit& u, int wr, int wc, int fr, int fq, int) const {
        const int row0 = u.pm * 256 + wr * 64 + fr, col0 = u.pn * 256 + wc * 32 + 4 * fq;
#pragma unroll
        for (int ai = 0; ai < 2; ++ai)
#pragma unroll
            for (int m = 0; m < 4; ++m) { const size_t off = (size_t)(row0 + ai * 128 + m * 16) * D + col0;
#pragma unroll
                for (int bj = 0; bj < 2; ++bj)
#pragma unroll
                    for (int n = 0; n < 2; ++n) { const f32x4 bs = *(const f32x4*)(base + off + bj * 128 + n * 16); *(f32x4*)(out + off + bj * 128 + n * 16) = bs * alpha + acc[ai][bj][m][n]; } }
    }
};
__device__ __forceinline__ void ph_outproj(KP p, int l, LAS unsigned char* lds) {
    SchedPlain<0, 4, D> S{(const char*)(p->ws + WS_MERGED), (const char*)(p->ws + WS_WO), (int)gridDim.x, (int)blockIdx.x};
    EpiResid E{(l == 0) ? p->in[I_X] : p->out, p->out, DN_ALPHA};
    mg::gemm_run(lds, S, E);
}

__device__ __forceinline__ void ln_rows(KP p, int l, int mode, LAS unsigned char* lds) {
    const int tid = my_tid(), lane = tid & 63, wave = tid >> 6;
    const float* g = p->in[I_LNG] + (size_t)(l * 2 + mode) * D; const float* bb = p->in[I_LNB] + (size_t)(l * 2 + mode) * D;
    bf16_t* OB = (bf16_t*)(p->ws + (mode == 0 ? WS_X1B : WS_XB)); const bool wb = (mode == 0) || (l == 0);
    const bool moe = (mode == 0) && (l & 1); const float* rw = p->in[I_RTW] + (size_t)(l >> 1) * D * NE; const float* rb = p->in[I_RTB] + (l >> 1) * NE;
    int* TOKE = (int*)(p->ws + WS_TOKE); float* TOKW = (float*)(p->ws + WS_TOKW);
    f32x4 gv[4], bv[4];
#pragma unroll
    for (int j = 0; j < 4; ++j) { gv[j] = *(const f32x4*)(g + 4 * lane + 256 * j); bv[j] = *(const f32x4*)(bb + 4 * lane + 256 * j); }
    const int rows_per_wg = T / gridDim.x;
#pragma unroll 2
    for (int rr = wave; rr < rows_per_wg; rr += 8) {
        const int row = blockIdx.x * rows_per_wg + rr; float* xr = p->out + (size_t)row * D;
        f32x4 v[4]; float s = 0.f;
#pragma unroll
        for (int j = 0; j < 4; ++j) v[j] = *(const f32x4*)(xr + 4 * lane + 256 * j);
        if (mode == 1 && (l & 1)) {
            const int* RO = (const int*)(p->ws + WS_ROWOF); const bf16_t* YB = (const bf16_t*)(p->ws + WS_AG);
#pragma unroll
            for (int sl = 0; sl < 2; ++sl) { const int yr = RO[row * 2 + sl]; const float w = TOKW[row * 2 + sl];
#pragma unroll
                for (int j = 0; j < 4; ++j) { const u32x2 y = *(const u32x2*)(YB + (size_t)yr * D + 4 * lane + 256 * j);
                    v[j].x += w * bflo(y.x); v[j].y += w * bfhi(y.x); v[j].z += w * bflo(y.y); v[j].w += w * bfhi(y.y); } } }
#pragma unroll
        for (int j = 0; j < 4; ++j) s += (v[j].x + v[j].y) + (v[j].z + v[j].w);
        const float mean = wave_sum(s) * (1.f / D); float s2 = 0.f;
#pragma unroll
        for (int j = 0; j < 4; ++j) { v[j] = v[j] - mean; s2 += (v[j].x * v[j].x + v[j].y * v[j].y) + (v[j].z * v[j].z + v[j].w * v[j].w); }
        const float rstd = rsqrtf(wave_sum(s2) * (1.f / D) + LN_EPS);
        const float osc = (mode == 0) ? DN_ALPHA : 1.f;
#pragma unroll
        for (int j = 0; j < 4; ++j) { v[j] = v[j] * rstd * gv[j] + bv[j]; *(f32x4*)(xr + 4 * lane + 256 * j) = v[j] * osc;
            if (wb) *(unsigned long long*)(OB + (size_t)row * D + 4 * lane + 256 * j) = (unsigned long long)pk2(v[j].x, v[j].y) | ((unsigned long long)pk2(v[j].z, v[j].w) << 32); }
        if (moe) {
            float lg[8];
#pragma unroll
            for (int e = 0; e < 8; ++e) lg[e] = 0.f;
#pragma unroll
            for (int j = 0; j < 4; ++j)
#pragma unroll
                for (int q = 0; q < 4; ++q) { const int c = 4 * lane + 256 * j + q; const f32x4 w0 = *(const f32x4*)(rw + (size_t)c * 8), w1 = *(const f32x4*)(rw + (size_t)c * 8 + 4); const float x = v[j][q];
                    lg[0] += x * w0.x; lg[1] += x * w0.y; lg[2] += x * w0.z; lg[3] += x * w0.w; lg[4] += x * w1.x; lg[5] += x * w1.y; lg[6] += x * w1.z; lg[7] += x * w1.w; }
#pragma unroll
            for (int e = 0; e < 8; ++e) lg[e] = wave_sum(lg[e]) + rb[e];
            int e1 = 0; float v1 = lg[0];
#pragma unroll
            for (int e = 1; e < 8; ++e) if (lg[e] > v1) { v1 = lg[e]; e1 = e; }
            int e2 = -1; float v2 = -INFINITY;
#pragma unroll
            for (int e = 0; e < 8; ++e) if (e != e1 && lg[e] > v2) { v2 = lg[e]; e2 = e; }
            const float w1 = 1.f / (1.f + __expf(v2 - v1));
            if (lane == 0) { TOKE[row * 2] = e1; TOKE[row * 2 + 1] = e2; TOKW[row * 2] = w1; TOKW[row * 2 + 1] = 1.f - w1; }
        }
    }
    if (moe) {
        __syncthreads();
        if (tid < 8) { int cnt = 0; for (int rr = 0; rr < rows_per_wg; ++rr) { const int row = blockIdx.x * rows_per_wg + rr; cnt += (TOKE[row * 2] == tid) + (TOKE[row * 2 + 1] == tid); }
            ((int*)(p->ws + WS_WGCNT))[blockIdx.x * 8 + tid] = cnt; }
    }
}
__device__ __forceinline__ void ph_ln1(KP p, int l, LAS unsigned char* lds) {
    ln_rows(p, l, 0, lds);
    __syncthreads();
    const int tid_ = my_tid(); const int lane = tid_ & 63, wave = tid_ >> 6, gw = blockIdx.x * 8 + wave, NGW = gridDim.x * 8;
    LAS float* scr = (LAS float*)(lds + wave * 8448);
    bf16_t* W13 = (bf16_t*)(p->ws + WS_WF13);
    if ((l & 1) == 0) {
        const int j = l >> 1; const float* w1 = p->in[I_F1] + (size_t)j * D * DFF; const float* w3 = p->in[I_F3] + (size_t)j * D * DFF; const float* w2 = p->in[I_F2] + (size_t)j * DFF * D;
        bf16_t* W2 = (bf16_t*)(p->ws + WS_WF2_DENSE);
        const int n1 = tr_nitems(D, DFF), n2 = tr_nitems(DFF, D);
        for (int it = gw; it < 2 * n1 + n2; it += NGW) { int r = it;
            if (r < n1) { tr_item(w1, D, DFF, W13, D, 2, 0, scr, r, lane); continue; } r -= n1;
            if (r < n1) { tr_item(w3, D, DFF, W13, D, 3, 0, scr, r, lane); continue; } r -= n1;
            tr_item(w2, DFF, D, W2, DFF, 0, 0, scr, r, lane); }
    } else {
        const int j = l >> 1; bf16_t* W2 = (bf16_t*)(p->ws + WS_WF2_MOE);
        const int n1 = tr_nitems(D, DFE), n2 = tr_nitems(DFE, D), per = 2 * n1 + n2;
        for (int it = gw; it < NE * per; it += NGW) { const int e = it / per; int r = it % per;
            const float* w1 = p->in[I_E1] + ((size_t)j * NE + e) * D * DFE; const float* w3 = p->in[I_E3] + ((size_t)j * NE + e) * D * DFE; const float* w2 = p->in[I_E2] + ((size_t)j * NE + e) * DFE * D;
            if (r < n1) { tr_item(w1, D, DFE, W13, D, 2, e * 2 * DFE, scr, r, lane); continue; } r -= n1;
            if (r < n1) { tr_item(w3, D, DFE, W13, D, 3, e * 2 * DFE, scr, r, lane); continue; } r -= n1;
            tr_item(w2, DFE, D, W2, DFE, 0, e * D, scr, r, lane); }
    }
}

__device__ __forceinline__ void moe_tables(KP p, LAS int* tb  ) {
    const int tid = my_tid(), lane = tid & 63, e = tid >> 6; const int* WG = (const int*)(p->ws + WS_WGCNT);
    { int tot = 0, mine = 0;
#pragma unroll
        for (int k = 0; k < 4; ++k) { const int w = lane + 64 * k; const int c = (w < (int)gridDim.x) ? WG[w * 8 + e] : 0; tot += c; mine += (w < (int)blockIdx.x) ? c : 0; }
        tot = (int)wave_sum((float)tot); mine = (int)wave_sum((float)mine);
        if (lane == 0) { tb[e] = tot; tb[16 + e] = mine; } }
    __syncthreads();
    if (tid == 0) { int base = 0; for (int x = 0; x < 8; ++x) { tb[8 + x] = base; base += ((tb[x] + 255) >> 8) << 8; } tb[24] = base; }
    __syncthreads();
}
__device__ __forceinline__ void ph_moe_assign(KP p, int l, LAS unsigned char* lds) {
    const int tid = my_tid(), lane = tid & 63, wave = tid >> 6;
    LAS int* tb = (LAS int*)lds; LAS int* rowof = tb + 32;
    moe_tables(p, tb);
    const int rows_per_wg = T / gridDim.x; const int* TOKE = (const int*)(p->ws + WS_TOKE); const float* TOKW = (const float*)(p->ws + WS_TOKW);
    int* ROWTOK = (int*)(p->ws + WS_ROWTOK); float* ROWW = (float*)(p->ws + WS_ROWW);
    LAS int* wcnt = tb + 192;
    if (tid < 128) {
        const int row = blockIdx.x * rows_per_wg + (tid >> 1), s = tid & 1, e = TOKE[row * 2 + s]; const unsigned long long ltm = (1ull << lane) - 1ull;
        int rank = 0;
#pragma unroll
        for (int x = 0; x < 8; ++x) { const unsigned long long m = __ballot(e == x); if (e == x) rank = __builtin_popcountll(m & ltm); if (lane == 0) wcnt[wave * 8 + x] = __builtin_popcountll(m); }
        asm volatile("s_waitcnt lgkmcnt(0)" ::: "memory");
        __builtin_amdgcn_s_barrier();
        if (wave == 1) rank += wcnt[e];
        const int run = tb[8 + e] + tb[16 + e] + rank;
        ROWTOK[run] = row; ROWW[run] = TOKW[row * 2 + s]; rowof[tid] = run; ((int*)(p->ws + WS_ROWOF))[row * 2 + s] = run;
    } else { __builtin_amdgcn_s_barrier(); }
    bf16_t* AG = (bf16_t*)(p->ws + WS_AG);
    if (blockIdx.x < 8) { const int e = blockIdx.x, lo = tb[8 + e] + tb[e], hi = tb[8 + e] + (((tb[e] + 255) >> 8) << 8);
        for (int r = lo + wave; r < hi; r += 8) { if (lane == 0) { ROWTOK[r] = -1; ROWW[r] = 0.f; }
#pragma unroll
            for (int j = 0; j < 2; ++j) *(u32x4*)(AG + (size_t)r * D + 8 * lane + 512 * j) = (u32x4){0u, 0u, 0u, 0u}; } }
    __syncthreads();
    const bf16_t* X1B = (const bf16_t*)(p->ws + WS_X1B);
    for (int pr = wave; pr < rows_per_wg * 2; pr += 8) { const int row = blockIdx.x * rows_per_wg + (pr >> 1), dst = rowof[pr];
#pragma unroll
        for (int j = 0; j < 2; ++j) *(u32x4*)(AG + (size_t)dst * D + 8 * lane + 512 * j) = *(const u32x4*)(X1B + (size_t)row * D + 8 * lane + 512 * j); }
}

struct EpiSwiglu {
    bf16_t* H; int ldh;
    __device__ __forceinline__ void operator()(const AccT& acc, const mg::Unit& u, int wr, int wc, int fr, int fq, int) const {
        const int row0 = u.pm * 256 + wr * 64 + fr, col0 = u.pn * 128 + wc * 32 + 8 * fq;
#pragma unroll
        for (int ai = 0; ai < 2; ++ai)
#pragma unroll
            for (int m = 0; m < 4; ++m) { float hv[8];
#pragma unroll
                for (int n = 0; n < 2; ++n)
#pragma unroll
                    for (int j = 0; j < 4; ++j) { const float a = acc[ai][0][m][n][j], b = acc[ai][1][m][n][j]; hv[4 * n + j] = a * sigm(a) * b; }
                u32x4 w; w.x = pk2(hv[0], hv[1]); w.y = pk2(hv[2], hv[3]); w.z = pk2(hv[4], hv[5]); w.w = pk2(hv[6], hv[7]);
                *(u32x4*)(H + (size_t)(row0 + ai * 128 + m * 16) * ldh + col0) = w; asm volatile("" ::: "memory"); }
    }
};
template <int PERM_, int NN, int K, int BROWS> struct SchedMoe {
    static constexpr int PERM = PERM_;
    const char* A; const char* B; const LAS int* tstart; int G, c;
    __device__ __forceinline__ bool next(int i, mg::Unit& u) const {
        const int L = i * G + c; if (L >= tstart[8] * NN) return false;
        const int rt = L / NN, pn = L % NN; int e = 0;
#pragma unroll
        for (int x = 1; x < 8; ++x) if (rt >= tstart[x]) e = x;
        u.A = A + (size_t)rt * 256 * (K * 2); u.B = B + ((size_t)e * BROWS + (size_t)pn * 256) * (K * 2); u.ld = K * 2; u.nt = K / 64; u.pm = rt; u.pn = pn; u.tag = 0; return true;
    }
};
template <class SM> __device__ __forceinline__ void moe_sched_tiles(KP p, LAS unsigned char* lds, SM& S) {
    LAS int* tb = (LAS int*)(lds + LDS_BYTES - 512);
    moe_tables(p, tb);
    { const int t_ = my_tid(); if (t_ < 8) tb[32 + t_] = tb[8 + t_] >> 8; if (t_ == 8) tb[40] = tb[24] >> 8; }
    __syncthreads();
    S.tstart = tb + 32;
}
__device__ __forceinline__ void ph_ffn_up(KP p, int l, LAS unsigned char* lds) {
    if ((l & 1) == 0) {
        SchedPlain<1, 2 * DFF / 256, D> S{(const char*)(p->ws + WS_X1B), (const char*)(p->ws + WS_WF13), (int)gridDim.x, (int)blockIdx.x};
        EpiSwiglu E{(bf16_t*)(p->ws + WS_H), DFF};
        mg::gemm_run(lds, S, E);
    } else {
        SchedMoe<1, 2 * DFE / 256, D, 2 * DFE> S; S.A = (const char*)(p->ws + WS_AG); S.B = (const char*)(p->ws + WS_WF13);
        S.G = (int)gridDim.x; S.c = (int)blockIdx.x; moe_sched_tiles(p, lds, S);
        EpiSwiglu E{(bf16_t*)(p->ws + WS_H), DFE};
        mg::gemm_run(lds, S, E);
    }
}

struct EpiAccum {
    float* out;
    __device__ __forceinline__ void operator()(const AccT& acc, const mg::Unit& u, int wr, int wc, int fr, int fq, int) const {
        const int row0 = u.pm * 256 + wr * 64 + fr, col0 = u.pn * 256 + wc * 32 + 4 * fq;
#pragma unroll
        for (int ai = 0; ai < 2; ++ai)
#pragma unroll
            for (int m = 0; m < 4; ++m) { float* rp = out + (size_t)(row0 + ai * 128 + m * 16) * D + col0;
#pragma unroll
                for (int bj = 0; bj < 2; ++bj)
#pragma unroll
                    for (int n = 0; n < 2; ++n) { f32x4* q = (f32x4*)(rp + bj * 128 + n * 16); *q = *q + acc[ai][bj][m][n]; } }
    }
};
struct EpiScatter {
    float* out; const int* rowtok; const float* roww;
    __device__ __forceinline__ void operator()(const AccT& acc, const mg::Unit& u, int wr, int wc, int fr, int fq, int) const {
        const int row0 = u.pm * 256 + wr * 64 + fr, col0 = u.pn * 256 + wc * 32 + 4 * fq;
#pragma unroll
        for (int ai = 0; ai < 2; ++ai)
#pragma unroll
            for (int m = 0; m < 4; ++m) { const int r = row0 + ai * 128 + m * 16; const int tok = rowtok[r]; const float w = roww[r];
                if (tok >= 0) { float* rp = out + (size_t)tok * D + col0;
#pragma unroll
                    for (int bj = 0; bj < 2; ++bj)
#pragma unroll
                        for (int n = 0; n < 2; ++n)
#pragma unroll
                            for (int j = 0; j < 4; ++j) unsafeAtomicAdd(rp + bj * 128 + n * 16 + j, w * acc[ai][bj][m][n][j]); } }
    }
};
__device__ __forceinline__ void ph_ffn_down(KP p, int l, LAS unsigned char* lds) {
    if ((l & 1) == 0) {
        SchedPlain<0, 4, DFF> S{(const char*)(p->ws + WS_H), (const char*)(p->ws + WS_WF2_DENSE), (int)gridDim.x, (int)blockIdx.x};
        EpiAccum E{p->out};
        mg::gemm_run(lds, S, E);
    } else {
        SchedMoe<1, 4, DFE, D> S; S.A = (const char*)(p->ws + WS_H); S.B = (const char*)(p->ws + WS_WF2_MOE);
        S.G = (int)gridDim.x; S.c = (int)blockIdx.x; moe_sched_tiles(p, lds, S);
        EpiBf16Store E{(bf16_t*)(p->ws + WS_AG), D};
        mg::gemm_run(lds, S, E);
    }
}


#define XB_TMO      128
#define XB_XCNT(j)  (256  + 64 * (j))
#define XB_XSUB(j)  (1280 + 64 * (j))
#define XB_XGEN(j)  (2304 + 64 * (j))
#define XB_TOP      3328
#define XB_TOPGEN   3392
#define XCD_BAR_WORDS 3456
#define XB_SPIN_CAP (1u << 18)
__device__ __forceinline__ unsigned xb_ld(unsigned* p)              { return __hip_atomic_load(p, __ATOMIC_RELAXED, __HIP_MEMORY_SCOPE_AGENT); }
__device__ __forceinline__ unsigned xb_add(unsigned* p, unsigned v) { return __hip_atomic_fetch_add(p, v, __ATOMIC_RELAXED, __HIP_MEMORY_SCOPE_AGENT); }
__device__ __forceinline__ unsigned xb_xcc_id() { return (unsigned)__builtin_amdgcn_s_getreg((3 << 11) | 20) & 0xFu; }
#define XB_SPIN(cond, bar) do { unsigned _sp = 0; while (cond) { __builtin_amdgcn_s_sleep(1); \
    if ((++_sp & 255u) == 0u) { if (xb_ld(&(bar)[XB_TMO])) break; if (_sp > XB_SPIN_CAP) { atomicAdd(&(bar)[XB_TMO], 1u); break; } } } } while (0)
struct XcdBarrier { unsigned* bar; unsigned x; volatile LAS unsigned* st; };
__device__ __forceinline__ XcdBarrier xcd_barrier_post(unsigned* bar, volatile LAS unsigned* st) {
    XcdBarrier b; b.bar = bar; b.x = xb_xcc_id(); b.st = st;
    if (threadIdx.x == 0) (void)xb_add(&bar[XB_XCNT(b.x)], 1u);
    return b;
}
__device__ __forceinline__ void xcd_barrier_complete(unsigned* bar, unsigned x, unsigned& nloc, unsigned& nx) {
    const unsigned G = gridDim.x * gridDim.y * gridDim.z;
    unsigned sum, cnt, mine, sp = 0u;
    for (;;) {
        sum = 0u; cnt = 0u; mine = 0u;
#pragma unroll
        for (unsigned j = 0; j < 16; ++j) { const unsigned c = xb_ld(&bar[XB_XCNT(j)]); sum += c; cnt += (c > 0u) ? 1u : 0u; mine = (j == x) ? c : mine; }
        if (sum == G) break;
        __builtin_amdgcn_s_sleep(1);
        if ((++sp & 255u) == 0u) { if (xb_ld(&bar[XB_TMO])) break; if (sp > XB_SPIN_CAP) { atomicAdd(&bar[XB_TMO], 1u); break; } }
    }
    nloc = mine > 0u ? mine : 1u; nx = cnt > 0u ? cnt : 1u;
}
__device__ __forceinline__ void xcd_barrier(const XcdBarrier& b) {
    asm volatile("s_waitcnt vmcnt(0)" ::: "memory");
    __syncthreads();
    if (threadIdx.x == 0) {
        unsigned* bar = b.bar;
        __builtin_amdgcn_s_waitcnt(0);
        unsigned nloc = b.st[0], nx = b.st[1];
        if (nloc == 0u) { xcd_barrier_complete(bar, b.x, nloc, nx); b.st[0] = nloc; b.st[1] = nx; }
        const unsigned old = xb_add(&bar[XB_XSUB(b.x)], 1u);
        const unsigned gen = old / nloc;
        if (old + 1u == (gen + 1u) * nloc) {
            __builtin_amdgcn_fence(__ATOMIC_RELEASE, "agent");
            asm volatile("s_waitcnt vmcnt(0)" ::: "memory");
            const unsigned og = xb_add(&bar[XB_TOP], 1u);
            const unsigned tg = og / nx;
            if (og + 1u == (tg + 1u) * nx) xb_add(&bar[XB_TOPGEN], 1u);
            else XB_SPIN(xb_ld(&bar[XB_TOPGEN]) == tg, bar);
            __builtin_amdgcn_fence(__ATOMIC_ACQUIRE, "agent");
            xb_add(&bar[XB_XGEN(b.x)], 1u);
            asm volatile("s_waitcnt vmcnt(0)" ::: "memory");
        } else {
            XB_SPIN(xb_ld(&bar[XB_XGEN(b.x)]) == gen, bar);
            __builtin_amdgcn_fence(__ATOMIC_ACQUIRE, "agent");
            asm volatile("s_waitcnt vmcnt(0)" ::: "memory");
        }
    }
    __syncthreads();
}

constexpr int PH_PER_LAYER = 12, NPHASE = 2 * PH_PER_LAYER;
template <int K> __device__ __forceinline__ void run_phase(KP p, int l, LAS unsigned char* lds) {
    asm volatile("" : "+s"(lds));
    if constexpr (K == 0) ph_conv_mixer(p, l, lds);
    else if constexpr (K == 1) ph_inproj(p, l, lds);
    else if constexpr (K == 2) ph_prep(p, l, lds);
    else if constexpr (K == 21) ph_lora(p, l, lds);
    else if constexpr (K == 30) ph_scan(p, l, lds);
    else if constexpr (K == 31) ph_attn(p, l, lds);
    else if constexpr (K == 32) dsa_select(p, lds);
    else if constexpr (K == 4) ph_dsa_xb(p, l, lds);
    else if constexpr (K == 5) ph_merge(p, l, lds);
    else if constexpr (K == 6) ph_outproj(p, l, lds);
    else if constexpr (K == 7) ph_ln1(p, l, lds);
    else if constexpr (K == 8) ph_moe_assign(p, l, lds);
    else if constexpr (K == 9) ph_ffn_up(p, l, lds);
    else if constexpr (K == 10) ph_ffn_down(p, l, lds);
    else ln_rows(p, l, 1, lds);
}
template <int K> __global__ void __launch_bounds__(NTHREADS, 2) k_phase(Params, int l) {
    extern __shared__ __attribute__((aligned(16))) unsigned char lds_raw[];
    run_phase<K>(get_params(), l, (LAS unsigned char*)lds_raw);
}
#if FUSED
#define PH(K, L) do { run_phase<K>(get_params(), L, lds); __syncthreads(); } while (0)
#define SYNC() xcd_barrier(xbar)
__global__ void __launch_bounds__(NTHREADS, 2) k_fused(Params) {
    extern __shared__ __attribute__((aligned(16))) unsigned char lds_raw[];
    LAS unsigned char* lds = (LAS unsigned char*)lds_raw;
    cg::grid_group grid = cg::this_grid();
    volatile LAS unsigned* bst = (volatile LAS unsigned*)(lds + LDS_BYTES - 128);
    if (threadIdx.x < 2) bst[threadIdx.x] = 0u;
    __syncthreads();
    const XcdBarrier xbar = xcd_barrier_post((unsigned*)(get_params()->ws + WS_CTL) + 1024, bst);
    PH(0, 0); grid.sync();
    PH(1, 0); SYNC(); PH(2, 0); SYNC(); PH(21, 0); SYNC(); PH(30, 0); SYNC(); PH(31, 0); SYNC(); PH(32, 0); SYNC(); PH(4, 0); SYNC(); PH(5, 0); SYNC(); PH(6, 0); SYNC(); PH(7, 0); PH(0, 1); SYNC();
    PH(9, 0); SYNC(); PH(10, 0); SYNC(); PH(11, 0); SYNC();
    PH(1, 1); SYNC(); PH(2, 1); SYNC(); PH(21, 1); SYNC(); PH(30, 1); SYNC(); PH(31, 1); SYNC(); PH(32, 1); SYNC(); PH(4, 1); SYNC(); PH(5, 1); SYNC(); PH(6, 1); SYNC(); PH(7, 1); SYNC();
    PH(8, 1); SYNC(); PH(9, 1); SYNC(); PH(10, 1); SYNC(); PH(11, 1);
}
#undef PH
#undef SYNC
#endif
template <int K> static void launch_phase(const Params& p, int l, hipStream_t stream) {
    static bool attr = false;
    if (!attr) { (void)hipFuncSetAttribute((const void*)k_phase<K>, hipFuncAttributeMaxDynamicSharedMemorySize, LDS_BYTES); attr = true; }
    hipLaunchKernelGGL(k_phase<K>, dim3(256), dim3(NTHREADS), LDS_BYTES, stream, p, l);
}

extern "C" void kernel_launch(void* const* d_in, const int* in_sizes, int n_in, void* d_out, int out_size, void* d_ws, size_t ws_size, hipStream_t stream) {
    if (n_in != 28 || out_size != T * D || ws_size < WS_END) { fprintf(stderr, "kernel_launch: unexpected problem (n_in %d out %d ws %zu)\n", n_in, out_size, ws_size); return; }
    (void)hipMemsetAsync((char*)d_ws + WS_CTL, 0, 32768, stream);
    Params p{};
    for (int i = 0; i < 28; ++i) p.in[i] = (const float*)d_in[i];
    p.out = (float*)d_out; p.ws = (unsigned char*)d_ws;
#if FUSED
    static bool attr = false;
    if (!attr) { (void)hipFuncSetAttribute((const void*)k_fused, hipFuncAttributeMaxDynamicSharedMemorySize, LDS_BYTES); attr = true; }
    void* args[] = {&p};
    hipError_t e = hipLaunchCooperativeKernel((const void*)k_fused, dim3(256), dim3(NTHREADS), args, LDS_BYTES, stream);
    if (e != hipSuccess) fprintf(stderr, "cooperative launch failed: %s\n", hipGetErrorString(e));
    return;
#endif
    for (int l = 0; l < 2; ++l) {
        launch_phase<0>(p, l, stream); launch_phase<1>(p, l, stream); launch_phase<2>(p, l, stream); launch_phase<21>(p, l, stream);
        launch_phase<30>(p, l, stream); launch_phase<31>(p, l, stream); launch_phase<32>(p, l, stream);
        launch_phase<4>(p, l, stream); launch_phase<5>(p, l, stream); launch_phase<6>(p, l, stream); launch_phase<7>(p, l, stream);
        if (l & 1) launch_phase<8>(p, l, stream);
        launch_phase<9>(p, l, stream); launch_phase<10>(p, l, stream); launch_phase<11>(p, l, stream);
    }
}
```

```cpp
#include <hip/hip_runtime.h>
#include <hip/hip_cooperative_groups.h>
#include <cstdio>
#include <cstdint>
namespace cg = cooperative_groups;

#ifndef FUSED
#define FUSED 1
#endif

#define LAS __attribute__((address_space(3)))
typedef unsigned short bf16_t;
typedef short bf16x8 __attribute__((ext_vector_type(8)));
typedef float f32x4 __attribute__((ext_vector_type(4)));
typedef float f32x2 __attribute__((ext_vector_type(2)));
typedef unsigned u32x4 __attribute__((ext_vector_type(4)));
typedef unsigned u32x2 __attribute__((ext_vector_type(2)));

constexpr int T = 16384, D = 1024, SEQ = 2048, NB = 8;
constexpr int NPM = 3328;
constexpr int C_SWA_Q = 0, C_SWA_K = 512, C_SWA_V = 640, C_RW = 768;
constexpr int C_FOX_Q = 1792, C_FOX_K = 2048, C_FOX_V = 2304;
constexpr int C_DSA_Q = 2560, C_DSA_K = 2816, C_DSA_V = 2880, C_DSA_KI = 2944, C_FLOG = 3008, C_WIDX = 3012, C_DSA_QI = 3072;
constexpr int D_IN = 7368, NWIN = 7424;
constexpr int OC = 1280;
constexpr int DFF = 2816, DFE = 1408, NE = 8;
constexpr int MAXROWS = 34816;
constexpr float DN_ALPHA = 1.41421356237f;
constexpr float LN_EPS = 1e-5f;

constexpr size_t MiB = 1u << 20;
constexpr size_t WS_CTL = 0;
constexpr size_t WS_WIN = 1 * MiB, WS_WB = 16 * MiB, WS_WO = 19 * MiB;
constexpr size_t WS_THR = 21 * MiB + 256 * 1024  , WS_ROWOF = 21 * MiB  , WS_FOXC = 21 * MiB, WS_TOKE = 21 * MiB + 256 * 1024, WS_TOKW = 21 * MiB + 384 * 1024, WS_ROWTOK = 21 * MiB + 512 * 1024,
                 WS_ROWW = 21 * MiB + 768 * 1024, WS_WGCNT = 21 * MiB + 920 * 1024;
constexpr size_t WS_OCAT = 22 * MiB, WS_X1B = 22 * MiB;
constexpr size_t WS_PMIX = 62 * MiB, WS_MERGED = 62 * MiB, WS_MACC = 94 * MiB;
constexpr size_t WS_WF13 = 62 * MiB, WS_WF2_DENSE = 73 * MiB, WS_WF2_MOE = 106 * MiB, WS_H = 128 * MiB;
constexpr size_t WS_RW = 166 * MiB, WS_XB = 22 * MiB  , WS_SCORES = 166 * MiB, WS_XB2 = 246 * MiB, WS_GSC = 158 * MiB, WS_AG = 222 * MiB;
constexpr size_t WS_BONUS = 278 * MiB, WS_Y = 279 * MiB, WS_LORA_A = 279 * MiB  ;
constexpr size_t WS_WLORA = 15 * MiB + 512 * 1024;
constexpr size_t WS_MASKB = 295 * MiB;
constexpr size_t WS_END = 299 * MiB;
constexpr size_t RWSZ = 16 * MiB;

constexpr int LDS_BYTES = 155648;
constexpr int NTHREADS = 512;

struct Params { const float* in[28]; float* out; unsigned char* ws; };
typedef const __attribute__((address_space(4))) Params* KP;
__device__ __forceinline__ KP get_params() { KP k = (KP)__builtin_amdgcn_kernarg_segment_ptr(); asm volatile("" : "+s"(k)); return k; }
enum { I_X = 0, I_WIN, I_SINKS, I_MU, I_W0, I_WUP, I_A0, I_AUP, I_GUP, I_KK, I_KA, I_RK, I_GNG, I_GNB, I_FB, I_GB, I_WBR, I_WOUT, I_LNG, I_LNB,
       I_F1, I_F3, I_F2, I_RTW, I_RTB, I_E1, I_E3, I_E2 };

__device__ __forceinline__ float bflo(unsigned u) { return __uint_as_float(u << 16); }
__device__ __forceinline__ float bfhi(unsigned u) { return __uint_as_float(u & 0xffff0000u); }
__device__ __forceinline__ float bf2f(bf16_t b) { return __uint_as_float((unsigned)b << 16); }
__device__ __forceinline__ unsigned f2bf(float f) { unsigned u = __float_as_uint(f); return (u + 0x7fffu + ((u >> 16) & 1u)) >> 16; }
__device__ __forceinline__ unsigned pk2(float lo, float hi) { unsigned r; asm("v_cvt_pk_bf16_f32 %0, %1, %2" : "=v"(r) : "v"(lo), "v"(hi)); return r; }
__device__ __forceinline__ float wave_sum(float v) {
#pragma unroll
    for (int o = 1; o < 64; o <<= 1) v += __shfl_xor(v, o);
    return v;
}
__device__ __forceinline__ float wave_max(float v) {
#pragma unroll
    for (int o = 1; o < 64; o <<= 1) v = fmaxf(v, __shfl_xor(v, o));
    return v;
}
__device__ __forceinline__ float sigm(float x) { return 1.f / (1.f + __expf(-x)); }
#define LDS_FENCE() asm volatile("s_waitcnt lgkmcnt(0)" ::: "memory")
__device__ __forceinline__ int my_tid() { int t = threadIdx.x; asm volatile("" : "+v"(t)); return t; }
__device__ __forceinline__ void unpack8(const u32x4 v, float* f) {
    f[0] = bflo(v.x); f[1] = bfhi(v.x); f[2] = bflo(v.y); f[3] = bfhi(v.y); f[4] = bflo(v.z); f[5] = bfhi(v.z); f[6] = bflo(v.w); f[7] = bfhi(v.w);
}

namespace mg {
constexpr int BM = 256, BK = 64, HALF = 128, HTB = HALF * BK * 2, STAGE_BYTES = 8 * HTB;
__device__ __forceinline__ int lds_byte(int r, int c) { const int st = (r >> 4) * 2 + (c >> 5), rr = r & 15, cc = c & 31, ob = rr * 64 + cc * 2; return st * 1024 + (ob ^ (((ob >> 9) & 1) << 5)); }
__device__ __forceinline__ void stage_rc(int b, int& R, int& C) { const int st = b / 1024, sb = b % 1024, swz = sb ^ (((sb >> 9) & 1) << 5); R = (st >> 1) * 16 + swz / 64; C = (st & 1) * 32 + (swz % 64) / 2; }
__device__ __forceinline__ int perm32(int rho) { const int n = rho >> 4, i = rho & 15; return 8 * (i >> 2) + 4 * n + (i & 3); }

struct Unit { const char* A; const char* B; unsigned ld; int nt; int pm, pn, tag; };

__device__ __forceinline__ bool static_tile(int i, int G, int c, int nM, int nN, int& pm, int& pn) {
    const int nwg = nM * nN; const long L = (long)i * G + c; if (L >= nwg) return false;
    int wgid = (int)L; { const int q = nwg / 8, r = nwg % 8, xcd = wgid % 8, off = wgid / 8; wgid = (xcd < r ? xcd * (q + 1) : r * (q + 1) + (xcd - r) * q) + off; }
    const int nig = 8 * nN, gid = wgid / nig, fm = gid * 8, gsz = (nM - fm) < 8 ? (nM - fm) : 8;
    pm = fm + ((wgid % nig) % gsz); pn = (wgid % nig) / gsz; return true;
}

template <class Sched, class Epi>
__device__ __forceinline__ void gemm_run(LAS unsigned char* lds, const Sched& S, const Epi& E) {
    const int tid = my_tid(), wid = __builtin_amdgcn_readfirstlane(tid >> 6), lane = tid & 63, wr = wid >> 2, wc = wid & 3, fr = lane & 15, fq = lane >> 4;
    int R0, C0; stage_rc(tid * 16, R0, C0); const unsigned RA = (unsigned)R0, RB = (unsigned)(Sched::PERM ? ((R0 & ~31) + perm32(R0 & 31)) : R0), C02 = (unsigned)C0 * 2u;
    const unsigned ldsw = (unsigned)wid * 1024u;
    const int aoff = lds_byte(wr * 64 + fr, fq * 8), boff = lds_byte(wc * 32 + fr, fq * 8);
#define MG_SA(b, h) (((b) * 2 + (h)) * HTB)
#define MG_SB(b, h) ((4 + (b) * 2 + (h)) * HTB)
#define MG_STAGE(bufoff, gptr, v0, s64) do { \
        __builtin_amdgcn_global_load_lds((const unsigned*)((gptr) + (v0)), (LAS unsigned*)(lds + (bufoff) + ldsw), 16, 0, 0); \
        __builtin_amdgcn_global_load_lds((const unsigned*)((gptr) + (s64) + (v0)), (LAS unsigned*)(lds + (bufoff) + ldsw + 8192), 16, 0, 0); } while (0)
#define MG_LDA(dst, b, h) do { _Pragma("unroll") for (int m = 0; m < 4; ++m) _Pragma("unroll") for (int k = 0; k < 2; ++k) dst[m][k] = *(const LAS bf16x8*)(lds + MG_SA(b, h) + aoff + m * 2048 + k * 1024); } while (0)
#define MG_LDB(dst, b, h) do { _Pragma("unroll") for (int n = 0; n < 2; ++n) _Pragma("unroll") for (int k = 0; k < 2; ++k) dst[n][k] = *(const LAS bf16x8*)(lds + MG_SB(b, h) + boff + n * 2048 + k * 1024); } while (0)
#define MG_MMA(ai, bj, At, Bt) do { __builtin_amdgcn_s_setprio(1); _Pragma("unroll") for (int m = 0; m < 4; ++m) _Pragma("unroll") for (int n = 0; n < 2; ++n) _Pragma("unroll") for (int k = 0; k < 2; ++k) \
        acc[ai][bj][m][n] = __builtin_amdgcn_mfma_f32_16x16x32_bf16(Bt[n][k], At[m][k], acc[ai][bj][m][n], 0, 0, 0); __builtin_amdgcn_s_setprio(0); } while (0)
#define MG_WAIT_V(n) asm volatile("s_waitcnt vmcnt(" #n ")" ::: "memory")
#define MG_WAIT_L(n) asm volatile("s_waitcnt lgkmcnt(" #n ")" ::: "memory")
#define MG_BAR __builtin_amdgcn_s_barrier()
#define MG_SCHED __builtin_amdgcn_sched_barrier(0)
    Unit cur; int ui = 0;
    if (!S.next(0, cur)) return;
    f32x4 acc[2][2][4][2];
#pragma unroll
    for (int a = 0; a < 2; ++a)
#pragma unroll
        for (int b = 0; b < 2; ++b)
#pragma unroll
            for (int m = 0; m < 4; ++m)
#pragma unroll
                for (int n = 0; n < 2; ++n) acc[a][b][m][n] = (f32x4){0.f, 0.f, 0.f, 0.f};
    bf16x8 At[4][2], B0[2][2], B1[2][2];
    const size_t kstep = (size_t)(BK * 2);
    {
        const char* cA = cur.A; const char* cB = cur.B; const unsigned ld = cur.ld, vA = RA * ld + C02, vB = RB * ld + C02, s64 = 64u * ld, sh = 128u * ld;
        MG_STAGE(MG_SB(0, 0), cB, vB, s64); MG_STAGE(MG_SB(0, 1), cB + sh, vB, s64); MG_STAGE(MG_SA(0, 0), cA, vA, s64); MG_STAGE(MG_SA(0, 1), cA + sh, vA, s64);
        if (wr == 1) MG_BAR;
        MG_WAIT_V(2); MG_BAR;
        MG_STAGE(MG_SB(1, 0), cB + kstep, vB, s64); MG_STAGE(MG_SA(1, 0), cA + kstep, vA, s64); MG_STAGE(MG_SB(1, 1), cB + sh + kstep, vB, s64);
        MG_WAIT_V(6); MG_BAR;
    }
    for (;;) {
        const char* cA = cur.A; const char* cB = cur.B; const unsigned cld = cur.ld; const int nt = cur.nt;
        for (int t = 0; t < nt; t += 2) {
            const bool last = (t == nt - 2);
            const char* a1 = cA + (size_t)(t + 1) * kstep;
            const char* a2 = cA + (size_t)(t + 2) * kstep; const char* b2 = cB + (size_t)(t + 2) * kstep; unsigned xld = cld;
            if (last) { Unit n2; if (S.next(ui + 1, n2)) { a2 = n2.A; b2 = n2.B; xld = n2.ld; } else { a2 = cA; b2 = cB; } }
            const char* a3 = a2 + kstep; const char* b3 = b2 + kstep;
            const unsigned cvA = RA * cld + C02, c64 = 64u * cld, ch = 128u * cld;
            const unsigned xvA = RA * xld + C02, xvB = RB * xld + C02, x64 = 64u * xld, xh = 128u * xld;
            MG_LDB(B0, 0, 0); MG_LDB(B1, 0, 1); MG_SCHED; MG_LDA(At, 0, 0); MG_STAGE(MG_SA(1, 1), a1 + ch, cvA, c64);
            MG_WAIT_V(8); MG_WAIT_L(0); MG_BAR; MG_MMA(0, 0, At, B0); MG_MMA(0, 1, At, B1); MG_BAR; MG_SCHED;
            MG_LDA(At, 0, 1); MG_STAGE(MG_SB(0, 0), b2, xvB, x64); MG_STAGE(MG_SB(0, 1), b2 + xh, xvB, x64); MG_STAGE(MG_SA(0, 0), a2, xvA, x64);
            MG_WAIT_V(8); MG_WAIT_L(0); MG_BAR; MG_MMA(1, 0, At, B0); MG_MMA(1, 1, At, B1); MG_BAR; MG_SCHED;
            MG_LDB(B0, 1, 0); MG_LDB(B1, 1, 1); MG_SCHED; MG_LDA(At, 1, 0); MG_STAGE(MG_SA(0, 1), a2 + xh, xvA, x64);
            MG_WAIT_V(8); MG_WAIT_L(0); MG_BAR; MG_MMA(0, 0, At, B0); MG_MMA(0, 1, At, B1); MG_BAR; MG_SCHED;
            MG_LDA(At, 1, 1); MG_STAGE(MG_SB(1, 0), b3, xvB, x64); MG_STAGE(MG_SB(1, 1), b3 + xh, xvB, x64); MG_STAGE(MG_SA(1, 0), a3, xvA, x64);
            MG_WAIT_V(8); MG_WAIT_L(0); MG_BAR; MG_MMA(1, 0, At, B0); MG_MMA(1, 1, At, B1); MG_BAR; MG_SCHED;
        }
        if (wr == 0) MG_BAR;
        { int e_fr = fr, e_fq = fq, e_tid = tid; asm volatile("" : "+v"(e_fr), "+v"(e_fq), "+v"(e_tid));
          E(acc, cur, wr, wc, e_fr, e_fq, e_tid); }
        Unit nxt;
        if (!S.next(ui + 1, nxt)) break;
#pragma unroll
        for (int a = 0; a < 2; ++a)
#pragma unroll
            for (int b = 0; b < 2; ++b)
#pragma unroll
                for (int m = 0; m < 4; ++m)
#pragma unroll
                    for (int n = 0; n < 2; ++n) acc[a][b][m][n] = (f32x4){0.f, 0.f, 0.f, 0.f};
        cur = nxt; ++ui;
        if (wr == 1) MG_BAR;
    }
    MG_WAIT_V(0);
    MG_BAR;
#undef MG_SA
#undef MG_SB
#undef MG_STAGE
#undef MG_LDA
#undef MG_LDB
#undef MG_MMA
#undef MG_WAIT_V
#undef MG_WAIT_L
#undef MG_BAR
#undef MG_SCHED
}
}

typedef f32x4 AccT[2][2][4][2];

__device__ __forceinline__ int rowmap(int mode, int n) {
    if (mode == 0) return n;
    if (mode == 1) { if (n < 2560) return n; if (n < 2564) return C_FLOG + (n - 2560); if (n < 2948) return n - 4; if (n < 3204) return C_DSA_QI + (n - 2948); if (n < 3268) return C_DSA_KI + (n - 3204); if (n < 3272) return C_WIDX + (n - 3268); return n + 56; }
    if (mode == 2) return 256 * (n >> 7) + (n & 127);
    return 256 * (n >> 7) + 128 + (n & 127);
}
__device__ __forceinline__ void tr_item(const float* __restrict__ W, int K, int N, bf16_t* WT, int ldt, int mode, int row_off, LAS float* scr, int item, int lane) {
    const int nblk = (N + 31) / 32, kb = item / nblk, nb = item % nblk, k0 = 64 * kb, n0 = 32 * nb;
    const int nl = lane & 31, n = n0 + nl;
    float tv[32];
    const int nc = (n < N) ? n : N - 1;
#pragma unroll
    for (int i = 0; i < 32; ++i) { const int kk = 2 * i + (lane >> 5); tv[i] = W[(size_t)(k0 + kk) * N + nc]; }
#pragma unroll
    for (int i = 0; i < 32; ++i) { const int kk = 2 * i + (lane >> 5); scr[kk * 33 + nl] = (n < N) ? tv[i] : 0.f; }
    LDS_FENCE();
    const int c = lane & 7;
#pragma unroll
    for (int j = 0; j < 4; ++j) { const int n2l = (lane >> 3) + 8 * j, n2 = n0 + n2l; const LAS float* s = scr + (8 * c) * 33 + n2l;
        u32x4 o; o.x = pk2(s[0 * 33], s[1 * 33]); o.y = pk2(s[2 * 33], s[3 * 33]); o.z = pk2(s[4 * 33], s[5 * 33]); o.w = pk2(s[6 * 33], s[7 * 33]);
        if (n2 < N) *(u32x4*)(WT + (size_t)(row_off + rowmap(mode, n2)) * ldt + k0 + 8 * c) = o; }
    LDS_FENCE();
}
__device__ __forceinline__ int tr_nitems(int K, int N) { return (K / 64) * ((N + 31) / 32); }

__device__ __forceinline__ void row_to_bf16(const float* xrow, bf16_t* orow, int lane) {
    const f32x4* xr = (const f32x4*)xrow + lane; unsigned long long* o8 = (unsigned long long*)orow + lane;
#pragma unroll
    for (int j = 0; j < 4; ++j) { const f32x4 v = xr[64 * j]; o8[64 * j] = (unsigned long long)pk2(v.x, v.y) | ((unsigned long long)pk2(v.z, v.w) << 32); }
}

__device__ __forceinline__ void ph_conv_mixer(KP p, int l, LAS unsigned char* lds) {
    const int tid_ = my_tid(); const int lane = tid_ & 63, wave = tid_ >> 6, gw = blockIdx.x * 8 + wave, NGW = gridDim.x * 8;
    LAS float* scr = (LAS float*)(lds + wave * 8448);
    const float* win = p->in[I_WIN] + (size_t)l * D * D_IN; const float* wbr = p->in[I_WBR] + (size_t)l * OC * D; const float* wo = p->in[I_WOUT] + (size_t)l * D * D;
    bf16_t* WIN = (bf16_t*)(p->ws + WS_WIN); bf16_t* WB = (bf16_t*)(p->ws + WS_WB); bf16_t* WO = (bf16_t*)(p->ws + WS_WO);
    const int n1 = tr_nitems(D, D_IN), n2 = tr_nitems(OC, D), n3 = tr_nitems(D, D);
    for (int it = gw; it < n1 + n2 + n3; it += NGW) {
        int r = it;
        if (r < n1) { tr_item(win, D, D_IN, WIN, D, 1, 0, scr, r, lane); continue; } r -= n1;
        if (r < n2) { tr_item(wbr, OC, D, WB, OC, 0, 0, scr, r, lane); continue; } r -= n2;
        tr_item(wo, D, D, WO, D, 0, 0, scr, r, lane);
    }
    {
        bf16_t* WL = (bf16_t*)(p->ws + WS_WLORA);
        const float* wup = p->in[I_WUP] + (size_t)l * 64 * 256; const float* aup = p->in[I_AUP] + (size_t)l * 64 * 256; const float* gup = p->in[I_GUP] + (size_t)l * 128 * 256;
        const int m1 = tr_nitems(64, 256), m2 = tr_nitems(128, 256);
        for (int it = gw; it < 2 * m1 + m2; it += NGW) { int r = it;
            if (r < m1) { tr_item(wup, 64, 256, WL, 256, 0, 0, scr, r, lane); continue; } r -= m1;
            if (r < m1) { tr_item(aup, 64, 256, WL + 64, 256, 0, 256, scr, r, lane); continue; } r -= m1;
            tr_item(gup, 128, 256, WL + 128, 256, 0, 512, scr, r, lane); }
        for (int ch = gw * 64 + lane; ch < 768 * 32; ch += NGW * 64) { const int row = ch >> 5, k8 = (ch & 31) * 8, blk = row >> 8;
            const bool used = (blk == 0) ? (k8 < 64) : ((blk == 1) ? (k8 >= 64 && k8 < 128) : (k8 >= 128));
            if (!used) *(u32x4*)(WL + (size_t)row * 256 + k8) = (u32x4){0u, 0u, 0u, 0u}; }
    }
    if (l == 0) { bf16_t* XB = (bf16_t*)(p->ws + WS_XB); for (int m = gw; m < T; m += NGW) row_to_bf16(p->in[I_X] + (size_t)m * D, XB + (size_t)m * D, lane); }
}

struct SchedInproj {
    static constexpr int PERM = 1;
    const char* A; const char* B; int G, c;
    __device__ __forceinline__ bool next(int i, mg::Unit& u) const {
        int pm, pn; if (!mg::static_tile(i, G, c, T / 256, NPM / 256 - 1, pm, pn)) return false;
        u.A = A + (size_t)pm * 256 * 2048; u.B = B + (size_t)pn * 256 * 2048; u.ld = 2048; u.nt = 16; u.pm = pm; u.pn = pn; u.tag = 0; return true;
    }
};
template <int PERM_, int NN, int K> struct SchedPlain {
    static constexpr int PERM = PERM_;
    const char* A; const char* B; int G, c;
    __device__ __forceinline__ bool next(int i, mg::Unit& u) const {
        int pm, pn; if (!mg::static_tile(i, G, c, T / 256, NN, pm, pn)) return false;
        u.A = A + (size_t)pm * 256 * K * 2; u.B = B + (size_t)pn * 256 * K * 2; u.ld = K * 2; u.nt = K / 64; u.pm = pm; u.pn = pn; u.tag = 0; return true;
    }
};
struct EpiBf16Store {
    bf16_t* O; int ldo;
    __device__ __forceinline__ void operator()(const AccT& acc, const mg::Unit& u, int wr, int wc, int fr, int fq, int) const {
        const int row0 = u.pm * 256 + wr * 64 + fr, col0 = u.pn * 256 + wc * 32 + 8 * fq;
#pragma unroll
        for (int ai = 0; ai < 2; ++ai)
#pragma unroll
            for (int m = 0; m < 4; ++m) { bf16_t* rowp = O + (size_t)(row0 + ai * 128 + m * 16) * ldo + col0;
#pragma unroll
                for (int bj = 0; bj < 2; ++bj) { const f32x4 v0 = acc[ai][bj][m][0], v1 = acc[ai][bj][m][1];
                    u32x4 w; w.x = pk2(v0[0], v0[1]); w.y = pk2(v0[2], v0[3]); w.z = pk2(v1[0], v1[1]); w.w = pk2(v1[2], v1[3]);
                    *(u32x4*)(rowp + bj * 128) = w; } }
    }
};
__device__ __forceinline__ void ph_inproj(KP p, int l, LAS unsigned char* lds) {
    SchedInproj S{(const char*)(p->ws + WS_XB), (const char*)(p->ws + WS_WIN), (int)gridDim.x, (int)blockIdx.x};
    EpiBf16Store E{(bf16_t*)(p->ws + WS_PMIX), NPM};
    mg::gemm_run(lds, S, E);
}

__device__ __forceinline__ void ph_prep(KP p, int l, LAS unsigned char* lds) {
    const int tid = my_tid(), lane = tid & 63, wave = tid >> 6;
    const bf16_t* P = (const bf16_t*)(p->ws + WS_PMIX);
    if (blockIdx.x < 8 && wave < 4) {
        const int b = blockIdx.x, h = wave; const float fb = p->in[I_FB][l * 4 + h];
        float v[32]; float s = 0.f;
#pragma unroll
        for (int i = 0; i < 32; ++i) { const int t = 32 * lane + i; const float x = bf2f(P[(size_t)(b * SEQ + t) * NPM + C_FLOG + h]) + fb;
            const float ls = fminf(x, 0.f) - log1pf(__expf(-fabsf(x))); s += ls; v[i] = s; }
        float incl = s;
#pragma unroll
        for (int o = 1; o < 64; o <<= 1) { const float n = __shfl_up(incl, o); if (lane >= o) incl += n; }
        const float excl = incl - s; float* C = (float*)(p->ws + WS_FOXC) + (size_t)(b * 4 + h) * SEQ + 32 * lane;
#pragma unroll
        for (int i = 0; i < 32; ++i) C[i] = v[i] + excl;
    }
    const float* mu = p->in[I_MU] + l * 1024; const float* kkw = p->in[I_KK] + l * 256;
    float* RWr = (float*)(p->ws + WS_RW); float* RWk = RWr + (size_t)2 * T * 256; float* RWkk = RWr + (size_t)3 * T * 256; float* RWv = RWr + (size_t)5 * T * 256;
    bf16_t* LA = (bf16_t*)(p->ws + WS_LORA_A);
    const int gw = blockIdx.x * 8 + wave, NGW = gridDim.x * 8;
    float m0[8], m1[8], kkc[8];
    { const f32x4 a = *(const f32x4*)(mu + 8 * lane), b = *(const f32x4*)(mu + 8 * lane + 4), c = *(const f32x4*)(mu + 512 + 8 * lane), d = *(const f32x4*)(mu + 512 + 8 * lane + 4);
      m0[0] = a.x; m0[1] = a.y; m0[2] = a.z; m0[3] = a.w; m0[4] = b.x; m0[5] = b.y; m0[6] = b.z; m0[7] = b.w; m1[0] = c.x; m1[1] = c.y; m1[2] = c.z; m1[3] = c.w; m1[4] = d.x; m1[5] = d.y; m1[6] = d.z; m1[7] = d.w;
      const f32x4 e = *(const f32x4*)(kkw + 8 * (lane & 31)), f = *(const f32x4*)(kkw + 8 * (lane & 31) + 4); kkc[0] = e.x; kkc[1] = e.y; kkc[2] = e.z; kkc[3] = e.w; kkc[4] = f.x; kkc[5] = f.y; kkc[6] = f.z; kkc[7] = f.w; }
#pragma unroll 2
    for (int t = gw; t < T; t += NGW) {
        const bf16_t* pr = P + (size_t)t * NPM + C_RW; const bool first = (t & (SEQ - 1)) == 0; const bf16_t* pp = first ? pr : pr - NPM;
        float x0[8], x1[8], y0[8], y1[8];
        unpack8(*(const u32x4*)(pr + 8 * lane), x0); unpack8(*(const u32x4*)(pr + 512 + 8 * lane), x1);
        unpack8(*(const u32x4*)(pp + 8 * lane), y0); unpack8(*(const u32x4*)(pp + 512 + 8 * lane), y1);
#pragma unroll
        for (int j = 0; j < 8; ++j) { const float q0 = first ? 0.f : y0[j], q1 = first ? 0.f : y1[j]; x0[j] += m0[j] * (q0 - x0[j]); x1[j] += m1[j] * (q1 - x1[j]); }
        const size_t o = (size_t)t * 256 + 8 * (lane & 31);
        if (lane < 32) {
            *(f32x4*)(RWr + o) = (f32x4){x0[0], x0[1], x0[2], x0[3]}; *(f32x4*)(RWr + o + 4) = (f32x4){x0[4], x0[5], x0[6], x0[7]};
            *(f32x4*)(RWv + o) = (f32x4){x1[0], x1[1], x1[2], x1[3]}; *(f32x4*)(RWv + o + 4) = (f32x4){x1[4], x1[5], x1[6], x1[7]};
        }
        float kk[8], ss = 0.f;
#pragma unroll
        for (int j = 0; j < 8; ++j) { kk[j] = x0[j] * kkc[j]; ss += kk[j] * kk[j]; }
        ss += __shfl_xor(ss, 1); ss += __shfl_xor(ss, 2); ss += __shfl_xor(ss, 4);
        const float rn = rsqrtf(ss + 1e-12f);
        if (lane >= 32) {
            *(f32x4*)(RWk + o) = (f32x4){x0[0], x0[1], x0[2], x0[3]}; *(f32x4*)(RWk + o + 4) = (f32x4){x0[4], x0[5], x0[6], x0[7]};
            *(f32x4*)(RWkk + o) = (f32x4){kk[0] * rn, kk[1] * rn, kk[2] * rn, kk[3] * rn}; *(f32x4*)(RWkk + o + 4) = (f32x4){kk[4] * rn, kk[5] * rn, kk[6] * rn, kk[7] * rn};
            float a[8];
#pragma unroll
            for (int j = 0; j < 8; ++j) a[j] = (lane < 40) ? tanhf(x1[j]) : ((lane < 48) ? x1[j] : sigm(x1[j]));
            u32x4 w; w.x = pk2(a[0], a[1]); w.y = pk2(a[2], a[3]); w.z = pk2(a[4], a[5]); w.w = pk2(a[6], a[7]);
            *(u32x4*)(LA + (size_t)t * 256 + 8 * (lane - 32)) = w;
        }
    }
}
struct SchedLoraPlus {
    static constexpr int PERM = 1; static constexpr bool DUAL = false;
    const char* LA; const char* WL; const char* XB; const char* WIN; int c;
    __device__ __forceinline__ bool next(int i, mg::Unit& u) const {
        if (i > 0) return false;
        if (c < 192) { int pm, pn; mg::static_tile(0, 256, c, T / 256, 3, pm, pn); u.A = LA + (size_t)pm * 256 * 512; u.B = WL + (size_t)pn * 256 * 512; u.ld = 512; u.nt = 4; u.pm = pm; u.pn = pn; u.tag = 0; }
        else { const int pm = c - 192; u.A = XB + (size_t)pm * 256 * 2048; u.B = WIN + (size_t)12 * 256 * 2048; u.ld = 2048; u.nt = 16; u.pm = pm; u.pn = 12; u.tag = 1; }
        return true;
    }
};
struct EpiLora {
    const float* w0; const float* a0; const float* ka; float* RW; bf16_t* PM;
    __device__ __forceinline__ void operator()(const AccT& acc, const mg::Unit& u, int wr, int wc, int fr, int fq, int) const {
        const int row0 = u.pm * 256 + wr * 64 + fr, col0 = wc * 32 + 8 * fq;
        if (u.tag == 1) {
#pragma unroll
            for (int ai = 0; ai < 2; ++ai)
#pragma unroll
                for (int m = 0; m < 4; ++m) { bf16_t* rowp = PM + (size_t)(row0 + ai * 128 + m * 16) * NPM + u.pn * 256 + col0;
#pragma unroll
                    for (int bj = 0; bj < 2; ++bj) { const f32x4 v0 = acc[ai][bj][m][0], v1 = acc[ai][bj][m][1];
                        u32x4 w; w.x = pk2(v0[0], v0[1]); w.y = pk2(v0[2], v0[3]); w.z = pk2(v1[0], v1[1]); w.w = pk2(v1[2], v1[3]);
                        *(u32x4*)(rowp + bj * 128) = w; } }
            return;
        }
        float* RWw = RW + (size_t)1 * T * 256; float* RWk = RW + (size_t)2 * T * 256; float* RWkk = RW + (size_t)3 * T * 256; float* RWkka = RW + (size_t)4 * T * 256; float* RWg = RW + (size_t)6 * T * 256;
#pragma unroll
        for (int bj = 0; bj < 2; ++bj)
#pragma unroll
            for (int n = 0; n < 2; ++n) { const int c = col0 + bj * 128 + 4 * n;
                f32x4 c0 = (f32x4){0.f, 0.f, 0.f, 0.f}, c1 = c0;
                if (u.pn == 0) c0 = *(const f32x4*)(w0 + c); else if (u.pn == 1) { c0 = *(const f32x4*)(a0 + c); c1 = *(const f32x4*)(ka + c); }
#pragma unroll
                for (int ai = 0; ai < 2; ++ai)
#pragma unroll
                    for (int m = 0; m < 4; ++m) { const size_t o = (size_t)(row0 + ai * 128 + m * 16) * 256 + c; const f32x4 x = acc[ai][bj][m][n];
                        if (u.pn == 0) { f32x4 w;
#pragma unroll
                            for (int j = 0; j < 4; ++j) w[j] = __expf(-sigm(c0[j] + x[j]) * 0.60653065971f);
                            *(f32x4*)(RWw + o) = w; }
                        else if (u.pn == 1) { const f32x4 k = *(const f32x4*)(RWk + o), kk = *(const f32x4*)(RWkk + o); f32x4 k2, kka;
#pragma unroll
                            for (int j = 0; j < 4; ++j) { const float a = sigm(c0[j] + x[j]); k2[j] = k[j] * (1.f + (a - 1.f) * c1[j]); kka[j] = kk[j] * a; }
                            *(f32x4*)(RWk + o) = k2; *(f32x4*)(RWkka + o) = kka; }
                        else *(f32x4*)(RWg + o) = x;
                        asm volatile("" ::: "memory"); } }
    }
};
__device__ __forceinline__ void ph_lora(KP p, int l, LAS unsigned char* lds) {
    SchedLoraPlus S{(const char*)(p->ws + WS_LORA_A), (const char*)(p->ws + WS_WLORA), (const char*)(p->ws + WS_XB), (const char*)(p->ws + WS_WIN), (int)blockIdx.x};
    EpiLora E{p->in[I_W0] + l * 256, p->in[I_A0] + l * 256, p->in[I_KA] + l * 256, (float*)(p->ws + WS_RW), (bf16_t*)(p->ws + WS_PMIX)};
    mg::gemm_run(lds, S, E);
}

template <int CTRL, int ROWM, int BANKM> __device__ __forceinline__ float dpp_add(float acc, float src) {
    return acc + __int_as_float(__builtin_amdgcn_update_dpp(0, __float_as_int(src), CTRL, ROWM, BANKM, true));
}
__device__ __forceinline__ float wave_sum_s(float v) {
    float a = v;
    a = dpp_add<0x111, 0xf, 0xf>(a, v); a = dpp_add<0x112, 0xf, 0xf>(a, v); a = dpp_add<0x113, 0xf, 0xf>(a, v);
    a = dpp_add<0x114, 0xf, 0xe>(a, a); a = dpp_add<0x118, 0xf, 0xc>(a, a);
    a = dpp_add<0x142, 0xa, 0xf>(a, a); a = dpp_add<0x143, 0xc, 0xf>(a, a);
    return __int_as_float(__builtin_amdgcn_readlane(__float_as_int(a), 63));
}
typedef float f32x16 __attribute__((ext_vector_type(16)));
constexpr int KT_PITCH = 144, VT_PITCH = 136;
constexpr int AT_K_BYTES = 64 * KT_PITCH, AT_V_BYTES = 64 * VT_PITCH, AT_TILE_BYTES = AT_K_BYTES + AT_V_BYTES + 256;
constexpr float LOG2E = 1.4426950408889634f;
constexpr float NEGBIG = -1e30f;
__device__ __forceinline__ int crow(int reg, int h) { return (reg & 3) + 8 * (reg >> 2) + 4 * h; }
__device__ __forceinline__ unsigned fkey(float f) { const unsigned u = __float_as_uint(f); return (u & 0x80000000u) ? ~u : (u | 0x80000000u); }

__device__ __forceinline__ void at_stage(LAS unsigned char* tile, const bf16_t* Krows, const bf16_t* Vrows, int tid) {
    { const int row = tid >> 3, ch = tid & 7; const u32x4 v = *(const u32x4*)(Krows + (size_t)row * NPM + 8 * ch); *(LAS u32x4*)(tile + row * KT_PITCH + ch * 16) = v; }
    { const int kv = tid & 63, dch = tid >> 6; const u32x4 v = *(const u32x4*)(Vrows + (size_t)kv * NPM + 8 * dch);
      LAS bf16_t* vt = (LAS bf16_t*)(tile + AT_K_BYTES + (8 * dch) * VT_PITCH) + kv; constexpr int P2 = VT_PITCH / 2;
      vt[0 * P2] = (bf16_t)(v.x & 0xffffu); vt[1 * P2] = (bf16_t)(v.x >> 16); vt[2 * P2] = (bf16_t)(v.y & 0xffffu); vt[3 * P2] = (bf16_t)(v.y >> 16);
      vt[4 * P2] = (bf16_t)(v.z & 0xffffu); vt[5 * P2] = (bf16_t)(v.z >> 16); vt[6 * P2] = (bf16_t)(v.w & 0xffffu); vt[7 * P2] = (bf16_t)(v.w >> 16); }
}
struct AtRegs { u32x4 k, v; };
__device__ __forceinline__ AtRegs at_gload(const bf16_t* Krows, const bf16_t* Vrows, int tid) {
    AtRegs a; a.k = *(const u32x4*)(Krows + (size_t)(tid >> 3) * NPM + 8 * (tid & 7)); a.v = *(const u32x4*)(Vrows + (size_t)(tid & 63) * NPM + 8 * (tid >> 6)); return a;
}
__device__ __forceinline__ void at_sstore(LAS unsigned char* tile, const AtRegs& a, int tid) {
    *(LAS u32x4*)(tile + (tid >> 3) * KT_PITCH + (tid & 7) * 16) = a.k;
    const u32x4 v = a.v; LAS bf16_t* vt = (LAS bf16_t*)(tile + AT_K_BYTES + (8 * (tid >> 6)) * VT_PITCH) + (tid & 63); constexpr int P2 = VT_PITCH / 2;
    vt[0 * P2] = (bf16_t)(v.x & 0xffffu); vt[1 * P2] = (bf16_t)(v.x >> 16); vt[2 * P2] = (bf16_t)(v.y & 0xffffu); vt[3 * P2] = (bf16_t)(v.y >> 16);
    vt[4 * P2] = (bf16_t)(v.z & 0xffffu); vt[5 * P2] = (bf16_t)(v.z >> 16); vt[6 * P2] = (bf16_t)(v.w & 0xffffu); vt[7 * P2] = (bf16_t)(v.w >> 16);
}
__device__ __forceinline__ void at_qk(f32x16& p0, f32x16& p1, const LAS unsigned char* Kt, const bf16x8 (&qr)[4], int r, int h) {
#pragma unroll
    for (int i = 0; i < 16; ++i) { p0[i] = 0.f; p1[i] = 0.f; }
#pragma unroll
    for (int ds = 0; ds < 4; ++ds) {
        const bf16x8 a0 = *(const LAS bf16x8*)(Kt + r * KT_PITCH + (16 * ds + 8 * h) * 2);
        const bf16x8 a1 = *(const LAS bf16x8*)(Kt + (32 + r) * KT_PITCH + (16 * ds + 8 * h) * 2);
        p0 = __builtin_amdgcn_mfma_f32_32x32x16_bf16(a0, qr[ds], p0, 0, 0, 0);
        p1 = __builtin_amdgcn_mfma_f32_32x32x16_bf16(a1, qr[ds], p1, 0, 0, 0);
    }
}
__device__ __forceinline__ void at_pv(f32x16 (&o)[2], const LAS unsigned char* Vt, const bf16x8 (&pk)[4], int r, int h) {
#pragma unroll
    for (int dh = 0; dh < 2; ++dh)
#pragma unroll
        for (int ks = 0; ks < 4; ++ks) { const LAS unsigned char* bp = Vt + (32 * dh + r) * VT_PITCH + (16 * ks + 4 * h) * 2;
            const u32x2 lo = *(const LAS u32x2*)bp, hi = *(const LAS u32x2*)(bp + 16);
            const u32x4 av = (u32x4){lo.x, lo.y, hi.x, hi.y};
            o[dh] = __builtin_amdgcn_mfma_f32_32x32x16_bf16(__builtin_bit_cast(bf16x8, av), pk[ks], o[dh], 0, 0, 0); }
}
template <bool BIAS, bool MASK, bool DSAM = false>
__device__ __forceinline__ void at_softmax(f32x16& p0, f32x16& p1, float& m, float& l, f32x16 (&o)[2], bf16x8 (&pk)[4], float sc2, const LAS float* bias2, int kmax, int h, unsigned mb = 0u) {
    float mt = NEGBIG;
#pragma unroll
    for (int g = 0; g < 4; ++g) {
        f32x4 b0 = (f32x4){0.f, 0.f, 0.f, 0.f}, b1 = b0;
        if (BIAS) { b0 = *(const LAS f32x4*)(bias2 + 8 * g + 4 * h); b1 = *(const LAS f32x4*)(bias2 + 32 + 8 * g + 4 * h); }
#pragma unroll
        for (int j = 0; j < 4; ++j) { const int reg = 4 * g + j, kv = 8 * g + 4 * h + j;
            float x0 = p0[reg] * sc2 + b0[j], x1 = p1[reg] * sc2 + b1[j];
            if (MASK) { if (kv > kmax) x0 = NEGBIG; if (kv + 32 > kmax) x1 = NEGBIG; }
            if (DSAM) { if (!((mb >> reg) & 1u)) x0 = NEGBIG; if (!((mb >> (16 + reg)) & 1u)) x1 = NEGBIG; }
            p0[reg] = x0; p1[reg] = x1; mt = fmaxf(mt, fmaxf(x0, x1)); }
    }
    mt = fmaxf(mt, __shfl_xor(mt, 32));
    const float mn = fmaxf(m, mt);
    if (__any(mn > m)) { const float al = __builtin_amdgcn_exp2f(m - mn); l *= al;
#pragma unroll
        for (int i = 0; i < 16; ++i) { o[0][i] *= al; o[1][i] *= al; }
        m = mn; }
    float s = 0.f;
#pragma unroll
    for (int i = 0; i < 16; ++i) { const float e0 = (p0[i] > -1e29f) ? __builtin_amdgcn_exp2f(p0[i] - m) : 0.f, e1 = (p1[i] > -1e29f) ? __builtin_amdgcn_exp2f(p1[i] - m) : 0.f; p0[i] = e0; p1[i] = e1; s += e0 + e1; }
    l += s;
#pragma unroll
    for (int ks = 0; ks < 2; ++ks) { u32x4 w0, w1;
        w0.x = pk2(p0[8 * ks + 0], p0[8 * ks + 1]); w0.y = pk2(p0[8 * ks + 2], p0[8 * ks + 3]); w0.z = pk2(p0[8 * ks + 4], p0[8 * ks + 5]); w0.w = pk2(p0[8 * ks + 6], p0[8 * ks + 7]);
        w1.x = pk2(p1[8 * ks + 0], p1[8 * ks + 1]); w1.y = pk2(p1[8 * ks + 2], p1[8 * ks + 3]); w1.z = pk2(p1[8 * ks + 4], p1[8 * ks + 5]); w1.w = pk2(p1[8 * ks + 6], p1[8 * ks + 7]);
        pk[ks] = __builtin_bit_cast(bf16x8, w0); pk[2 + ks] = __builtin_bit_cast(bf16x8, w1); }
}
__device__ __forceinline__ void at_loadq(bf16x8 (&qr)[4], const bf16_t* qrow, int h) {
#pragma unroll
    for (int ds = 0; ds < 4; ++ds) qr[ds] = *(const bf16x8*)(qrow + 16 * ds + 8 * h);
}
__device__ __forceinline__ void at_store(bf16_t* orow, const f32x16 (&o)[2], float inv, int h) {
#pragma unroll
    for (int dh = 0; dh < 2; ++dh)
#pragma unroll
        for (int g = 0; g < 4; ++g) { u32x2 w; w.x = pk2(o[dh][4 * g] * inv, o[dh][4 * g + 1] * inv); w.y = pk2(o[dh][4 * g + 2] * inv, o[dh][4 * g + 3] * inv);
            *(u32x2*)(orow + 32 * dh + 8 * g + 4 * h) = w; }
}

__device__ __forceinline__ void fox_unit(KP p, int bh, int qb, LAS unsigned char* lds) {
    const int tid = my_tid(), lane = tid & 63, wave = tid >> 6, r = lane & 31, h = lane >> 5, wv = wave & 3, g = wave >> 2;
    const int b = bh >> 2, hd = bh & 3;
    const bf16_t* P = (const bf16_t*)(p->ws + WS_PMIX) + (size_t)b * SEQ * NPM; bf16_t* OCT = (bf16_t*)(p->ws + WS_OCAT); const float* FC = (const float*)(p->ws + WS_FOXC) + (size_t)bh * SEQ;
    const int q0 = 128 * qb, qbase = q0 + 32 * wv; const float cref = FC[q0];
    bf16x8 qr[4]; at_loadq(qr, P + (size_t)(qbase + r) * NPM + C_FOX_Q + hd * 64, h);
    f32x16 o[2]; float m = NEGBIG, l = 0.f;
#pragma unroll
    for (int i = 0; i < 16; ++i) { o[0][i] = 0.f; o[1][i] = 0.f; }
    const bf16_t* Kc = P + C_FOX_K + hd * 64; const bf16_t* Vc = P + C_FOX_V + hd * 64;
    AtRegs pre0 = at_gload(Kc, Vc, tid), pre1 = at_gload(Kc + (size_t)64 * NPM, Vc + (size_t)64 * NPM, tid);
    float bpre = (tid < 128) ? FC[tid] : 0.f;
#pragma unroll 1
    for (int st = 0; st <= qb; ++st) {
        __syncthreads();
        at_sstore(lds, pre0, tid); at_sstore(lds + AT_TILE_BYTES, pre1, tid);
        if (tid < 128) ((LAS float*)(lds + (tid >> 6) * AT_TILE_BYTES + AT_K_BYTES + AT_V_BYTES))[tid & 63] = (cref - bpre) * LOG2E;
        __syncthreads();
        if (st < qb) { const size_t ko = (size_t)(128 * (st + 1)) * NPM; pre0 = at_gload(Kc + ko, Vc + ko, tid); pre1 = at_gload(Kc + ko + (size_t)64 * NPM, Vc + ko + (size_t)64 * NPM, tid);
            if (tid < 128) bpre = FC[128 * (st + 1) + tid]; }
        const int k0 = 64 * (2 * st + g); const LAS unsigned char* tile = lds + g * AT_TILE_BYTES;
        if (k0 <= qbase + 31) {
            f32x16 p0, p1; bf16x8 pk[4];
            at_qk(p0, p1, tile, qr, r, h);
            const LAS float* b2 = (const LAS float*)(tile + AT_K_BYTES + AT_V_BYTES);
            if (k0 + 63 > qbase) at_softmax<true, true>(p0, p1, m, l, o, pk, 0.125f * LOG2E, b2, qbase + r - k0, h);
            else at_softmax<true, false>(p0, p1, m, l, o, pk, 0.125f * LOG2E, b2, 0, h);
            at_pv(o, tile + AT_K_BYTES, pk, r, h);
        }
    }
    __syncthreads();
    LAS float* cb = (LAS float*)lds + (size_t)wv * (34 * 64);
    if (g == 1) { cb[lane] = m; cb[64 + lane] = l;
#pragma unroll
        for (int i = 0; i < 16; ++i) { cb[(2 + i) * 64 + lane] = o[0][i]; cb[(18 + i) * 64 + lane] = o[1][i]; } }
    __syncthreads();
    if (g == 0) { const float mb = cb[lane], lb = cb[64 + lane]; const float M = fmaxf(m, mb), sa = __builtin_amdgcn_exp2f(m - M), sb = __builtin_amdgcn_exp2f(mb - M);
        l = l * sa + lb * sb;
#pragma unroll
        for (int i = 0; i < 16; ++i) { o[0][i] = o[0][i] * sa + cb[(2 + i) * 64 + lane] * sb; o[1][i] = o[1][i] * sa + cb[(18 + i) * 64 + lane] * sb; }
        const float lt = l + __shfl_xor(l, 32);
        at_store(OCT + (size_t)(b * SEQ + qbase + r) * OC + 768 + hd * 64, o, 1.f / lt, h); }
}
__device__ __forceinline__ void swa_unit(KP p, int l_, int item, LAS unsigned char* lds) {
    const int tid = my_tid(), lane = tid & 63, wave = tid >> 6, r = lane & 31, h = lane >> 5;
    const int hk = item & 1, c = (item >> 1) & 31, b = item >> 6, head = hk * 4 + (wave >> 1), qpos = c * 64 + 32 * (wave & 1);
    const bf16_t* P = (const bf16_t*)(p->ws + WS_PMIX) + (size_t)b * SEQ * NPM; bf16_t* OCT = (bf16_t*)(p->ws + WS_OCAT);
    bf16x8 qr[4]; at_loadq(qr, P + (size_t)(qpos + r) * NPM + C_SWA_Q + head * 64, h);
    f32x16 o[2]; float m = p->in[I_SINKS][l_ * 8 + head] * LOG2E, l = (h == 0) ? 1.f : 0.f;
#pragma unroll
    for (int i = 0; i < 16; ++i) { o[0][i] = 0.f; o[1][i] = 0.f; }
    const int nch = (c + 1 < 3) ? (c + 1) : 3;
    const bf16_t* Kc = P + (size_t)(64 * (c - nch + 1)) * NPM + C_SWA_K + hk * 64; const bf16_t* Vc = P + (size_t)(64 * (c - nch + 1)) * NPM + C_SWA_V + hk * 64;
    AtRegs pre = at_gload(Kc, Vc, tid);
#pragma unroll 1
    for (int st = 0; st < nch; ++st) {
        __syncthreads();
        at_sstore(lds, pre, tid);
        __syncthreads();
        if (st + 1 < nch) pre = at_gload(Kc + (size_t)(64 * (st + 1)) * NPM, Vc + (size_t)(64 * (st + 1)) * NPM, tid);
        f32x16 p0, p1; bf16x8 pk[4];
        at_qk(p0, p1, lds, qr, r, h);
        at_softmax<false, false>(p0, p1, m, l, o, pk, 0.125f * LOG2E, nullptr, 0, h);
        at_pv(o, lds + AT_K_BYTES, pk, r, h);
    }
    const float lt = l + __shfl_xor(l, 32);
    at_store(OCT + (size_t)(b * SEQ + qpos + r) * OC + head * 64, o, 1.f / lt, h);
}

__device__ __forceinline__ size_t dsa_chunk_off(int b, int c) { return (size_t)b * (4096 * 528) + (size_t)4096 * (c * (c + 1) / 2); }
__device__ __forceinline__ void dsa_scores(KP p, LAS unsigned char* lds) {
    const int tid = my_tid(), lane = tid & 63, wave = tid >> 6, r = lane & 31, h = lane >> 5;
    const bf16_t* Pm = (const bf16_t*)(p->ws + WS_PMIX); float* SCR = (float*)(p->ws + WS_SCORES);
    LAS float* tb = (LAS float*)(lds + wave * (32 * 36 * 4));
    const int gw = blockIdx.x * 8 + wave, NGW = gridDim.x * 8;
    constexpr int PERB = 1036;
    for (int it = gw; it < NB * PERB; it += NGW) {
        const int b = it / PERB; int rem = it % PERB; const int qh = rem & 1; rem >>= 1;
        int c = 4; { int acc = 0; while (rem >= acc + c + 1) { acc += c + 1; ++c; } rem -= acc; } const int kb = rem;
        const bf16_t* Pb = Pm + (size_t)b * SEQ * NPM; const int qbase = c * 64 + 32 * qh;
        const bf16_t* qrow = Pb + (size_t)(qbase + r) * NPM;
        float wq[4];
#pragma unroll
        for (int hh = 0; hh < 4; ++hh) wq[hh] = bf2f(qrow[C_WIDX + hh]) * 0.0625f;
        float* dst = SCR + dsa_chunk_off(b, c) + (size_t)(32 * qh) * (64 * (c + 1)) + 64 * kb;
#pragma unroll 1
        for (int kh = 0; kh < 2; ++kh) {
            const bf16_t* krow = Pb + (size_t)(64 * kb + 32 * kh + r) * NPM + C_DSA_KI;
            bf16x8 kf[4];
#pragma unroll
            for (int ds = 0; ds < 4; ++ds) kf[ds] = *(const bf16x8*)(krow + 16 * ds + 8 * h);
            f32x16 sc;
#pragma unroll
            for (int i = 0; i < 16; ++i) sc[i] = 0.f;
#pragma unroll
            for (int hh = 0; hh < 4; ++hh) { f32x16 a;
#pragma unroll
                for (int i = 0; i < 16; ++i) a[i] = 0.f;
#pragma unroll
                for (int ds = 0; ds < 4; ++ds) { const bf16x8 qf = *(const bf16x8*)(qrow + C_DSA_QI + hh * 64 + 16 * ds + 8 * h); a = __builtin_amdgcn_mfma_f32_32x32x16_bf16(kf[ds], qf, a, 0, 0, 0); }
#pragma unroll
                for (int i = 0; i < 16; ++i) sc[i] += fmaxf(a[i], 0.f) * wq[hh]; }
#pragma unroll
            for (int g = 0; g < 4; ++g) *(LAS f32x4*)(tb + r * 36 + 8 * g + 4 * h) = (f32x4){sc[4 * g] + 0.f, sc[4 * g + 1] + 0.f, sc[4 * g + 2] + 0.f, sc[4 * g + 3] + 0.f};
            LDS_FENCE();
#pragma unroll
            for (int i = 0; i < 4; ++i) { const int q = 8 * i + (lane >> 3), cc = (lane & 7) * 4; const f32x4 v = *(const LAS f32x4*)(tb + q * 36 + cc);
                *(f32x4*)(dst + (size_t)q * (64 * (c + 1)) + 32 * kh + cc) = v; }
            LDS_FENCE();
        }
    }
}
__device__ __forceinline__ int count_ge8(int cnt, unsigned cand, unsigned k0, unsigned k1, unsigned k2, unsigned k3, unsigned k4, unsigned k5, unsigned k6, unsigned k7) {
    int t; unsigned long long m0, m1, m2, m3;
    asm volatile("v_cmp_ge_u32_e64 %2, %7, %6\n\tv_cmp_ge_u32_e64 %3, %8, %6\n\tv_cmp_ge_u32_e64 %4, %9, %6\n\tv_cmp_ge_u32_e64 %5, %10, %6\n\t"
                 "s_bcnt1_i32_b64 %1, %2\n\ts_add_i32 %0, %0, %1\n\tv_cmp_ge_u32_e64 %2, %11, %6\n\t"
                 "s_bcnt1_i32_b64 %1, %3\n\ts_add_i32 %0, %0, %1\n\tv_cmp_ge_u32_e64 %3, %12, %6\n\t"
                 "s_bcnt1_i32_b64 %1, %4\n\ts_add_i32 %0, %0, %1\n\tv_cmp_ge_u32_e64 %4, %13, %6\n\t"
                 "s_bcnt1_i32_b64 %1, %5\n\ts_add_i32 %0, %0, %1\n\tv_cmp_ge_u32_e64 %5, %14, %6\n\t"
                 "s_bcnt1_i32_b64 %1, %2\n\ts_add_i32 %0, %0, %1\n\t"
                 "s_bcnt1_i32_b64 %1, %3\n\ts_add_i32 %0, %0, %1\n\t"
                 "s_bcnt1_i32_b64 %1, %4\n\ts_add_i32 %0, %0, %1\n\t"
                 "s_bcnt1_i32_b64 %1, %5\n\ts_add_i32 %0, %0, %1"
                 : "+s"(cnt), "=&s"(t), "=&s"(m0), "=&s"(m1), "=&s"(m2), "=&s"(m3)
                 : "v"(cand), "v"(k0), "v"(k1), "v"(k2), "v"(k3), "v"(k4), "v"(k5), "v"(k6), "v"(k7) : "scc");
    return cnt;
}
__device__ __forceinline__ int count_lane4(int cnt, unsigned cand, unsigned k0, unsigned k1, unsigned k2, unsigned k3) {
    asm volatile("v_cmp_ge_u32_e32 vcc, %2, %1\n\tv_addc_co_u32_e32 %0, vcc, 0, %0, vcc\n\t"
                 "v_cmp_ge_u32_e32 vcc, %3, %1\n\tv_addc_co_u32_e32 %0, vcc, 0, %0, vcc\n\t"
                 "v_cmp_ge_u32_e32 vcc, %4, %1\n\tv_addc_co_u32_e32 %0, vcc, 0, %0, vcc\n\t"
                 "v_cmp_ge_u32_e32 vcc, %5, %1\n\tv_addc_co_u32_e32 %0, vcc, 0, %0, vcc"
                 : "+v"(cnt) : "v"(cand), "v"(k0), "v"(k1), "v"(k2), "v"(k3) : "vcc");
    return cnt;
}
__device__ __forceinline__ int count_ge32(const unsigned (&key)[32], unsigned cand) {
    int cnt = 0;
#pragma unroll
    for (int i = 0; i < 32; i += 8) cnt = count_ge8(cnt, cand, key[i], key[i + 1], key[i + 2], key[i + 3], key[i + 4], key[i + 5], key[i + 6], key[i + 7]);
    return cnt;
}
__device__ __forceinline__ void dsa_select(KP p, LAS unsigned char* lds) {
    const int tid = my_tid(), lane0 = tid & 63, wave = tid >> 6, gw = blockIdx.x * 8 + wave, NGW = gridDim.x * 8;
#pragma unroll 1
    for (int it = gw; it < NB * 28 * 64; it += NGW) {
        int lane = lane0; asm volatile("" : "+v"(lane));
        const int b = it / (28 * 64), rem = it % (28 * 64), c = 4 + (rem >> 6), ql = rem & 63, nadm = 64 * (c + 1);
        const float* srow = (const float*)(p->ws + WS_SCORES) + dsa_chunk_off(b, c) + (size_t)ql * nadm;
        unsigned key[32];
#pragma unroll
        for (int i = 0; i < 32; ++i) { const int kv = 64 * i + lane; key[i] = __float_as_uint(srow[kv < nadm ? kv : nadm - 1]); }
#pragma unroll
        for (int i = 0; i < 32; ++i) asm volatile("" : "+v"(key[i]));
#pragma unroll
        for (int i = 0; i < 32; ++i) { const int kv = 64 * i + lane; key[i] = (kv < nadm) ? fkey(__uint_as_float(key[i]) + 0.f) : 0u; }
        unsigned Tk = 0u;
#define SEL_COUNT(cnt_, cand_) do { int cl_ = 0; cl_ = count_lane4(cl_, cand_, key[0], key[1], key[2], key[3]); \
            cnt_ = count_ge8(0, cand_, key[4], key[5], key[6], key[7], key[8], key[9], key[10], key[11]); \
            if (c >= 12) { cl_ = count_lane4(cl_, cand_, key[12], key[13], key[14], key[15]); \
                if (c >= 16) { cnt_ = count_ge8(cnt_, cand_, key[16], key[17], key[18], key[19], key[20], key[21], key[22], key[23]); \
                    if (c >= 24) { cl_ = count_lane4(cl_, cand_, key[24], key[25], key[26], key[27]); if (c >= 28) cl_ = count_lane4(cl_, cand_, key[28], key[29], key[30], key[31]); } } } \
            cnt_ += (int)wave_sum_s((float)cl_); } while (0)
#pragma unroll 1
        for (int bit = 31; bit >= 12; --bit) { const unsigned cand = Tk | (1u << bit); int cnt; SEL_COUNT(cnt, cand); if (cnt >= 256) Tk = cand; }
        { const unsigned pfx = Tk >> 12; unsigned e0 = 0u, e1 = 0u; int nb = 0;
#pragma unroll
            for (int i = 0; i < 32; ++i) { const bool inb = (key[i] >> 12) == pfx && key[i] != 0u; e1 = (inb && nb == 1) ? key[i] : e1; e0 = (inb && nb == 0) ? key[i] : e0; nb += inb ? 1 : 0; }
            if (__any(nb > 2)) {
#pragma unroll 1
                for (int bit = 11; bit >= 0; --bit) { const unsigned cand = Tk | (1u << bit); int cnt; SEL_COUNT(cnt, cand); if (cnt >= 256) Tk = cand; }
            } else {
                int above = 0; if (pfx != 0xfffffu) { SEL_COUNT(above, Tk + 0x1000u); }
                const int need = 256 - above;
#pragma unroll 1
                for (int bit = 11; bit >= 0; --bit) { const unsigned cand = Tk | (1u << bit); const int cl = ((e0 >= cand) ? 1 : 0) + ((e1 >= cand) ? 1 : 0);
                    if ((int)wave_sum_s((float)cl) >= need) Tk = cand; }
            }
        }
#undef SEL_COUNT
        const int cge = count_ge32(key, Tk), cgt = count_ge32(key, Tk + 1u), quota = 256 - cgt, nt = cge - cgt;
        int cut = -1, acc = 0; const unsigned long long ltm = (1ull << lane) - 1ull;
#pragma unroll
        for (int i = 0; i < 32; ++i) { const unsigned long long tm = __ballot(key[i] == Tk); const int n = __builtin_popcountll(tm);
            if (acc < quota && acc + n >= quota) { const unsigned long long hit = __ballot(key[i] == Tk && __builtin_popcountll(tm & ltm) == quota - acc - 1); cut = 64 * i + (int)__builtin_ctzll(hit); }
            acc += n; }
        (void)nt;
        unsigned long long mine = 0ull;
#pragma unroll
        for (int i = 0; i < 32; ++i) { const unsigned long long sm = __ballot((key[i] > Tk) || (key[i] == Tk && 64 * i + lane <= cut)); mine = (lane == i) ? sm : mine; }
        if (lane < 32) ((unsigned long long*)(p->ws + WS_MASKB))[(size_t)(b * SEQ + c * 64 + ql) * 32 + lane] = mine;
    }
}
__device__ __forceinline__ void dsa_unit(KP p, int b, int c, int hp, LAS unsigned char* lds) {
    const int tid = my_tid(), lane = tid & 63, wave = tid >> 6, r = lane & 31, h = lane >> 5, wv = wave & 3, g = wave >> 2;
    const bf16_t* P = (const bf16_t*)(p->ws + WS_PMIX) + (size_t)b * SEQ * NPM; bf16_t* OCT = (bf16_t*)(p->ws + WS_OCAT);
    const int nadm = 64 * (c + 1);
    const float* SCRc = (const float*)(p->ws + WS_SCORES) + dsa_chunk_off(b, c);
    const bool sel = nadm > 256;
    const int head = 2 * hp + (wv >> 1), ql = 32 * (wv & 1) + r, qbase = 64 * c + 32 * (wv & 1);
    const unsigned long long* mrow = (const unsigned long long*)(p->ws + WS_MASKB) + (size_t)(b * SEQ + c * 64 + ql) * 32;
    bf16x8 qr[4]; at_loadq(qr, P + (size_t)(qbase + r) * NPM + C_DSA_Q + head * 64, h);
    f32x16 o[2]; float m = NEGBIG, l = 0.f;
#pragma unroll
    for (int i = 0; i < 16; ++i) { o[0][i] = 0.f; o[1][i] = 0.f; }
    const int nst = (c + 2) >> 1;
    const bf16_t* Kc = P + C_DSA_K; const bf16_t* Vc = P + C_DSA_V;
    AtRegs pre0 = at_gload(Kc, Vc, tid), pre1 = at_gload(Kc + (size_t)((c >= 1) ? 64 : 0) * NPM, Vc + (size_t)((c >= 1) ? 64 : 0) * NPM, tid);
#pragma unroll 1
    for (int st = 0; st < nst; ++st) {
        __syncthreads();
        at_sstore(lds, pre0, tid); at_sstore(lds + AT_TILE_BYTES, pre1, tid);
        __syncthreads();
        if (st + 1 < nst) { const int j0 = 2 * st + 2, j1 = (j0 + 1 <= c) ? j0 + 1 : j0; pre0 = at_gload(Kc + (size_t)(64 * j0) * NPM, Vc + (size_t)(64 * j0) * NPM, tid); pre1 = at_gload(Kc + (size_t)(64 * j1) * NPM, Vc + (size_t)(64 * j1) * NPM, tid); }
        const int jt = 2 * st + g; const LAS unsigned char* tile = lds + g * AT_TILE_BYTES;
        if (jt <= c) {
            unsigned mb = 0u;
            if (sel) { const unsigned long long m64 = mrow[jt] >> (4 * h);
#pragma unroll
                for (int kvh = 0; kvh < 2; ++kvh)
#pragma unroll
                    for (int reg = 0; reg < 16; ++reg) mb |= (unsigned)((m64 >> (32 * kvh + (reg & 3) + 8 * (reg >> 2))) & 1ull) << (16 * kvh + reg); }
            f32x16 p0, p1; bf16x8 pk[4];
            at_qk(p0, p1, tile, qr, r, h);
            if (sel) at_softmax<false, false, true>(p0, p1, m, l, o, pk, 0.125f * LOG2E, nullptr, 0, h, mb);
            else at_softmax<false, false>(p0, p1, m, l, o, pk, 0.125f * LOG2E, nullptr, 0, h);
            at_pv(o, tile + AT_K_BYTES, pk, r, h);
        }
    }
    __syncthreads();
    LAS float* cb = (LAS float*)lds + (size_t)wv * (34 * 64);
    if (g == 1) { cb[lane] = m; cb[64 + lane] = l;
#pragma unroll
        for (int i = 0; i < 16; ++i) { cb[(2 + i) * 64 + lane] = o[0][i]; cb[(18 + i) * 64 + lane] = o[1][i]; } }
    __syncthreads();
    if (g == 0) { const float mb = cb[lane], lb = cb[64 + lane]; const float M = fmaxf(m, mb), sa = __builtin_amdgcn_exp2f(m - M), sb = __builtin_amdgcn_exp2f(mb - M);
        l = l * sa + lb * sb;
#pragma unroll
        for (int i = 0; i < 16; ++i) { o[0][i] = o[0][i] * sa + cb[(2 + i) * 64 + lane] * sb; o[1][i] = o[1][i] * sa + cb[(18 + i) * 64 + lane] * sb; }
        const float lt = l + __shfl_xor(l, 32);
        at_store(OCT + (size_t)(b * SEQ + qbase + r) * OC + 1024 + head * 64, o, 1.f / lt, h); }
}

template <int N> __device__ __forceinline__ float dpp_ror(float x) { return __int_as_float(__builtin_amdgcn_update_dpp(0, __float_as_int(x), 0x120 + N, 0xf, 0xf, false)); }
__device__ __forceinline__ void row16_sum2(float& a, float& b) {
    a += dpp_ror<8>(a); b += dpp_ror<8>(b); a += dpp_ror<4>(a); b += dpp_ror<4>(b); a += dpp_ror<2>(a); b += dpp_ror<2>(b); a += dpp_ror<1>(a); b += dpp_ror<1>(b);
}
__device__ __forceinline__ float row16_sum(float x) { x += dpp_ror<8>(x); x += dpp_ror<4>(x); x += dpp_ror<2>(x); x += dpp_ror<1>(x); return x; }
__device__ __forceinline__ void rwkv_scan2(KP p, int l, int sw, LAS unsigned char* lds) {
    const int tid = my_tid(), lane = tid & 63, wave = tid >> 6; const int bh = sw >> 2, b = bh >> 2, h = bh & 3, rowbase = 16 * (sw & 3);
    const int rl = lane >> 4, c = lane & 15, r16 = 4 * (wave & 3) + rl;
    const float* RW = (const float*)(p->ws + WS_RW);
    const float* RWv = RW + (size_t)5 * T * 256; float* Y = (float*)(p->ws + WS_Y); float* BONW = (float*)(p->ws + WS_BONUS); const float rkl = p->in[I_RK][l * 256 + h * 64 + lane];
    LAS float* L = (LAS float*)lds;
    LAS float* Lv = L + 5 * 1024; LAS float* Ly = Lv + 256;
    f32x4 S = (f32x4){0.f, 0.f, 0.f, 0.f}, rprev = (f32x4){0.f, 0.f, 0.f, 0.f};
    const size_t hb = (size_t)b * SEQ * 256 + h * 64;
    f32x2 pre[5]; float vpre = 0.f;
#pragma unroll
    for (int a = 0; a < 5; ++a) { const int e = 2 * tid; pre[a] = *(const f32x2*)(RW + (size_t)a * T * 256 + hb + (size_t)(e >> 6) * 256 + (e & 63)); }
    if (tid < 256) vpre = RWv[hb + (size_t)(tid >> 4) * 256 + rowbase + (tid & 15)];
#pragma unroll 1
    for (int tb = 0; tb < SEQ; tb += 16) {
        __syncthreads();
        if (tb > 0 && tid < 256) { const int st = tb - 17 + (tid >> 4); if (st >= 0) Y[hb + (size_t)st * 256 + rowbase + (tid & 15)] = Ly[tid]; }
#pragma unroll
        for (int a = 0; a < 5; ++a) *(LAS f32x2*)(L + a * 1024 + 2 * tid) = pre[a];
        if (tid < 256) Lv[tid] = vpre;
        __syncthreads();
        if (tb + 16 < SEQ) {
#pragma unroll
            for (int a = 0; a < 5; ++a) { const int e = 2 * tid; pre[a] = *(const f32x2*)(RW + (size_t)a * T * 256 + hb + (size_t)(tb + 16 + (e >> 6)) * 256 + (e & 63)); }
            if (tid < 256) vpre = RWv[hb + (size_t)(tb + 16 + (tid >> 4)) * 256 + rowbase + (tid & 15)];
        }
        if ((sw & 3) == 0 && wave >= 4) {
#pragma unroll
            for (int i4 = 0; i4 < 4; ++i4) { const int i = 4 * (wave - 4) + i4; const float s = wave_sum(L[0 * 1024 + i * 64 + lane] * L[2 * 1024 + i * 64 + lane] * rkl);
                if (lane == 0) BONW[(size_t)(b * SEQ + tb + i) * 4 + h] = s; }
        }
        if (wave < 4) {
            f32x4 r_ = *(const LAS f32x4*)(L + 0 * 1024 + 4 * c), w_ = *(const LAS f32x4*)(L + 1 * 1024 + 4 * c), k_ = *(const LAS f32x4*)(L + 2 * 1024 + 4 * c);
            f32x4 kk_ = *(const LAS f32x4*)(L + 3 * 1024 + 4 * c), ka_ = *(const LAS f32x4*)(L + 4 * 1024 + 4 * c); float v_ = Lv[r16];
#pragma unroll
            for (int i = 0; i < 16; ++i) {
                f32x4 rn = r_, wn = w_, kn = k_, kkn = kk_, kan = ka_; float vn = v_;
                if (i < 15) { rn = *(const LAS f32x4*)(L + 0 * 1024 + (i + 1) * 64 + 4 * c); wn = *(const LAS f32x4*)(L + 1 * 1024 + (i + 1) * 64 + 4 * c); kn = *(const LAS f32x4*)(L + 2 * 1024 + (i + 1) * 64 + 4 * c);
                    kkn = *(const LAS f32x4*)(L + 3 * 1024 + (i + 1) * 64 + 4 * c); kan = *(const LAS f32x4*)(L + 4 * 1024 + (i + 1) * 64 + 4 * c); vn = Lv[(i + 1) * 16 + r16]; }
                float pa = (S.x * kk_.x + S.y * kk_.y) + (S.z * kk_.z + S.w * kk_.w);
                float py = (S.x * rprev.x + S.y * rprev.y) + (S.z * rprev.z + S.w * rprev.w);
                row16_sum2(pa, py);
                Ly[i * 16 + r16] = py;
                S = S * w_ - ka_ * pa + k_ * v_;
                rprev = r_;
                r_ = rn; w_ = wn; k_ = kn; kk_ = kkn; ka_ = kan; v_ = vn;
            }
        }
    }
    __syncthreads();
    if (tid < 256) { const int st = SEQ - 17 + (tid >> 4); Y[hb + (size_t)st * 256 + rowbase + (tid & 15)] = Ly[tid]; }
    if (wave < 4) { const float py = row16_sum((S.x * rprev.x + S.y * rprev.y) + (S.z * rprev.z + S.w * rprev.w)); if (c == 0) Y[hb + (size_t)(SEQ - 1) * 256 + rowbase + r16] = py; }
}
__device__ __forceinline__ void rwkv_post(KP p, int l) {
    const int tid = my_tid(), lane = tid & 63, wave = tid >> 6, gw = blockIdx.x * 8 + wave, NGW = gridDim.x * 8;
    const float* RW = (const float*)(p->ws + WS_RW); const float* RWv = RW + (size_t)5 * T * 256; const float* RWg = RW + (size_t)6 * T * 256;
    const float* Y = (const float*)(p->ws + WS_Y); const float* BON = (const float*)(p->ws + WS_BONUS); bf16_t* OCT = (bf16_t*)(p->ws + WS_OCAT);
    float gng[4], gnb[4];
#pragma unroll
    for (int hh = 0; hh < 4; ++hh) { gng[hh] = p->in[I_GNG][l * 256 + hh * 64 + lane]; gnb[hh] = p->in[I_GNB][l * 256 + hh * 64 + lane]; }
    for (int t = gw; t < T; t += NGW) {
#pragma unroll
        for (int hh = 0; hh < 4; ++hh) { const size_t o = (size_t)t * 256 + hh * 64 + lane; const float yy = Y[o];
            const float mean = wave_sum(yy) * (1.f / 64.f); const float d = yy - mean; const float var = wave_sum(d * d) * (1.f / 64.f);
            const float ov = (d * rsqrtf(var + 64e-5f) * gng[hh] + gnb[hh] + BON[t * 4 + hh] * RWv[o]) * RWg[o];
            OCT[(size_t)t * OC + 512 + hh * 64 + lane] = (bf16_t)f2bf(ov); }
    }
}

__device__ __forceinline__ void ph_scan(KP p, int l, LAS unsigned char* lds) {
    if (blockIdx.x < 128) { rwkv_scan2(p, l, blockIdx.x, lds); return; }
    const int tid = my_tid(); unsigned* ctl = (unsigned*)(p->ws + WS_CTL) + 512 + 64 * l; LAS int* slot = (LAS int*)(lds + LDS_BYTES - 256);
    for (;;) { if (tid == 0) *slot = (int)atomicAdd(ctl, 1u); __syncthreads(); const int it = *slot; __syncthreads(); if (it >= 512) break; fox_unit(p, it & 31, 15 - (it >> 5), lds); __syncthreads(); }
    for (;;) { if (tid == 0) *slot = (int)atomicAdd(ctl + 16, 1u); __syncthreads(); const int it = *slot; __syncthreads(); if (it >= 512) break; swa_unit(p, l, it, lds); __syncthreads(); }
}
__device__ __forceinline__ void ph_attn(KP p, int l, LAS unsigned char* lds) {
    dsa_scores(p, lds);
    rwkv_post(p, l);
}
__device__ __forceinline__ void ph_dsa_xb(KP p, int l, LAS unsigned char* lds) {
    {
        const int w = blockIdx.x, b = w >> 5, s = (w >> 1) & 15, hp = w & 1;
        dsa_unit(p, b, 31 - s, hp, lds);
        __syncthreads();
        dsa_unit(p, b, s, hp, lds);
        __syncthreads();
    }
}

struct SchedMerge {
    static constexpr int PERM = 1;
    const char* XB; const char* WIN; const char* OCT; const char* WB; int G, c;
    __device__ __forceinline__ bool next(int i, mg::Unit& u) const {
        int pm, pn; if (!mg::static_tile(i >> 3, G, c, T / 256, 4, pm, pn)) return false;
        const int j = i & 7, br = j >> 1; u.pm = pm; u.pn = pn; u.tag = j;
        if ((j & 1) == 0) { u.A = XB + (size_t)pm * 256 * 2048; u.B = WIN + (size_t)(3328 + 1024 * br + 256 * pn) * 2048; u.ld = 2048; u.nt = 16; }
        else { const int koff = (br == 0) ? 0 : 256 + 256 * br, kk = (br == 0) ? 512 : 256;
            u.A = OCT + (size_t)pm * 256 * (OC * 2) + koff * 2; u.B = WB + (size_t)pn * 256 * (OC * 2) + koff * 2; u.ld = OC * 2; u.nt = kk / 64; }
        return true;
    }
};
struct EpiMerge {
    const float* gbias; u32x4* gsc; u32x4* macc; bf16_t* MB;
    __device__ __forceinline__ void operator()(const AccT& acc, const mg::Unit& u, int wr, int wc, int fr, int fq, int tid) const {
        const int br = u.tag >> 1; const int col0 = u.pn * 256 + wc * 32 + 8 * fq, row0 = u.pm * 256 + wr * 64 + fr;
        if ((u.tag & 1) == 0) {
            f32x4 bv[2][2];
#pragma unroll
            for (int bj = 0; bj < 2; ++bj)
#pragma unroll
                for (int n = 0; n < 2; ++n) bv[bj][n] = *(const f32x4*)(gbias + br * 1024 + col0 + bj * 128 + 4 * n);
#pragma unroll
            for (int ai = 0; ai < 2; ++ai)
#pragma unroll
                for (int m = 0; m < 4; ++m)
#pragma unroll
                    for (int bj = 0; bj < 2; ++bj) { f32x4 g[2];
#pragma unroll
                        for (int n = 0; n < 2; ++n) { const f32x4 x = acc[ai][bj][m][n] + bv[bj][n];
#pragma unroll
                            for (int j = 0; j < 4; ++j) g[n][j] = sigm(x[j]); }
                        u32x4 w; w.x = pk2(g[0][0], g[0][1]); w.y = pk2(g[0][2], g[0][3]); w.z = pk2(g[1][0], g[1][1]); w.w = pk2(g[1][2], g[1][3]);
                        gsc[(((ai * 4 + m) * 2 + bj) * 512) + tid] = w; asm volatile("" ::: "memory"); }
        } else {
#pragma unroll
            for (int ai = 0; ai < 2; ++ai)
#pragma unroll
                for (int m = 0; m < 4; ++m) { bf16_t* rowp = MB + (size_t)(row0 + ai * 128 + m * 16) * D + col0;
#pragma unroll
                    for (int bj = 0; bj < 2; ++bj) { const int idx = (((ai * 4 + m) * 2 + bj) * 512) + tid; float g[8], r[8]; unpack8(gsc[idx], g);
#pragma unroll
                        for (int n = 0; n < 2; ++n)
#pragma unroll
                            for (int j = 0; j < 4; ++j) r[4 * n + j] = g[4 * n + j] * acc[ai][bj][m][n][j];
                        if (br > 0) { float pm[8]; unpack8(macc[idx], pm);
#pragma unroll
                            for (int j = 0; j < 8; ++j) r[j] += pm[j]; }
                        u32x4 w; w.x = pk2(r[0], r[1]); w.y = pk2(r[2], r[3]); w.z = pk2(r[4], r[5]); w.w = pk2(r[6], r[7]);
                        if (br < 3) macc[idx] = w; else *(u32x4*)(rowp + bj * 128) = w;
                        asm volatile("" ::: "memory"); } }
        }
    }
};
__device__ __forceinline__ void ph_merge(KP p, int l, LAS unsigned char* lds) {
    SchedMerge S{(const char*)(p->ws + WS_XB2), (const char*)(p->ws + WS_WIN), (const char*)(p->ws + WS_OCAT), (const char*)(p->ws + WS_WB), (int)gridDim.x, (int)blockIdx.x};
    EpiMerge E{p->in[I_GB] + (size_t)l * 4096, (u32x4*)(p->ws + WS_GSC) + (size_t)blockIdx.x * 8192, (u32x4*)(p->ws + WS_MACC) + (size_t)blockIdx.x * 8192, (bf16_t*)(p->ws + WS_MERGED)};
    mg::gemm_run(lds, S, E);
}

struct EpiResid {
    const float* base; float* out; float alpha;
    __device__ __forceinline__ void operator()(const AccT& acc, const mg::Unit& u, int wr, int wc, int fr, int fq, int) const {
        const int row0 = u.pm * 256 + wr * 64 + fr, col0 = u.pn * 256 + wc * 32 + 4 * fq;
#pragma unroll
        for (int ai = 0; ai < 2; ++ai)
#pragma unroll
            for (int m = 0; m < 4; ++m) { const size_t off = (size_t)(row0 + ai * 128 + m * 16) * D + col0;
#pragma unroll
                for (int bj = 0; bj < 2; ++bj)
#pragma unroll
                    for (int n = 0; n < 2; ++n) { const f32x4 bs = *(const f32x4*)(base + off + bj * 128 + n * 16); *(f32x4*)(out + off + bj * 128 + n * 16) = bs * alpha + acc[ai][bj][m][n]; } }
    }
};
__device__ __forceinline__ void ph_outproj(KP p, int l, LAS unsigned char* lds) {
    SchedPlain<0, 4, D> S{(const char*)(p->ws + WS_MERGED), (const char*)(p->ws + WS_WO), (int)gridDim.x, (int)blockIdx.x};
    EpiResid E{(l == 0) ? p->in[I_X] : p->out, p->out, DN_ALPHA};
    mg::gemm_run(lds, S, E);
}

__device__ __forceinline__ void ln_rows(KP p, int l, int mode, LAS unsigned char* lds) {
    const int tid = my_tid(), lane = tid & 63, wave = tid >> 6;
    const float* g = p->in[I_LNG] + (size_t)(l * 2 + mode) * D; const float* bb = p->in[I_LNB] + (size_t)(l * 2 + mode) * D;
    bf16_t* OB = (bf16_t*)(p->ws + (mode == 0 ? WS_X1B : WS_XB)); const bool wb = (mode == 0) || (l == 0);
    const bool moe = (mode == 0) && (l & 1); const float* rw = p->in[I_RTW] + (size_t)(l >> 1) * D * NE; const float* rb = p->in[I_RTB] + (l >> 1) * NE;
    int* TOKE = (int*)(p->ws + WS_TOKE); float* TOKW = (float*)(p->ws + WS_TOKW);
    f32x4 gv[4], bv[4];
#pragma unroll
    for (int j = 0; j < 4; ++j) { gv[j] = *(const f32x4*)(g + 4 * lane + 256 * j); bv[j] = *(const f32x4*)(bb + 4 * lane + 256 * j); }
    const int rows_per_wg = T / gridDim.x;
#pragma unroll 2
    for (int rr = wave; rr < rows_per_wg; rr += 8) {
        const int row = blockIdx.x * rows_per_wg + rr; float* xr = p->out + (size_t)row * D;
        f32x4 v[4]; float s = 0.f;
#pragma unroll
        for (int j = 0; j < 4; ++j) v[j] = *(const f32x4*)(xr + 4 * lane + 256 * j);
        if (mode == 1 && (l & 1)) {
            const int* RO = (const int*)(p->ws + WS_ROWOF); const bf16_t* YB = (const bf16_t*)(p->ws + WS_AG);
#pragma unroll
            for (int sl = 0; sl < 2; ++sl) { const int yr = RO[row * 2 + sl]; const float w = TOKW[row * 2 + sl];
#pragma unroll
                for (int j = 0; j < 4; ++j) { const u32x2 y = *(const u32x2*)(YB + (size_t)yr * D + 4 * lane + 256 * j);
                    v[j].x += w * bflo(y.x); v[j].y += w * bfhi(y.x); v[j].z += w * bflo(y.y); v[j].w += w * bfhi(y.y); } } }
#pragma unroll
        for (int j = 0; j < 4; ++j) s += (v[j].x + v[j].y) + (v[j].z + v[j].w);
        const float mean = wave_sum(s) * (1.f / D); float s2 = 0.f;
#pragma unroll
        for (int j = 0; j < 4; ++j) { v[j] = v[j] - mean; s2 += (v[j].x * v[j].x + v[j].y * v[j].y) + (v[j].z * v[j].z + v[j].w * v[j].w); }
        const float rstd = rsqrtf(wave_sum(s2) * (1.f / D) + LN_EPS);
        const float osc = (mode == 0) ? DN_ALPHA : 1.f;
#pragma unroll
        for (int j = 0; j < 4; ++j) { v[j] = v[j] * rstd * gv[j] + bv[j]; *(f32x4*)(xr + 4 * lane + 256 * j) = v[j] * osc;
            if (wb) *(unsigned long long*)(OB + (size_t)row * D + 4 * lane + 256 * j) = (unsigned long long)pk2(v[j].x, v[j].y) | ((unsigned long long)pk2(v[j].z, v[j].w) << 32); }
        if (moe) {
            float lg[8];
#pragma unroll
            for (int e = 0; e < 8; ++e) lg[e] = 0.f;
#pragma unroll
            for (int j = 0; j < 4; ++j)
#pragma unroll
                for (int q = 0; q < 4; ++q) { const int c = 4 * lane + 256 * j + q; const f32x4 w0 = *(const f32x4*)(rw + (size_t)c * 8), w1 = *(const f32x4*)(rw + (size_t)c * 8 + 4); const float x = v[j][q];
                    lg[0] += x * w0.x; lg[1] += x * w0.y; lg[2] += x * w0.z; lg[3] += x * w0.w; lg[4] += x * w1.x; lg[5] += x * w1.y; lg[6] += x * w1.z; lg[7] += x * w1.w; }
#pragma unroll
            for (int e = 0; e < 8; ++e) lg[e] = wave_sum(lg[e]) + rb[e];
            int e1 = 0; float v1 = lg[0];
#pragma unroll
            for (int e = 1; e < 8; ++e) if (lg[e] > v1) { v1 = lg[e]; e1 = e; }
            int e2 = -1; float v2 = -INFINITY;
#pragma unroll
            for (int e = 0; e < 8; ++e) if (e != e1 && lg[e] > v2) { v2 = lg[e]; e2 = e; }
            const float w1 = 1.f / (1.f + __expf(v2 - v1));
            if (lane == 0) { TOKE[row * 2] = e1; TOKE[row * 2 + 1] = e2; TOKW[row * 2] = w1; TOKW[row * 2 + 1] = 1.f - w1; }
        }
    }
    if (moe) {
        __syncthreads();
        if (tid < 8) { int cnt = 0; for (int rr = 0; rr < rows_per_wg; ++rr) { const int row = blockIdx.x * rows_per_wg + rr; cnt += (TOKE[row * 2] == tid) + (TOKE[row * 2 + 1] == tid); }
            ((int*)(p->ws + WS_WGCNT))[blockIdx.x * 8 + tid] = cnt; }
    }
}
__device__ __forceinline__ void ph_ln1(KP p, int l, LAS unsigned char* lds) {
    ln_rows(p, l, 0, lds);
    __syncthreads();
    const int tid_ = my_tid(); const int lane = tid_ & 63, wave = tid_ >> 6, gw = blockIdx.x * 8 + wave, NGW = gridDim.x * 8;
    LAS float* scr = (LAS float*)(lds + wave * 8448);
    bf16_t* W13 = (bf16_t*)(p->ws + WS_WF13);
    if ((l & 1) == 0) {
        const int j = l >> 1; const float* w1 = p->in[I_F1] + (size_t)j * D * DFF; const float* w3 = p->in[I_F3] + (size_t)j * D * DFF; const float* w2 = p->in[I_F2] + (size_t)j * DFF * D;
        bf16_t* W2 = (bf16_t*)(p->ws + WS_WF2_DENSE);
        const int n1 = tr_nitems(D, DFF), n2 = tr_nitems(DFF, D);
        for (int it = gw; it < 2 * n1 + n2; it += NGW) { int r = it;
            if (r < n1) { tr_item(w1, D, DFF, W13, D, 2, 0, scr, r, lane); continue; } r -= n1;
            if (r < n1) { tr_item(w3, D, DFF, W13, D, 3, 0, scr, r, lane); continue; } r -= n1;
            tr_item(w2, DFF, D, W2, DFF, 0, 0, scr, r, lane); }
    } else {
        const int j = l >> 1; bf16_t* W2 = (bf16_t*)(p->ws + WS_WF2_MOE);
        const int n1 = tr_nitems(D, DFE), n2 = tr_nitems(DFE, D), per = 2 * n1 + n2;
        for (int it = gw; it < NE * per; it += NGW) { const int e = it / per; int r = it % per;
            const float* w1 = p->in[I_E1] + ((size_t)j * NE + e) * D * DFE; const float* w3 = p->in[I_E3] + ((size_t)j * NE + e) * D * DFE; const float* w2 = p->in[I_E2] + ((size_t)j * NE + e) * DFE * D;
            if (r < n1) { tr_item(w1, D, DFE, W13, D, 2, e * 2 * DFE, scr, r, lane); continue; } r -= n1;
            if (r < n1) { tr_item(w3, D, DFE, W13, D, 3, e * 2 * DFE, scr, r, lane); continue; } r -= n1;
            tr_item(w2, DFE, D, W2, DFE, 0, e * D, scr, r, lane); }
    }
}

__device__ __forceinline__ void moe_tables(KP p, LAS int* tb  ) {
    const int tid = my_tid(), lane = tid & 63, e = tid >> 6; const int* WG = (const int*)(p->ws + WS_WGCNT);
    { int tot = 0, mine = 0;
#pragma unroll
        for (int k = 0; k < 4; ++k) { const int w = lane + 64 * k; const int c = (w < (int)gridDim.x) ? WG[w * 8 + e] : 0; tot += c; mine += (w < (int)blockIdx.x) ? c : 0; }
        tot = (int)wave_sum((float)tot); mine = (int)wave_sum((float)mine);
        if (lane == 0) { tb[e] = tot; tb[16 + e] = mine; } }
    __syncthreads();
    if (tid == 0) { int base = 0; for (int x = 0; x < 8; ++x) { tb[8 + x] = base; base += ((tb[x] + 255) >> 8) << 8; } tb[24] = base; }
    __syncthreads();
}
__device__ __forceinline__ void ph_moe_assign(KP p, int l, LAS unsigned char* lds) {
    const int tid = my_tid(), lane = tid & 63, wave = tid >> 6;
    LAS int* tb = (LAS int*)lds; LAS int* rowof = tb + 32;
    moe_tables(p, tb);
    const int rows_per_wg = T / gridDim.x; const int* TOKE = (const int*)(p->ws + WS_TOKE); const float* TOKW = (const float*)(p->ws + WS_TOKW);
    int* ROWTOK = (int*)(p->ws + WS_ROWTOK); float* ROWW = (float*)(p->ws + WS_ROWW);
    LAS int* wcnt = tb + 192;
    if (tid < 128) {
        const int row = blockIdx.x * rows_per_wg + (tid >> 1), s = tid & 1, e = TOKE[row * 2 + s]; const unsigned long long ltm = (1ull << lane) - 1ull;
        int rank = 0;
#pragma unroll
        for (int x = 0; x < 8; ++x) { const unsigned long long m = __ballot(e == x); if (e == x) rank = __builtin_popcountll(m & ltm); if (lane == 0) wcnt[wave * 8 + x] = __builtin_popcountll(m); }
        asm volatile("s_waitcnt lgkmcnt(0)" ::: "memory");
        __builtin_amdgcn_s_barrier();
        if (wave == 1) rank += wcnt[e];
        const int run = tb[8 + e] + tb[16 + e] + rank;
        ROWTOK[run] = row; ROWW[run] = TOKW[row * 2 + s]; rowof[tid] = run; ((int*)(p->ws + WS_ROWOF))[row * 2 + s] = run;
    } else { __builtin_amdgcn_s_barrier(); }
    bf16_t* AG = (bf16_t*)(p->ws + WS_AG);
    if (blockIdx.x < 8) { const int e = blockIdx.x, lo = tb[8 + e] + tb[e], hi = tb[8 + e] + (((tb[e] + 255) >> 8) << 8);
        for (int r = lo + wave; r < hi; r += 8) { if (lane == 0) { ROWTOK[r] = -1; ROWW[r] = 0.f; }
#pragma unroll
            for (int j = 0; j < 2; ++j) *(u32x4*)(AG + (size_t)r * D + 8 * lane + 512 * j) = (u32x4){0u, 0u, 0u, 0u}; } }
    __syncthreads();
    const bf16_t* X1B = (const bf16_t*)(p->ws + WS_X1B);
    for (int pr = wave; pr < rows_per_wg * 2; pr += 8) { const int row = blockIdx.x * rows_per_wg + (pr >> 1), dst = rowof[pr];
#pragma unroll
        for (int j = 0; j < 2; ++j) *(u32x4*)(AG + (size_t)dst * D + 8 * lane + 512 * j) = *(const u32x4*)(X1B + (size_t)row * D + 8 * lane + 512 * j); }
}

struct EpiSwiglu {
    bf16_t* H; int ldh;
    __device__ __forceinline__ void operator()(const AccT& acc, const mg::Unit& u, int wr, int wc, int fr, int fq, int) const {
        const int row0 = u.pm * 256 + wr * 64 + fr, col0 = u.pn * 128 + wc * 32 + 8 * fq;
#pragma unroll
        for (int ai = 0; ai < 2; ++ai)
#pragma unroll
            for (int m = 0; m < 4; ++m) { float hv[8];
#pragma unroll
                for (int n = 0; n < 2; ++n)
#pragma unroll
                    for (int j = 0; j < 4; ++j) { const float a = acc[ai][0][m][n][j], b = acc[ai][1][m][n][j]; hv[4 * n + j] = a * sigm(a) * b; }
                u32x4 w; w.x = pk2(hv[0], hv[1]); w.y = pk2(hv[2], hv[3]); w.z = pk2(hv[4], hv[5]); w.w = pk2(hv[6], hv[7]);
                *(u32x4*)(H + (size_t)(row0 + ai * 128 + m * 16) * ldh + col0) = w; asm volatile("" ::: "memory"); }
    }
};
template <int PERM_, int NN, int K, int BROWS> struct SchedMoe {
    static constexpr int PERM = PERM_;
    const char* A; const char* B; const LAS int* tstart; int G, c;
    __device__ __forceinline__ bool next(int i, mg::Unit& u) const {
        const int L = i * G + c; if (L >= tstart[8] * NN) return false;
        const int rt = L / NN, pn = L % NN; int e = 0;
#pragma unroll
        for (int x = 1; x < 8; ++x) if (rt >= tstart[x]) e = x;
        u.A = A + (size_t)rt * 256 * (K * 2); u.B = B + ((size_t)e * BROWS + (size_t)pn * 256) * (K * 2); u.ld = K * 2; u.nt = K / 64; u.pm = rt; u.pn = pn; u.tag = 0; return true;
    }
};
template <class SM> __device__ __forceinline__ void moe_sched_tiles(KP p, LAS unsigned char* lds, SM& S) {
    LAS int* tb = (LAS int*)(lds + LDS_BYTES - 512);
    moe_tables(p, tb);
    { const int t_ = my_tid(); if (t_ < 8) tb[32 + t_] = tb[8 + t_] >> 8; if (t_ == 8) tb[40] = tb[24] >> 8; }
    __syncthreads();
    S.tstart = tb + 32;
}
__device__ __forceinline__ void ph_ffn_up(KP p, int l, LAS unsigned char* lds) {
    if ((l & 1) == 0) {
        SchedPlain<1, 2 * DFF / 256, D> S{(const char*)(p->ws + WS_X1B), (const char*)(p->ws + WS_WF13), (int)gridDim.x, (int)blockIdx.x};
        EpiSwiglu E{(bf16_t*)(p->ws + WS_H), DFF};
        mg::gemm_run(lds, S, E);
    } else {
        SchedMoe<1, 2 * DFE / 256, D, 2 * DFE> S; S.A = (const char*)(p->ws + WS_AG); S.B = (const char*)(p->ws + WS_WF13);
        S.G = (int)gridDim.x; S.c = (int)blockIdx.x; moe_sched_tiles(p, lds, S);
        EpiSwiglu E{(bf16_t*)(p->ws + WS_H), DFE};
        mg::gemm_run(lds, S, E);
    }
}

struct EpiAccum {
    float* out;
    __device__ __forceinline__ void operator()(const AccT& acc, const mg::Unit& u, int wr, int wc, int fr, int fq, int) const {
        const int row0 = u.pm * 256 + wr * 64 + fr, col0 = u.pn * 256 + wc * 32 + 4 * fq;
#pragma unroll
        for (int ai = 0; ai < 2; ++ai)
#pragma unroll
            for (int m = 0; m < 4; ++m) { float* rp = out + (size_t)(row0 + ai * 128 + m * 16) * D + col0;
#pragma unroll
                for (int bj = 0; bj < 2; ++bj)
#pragma unroll
                    for (int n = 0; n < 2; ++n) { f32x4* q = (f32x4*)(rp + bj * 128 + n * 16); *q = *q + acc[ai][bj][m][n]; } }
    }
};
struct EpiScatter {
    float* out; const int* rowtok; const float* roww;
    __device__ __forceinline__ void operator()(const AccT& acc, const mg::Unit& u, int wr, int wc, int fr, int fq, int) const {
        const int row0 = u.pm * 256 + wr * 64 + fr, col0 = u.pn * 256 + wc * 32 + 4 * fq;
#pragma unroll
        for (int ai = 0; ai < 2; ++ai)
#pragma unroll
            for (int m = 0; m < 4; ++m) { const int r = row0 + ai * 128 + m * 16; const int tok = rowtok[r]; const float w = roww[r];
                if (tok >= 0) { float* rp = out + (size_t)tok * D + col0;
#pragma unroll
                    for (int bj = 0; bj < 2; ++bj)
#pragma unroll
                        for (int n = 0; n < 2; ++n)
#pragma unroll
                            for (int j = 0; j < 4; ++j) unsafeAtomicAdd(rp + bj * 128 + n * 16 + j, w * acc[ai][bj][m][n][j]); } }
    }
};
__device__ __forceinline__ void ph_ffn_down(KP p, int l, LAS unsigned char* lds) {
    if ((l & 1) == 0) {
        SchedPlain<0, 4, DFF> S{(const char*)(p->ws + WS_H), (const char*)(p->ws + WS_WF2_DENSE), (int)gridDim.x, (int)blockIdx.x};
        EpiAccum E{p->out};
        mg::gemm_run(lds, S, E);
    } else {
        SchedMoe<1, 4, DFE, D> S; S.A = (const char*)(p->ws + WS_H); S.B = (const char*)(p->ws + WS_WF2_MOE);
        S.G = (int)gridDim.x; S.c = (int)blockIdx.x; moe_sched_tiles(p, lds, S);
        EpiBf16Store E{(bf16_t*)(p->ws + WS_AG), D};
        mg::gemm_run(lds, S, E);
    }
}


#define XB_TMO      128
#define XB_XCNT(j)  (256  + 64 * (j))
#define XB_XSUB(j)  (1280 + 64 * (j))
#define XB_XGEN(j)  (2304 + 64 * (j))
#define XB_TOP      3328
#define XB_TOPGEN   3392
#define XCD_BAR_WORDS 3456
#define XB_SPIN_CAP (1u << 18)
__device__ __forceinline__ unsigned xb_ld(unsigned* p)              { return __hip_atomic_load(p, __ATOMIC_RELAXED, __HIP_MEMORY_SCOPE_AGENT); }
__device__ __forceinline__ unsigned xb_add(unsigned* p, unsigned v) { return __hip_atomic_fetch_add(p, v, __ATOMIC_RELAXED, __HIP_MEMORY_SCOPE_AGENT); }
__device__ __forceinline__ unsigned xb_xcc_id() { return (unsigned)__builtin_amdgcn_s_getreg((3 << 11) | 20) & 0xFu; }
#define XB_SPIN(cond, bar) do { unsigned _sp = 0; while (cond) { __builtin_amdgcn_s_sleep(1); \
    if ((++_sp & 255u) == 0u) { if (xb_ld(&(bar)[XB_TMO])) break; if (_sp > XB_SPIN_CAP) { atomicAdd(&(bar)[XB_TMO], 1u); break; } } } } while (0)
struct XcdBarrier { unsigned* bar; unsigned x; volatile LAS unsigned* st; };
__device__ __forceinline__ XcdBarrier xcd_barrier_post(unsigned* bar, volatile LAS unsigned* st) {
    XcdBarrier b; b.bar = bar; b.x = xb_xcc_id(); b.st = st;
    if (threadIdx.x == 0) (void)xb_add(&bar[XB_XCNT(b.x)], 1u);
    return b;
}
__device__ __forceinline__ void xcd_barrier_complete(unsigned* bar, unsigned x, unsigned& nloc, unsigned& nx) {
    const unsigned G = gridDim.x * gridDim.y * gridDim.z;
    unsigned sum, cnt, mine, sp = 0u;
    for (;;) {
        sum = 0u; cnt = 0u; mine = 0u;
#pragma unroll
        for (unsigned j = 0; j < 16; ++j) { const unsigned c = xb_ld(&bar[XB_XCNT(j)]); sum += c; cnt += (c > 0u) ? 1u : 0u; mine = (j == x) ? c : mine; }
        if (sum == G) break;
        __builtin_amdgcn_s_sleep(1);
        if ((++sp & 255u) == 0u) { if (xb_ld(&bar[XB_TMO])) break; if (sp > XB_SPIN_CAP) { atomicAdd(&bar[XB_TMO], 1u); break; } }
    }
    nloc = mine > 0u ? mine : 1u; nx = cnt > 0u ? cnt : 1u;
}
__device__ __forceinline__ void xcd_barrier(const XcdBarrier& b) {
    asm volatile("s_waitcnt vmcnt(0)" ::: "memory");
    __syncthreads();
    if (threadIdx.x == 0) {
        unsigned* bar = b.bar;
        __builtin_amdgcn_s_waitcnt(0);
        unsigned nloc = b.st[0], nx = b.st[1];
        if (nloc == 0u) { xcd_barrier_complete(bar, b.x, nloc, nx); b.st[0] = nloc; b.st[1] = nx; }
        const unsigned old = xb_add(&bar[XB_XSUB(b.x)], 1u);
        const unsigned gen = old / nloc;
        if (old + 1u == (gen + 1u) * nloc) {
            __builtin_amdgcn_fence(__ATOMIC_RELEASE, "agent");
            asm volatile("s_waitcnt vmcnt(0)" ::: "memory");
            const unsigned og = xb_add(&bar[XB_TOP], 1u);
            const unsigned tg = og / nx;
            if (og + 1u == (tg + 1u) * nx) xb_add(&bar[XB_TOPGEN], 1u);
            else XB_SPIN(xb_ld(&bar[XB_TOPGEN]) == tg, bar);
            __builtin_amdgcn_fence(__ATOMIC_ACQUIRE, "agent");
            xb_add(&bar[XB_XGEN(b.x)], 1u);
            asm volatile("s_waitcnt vmcnt(0)" ::: "memory");
        } else {
            XB_SPIN(xb_ld(&bar[XB_XGEN(b.x)]) == gen, bar);
            __builtin_amdgcn_fence(__ATOMIC_ACQUIRE, "agent");
            asm volatile("s_waitcnt vmcnt(0)" ::: "memory");
        }
    }
    __syncthreads();
}

constexpr int PH_PER_LAYER = 12, NPHASE = 2 * PH_PER_LAYER;
template <int K> __device__ __forceinline__ void run_phase(KP p, int l, LAS unsigned char* lds) {
    asm volatile("" : "+s"(lds));
    if constexpr (K == 0) ph_conv_mixer(p, l, lds);
    else if constexpr (K == 1) ph_inproj(p, l, lds);
    else if constexpr (K == 2) ph_prep(p, l, lds);
    else if constexpr (K == 21) ph_lora(p, l, lds);
    else if constexpr (K == 30) ph_scan(p, l, lds);
    else if constexpr (K == 31) ph_attn(p, l, lds);
    else if constexpr (K == 32) { dsa_select(p, lds);
        const int tid = my_tid(), lane = tid & 63, wave = tid >> 6, gw = blockIdx.x * 8 + wave, NGW = gridDim.x * 8;
        const float* srcp = (l == 0) ? p->in[I_X] : p->out; bf16_t* XB = (bf16_t*)(p->ws + WS_XB2);
        for (int m = gw; m < T; m += NGW) row_to_bf16(srcp + (size_t)m * D, XB + (size_t)m * D, lane); }
    else if constexpr (K == 4) ph_dsa_xb(p, l, lds);
    else if constexpr (K == 5) ph_merge(p, l, lds);
    else if constexpr (K == 6) ph_outproj(p, l, lds);
    else if constexpr (K == 7) ph_ln1(p, l, lds);
    else if constexpr (K == 8) ph_moe_assign(p, l, lds);
    else if constexpr (K == 9) ph_ffn_up(p, l, lds);
    else if constexpr (K == 10) ph_ffn_down(p, l, lds);
    else ln_rows(p, l, 1, lds);
}
template <int K> __global__ void __launch_bounds__(NTHREADS, 2) k_phase(Params, int l) {
    extern __shared__ __attribute__((aligned(16))) unsigned char lds_raw[];
    run_phase<K>(get_params(), l, (LAS unsigned char*)lds_raw);
}
#if FUSED
#define PH(K, L) do { run_phase<K>(get_params(), L, lds); __syncthreads(); } while (0)
#define SYNC() xcd_barrier(xbar)
__global__ void __launch_bounds__(NTHREADS, 2) k_fused(Params) {
    extern __shared__ __attribute__((aligned(16))) unsigned char lds_raw[];
    LAS unsigned char* lds = (LAS unsigned char*)lds_raw;
    cg::grid_group grid = cg::this_grid();
    volatile LAS unsigned* bst = (volatile LAS unsigned*)(lds + LDS_BYTES - 128);
    if (threadIdx.x < 2) bst[threadIdx.x] = 0u;
    __syncthreads();
    const XcdBarrier xbar = xcd_barrier_post((unsigned*)(get_params()->ws + WS_CTL) + 1024, bst);
    PH(0, 0); grid.sync();
    PH(1, 0); SYNC(); PH(2, 0); SYNC(); PH(21, 0); SYNC(); PH(30, 0); SYNC(); PH(31, 0); SYNC(); PH(32, 0); SYNC(); PH(4, 0); SYNC(); PH(5, 0); SYNC(); PH(6, 0); SYNC(); PH(7, 0); PH(0, 1); SYNC();
    PH(9, 0); SYNC(); PH(10, 0); SYNC(); PH(11, 0); SYNC();
    PH(1, 1); SYNC(); PH(2, 1); SYNC(); PH(21, 1); SYNC(); PH(30, 1); SYNC(); PH(31, 1); SYNC(); PH(32, 1); SYNC(); PH(4, 1); SYNC(); PH(5, 1); SYNC(); PH(6, 1); SYNC(); PH(7, 1); SYNC();
    PH(8, 1); SYNC(); PH(9, 1); SYNC(); PH(10, 1); SYNC(); PH(11, 1);
}
#undef PH
#undef SYNC
#endif
template <int K> static void launch_phase(const Params& p, int l, hipStream_t stream) {
    static bool attr = false;
    if (!attr) { (void)hipFuncSetAttribute((const void*)k_phase<K>, hipFuncAttributeMaxDynamicSharedMemorySize, LDS_BYTES); attr = true; }
    hipLaunchKernelGGL(k_phase<K>, dim3(256), dim3(NTHREADS), LDS_BYTES, stream, p, l);
}

extern "C" void kernel_launch(void* const* d_in, const int* in_sizes, int n_in, void* d_out, int out_size, void* d_ws, size_t ws_size, hipStream_t stream) {
    if (n_in != 28 || out_size != T * D || ws_size < WS_END) { fprintf(stderr, "kernel_launch: unexpected problem (n_in %d out %d ws %zu)\n", n_in, out_size, ws_size); return; }
    (void)hipMemsetAsync((char*)d_ws + WS_CTL, 0, 32768, stream);
    Params p{};
    for (int i = 0; i < 28; ++i) p.in[i] = (const float*)d_in[i];
    p.out = (float*)d_out; p.ws = (unsigned char*)d_ws;
#if FUSED
    static bool attr = false;
    if (!attr) { (void)hipFuncSetAttribute((const void*)k_fused, hipFuncAttributeMaxDynamicSharedMemorySize, LDS_BYTES); attr = true; }
    void* args[] = {&p};
    hipError_t e = hipLaunchCooperativeKernel((const void*)k_fused, dim3(256), dim3(NTHREADS), args, LDS_BYTES, stream);
    if (e != hipSuccess) fprintf(stderr, "cooperative launch failed: %s\n", hipGetErrorString(e));
    return;
#endif
    for (int l = 0; l < 2; ++l) {
        launch_phase<0>(p, l, stream); launch_phase<1>(p, l, stream); launch_phase<2>(p, l, stream); launch_phase<21>(p, l, stream);
        launch_phase<30>(p, l, stream); launch_phase<31>(p, l, stream); launch_phase<32>(p, l, stream);
        launch_phase<4>(p, l, stream); launch_phase<5>(p, l, stream); launch_phase<6>(p, l, stream); launch_phase<7>(p, l, stream);
        if (l & 1) launch_phase<8>(p, l, stream);
        launch_phase<9>(p, l, stream); launch_phase<10>(p, l, stream); launch_phase<11>(p, l, stream);
    }
}
```

```cpp
#include <hip/hip_runtime.h>
#include <hip/hip_cooperative_groups.h>
#include <cstdio>
#include <cstdint>
namespace cg = cooperative_groups;

#ifndef FUSED
#define FUSED 1
#endif

#define LAS __attribute__((address_space(3)))
typedef unsigned short bf16_t;
typedef short bf16x8 __attribute__((ext_vector_type(8)));
typedef float f32x4 __attribute__((ext_vector_type(4)));
typedef float f32x2 __attribute__((ext_vector_type(2)));
typedef unsigned u32x4 __attribute__((ext_vector_type(4)));
typedef unsigned u32x2 __attribute__((ext_vector_type(2)));

constexpr int T = 16384, D = 1024, SEQ = 2048, NB = 8;
constexpr int NPM = 3328;
constexpr int C_SWA_Q = 0, C_SWA_K = 512, C_SWA_V = 640, C_RW = 768;
constexpr int C_FOX_Q = 1792, C_FOX_K = 2048, C_FOX_V = 2304;
constexpr int C_DSA_Q = 2560, C_DSA_K = 2816, C_DSA_V = 2880, C_DSA_KI = 2944, C_FLOG = 3008, C_WIDX = 3012, C_DSA_QI = 3072;
constexpr int D_IN = 7368, NWIN = 7424;
constexpr int OC = 1280;
constexpr int DFF = 2816, DFE = 1408, NE = 8;
constexpr int MAXROWS = 34816;
constexpr float DN_ALPHA = 1.41421356237f;
constexpr float LN_EPS = 1e-5f;

constexpr size_t MiB = 1u << 20;
constexpr size_t WS_CTL = 0;
constexpr size_t WS_WIN = 1 * MiB, WS_WB = 16 * MiB, WS_WO = 19 * MiB;
constexpr size_t WS_THR = 21 * MiB + 256 * 1024  , WS_ROWOF = 21 * MiB  , WS_FOXC = 21 * MiB, WS_TOKE = 21 * MiB + 256 * 1024, WS_TOKW = 21 * MiB + 384 * 1024, WS_ROWTOK = 21 * MiB + 512 * 1024,
                 WS_ROWW = 21 * MiB + 768 * 1024, WS_WGCNT = 21 * MiB + 920 * 1024;
constexpr size_t WS_OCAT = 22 * MiB, WS_X1B = 22 * MiB;
constexpr size_t WS_PMIX = 62 * MiB, WS_MERGED = 62 * MiB, WS_MACC = 94 * MiB;
constexpr size_t WS_WF13 = 62 * MiB, WS_WF2_DENSE = 73 * MiB, WS_WF2_MOE = 106 * MiB, WS_H = 128 * MiB;
constexpr size_t WS_RW = 166 * MiB, WS_XB = 22 * MiB  , WS_SCORES = 166 * MiB, WS_XB2 = 246 * MiB, WS_GSC = 158 * MiB, WS_AG = 222 * MiB;
constexpr size_t WS_BONUS = 278 * MiB, WS_Y = 279 * MiB, WS_LORA_A = 279 * MiB  ;
constexpr size_t WS_WLORA = 15 * MiB + 512 * 1024;
constexpr size_t WS_MASKB = 295 * MiB;
constexpr size_t WS_END = 299 * MiB;
constexpr size_t RWSZ = 16 * MiB;

constexpr int LDS_BYTES = 155648;
constexpr int NTHREADS = 512;

struct Params { const float* in[28]; float* out; unsigned char* ws; };
typedef const __attribute__((address_space(4))) Params* KP;
__device__ __forceinline__ KP get_params() { KP k = (KP)__builtin_amdgcn_kernarg_segment_ptr(); asm volatile("" : "+s"(k)); return k; }
enum { I_X = 0, I_WIN, I_SINKS, I_MU, I_W0, I_WUP, I_A0, I_AUP, I_GUP, I_KK, I_KA, I_RK, I_GNG, I_GNB, I_FB, I_GB, I_WBR, I_WOUT, I_LNG, I_LNB,
       I_F1, I_F3, I_F2, I_RTW, I_RTB, I_E1, I_E3, I_E2 };

__device__ __forceinline__ float bflo(unsigned u) { return __uint_as_float(u << 16); }
__device__ __forceinline__ float bfhi(unsigned u) { return __uint_as_float(u & 0xffff0000u); }
__device__ __forceinline__ float bf2f(bf16_t b) { return __uint_as_float((unsigned)b << 16); }
__device__ __forceinline__ unsigned f2bf(float f) { unsigned u = __float_as_uint(f); return (u + 0x7fffu + ((u >> 16) & 1u)) >> 16; }
__device__ __forceinline__ unsigned pk2(float lo, float hi) { unsigned r; asm("v_cvt_pk_bf16_f32 %0, %1, %2" : "=v"(r) : "v"(lo), "v"(hi)); return r; }
__device__ __forceinline__ float wave_sum(float v) {
#pragma unroll
    for (int o = 1; o < 64; o <<= 1) v += __shfl_xor(v, o);
    return v;
}
__device__ __forceinline__ float wave_max(float v) {
#pragma unroll
    for (int o = 1; o < 64; o <<= 1) v = fmaxf(v, __shfl_xor(v, o));
    return v;
}
__device__ __forceinline__ float sigm(float x) { return 1.f / (1.f + __expf(-x)); }
#define LDS_FENCE() asm volatile("s_waitcnt lgkmcnt(0)" ::: "memory")
__device__ __forceinline__ int my_tid() { int t = threadIdx.x; asm volatile("" : "+v"(t)); return t; }
__device__ __forceinline__ void unpack8(const u32x4 v, float* f) {
    f[0] = bflo(v.x); f[1] = bfhi(v.x); f[2] = bflo(v.y); f[3] = bfhi(v.y); f[4] = bflo(v.z); f[5] = bfhi(v.z); f[6] = bflo(v.w); f[7] = bfhi(v.w);
}

namespace mg {
constexpr int BM = 256, BK = 64, HALF = 128, HTB = HALF * BK * 2, STAGE_BYTES = 8 * HTB;
__device__ __forceinline__ int lds_byte(int r, int c) { const int st = (r >> 4) * 2 + (c >> 5), rr = r & 15, cc = c & 31, ob = rr * 64 + cc * 2; return st * 1024 + (ob ^ (((ob >> 9) & 1) << 5)); }
__device__ __forceinline__ void stage_rc(int b, int& R, int& C) { const int st = b / 1024, sb = b % 1024, swz = sb ^ (((sb >> 9) & 1) << 5); R = (st >> 1) * 16 + swz / 64; C = (st & 1) * 32 + (swz % 64) / 2; }
__device__ __forceinline__ int perm32(int rho) { const int n = rho >> 4, i = rho & 15; return 8 * (i >> 2) + 4 * n + (i & 3); }

struct Unit { const char* A; const char* B; unsigned ld; int nt; int pm, pn, tag; };

__device__ __forceinline__ bool static_tile(int i, int G, int c, int nM, int nN, int& pm, int& pn) {
    const int nwg = nM * nN; const long L = (long)i * G + c; if (L >= nwg) return false;
    int wgid = (int)L; { const int q = nwg / 8, r = nwg % 8, xcd = wgid % 8, off = wgid / 8; wgid = (xcd < r ? xcd * (q + 1) : r * (q + 1) + (xcd - r) * q) + off; }
    const int nig = 8 * nN, gid = wgid / nig, fm = gid * 8, gsz = (nM - fm) < 8 ? (nM - fm) : 8;
    pm = fm + ((wgid % nig) % gsz); pn = (wgid % nig) / gsz; return true;
}

template <class Sched, class Epi>
__device__ __forceinline__ void gemm_run(LAS unsigned char* lds, const Sched& S, const Epi& E) {
    const int tid = my_tid(), wid = __builtin_amdgcn_readfirstlane(tid >> 6), lane = tid & 63, wr = wid >> 2, wc = wid & 3, fr = lane & 15, fq = lane >> 4;
    int R0, C0; stage_rc(tid * 16, R0, C0); const unsigned RA = (unsigned)R0, RB = (unsigned)(Sched::PERM ? ((R0 & ~31) + perm32(R0 & 31)) : R0), C02 = (unsigned)C0 * 2u;
    const unsigned ldsw = (unsigned)wid * 1024u;
    const int aoff = lds_byte(wr * 64 + fr, fq * 8), boff = lds_byte(wc * 32 + fr, fq * 8);
#define MG_SA(b, h) (((b) * 2 + (h)) * HTB)
#define MG_SB(b, h) ((4 + (b) * 2 + (h)) * HTB)
#define MG_STAGE(bufoff, gptr, v0, s64) do { \
        __builtin_amdgcn_global_load_lds((const unsigned*)((gptr) + (v0)), (LAS unsigned*)(lds + (bufoff) + ldsw), 16, 0, 0); \
        __builtin_amdgcn_global_load_lds((const unsigned*)((gptr) + (s64) + (v0)), (LAS unsigned*)(lds + (bufoff) + ldsw + 8192), 16, 0, 0); } while (0)
#define MG_LDA(dst, b, h) do { _Pragma("unroll") for (int m = 0; m < 4; ++m) _Pragma("unroll") for (int k = 0; k < 2; ++k) dst[m][k] = *(const LAS bf16x8*)(lds + MG_SA(b, h) + aoff + m * 2048 + k * 1024); } while (0)
#define MG_LDB(dst, b, h) do { _Pragma("unroll") for (int n = 0; n < 2; ++n) _Pragma("unroll") for (int k = 0; k < 2; ++k) dst[n][k] = *(const LAS bf16x8*)(lds + MG_SB(b, h) + boff + n * 2048 + k * 1024); } while (0)
#define MG_MMA(ai, bj, At, Bt) do { __builtin_amdgcn_s_setprio(1); _Pragma("unroll") for (int m = 0; m < 4; ++m) _Pragma("unroll") for (int n = 0; n < 2; ++n) _Pragma("unroll") for (int k = 0; k < 2; ++k) \
        acc[ai][bj][m][n] = __builtin_amdgcn_mfma_f32_16x16x32_bf16(Bt[n][k], At[m][k], acc[ai][bj][m][n], 0, 0, 0); __builtin_amdgcn_s_setprio(0); } while (0)
#define MG_WAIT_V(n) asm volatile("s_waitcnt vmcnt(" #n ")" ::: "memory")
#define MG_WAIT_L(n) asm volatile("s_waitcnt lgkmcnt(" #n ")" ::: "memory")
#define MG_BAR __builtin_amdgcn_s_barrier()
#define MG_SCHED __builtin_amdgcn_sched_barrier(0)
    Unit cur; int ui = 0;
    if (!S.next(0, cur)) return;
    f32x4 acc[2][2][4][2];
#pragma unroll
    for (int a = 0; a < 2; ++a)
#pragma unroll
        for (int b = 0; b < 2; ++b)
#pragma unroll
            for (int m = 0; m < 4; ++m)
#pragma unroll
                for (int n = 0; n < 2; ++n) acc[a][b][m][n] = (f32x4){0.f, 0.f, 0.f, 0.f};
    bf16x8 At[4][2], B0[2][2], B1[2][2];
    const size_t kstep = (size_t)(BK * 2);
    {
        const char* cA = cur.A; const char* cB = cur.B; const unsigned ld = cur.ld, vA = RA * ld + C02, vB = RB * ld + C02, s64 = 64u * ld, sh = 128u * ld;
        MG_STAGE(MG_SB(0, 0), cB, vB, s64); MG_STAGE(MG_SB(0, 1), cB + sh, vB, s64); MG_STAGE(MG_SA(0, 0), cA, vA, s64); MG_STAGE(MG_SA(0, 1), cA + sh, vA, s64);
        if (wr == 1) MG_BAR;
        MG_WAIT_V(2); MG_BAR;
        MG_STAGE(MG_SB(1, 0), cB + kstep, vB, s64); MG_STAGE(MG_SA(1, 0), cA + kstep, vA, s64); MG_STAGE(MG_SB(1, 1), cB + sh + kstep, vB, s64);
        MG_WAIT_V(6); MG_BAR;
    }
    for (;;) {
        const char* cA = cur.A; const char* cB = cur.B; const unsigned cld = cur.ld; const int nt = cur.nt;
        for (int t = 0; t < nt; t += 2) {
            const bool last = (t == nt - 2);
            const char* a1 = cA + (size_t)(t + 1) * kstep;
            const char* a2 = cA + (size_t)(t + 2) * kstep; const char* b2 = cB + (size_t)(t + 2) * kstep; unsigned xld = cld;
            if (last) { Unit n2; if (S.next(ui + 1, n2)) { a2 = n2.A; b2 = n2.B; xld = n2.ld; } else { a2 = cA; b2 = cB; } }
            const char* a3 = a2 + kstep; const char* b3 = b2 + kstep;
            const unsigned cvA = RA * cld + C02, c64 = 64u * cld, ch = 128u * cld;
            const unsigned xvA = RA * xld + C02, xvB = RB * xld + C02, x64 = 64u * xld, xh = 128u * xld;
            MG_LDB(B0, 0, 0); MG_LDB(B1, 0, 1); MG_SCHED; MG_LDA(At, 0, 0); MG_STAGE(MG_SA(1, 1), a1 + ch, cvA, c64);
            MG_WAIT_V(8); MG_WAIT_L(0); MG_BAR; MG_MMA(0, 0, At, B0); MG_MMA(0, 1, At, B1); MG_BAR; MG_SCHED;
            MG_LDA(At, 0, 1); MG_STAGE(MG_SB(0, 0), b2, xvB, x64); MG_STAGE(MG_SB(0, 1), b2 + xh, xvB, x64); MG_STAGE(MG_SA(0, 0), a2, xvA, x64);
            MG_WAIT_V(8); MG_WAIT_L(0); MG_BAR; MG_MMA(1, 0, At, B0); MG_MMA(1, 1, At, B1); MG_BAR; MG_SCHED;
            MG_LDB(B0, 1, 0); MG_LDB(B1, 1, 1); MG_SCHED; MG_LDA(At, 1, 0); MG_STAGE(MG_SA(0, 1), a2 + xh, xvA, x64);
            MG_WAIT_V(8); MG_WAIT_L(0); MG_BAR; MG_MMA(0, 0, At, B0); MG_MMA(0, 1, At, B1); MG_BAR; MG_SCHED;
            MG_LDA(At, 1, 1); MG_STAGE(MG_SB(1, 0), b3, xvB, x64); MG_STAGE(MG_SB(1, 1), b3 + xh, xvB, x64); MG_STAGE(MG_SA(1, 0), a3, xvA, x64);
            MG_WAIT_V(8); MG_WAIT_L(0); MG_BAR; MG_MMA(1, 0, At, B0); MG_MMA(1, 1, At, B1); MG_BAR; MG_SCHED;
        }
        if (wr == 0) MG_BAR;
        { int e_fr = fr, e_fq = fq, e_tid = tid; asm volatile("" : "+v"(e_fr), "+v"(e_fq), "+v"(e_tid));
          E(acc, cur, wr, wc, e_fr, e_fq, e_tid); }
        Unit nxt;
        if (!S.next(ui + 1, nxt)) break;
#pragma unroll
        for (int a = 0; a < 2; ++a)
#pragma unroll
            for (int b = 0; b < 2; ++b)
#pragma unroll
                for (int m = 0; m < 4; ++m)
#pragma unroll
                    for (int n = 0; n < 2; ++n) acc[a][b][m][n] = (f32x4){0.f, 0.f, 0.f, 0.f};
        cur = nxt; ++ui;
        if (wr == 1) MG_BAR;
    }
    MG_WAIT_V(0);
    MG_BAR;
#undef MG_SA
#undef MG_SB
#undef MG_STAGE
#undef MG_LDA
#undef MG_LDB
#undef MG_MMA
#undef MG_WAIT_V
#undef MG_WAIT_L
#undef MG_BAR
#undef MG_SCHED
}
}

typedef f32x4 AccT[2][2][4][2];

__device__ __forceinline__ int rowmap(int mode, int n) {
    if (mode == 0) return n;
    if (mode == 1) { if (n < 2560) return n; if (n < 2564) return C_FLOG + (n - 2560); if (n < 2948) return n - 4; if (n < 3204) return C_DSA_QI + (n - 2948); if (n < 3268) return C_DSA_KI + (n - 3204); if (n < 3272) return C_WIDX + (n - 3268); return n + 56; }
    if (mode == 2) return 256 * (n >> 7) + (n & 127);
    return 256 * (n >> 7) + 128 + (n & 127);
}
__device__ __forceinline__ void tr_item(const float* __restrict__ W, int K, int N, bf16_t* WT, int ldt, int mode, int row_off, LAS float* scr, int item, int lane) {
    const int nblk = (N + 31) / 32, kb = item / nblk, nb = item % nblk, k0 = 64 * kb, n0 = 32 * nb;
    const int nl = lane & 31, n = n0 + nl;
    float tv[32];
    const int nc = (n < N) ? n : N - 1;
#pragma unroll
    for (int i = 0; i < 32; ++i) { const int kk = 2 * i + (lane >> 5); tv[i] = W[(size_t)(k0 + kk) * N + nc]; }
#pragma unroll
    for (int i = 0; i < 32; ++i) { const int kk = 2 * i + (lane >> 5); scr[kk * 33 + nl] = (n < N) ? tv[i] : 0.f; }
    LDS_FENCE();
    const int c = lane & 7;
#pragma unroll
    for (int j = 0; j < 4; ++j) { const int n2l = (lane >> 3) + 8 * j, n2 = n0 + n2l; const LAS float* s = scr + (8 * c) * 33 + n2l;
        u32x4 o; o.x = pk2(s[0 * 33], s[1 * 33]); o.y = pk2(s[2 * 33], s[3 * 33]); o.z = pk2(s[4 * 33], s[5 * 33]); o.w = pk2(s[6 * 33], s[7 * 33]);
        if (n2 < N) *(u32x4*)(WT + (size_t)(row_off + rowmap(mode, n2)) * ldt + k0 + 8 * c) = o; }
    LDS_FENCE();
}
__device__ __forceinline__ int tr_nitems(int K, int N) { return (K / 64) * ((N + 31) / 32); }

__device__ __forceinline__ void row_to_bf16(const float* xrow, bf16_t* orow, int lane) {
    const f32x4* xr = (const f32x4*)xrow + lane; unsigned long long* o8 = (unsigned long long*)orow + lane;
#pragma unroll
    for (int j = 0; j < 4; ++j) { const f32x4 v = xr[64 * j]; o8[64 * j] = (unsigned long long)pk2(v.x, v.y) | ((unsigned long long)pk2(v.z, v.w) << 32); }
}

__device__ __forceinline__ void ph_conv_mixer(KP p, int l, LAS unsigned char* lds) {
    const int tid_ = my_tid(); const int lane = tid_ & 63, wave = tid_ >> 6, gw = blockIdx.x * 8 + wave, NGW = gridDim.x * 8;
    LAS float* scr = (LAS float*)(lds + wave * 8448);
    const float* win = p->in[I_WIN] + (size_t)l * D * D_IN; const float* wbr = p->in[I_WBR] + (size_t)l * OC * D; const float* wo = p->in[I_WOUT] + (size_t)l * D * D;
    bf16_t* WIN = (bf16_t*)(p->ws + WS_WIN); bf16_t* WB = (bf16_t*)(p->ws + WS_WB); bf16_t* WO = (bf16_t*)(p->ws + WS_WO);
    const int n1 = tr_nitems(D, D_IN), n2 = tr_nitems(OC, D), n3 = tr_nitems(D, D);
    for (int it = gw; it < n1 + n2 + n3; it += NGW) {
        int r = it;
        if (r < n1) { tr_item(win, D, D_IN, WIN, D, 1, 0, scr, r, lane); continue; } r -= n1;
        if (r < n2) { tr_item(wbr, OC, D, WB, OC, 0, 0, scr, r, lane); continue; } r -= n2;
        tr_item(wo, D, D, WO, D, 0, 0, scr, r, lane);
    }
    {
        bf16_t* WL = (bf16_t*)(p->ws + WS_WLORA);
        const float* wup = p->in[I_WUP] + (size_t)l * 64 * 256; const float* aup = p->in[I_AUP] + (size_t)l * 64 * 256; const float* gup = p->in[I_GUP] + (size_t)l * 128 * 256;
        const int m1 = tr_nitems(64, 256), m2 = tr_nitems(128, 256);
        for (int it = gw; it < 2 * m1 + m2; it += NGW) { int r = it;
            if (r < m1) { tr_item(wup, 64, 256, WL, 256, 0, 0, scr, r, lane); continue; } r -= m1;
            if (r < m1) { tr_item(aup, 64, 256, WL + 64, 256, 0, 256, scr, r, lane); continue; } r -= m1;
            tr_item(gup, 128, 256, WL + 128, 256, 0, 512, scr, r, lane); }
        for (int ch = gw * 64 + lane; ch < 768 * 32; ch += NGW * 64) { const int row = ch >> 5, k8 = (ch & 31) * 8, blk = row >> 8;
            const bool used = (blk == 0) ? (k8 < 64) : ((blk == 1) ? (k8 >= 64 && k8 < 128) : (k8 >= 128));
            if (!used) *(u32x4*)(WL + (size_t)row * 256 + k8) = (u32x4){0u, 0u, 0u, 0u}; }
    }
    if (l == 0) { bf16_t* XB = (bf16_t*)(p->ws + WS_XB); for (int m = gw; m < T; m += NGW) row_to_bf16(p->in[I_X] + (size_t)m * D, XB + (size_t)m * D, lane); }
}

struct SchedInproj {
    static constexpr int PERM = 1;
    const char* A; const char* B; int G, c;
    __device__ __forceinline__ bool next(int i, mg::Unit& u) const {
        int pm, pn; if (!mg::static_tile(i, G, c, T / 256, NPM / 256 - 1, pm, pn)) return false;
        u.A = A + (size_t)pm * 256 * 2048; u.B = B + (size_t)pn * 256 * 2048; u.ld = 2048; u.nt = 16; u.pm = pm; u.pn = pn; u.tag = 0; return true;
    }
};
template <int PERM_, int NN, int K> struct SchedPlain {
    static constexpr int PERM = PERM_;
    const char* A; const char* B; int G, c;
    __device__ __forceinline__ bool next(int i, mg::Unit& u) const {
        int pm, pn; if (!mg::static_tile(i, G, c, T / 256, NN, pm, pn)) return false;
        u.A = A + (size_t)pm * 256 * K * 2; u.B = B + (size_t)pn * 256 * K * 2; u.ld = K * 2; u.nt = K / 64; u.pm = pm; u.pn = pn; u.tag = 0; return true;
    }
};
struct EpiBf16Store {
    bf16_t* O; int ldo;
    __device__ __forceinline__ void operator()(const AccT& acc, const mg::Unit& u, int wr, int wc, int fr, int fq, int) const {
        const int row0 = u.pm * 256 + wr * 64 + fr, col0 = u.pn * 256 + wc * 32 + 8 * fq;
#pragma unroll
        for (int ai = 0; ai < 2; ++ai)
#pragma unroll
            for (int m = 0; m < 4; ++m) { bf16_t* rowp = O + (size_t)(row0 + ai * 128 + m * 16) * ldo + col0;
#pragma unroll
                for (int bj = 0; bj < 2; ++bj) { const f32x4 v0 = acc[ai][bj][m][0], v1 = acc[ai][bj][m][1];
                    u32x4 w; w.x = pk2(v0[0], v0[1]); w.y = pk2(v0[2], v0[3]); w.z = pk2(v1[0], v1[1]); w.w = pk2(v1[2], v1[3]);
                    *(u32x4*)(rowp + bj * 128) = w; } }
    }
};
__device__ __forceinline__ void ph_inproj(KP p, int l, LAS unsigned char* lds) {
    SchedInproj S{(const char*)(p->ws + WS_XB), (const char*)(p->ws + WS_WIN), (int)gridDim.x, (int)blockIdx.x};
    EpiBf16Store E{(bf16_t*)(p->ws + WS_PMIX), NPM};
    mg::gemm_run(lds, S, E);
}

__device__ __forceinline__ void ph_prep(KP p, int l, LAS unsigned char* lds) {
    const int tid = my_tid(), lane = tid & 63, wave = tid >> 6;
    const bf16_t* P = (const bf16_t*)(p->ws + WS_PMIX);
    if (blockIdx.x < 8 && wave < 4) {
        const int b = blockIdx.x, h = wave; const float fb = p->in[I_FB][l * 4 + h];
        float v[32]; float s = 0.f;
#pragma unroll
        for (int i = 0; i < 32; ++i) { const int t = 32 * lane + i; const float x = bf2f(P[(size_t)(b * SEQ + t) * NPM + C_FLOG + h]) + fb;
            const float ls = fminf(x, 0.f) - log1pf(__expf(-fabsf(x))); s += ls; v[i] = s; }
        float incl = s;
#pragma unroll
        for (int o = 1; o < 64; o <<= 1) { const float n = __shfl_up(incl, o); if (lane >= o) incl += n; }
        const float excl = incl - s; float* C = (float*)(p->ws + WS_FOXC) + (size_t)(b * 4 + h) * SEQ + 32 * lane;
#pragma unroll
        for (int i = 0; i < 32; ++i) C[i] = v[i] + excl;
    }
    const float* mu = p->in[I_MU] + l * 1024; const float* kkw = p->in[I_KK] + l * 256;
    float* RWr = (float*)(p->ws + WS_RW); float* RWk = RWr + (size_t)2 * T * 256; float* RWkk = RWr + (size_t)3 * T * 256; float* RWv = RWr + (size_t)5 * T * 256;
    bf16_t* LA = (bf16_t*)(p->ws + WS_LORA_A);
    const int gw = blockIdx.x * 8 + wave, NGW = gridDim.x * 8;
    float m0[8], m1[8], kkc[8];
    { const f32x4 a = *(const f32x4*)(mu + 8 * lane), b = *(const f32x4*)(mu + 8 * lane + 4), c = *(const f32x4*)(mu + 512 + 8 * lane), d = *(const f32x4*)(mu + 512 + 8 * lane + 4);
      m0[0] = a.x; m0[1] = a.y; m0[2] = a.z; m0[3] = a.w; m0[4] = b.x; m0[5] = b.y; m0[6] = b.z; m0[7] = b.w; m1[0] = c.x; m1[1] = c.y; m1[2] = c.z; m1[3] = c.w; m1[4] = d.x; m1[5] = d.y; m1[6] = d.z; m1[7] = d.w;
      const f32x4 e = *(const f32x4*)(kkw + 8 * (lane & 31)), f = *(const f32x4*)(kkw + 8 * (lane & 31) + 4); kkc[0] = e.x; kkc[1] = e.y; kkc[2] = e.z; kkc[3] = e.w; kkc[4] = f.x; kkc[5] = f.y; kkc[6] = f.z; kkc[7] = f.w; }
#pragma unroll 2
    for (int t = gw; t < T; t += NGW) {
        const bf16_t* pr = P + (size_t)t * NPM + C_RW; const bool first = (t & (SEQ - 1)) == 0; const bf16_t* pp = first ? pr : pr - NPM;
        float x0[8], x1[8], y0[8], y1[8];
        unpack8(*(const u32x4*)(pr + 8 * lane), x0); unpack8(*(const u32x4*)(pr + 512 + 8 * lane), x1);
        unpack8(*(const u32x4*)(pp + 8 * lane), y0); unpack8(*(const u32x4*)(pp + 512 + 8 * lane), y1);
#pragma unroll
        for (int j = 0; j < 8; ++j) { const float q0 = first ? 0.f : y0[j], q1 = first ? 0.f : y1[j]; x0[j] += m0[j] * (q0 - x0[j]); x1[j] += m1[j] * (q1 - x1[j]); }
        const size_t o = (size_t)t * 256 + 8 * (lane & 31);
        if (lane < 32) {
            *(f32x4*)(RWr + o) = (f32x4){x0[0], x0[1], x0[2], x0[3]}; *(f32x4*)(RWr + o + 4) = (f32x4){x0[4], x0[5], x0[6], x0[7]};
            *(f32x4*)(RWv + o) = (f32x4){x1[0], x1[1], x1[2], x1[3]}; *(f32x4*)(RWv + o + 4) = (f32x4){x1[4], x1[5], x1[6], x1[7]};
        }
        float kk[8], ss = 0.f;
#pragma unroll
        for (int j = 0; j < 8; ++j) { kk[j] = x0[j] * kkc[j]; ss += kk[j] * kk[j]; }
        ss += __shfl_xor(ss, 1); ss += __shfl_xor(ss, 2); ss += __shfl_xor(ss, 4);
        const float rn = rsqrtf(ss + 1e-12f);
        if (lane >= 32) {
            *(f32x4*)(RWk + o) = (f32x4){x0[0], x0[1], x0[2], x0[3]}; *(f32x4*)(RWk + o + 4) = (f32x4){x0[4], x0[5], x0[6], x0[7]};
            *(f32x4*)(RWkk + o) = (f32x4){kk[0] * rn, kk[1] * rn, kk[2] * rn, kk[3] * rn}; *(f32x4*)(RWkk + o + 4) = (f32x4){kk[4] * rn, kk[5] * rn, kk[6] * rn, kk[7] * rn};
            float a[8];
#pragma unroll
            for (int j = 0; j < 8; ++j) a[j] = (lane < 40) ? tanhf(x1[j]) : ((lane < 48) ? x1[j] : sigm(x1[j]));
            u32x4 w; w.x = pk2(a[0], a[1]); w.y = pk2(a[2], a[3]); w.z = pk2(a[4], a[5]); w.w = pk2(a[6], a[7]);
            *(u32x4*)(LA + (size_t)t * 256 + 8 * (lane - 32)) = w;
        }
    }
}
struct SchedLoraPlus {
    static constexpr int PERM = 1; static constexpr bool DUAL = false;
    const char* LA; const char* WL; const char* XB; const char* WIN; int c;
    __device__ __forceinline__ bool next(int i, mg::Unit& u) const {
        if (i > 0) return false;
        if (c < 192) { int pm, pn; mg::static_tile(0, 256, c, T / 256, 3, pm, pn); u.A = LA + (size_t)pm * 256 * 512; u.B = WL + (size_t)pn * 256 * 512; u.ld = 512; u.nt = 4; u.pm = pm; u.pn = pn; u.tag = 0; }
        else { const int pm = c - 192; u.A = XB + (size_t)pm * 256 * 2048; u.B = WIN + (size_t)12 * 256 * 2048; u.ld = 2048; u.nt = 16; u.pm = pm; u.pn = 12; u.tag = 1; }
        return true;
    }
};
struct EpiLora {
    const float* w0; const float* a0; const float* ka; float* RW; bf16_t* PM;
    __device__ __forceinline__ void operator()(const AccT& acc, const mg::Unit& u, int wr, int wc, int fr, int fq, int) const {
        const int row0 = u.pm * 256 + wr * 64 + fr, col0 = wc * 32 + 8 * fq;
        if (u.tag == 1) {
#pragma unroll
            for (int ai = 0; ai < 2; ++ai)
#pragma unroll
                for (int m = 0; m < 4; ++m) { bf16_t* rowp = PM + (size_t)(row0 + ai * 128 + m * 16) * NPM + u.pn * 256 + col0;
#pragma unroll
                    for (int bj = 0; bj < 2; ++bj) { const f32x4 v0 = acc[ai][bj][m][0], v1 = acc[ai][bj][m][1];
                        u32x4 w; w.x = pk2(v0[0], v0[1]); w.y = pk2(v0[2], v0[3]); w.z = pk2(v1[0], v1[1]); w.w = pk2(v1[2], v1[3]);
                        *(u32x4*)(rowp + bj * 128) = w; } }
            return;
        }
        float* RWw = RW + (size_t)1 * T * 256; float* RWk = RW + (size_t)2 * T * 256; float* RWkk = RW + (size_t)3 * T * 256; float* RWkka = RW + (size_t)4 * T * 256; float* RWg = RW + (size_t)6 * T * 256;
#pragma unroll
        for (int bj = 0; bj < 2; ++bj)
#pragma unroll
            for (int n = 0; n < 2; ++n) { const int c = col0 + bj * 128 + 4 * n;
                f32x4 c0 = (f32x4){0.f, 0.f, 0.f, 0.f}, c1 = c0;
                if (u.pn == 0) c0 = *(const f32x4*)(w0 + c); else if (u.pn == 1) { c0 = *(const f32x4*)(a0 + c); c1 = *(const f32x4*)(ka + c); }
#pragma unroll
                for (int ai = 0; ai < 2; ++ai)
#pragma unroll
                    for (int m = 0; m < 4; ++m) { const size_t o = (size_t)(row0 + ai * 128 + m * 16) * 256 + c; const f32x4 x = acc[ai][bj][m][n];
                        if (u.pn == 0) { f32x4 w;
#pragma unroll
                            for (int j = 0; j < 4; ++j) w[j] = __expf(-sigm(c0[j] + x[j]) * 0.60653065971f);
                            *(f32x4*)(RWw + o) = w; }
                        else if (u.pn == 1) { const f32x4 k = *(const f32x4*)(RWk + o), kk = *(const f32x4*)(RWkk + o); f32x4 k2, kka;
#pragma unroll
                            for (int j = 0; j < 4; ++j) { const float a = sigm(c0[j] + x[j]); k2[j] = k[j] * (1.f + (a - 1.f) * c1[j]); kka[j] = kk[j] * a; }
                            *(f32x4*)(RWk + o) = k2; *(f32x4*)(RWkka + o) = kka; }
                        else *(f32x4*)(RWg + o) = x;
                        asm volatile("" ::: "memory"); } }
    }
};
__device__ __forceinline__ void ph_lora(KP p, int l, LAS unsigned char* lds) {
    SchedLoraPlus S{(const char*)(p->ws + WS_LORA_A), (const char*)(p->ws + WS_WLORA), (const char*)(p->ws + WS_XB), (const char*)(p->ws + WS_WIN), (int)blockIdx.x};
    EpiLora E{p->in[I_W0] + l * 256, p->in[I_A0] + l * 256, p->in[I_KA] + l * 256, (float*)(p->ws + WS_RW), (bf16_t*)(p->ws + WS_PMIX)};
    mg::gemm_run(lds, S, E);
}

template <int CTRL, int ROWM, int BANKM> __device__ __forceinline__ float dpp_add(float acc, float src) {
    return acc + __int_as_float(__builtin_amdgcn_update_dpp(0, __float_as_int(src), CTRL, ROWM, BANKM, true));
}
__device__ __forceinline__ float wave_sum_s(float v) {
    float a = v;
    a = dpp_add<0x111, 0xf, 0xf>(a, v); a = dpp_add<0x112, 0xf, 0xf>(a, v); a = dpp_add<0x113, 0xf, 0xf>(a, v);
    a = dpp_add<0x114, 0xf, 0xe>(a, a); a = dpp_add<0x118, 0xf, 0xc>(a, a);
    a = dpp_add<0x142, 0xa, 0xf>(a, a); a = dpp_add<0x143, 0xc, 0xf>(a, a);
    return __int_as_float(__builtin_amdgcn_readlane(__float_as_int(a), 63));
}
typedef float f32x16 __attribute__((ext_vector_type(16)));
constexpr int KT_PITCH = 144, VT_PITCH = 136;
constexpr int AT_K_BYTES = 64 * KT_PITCH, AT_V_BYTES = 64 * VT_PITCH, AT_TILE_BYTES = AT_K_BYTES + AT_V_BYTES + 256;
constexpr float LOG2E = 1.4426950408889634f;
constexpr float NEGBIG = -1e30f;
__device__ __forceinline__ int crow(int reg, int h) { return (reg & 3) + 8 * (reg >> 2) + 4 * h; }
__device__ __forceinline__ unsigned fkey(float f) { const unsigned u = __float_as_uint(f); return (u & 0x80000000u) ? ~u : (u | 0x80000000u); }

__device__ __forceinline__ void at_stage(LAS unsigned char* tile, const bf16_t* Krows, const bf16_t* Vrows, int tid) {
    { const int row = tid >> 3, ch = tid & 7; const u32x4 v = *(const u32x4*)(Krows + (size_t)row * NPM + 8 * ch); *(LAS u32x4*)(tile + row * KT_PITCH + ch * 16) = v; }
    { const int kv = tid & 63, dch = tid >> 6; const u32x4 v = *(const u32x4*)(Vrows + (size_t)kv * NPM + 8 * dch);
      LAS bf16_t* vt = (LAS bf16_t*)(tile + AT_K_BYTES + (8 * dch) * VT_PITCH) + kv; constexpr int P2 = VT_PITCH / 2;
      vt[0 * P2] = (bf16_t)(v.x & 0xffffu); vt[1 * P2] = (bf16_t)(v.x >> 16); vt[2 * P2] = (bf16_t)(v.y & 0xffffu); vt[3 * P2] = (bf16_t)(v.y >> 16);
      vt[4 * P2] = (bf16_t)(v.z & 0xffffu); vt[5 * P2] = (bf16_t)(v.z >> 16); vt[6 * P2] = (bf16_t)(v.w & 0xffffu); vt[7 * P2] = (bf16_t)(v.w >> 16); }
}
struct AtRegs { u32x4 k, v; };
__device__ __forceinline__ AtRegs at_gload(const bf16_t* Krows, const bf16_t* Vrows, int tid) {
    AtRegs a; a.k = *(const u32x4*)(Krows + (size_t)(tid >> 3) * NPM + 8 * (tid & 7)); a.v = *(const u32x4*)(Vrows + (size_t)(tid & 63) * NPM + 8 * (tid >> 6)); return a;
}
__device__ __forceinline__ void at_sstore(LAS unsigned char* tile, const AtRegs& a, int tid) {
    *(LAS u32x4*)(tile + (tid >> 3) * KT_PITCH + (tid & 7) * 16) = a.k;
    const u32x4 v = a.v; LAS bf16_t* vt = (LAS bf16_t*)(tile + AT_K_BYTES + (8 * (tid >> 6)) * VT_PITCH) + (tid & 63); constexpr int P2 = VT_PITCH / 2;
    vt[0 * P2] = (bf16_t)(v.x & 0xffffu); vt[1 * P2] = (bf16_t)(v.x >> 16); vt[2 * P2] = (bf16_t)(v.y & 0xffffu); vt[3 * P2] = (bf16_t)(v.y >> 16);
    vt[4 * P2] = (bf16_t)(v.z & 0xffffu); vt[5 * P2] = (bf16_t)(v.z >> 16); vt[6 * P2] = (bf16_t)(v.w & 0xffffu); vt[7 * P2] = (bf16_t)(v.w >> 16);
}
__device__ __forceinline__ void at_qk(f32x16& p0, f32x16& p1, const LAS unsigned char* Kt, const bf16x8 (&qr)[4], int r, int h) {
#pragma unroll
    for (int i = 0; i < 16; ++i) { p0[i] = 0.f; p1[i] = 0.f; }
#pragma unroll
    for (int ds = 0; ds < 4; ++ds) {
        const bf16x8 a0 = *(const LAS bf16x8*)(Kt + r * KT_PITCH + (16 * ds + 8 * h) * 2);
        const bf16x8 a1 = *(const LAS bf16x8*)(Kt + (32 + r) * KT_PITCH + (16 * ds + 8 * h) * 2);
        p0 = __builtin_amdgcn_mfma_f32_32x32x16_bf16(a0, qr[ds], p0, 0, 0, 0);
        p1 = __builtin_amdgcn_mfma_f32_32x32x16_bf16(a1, qr[ds], p1, 0, 0, 0);
    }
}
__device__ __forceinline__ void at_pv(f32x16 (&o)[2], const LAS unsigned char* Vt, const bf16x8 (&pk)[4], int r, int h) {
#pragma unroll
    for (int dh = 0; dh < 2; ++dh)
#pragma unroll
        for (int ks = 0; ks < 4; ++ks) { const LAS unsigned char* bp = Vt + (32 * dh + r) * VT_PITCH + (16 * ks + 4 * h) * 2;
            const u32x2 lo = *(const LAS u32x2*)bp, hi = *(const LAS u32x2*)(bp + 16);
            const u32x4 av = (u32x4){lo.x, lo.y, hi.x, hi.y};
            o[dh] = __builtin_amdgcn_mfma_f32_32x32x16_bf16(__builtin_bit_cast(bf16x8, av), pk[ks], o[dh], 0, 0, 0); }
}
template <bool BIAS, bool MASK, bool DSAM = false>
__device__ __forceinline__ void at_softmax(f32x16& p0, f32x16& p1, float& m, float& l, f32x16 (&o)[2], bf16x8 (&pk)[4], float sc2, const LAS float* bias2, int kmax, int h, unsigned mb = 0u) {
    float mt = NEGBIG;
#pragma unroll
    for (int g = 0; g < 4; ++g) {
        f32x4 b0 = (f32x4){0.f, 0.f, 0.f, 0.f}, b1 = b0;
        if (BIAS) { b0 = *(const LAS f32x4*)(bias2 + 8 * g + 4 * h); b1 = *(const LAS f32x4*)(bias2 + 32 + 8 * g + 4 * h); }
#pragma unroll
        for (int j = 0; j < 4; ++j) { const int reg = 4 * g + j, kv = 8 * g + 4 * h + j;
            float x0 = p0[reg] * sc2 + b0[j], x1 = p1[reg] * sc2 + b1[j];
            if (MASK) { if (kv > kmax) x0 = NEGBIG; if (kv + 32 > kmax) x1 = NEGBIG; }
            if (DSAM) { if (!((mb >> reg) & 1u)) x0 = NEGBIG; if (!((mb >> (16 + reg)) & 1u)) x1 = NEGBIG; }
            p0[reg] = x0; p1[reg] = x1; mt = fmaxf(mt, fmaxf(x0, x1)); }
    }
    mt = fmaxf(mt, __shfl_xor(mt, 32));
    const float mn = fmaxf(m, mt);
    if (__any(mn > m)) { const float al = __builtin_amdgcn_exp2f(m - mn); l *= al;
#pragma unroll
        for (int i = 0; i < 16; ++i) { o[0][i] *= al; o[1][i] *= al; }
        m = mn; }
    float s = 0.f;
#pragma unroll
    for (int i = 0; i < 16; ++i) { const float e0 = (p0[i] > -1e29f) ? __builtin_amdgcn_exp2f(p0[i] - m) : 0.f, e1 = (p1[i] > -1e29f) ? __builtin_amdgcn_exp2f(p1[i] - m) : 0.f; p0[i] = e0; p1[i] = e1; s += e0 + e1; }
    l += s;
#pragma unroll
    for (int ks = 0; ks < 2; ++ks) { u32x4 w0, w1;
        w0.x = pk2(p0[8 * ks + 0], p0[8 * ks + 1]); w0.y = pk2(p0[8 * ks + 2], p0[8 * ks + 3]); w0.z = pk2(p0[8 * ks + 4], p0[8 * ks + 5]); w0.w = pk2(p0[8 * ks + 6], p0[8 * ks + 7]);
        w1.x = pk2(p1[8 * ks + 0], p1[8 * ks + 1]); w1.y = pk2(p1[8 * ks + 2], p1[8 * ks + 3]); w1.z = pk2(p1[8 * ks + 4], p1[8 * ks + 5]); w1.w = pk2(p1[8 * ks + 6], p1[8 * ks + 7]);
        pk[ks] = __builtin_bit_cast(bf16x8, w0); pk[2 + ks] = __builtin_bit_cast(bf16x8, w1); }
}
__device__ __forceinline__ void at_loadq(bf16x8 (&qr)[4], const bf16_t* qrow, int h) {
#pragma unroll
    for (int ds = 0; ds < 4; ++ds) qr[ds] = *(const bf16x8*)(qrow + 16 * ds + 8 * h);
}
__device__ __forceinline__ void at_store(bf16_t* orow, const f32x16 (&o)[2], float inv, int h) {
#pragma unroll
    for (int dh = 0; dh < 2; ++dh)
#pragma unroll
        for (int g = 0; g < 4; ++g) { u32x2 w; w.x = pk2(o[dh][4 * g] * inv, o[dh][4 * g + 1] * inv); w.y = pk2(o[dh][4 * g + 2] * inv, o[dh][4 * g + 3] * inv);
            *(u32x2*)(orow + 32 * dh + 8 * g + 4 * h) = w; }
}

__device__ __forceinline__ void fox_unit(KP p, int bh, int qb, LAS unsigned char* lds) {
    const int tid = my_tid(), lane = tid & 63, wave = tid >> 6, r = lane & 31, h = lane >> 5, wv = wave & 3, g = wave >> 2;
    const int b = bh >> 2, hd = bh & 3;
    const bf16_t* P = (const bf16_t*)(p->ws + WS_PMIX) + (size_t)b * SEQ * NPM; bf16_t* OCT = (bf16_t*)(p->ws + WS_OCAT); const float* FC = (const float*)(p->ws + WS_FOXC) + (size_t)bh * SEQ;
    const int q0 = 128 * qb, qbase = q0 + 32 * wv; const float cref = FC[q0];
    bf16x8 qr[4]; at_loadq(qr, P + (size_t)(qbase + r) * NPM + C_FOX_Q + hd * 64, h);
    f32x16 o[2]; float m = NEGBIG, l = 0.f;
#pragma unroll
    for (int i = 0; i < 16; ++i) { o[0][i] = 0.f; o[1][i] = 0.f; }
    const bf16_t* Kc = P + C_FOX_K + hd * 64; const bf16_t* Vc = P + C_FOX_V + hd * 64;
    AtRegs pre0 = at_gload(Kc, Vc, tid), pre1 = at_gload(Kc + (size_t)64 * NPM, Vc + (size_t)64 * NPM, tid);
    float bpre = (tid < 128) ? FC[tid] : 0.f;
#pragma unroll 1
    for (int st = 0; st <= qb; ++st) {
        __syncthreads();
        at_sstore(lds, pre0, tid); at_sstore(lds + AT_TILE_BYTES, pre1, tid);
        if (tid < 128) ((LAS float*)(lds + (tid >> 6) * AT_TILE_BYTES + AT_K_BYTES + AT_V_BYTES))[tid & 63] = (cref - bpre) * LOG2E;
        __syncthreads();
        if (st < qb) { const size_t ko = (size_t)(128 * (st + 1)) * NPM; pre0 = at_gload(Kc + ko, Vc + ko, tid); pre1 = at_gload(Kc + ko + (size_t)64 * NPM, Vc + ko + (size_t)64 * NPM, tid);
            if (tid < 128) bpre = FC[128 * (st + 1) + tid]; }
        const int k0 = 64 * (2 * st + g); const LAS unsigned char* tile = lds + g * AT_TILE_BYTES;
        if (k0 <= qbase + 31) {
            f32x16 p0, p1; bf16x8 pk[4];
            at_qk(p0, p1, tile, qr, r, h);
            const LAS float* b2 = (const LAS float*)(tile + AT_K_BYTES + AT_V_BYTES);
            if (k0 + 63 > qbase) at_softmax<true, true>(p0, p1, m, l, o, pk, 0.125f * LOG2E, b2, qbase + r - k0, h);
            else at_softmax<true, false>(p0, p1, m, l, o, pk, 0.125f * LOG2E, b2, 0, h);
            at_pv(o, tile + AT_K_BYTES, pk, r, h);
        }
    }
    __syncthreads();
    LAS float* cb = (LAS float*)lds + (size_t)wv * (34 * 64);
    if (g == 1) { cb[lane] = m; cb[64 + lane] = l;
#pragma unroll
        for (int i = 0; i < 16; ++i) { cb[(2 + i) * 64 + lane] = o[0][i]; cb[(18 + i) * 64 + lane] = o[1][i]; } }
    __syncthreads();
    if (g == 0) { const float mb = cb[lane], lb = cb[64 + lane]; const float M = fmaxf(m, mb), sa = __builtin_amdgcn_exp2f(m - M), sb = __builtin_amdgcn_exp2f(mb - M);
        l = l * sa + lb * sb;
#pragma unroll
        for (int i = 0; i < 16; ++i) { o[0][i] = o[0][i] * sa + cb[(2 + i) * 64 + lane] * sb; o[1][i] = o[1][i] * sa + cb[(18 + i) * 64 + lane] * sb; }
        const float lt = l + __shfl_xor(l, 32);
        at_store(OCT + (size_t)(b * SEQ + qbase + r) * OC + 768 + hd * 64, o, 1.f / lt, h); }
}
__device__ __forceinline__ void swa_unit(KP p, int l_, int item, LAS unsigned char* lds) {
    const int tid = my_tid(), lane = tid & 63, wave = tid >> 6, r = lane & 31, h = lane >> 5;
    const int hk = item & 1, c = (item >> 1) & 31, b = item >> 6, head = hk * 4 + (wave >> 1), qpos = c * 64 + 32 * (wave & 1);
    const bf16_t* P = (const bf16_t*)(p->ws + WS_PMIX) + (size_t)b * SEQ * NPM; bf16_t* OCT = (bf16_t*)(p->ws + WS_OCAT);
    bf16x8 qr[4]; at_loadq(qr, P + (size_t)(qpos + r) * NPM + C_SWA_Q + head * 64, h);
    f32x16 o[2]; float m = p->in[I_SINKS][l_ * 8 + head] * LOG2E, l = (h == 0) ? 1.f : 0.f;
#pragma unroll
    for (int i = 0; i < 16; ++i) { o[0][i] = 0.f; o[1][i] = 0.f; }
    const int nch = (c + 1 < 3) ? (c + 1) : 3;
    const bf16_t* Kc = P + (size_t)(64 * (c - nch + 1)) * NPM + C_SWA_K + hk * 64; const bf16_t* Vc = P + (size_t)(64 * (c - nch + 1)) * NPM + C_SWA_V + hk * 64;
    AtRegs pre = at_gload(Kc, Vc, tid);
#pragma unroll 1
    for (int st = 0; st < nch; ++st) {
        __syncthreads();
        at_sstore(lds, pre, tid);
        __syncthreads();
        if (st + 1 < nch) pre = at_gload(Kc + (size_t)(64 * (st + 1)) * NPM, Vc + (size_t)(64 * (st + 1)) * NPM, tid);
        f32x16 p0, p1; bf16x8 pk[4];
        at_qk(p0, p1, lds, qr, r, h);
        at_softmax<false, false>(p0, p1, m, l, o, pk, 0.125f * LOG2E, nullptr, 0, h);
        at_pv(o, lds + AT_K_BYTES, pk, r, h);
    }
    const float lt = l + __shfl_xor(l, 32);
    at_store(OCT + (size_t)(b * SEQ + qpos + r) * OC + head * 64, o, 1.f / lt, h);
}

__device__ __forceinline__ size_t dsa_chunk_off(int b, int c) { return (size_t)b * (4096 * 528) + (size_t)4096 * (c * (c + 1) / 2); }
__device__ __forceinline__ void dsa_scores(KP p, LAS unsigned char* lds) {
    const int tid = my_tid(), lane = tid & 63, wave = tid >> 6, r = lane & 31, h = lane >> 5;
    const bf16_t* Pm = (const bf16_t*)(p->ws + WS_PMIX); float* SCR = (float*)(p->ws + WS_SCORES);
    LAS float* tb = (LAS float*)(lds + wave * (32 * 36 * 4));
    const int gw = blockIdx.x * 8 + wave, NGW = gridDim.x * 8;
    constexpr int PERB = 1036;
    for (int it = gw; it < NB * PERB; it += NGW) {
        const int b = it / PERB; int rem = it % PERB; const int qh = rem & 1; rem >>= 1;
        int c = 4; { int acc = 0; while (rem >= acc + c + 1) { acc += c + 1; ++c; } rem -= acc; } const int kb = rem;
        const bf16_t* Pb = Pm + (size_t)b * SEQ * NPM; const int qbase = c * 64 + 32 * qh;
        const bf16_t* qrow = Pb + (size_t)(qbase + r) * NPM;
        float wq[4];
#pragma unroll
        for (int hh = 0; hh < 4; ++hh) wq[hh] = bf2f(qrow[C_WIDX + hh]) * 0.0625f;
        float* dst = SCR + dsa_chunk_off(b, c) + (size_t)(32 * qh) * (64 * (c + 1)) + 64 * kb;
        bf16x8 qf[4][4], kf[2][4];
#pragma unroll
        for (int hh = 0; hh < 4; ++hh)
#pragma unroll
            for (int ds = 0; ds < 4; ++ds) qf[hh][ds] = *(const bf16x8*)(qrow + C_DSA_QI + hh * 64 + 16 * ds + 8 * h);
#pragma unroll
        for (int kh = 0; kh < 2; ++kh)
#pragma unroll
            for (int ds = 0; ds < 4; ++ds) kf[kh][ds] = *(const bf16x8*)(Pb + (size_t)(64 * kb + 32 * kh + r) * NPM + C_DSA_KI + 16 * ds + 8 * h);
#pragma unroll
        for (int kh = 0; kh < 2; ++kh) {
            f32x16 sc;
#pragma unroll
            for (int i = 0; i < 16; ++i) sc[i] = 0.f;
#pragma unroll
            for (int hh = 0; hh < 4; ++hh) { f32x16 a;
#pragma unroll
                for (int i = 0; i < 16; ++i) a[i] = 0.f;
#pragma unroll
                for (int ds = 0; ds < 4; ++ds) a = __builtin_amdgcn_mfma_f32_32x32x16_bf16(kf[kh][ds], qf[hh][ds], a, 0, 0, 0);
#pragma unroll
                for (int i = 0; i < 16; ++i) sc[i] += fmaxf(a[i], 0.f) * wq[hh]; }
#pragma unroll
            for (int g = 0; g < 4; ++g) *(LAS f32x4*)(tb + r * 36 + 8 * g + 4 * h) = (f32x4){sc[4 * g] + 0.f, sc[4 * g + 1] + 0.f, sc[4 * g + 2] + 0.f, sc[4 * g + 3] + 0.f};
            LDS_FENCE();
#pragma unroll
            for (int i = 0; i < 4; ++i) { const int q = 8 * i + (lane >> 3), cc = (lane & 7) * 4; const f32x4 v = *(const LAS f32x4*)(tb + q * 36 + cc);
                *(f32x4*)(dst + (size_t)q * (64 * (c + 1)) + 32 * kh + cc) = v; }
            LDS_FENCE();
        }
    }
}
__device__ __forceinline__ int count_ge8(int cnt, unsigned cand, unsigned k0, unsigned k1, unsigned k2, unsigned k3, unsigned k4, unsigned k5, unsigned k6, unsigned k7) {
    int t; unsigned long long m0, m1, m2, m3;
    asm volatile("v_cmp_ge_u32_e64 %2, %7, %6\n\tv_cmp_ge_u32_e64 %3, %8, %6\n\tv_cmp_ge_u32_e64 %4, %9, %6\n\tv_cmp_ge_u32_e64 %5, %10, %6\n\t"
                 "s_bcnt1_i32_b64 %1, %2\n\ts_add_i32 %0, %0, %1\n\tv_cmp_ge_u32_e64 %2, %11, %6\n\t"
                 "s_bcnt1_i32_b64 %1, %3\n\ts_add_i32 %0, %0, %1\n\tv_cmp_ge_u32_e64 %3, %12, %6\n\t"
                 "s_bcnt1_i32_b64 %1, %4\n\ts_add_i32 %0, %0, %1\n\tv_cmp_ge_u32_e64 %4, %13, %6\n\t"
                 "s_bcnt1_i32_b64 %1, %5\n\ts_add_i32 %0, %0, %1\n\tv_cmp_ge_u32_e64 %5, %14, %6\n\t"
                 "s_bcnt1_i32_b64 %1, %2\n\ts_add_i32 %0, %0, %1\n\t"
                 "s_bcnt1_i32_b64 %1, %3\n\ts_add_i32 %0, %0, %1\n\t"
                 "s_bcnt1_i32_b64 %1, %4\n\ts_add_i32 %0, %0, %1\n\t"
                 "s_bcnt1_i32_b64 %1, %5\n\ts_add_i32 %0, %0, %1"
                 : "+s"(cnt), "=&s"(t), "=&s"(m0), "=&s"(m1), "=&s"(m2), "=&s"(m3)
                 : "v"(cand), "v"(k0), "v"(k1), "v"(k2), "v"(k3), "v"(k4), "v"(k5), "v"(k6), "v"(k7) : "scc");
    return cnt;
}
__device__ __forceinline__ int count_lane4(int cnt, unsigned cand, unsigned k0, unsigned k1, unsigned k2, unsigned k3) {
    asm volatile("v_cmp_ge_u32_e32 vcc, %2, %1\n\tv_addc_co_u32_e32 %0, vcc, 0, %0, vcc\n\t"
                 "v_cmp_ge_u32_e32 vcc, %3, %1\n\tv_addc_co_u32_e32 %0, vcc, 0, %0, vcc\n\t"
                 "v_cmp_ge_u32_e32 vcc, %4, %1\n\tv_addc_co_u32_e32 %0, vcc, 0, %0, vcc\n\t"
                 "v_cmp_ge_u32_e32 vcc, %5, %1\n\tv_addc_co_u32_e32 %0, vcc, 0, %0, vcc"
                 : "+v"(cnt) : "v"(cand), "v"(k0), "v"(k1), "v"(k2), "v"(k3) : "vcc");
    return cnt;
}
__device__ __forceinline__ int count_ge32(const unsigned (&key)[32], unsigned cand) {
    int cnt = 0;
#pragma unroll
    for (int i = 0; i < 32; i += 8) cnt = count_ge8(cnt, cand, key[i], key[i + 1], key[i + 2], key[i + 3], key[i + 4], key[i + 5], key[i + 6], key[i + 7]);
    return cnt;
}
__device__ __forceinline__ void dsa_select(KP p, LAS unsigned char* lds) {
    const int tid = my_tid(), lane0 = tid & 63, wave = tid >> 6, gw = blockIdx.x * 8 + wave, NGW = gridDim.x * 8;
#pragma unroll 1
    for (int it = gw; it < NB * 28 * 64; it += NGW) {
        int lane = lane0; asm volatile("" : "+v"(lane));
        const int b = it / (28 * 64), rem = it % (28 * 64), c = 4 + (rem >> 6), ql = rem & 63, nadm = 64 * (c + 1);
        const float* srow = (const float*)(p->ws + WS_SCORES) + dsa_chunk_off(b, c) + (size_t)ql * nadm;
        unsigned key[32];
#pragma unroll
        for (int i = 0; i < 32; ++i) { const int kv = 64 * i + lane; key[i] = __float_as_uint(srow[kv < nadm ? kv : nadm - 1]); }
#pragma unroll
        for (int i = 0; i < 32; ++i) asm volatile("" : "+v"(key[i]));
#pragma unroll
        for (int i = 0; i < 32; ++i) { const int kv = 64 * i + lane; key[i] = (kv < nadm) ? fkey(__uint_as_float(key[i]) + 0.f) : 0u; }
        unsigned Tk = 0u;
#define SEL_COUNT(cnt_, cand_) do { int cl_ = 0; cl_ = count_lane4(cl_, cand_, key[0], key[1], key[2], key[3]); \
            cnt_ = count_ge8(0, cand_, key[4], key[5], key[6], key[7], key[8], key[9], key[10], key[11]); \
            if (c >= 12) { cl_ = count_lane4(cl_, cand_, key[12], key[13], key[14], key[15]); \
                if (c >= 16) { cnt_ = count_ge8(cnt_, cand_, key[16], key[17], key[18], key[19], key[20], key[21], key[22], key[23]); \
                    if (c >= 24) { cl_ = count_lane4(cl_, cand_, key[24], key[25], key[26], key[27]); if (c >= 28) cl_ = count_lane4(cl_, cand_, key[28], key[29], key[30], key[31]); } } } \
            cnt_ += (int)wave_sum_s((float)cl_); } while (0)
#pragma unroll 1
        for (int bit = 31; bit >= 12; --bit) { const unsigned cand = Tk | (1u << bit); int cnt; SEL_COUNT(cnt, cand); if (cnt >= 256) Tk = cand; }
        { const unsigned pfx = Tk >> 12; unsigned e0 = 0u, e1 = 0u; int nb = 0;
#pragma unroll
            for (int i = 0; i < 32; ++i) { const bool inb = (key[i] >> 12) == pfx && key[i] != 0u; e1 = (inb && nb == 1) ? key[i] : e1; e0 = (inb && nb == 0) ? key[i] : e0; nb += inb ? 1 : 0; }
            if (__any(nb > 2)) {
#pragma unroll 1
                for (int bit = 11; bit >= 0; --bit) { const unsigned cand = Tk | (1u << bit); int cnt; SEL_COUNT(cnt, cand); if (cnt >= 256) Tk = cand; }
            } else {
                int above = 0; if (pfx != 0xfffffu) { SEL_COUNT(above, Tk + 0x1000u); }
                const int need = 256 - above;
#pragma unroll 1
                for (int bit = 11; bit >= 0; --bit) { const unsigned cand = Tk | (1u << bit); const int cl = ((e0 >= cand) ? 1 : 0) + ((e1 >= cand) ? 1 : 0);
                    if ((int)wave_sum_s((float)cl) >= need) Tk = cand; }
            }
        }
#undef SEL_COUNT
        const int cge = count_ge32(key, Tk), cgt = count_ge32(key, Tk + 1u), quota = 256 - cgt, nt = cge - cgt;
        int cut = -1, acc = 0; const unsigned long long ltm = (1ull << lane) - 1ull;
#pragma unroll
        for (int i = 0; i < 32; ++i) { const unsigned long long tm = __ballot(key[i] == Tk); const int n = __builtin_popcountll(tm);
            if (acc < quota && acc + n >= quota) { const unsigned long long hit = __ballot(key[i] == Tk && __builtin_popcountll(tm & ltm) == quota - acc - 1); cut = 64 * i + (int)__builtin_ctzll(hit); }
            acc += n; }
        (void)nt;
        unsigned long long mine = 0ull;
#pragma unroll
        for (int i = 0; i < 32; ++i) { const unsigned long long sm = __ballot((key[i] > Tk) || (key[i] == Tk && 64 * i + lane <= cut)); mine = (lane == i) ? sm : mine; }
        if (lane < 32) ((unsigned long long*)(p->ws + WS_MASKB))[(size_t)(b * SEQ + c * 64 + ql) * 32 + lane] = mine;
    }
}
__device__ __forceinline__ void dsa_unit(KP p, int b, int c, int hp, LAS unsigned char* lds) {
    const int tid = my_tid(), lane = tid & 63, wave = tid >> 6, r = lane & 31, h = lane >> 5, wv = wave & 3, g = wave >> 2;
    const bf16_t* P = (const bf16_t*)(p->ws + WS_PMIX) + (size_t)b * SEQ * NPM; bf16_t* OCT = (bf16_t*)(p->ws + WS_OCAT);
    const int nadm = 64 * (c + 1);
    const float* SCRc = (const float*)(p->ws + WS_SCORES) + dsa_chunk_off(b, c);
    const bool sel = nadm > 256;
    const int head = 2 * hp + (wv >> 1), ql = 32 * (wv & 1) + r, qbase = 64 * c + 32 * (wv & 1);
    const unsigned long long* mrow = (const unsigned long long*)(p->ws + WS_MASKB) + (size_t)(b * SEQ + c * 64 + ql) * 32;
    bf16x8 qr[4]; at_loadq(qr, P + (size_t)(qbase + r) * NPM + C_DSA_Q + head * 64, h);
    f32x16 o[2]; float m = NEGBIG, l = 0.f;
#pragma unroll
    for (int i = 0; i < 16; ++i) { o[0][i] = 0.f; o[1][i] = 0.f; }
    const int nst = (c + 2) >> 1;
    const bf16_t* Kc = P + C_DSA_K; const bf16_t* Vc = P + C_DSA_V;
    AtRegs pre0 = at_gload(Kc, Vc, tid), pre1 = at_gload(Kc + (size_t)((c >= 1) ? 64 : 0) * NPM, Vc + (size_t)((c >= 1) ? 64 : 0) * NPM, tid);
#pragma unroll 1
    for (int st = 0; st < nst; ++st) {
        __syncthreads();
        at_sstore(lds, pre0, tid); at_sstore(lds + AT_TILE_BYTES, pre1, tid);
        __syncthreads();
        if (st + 1 < nst) { const int j0 = 2 * st + 2, j1 = (j0 + 1 <= c) ? j0 + 1 : j0; pre0 = at_gload(Kc + (size_t)(64 * j0) * NPM, Vc + (size_t)(64 * j0) * NPM, tid); pre1 = at_gload(Kc + (size_t)(64 * j1) * NPM, Vc + (size_t)(64 * j1) * NPM, tid); }
        const int jt = 2 * st + g; const LAS unsigned char* tile = lds + g * AT_TILE_BYTES;
        if (jt <= c) {
            unsigned mb = 0u;
            if (sel) { const unsigned long long m64 = mrow[jt] >> (4 * h);
#pragma unroll
                for (int kvh = 0; kvh < 2; ++kvh)
#pragma unroll
                    for (int reg = 0; reg < 16; ++reg) mb |= (unsigned)((m64 >> (32 * kvh + (reg & 3) + 8 * (reg >> 2))) & 1ull) << (16 * kvh + reg); }
            f32x16 p0, p1; bf16x8 pk[4];
            at_qk(p0, p1, tile, qr, r, h);
            if (sel) at_softmax<false, false, true>(p0, p1, m, l, o, pk, 0.125f * LOG2E, nullptr, 0, h, mb);
            else at_softmax<false, false>(p0, p1, m, l, o, pk, 0.125f * LOG2E, nullptr, 0, h);
            at_pv(o, tile + AT_K_BYTES, pk, r, h);
        }
    }
    __syncthreads();
    LAS float* cb = (LAS float*)lds + (size_t)wv * (34 * 64);
    if (g == 1) { cb[lane] = m; cb[64 + lane] = l;
#pragma unroll
        for (int i = 0; i < 16; ++i) { cb[(2 + i) * 64 + lane] = o[0][i]; cb[(18 + i) * 64 + lane] = o[1][i]; } }
    __syncthreads();
    if (g == 0) { const float mb = cb[lane], lb = cb[64 + lane]; const float M = fmaxf(m, mb), sa = __builtin_amdgcn_exp2f(m - M), sb = __builtin_amdgcn_exp2f(mb - M);
        l = l * sa + lb * sb;
#pragma unroll
        for (int i = 0; i < 16; ++i) { o[0][i] = o[0][i] * sa + cb[(2 + i) * 64 + lane] * sb; o[1][i] = o[1][i] * sa + cb[(18 + i) * 64 + lane] * sb; }
        const float lt = l + __shfl_xor(l, 32);
        at_store(OCT + (size_t)(b * SEQ + qbase + r) * OC + 1024 + head * 64, o, 1.f / lt, h); }
}

template <int N> __device__ __forceinline__ float dpp_ror(float x) { return __int_as_float(__builtin_amdgcn_update_dpp(0, __float_as_int(x), 0x120 + N, 0xf, 0xf, false)); }
__device__ __forceinline__ void row16_sum2(float& a, float& b) {
    a += dpp_ror<8>(a); b += dpp_ror<8>(b); a += dpp_ror<4>(a); b += dpp_ror<4>(b); a += dpp_ror<2>(a); b += dpp_ror<2>(b); a += dpp_ror<1>(a); b += dpp_ror<1>(b);
}
__device__ __forceinline__ float row16_sum(float x) { x += dpp_ror<8>(x); x += dpp_ror<4>(x); x += dpp_ror<2>(x); x += dpp_ror<1>(x); return x; }
__device__ __forceinline__ void rwkv_scan2(KP p, int l, int sw, LAS unsigned char* lds) {
    const int tid = my_tid(), lane = tid & 63, wave = tid >> 6; const int bh = sw >> 2, b = bh >> 2, h = bh & 3, rowbase = 16 * (sw & 3);
    const int rl = lane >> 4, c = lane & 15, r16 = 4 * (wave & 3) + rl;
    const float* RW = (const float*)(p->ws + WS_RW);
    const float* RWv = RW + (size_t)5 * T * 256; float* Y = (float*)(p->ws + WS_Y); float* BONW = (float*)(p->ws + WS_BONUS); const float rkl = p->in[I_RK][l * 256 + h * 64 + lane];
    LAS float* L = (LAS float*)lds;
    LAS float* Lv = L + 5 * 1024; LAS float* Ly = Lv + 256;
    f32x4 S = (f32x4){0.f, 0.f, 0.f, 0.f}, rprev = (f32x4){0.f, 0.f, 0.f, 0.f};
    const size_t hb = (size_t)b * SEQ * 256 + h * 64;
    f32x2 pre[5]; float vpre = 0.f;
#pragma unroll
    for (int a = 0; a < 5; ++a) { const int e = 2 * tid; pre[a] = *(const f32x2*)(RW + (size_t)a * T * 256 + hb + (size_t)(e >> 6) * 256 + (e & 63)); }
    if (tid < 256) vpre = RWv[hb + (size_t)(tid >> 4) * 256 + rowbase + (tid & 15)];
#pragma unroll 1
    for (int tb = 0; tb < SEQ; tb += 16) {
        __syncthreads();
        if (tb > 0 && tid < 256) { const int st = tb - 17 + (tid >> 4); if (st >= 0) Y[hb + (size_t)st * 256 + rowbase + (tid & 15)] = Ly[tid]; }
#pragma unroll
        for (int a = 0; a < 5; ++a) *(LAS f32x2*)(L + a * 1024 + 2 * tid) = pre[a];
        if (tid < 256) Lv[tid] = vpre;
        __syncthreads();
        if (tb + 16 < SEQ) {
#pragma unroll
            for (int a = 0; a < 5; ++a) { const int e = 2 * tid; pre[a] = *(const f32x2*)(RW + (size_t)a * T * 256 + hb + (size_t)(tb + 16 + (e >> 6)) * 256 + (e & 63)); }
            if (tid < 256) vpre = RWv[hb + (size_t)(tb + 16 + (tid >> 4)) * 256 + rowbase + (tid & 15)];
        }
        if ((sw & 3) == 0 && wave >= 4) {
#pragma unroll
            for (int i4 = 0; i4 < 4; ++i4) { const int i = 4 * (wave - 4) + i4; const float s = wave_sum(L[0 * 1024 + i * 64 + lane] * L[2 * 1024 + i * 64 + lane] * rkl);
                if (lane == 0) BONW[(size_t)(b * SEQ + tb + i) * 4 + h] = s; }
        }
        if (wave < 4) {
            f32x4 r_ = *(const LAS f32x4*)(L + 0 * 1024 + 4 * c), w_ = *(const LAS f32x4*)(L + 1 * 1024 + 4 * c), k_ = *(const LAS f32x4*)(L + 2 * 1024 + 4 * c);
            f32x4 kk_ = *(const LAS f32x4*)(L + 3 * 1024 + 4 * c), ka_ = *(const LAS f32x4*)(L + 4 * 1024 + 4 * c); float v_ = Lv[r16];
#pragma unroll
            for (int i = 0; i < 16; ++i) {
                f32x4 rn = r_, wn = w_, kn = k_, kkn = kk_, kan = ka_; float vn = v_;
                if (i < 15) { rn = *(const LAS f32x4*)(L + 0 * 1024 + (i + 1) * 64 + 4 * c); wn = *(const LAS f32x4*)(L + 1 * 1024 + (i + 1) * 64 + 4 * c); kn = *(const LAS f32x4*)(L + 2 * 1024 + (i + 1) * 64 + 4 * c);
                    kkn = *(const LAS f32x4*)(L + 3 * 1024 + (i + 1) * 64 + 4 * c); kan = *(const LAS f32x4*)(L + 4 * 1024 + (i + 1) * 64 + 4 * c); vn = Lv[(i + 1) * 16 + r16]; }
                float pa = (S.x * kk_.x + S.y * kk_.y) + (S.z * kk_.z + S.w * kk_.w);
                float py = (S.x * rprev.x + S.y * rprev.y) + (S.z * rprev.z + S.w * rprev.w);
                row16_sum2(pa, py);
                Ly[i * 16 + r16] = py;
                S = S * w_ - ka_ * pa + k_ * v_;
                rprev = r_;
                r_ = rn; w_ = wn; k_ = kn; kk_ = kkn; ka_ = kan; v_ = vn;
            }
        }
    }
    __syncthreads();
    if (tid < 256) { const int st = SEQ - 17 + (tid >> 4); Y[hb + (size_t)st * 256 + rowbase + (tid & 15)] = Ly[tid]; }
    if (wave < 4) { const float py = row16_sum((S.x * rprev.x + S.y * rprev.y) + (S.z * rprev.z + S.w * rprev.w)); if (c == 0) Y[hb + (size_t)(SEQ - 1) * 256 + rowbase + r16] = py; }
}
__device__ __forceinline__ void rwkv_post(KP p, int l) {
    const int tid = my_tid(), lane = tid & 63, wave = tid >> 6, gw = blockIdx.x * 8 + wave, NGW = gridDim.x * 8;
    const float* RW = (const float*)(p->ws + WS_RW); const float* RWv = RW + (size_t)5 * T * 256; const float* RWg = RW + (size_t)6 * T * 256;
    const float* Y = (const float*)(p->ws + WS_Y); const float* BON = (const float*)(p->ws + WS_BONUS); bf16_t* OCT = (bf16_t*)(p->ws + WS_OCAT);
    float gng[4], gnb[4];
#pragma unroll
    for (int hh = 0; hh < 4; ++hh) { gng[hh] = p->in[I_GNG][l * 256 + hh * 64 + lane]; gnb[hh] = p->in[I_GNB][l * 256 + hh * 64 + lane]; }
    for (int t = gw; t < T; t += NGW) {
#pragma unroll
        for (int hh = 0; hh < 4; ++hh) { const size_t o = (size_t)t * 256 + hh * 64 + lane; const float yy = Y[o];
            const float mean = wave_sum(yy) * (1.f / 64.f); const float d = yy - mean; const float var = wave_sum(d * d) * (1.f / 64.f);
            const float ov = (d * rsqrtf(var + 64e-5f) * gng[hh] + gnb[hh] + BON[t * 4 + hh] * RWv[o]) * RWg[o];
            OCT[(size_t)t * OC + 512 + hh * 64 + lane] = (bf16_t)f2bf(ov); }
    }
}

__device__ __forceinline__ void ph_scan(KP p, int l, LAS unsigned char* lds) {
    if (blockIdx.x < 128) { rwkv_scan2(p, l, blockIdx.x, lds); return; }
    const int tid = my_tid(); unsigned* ctl = (unsigned*)(p->ws + WS_CTL) + 512 + 64 * l; LAS int* slot = (LAS int*)(lds + LDS_BYTES - 256);
    for (;;) { if (tid == 0) *slot = (int)atomicAdd(ctl, 1u); __syncthreads(); const int it = *slot; __syncthreads(); if (it >= 512) break; fox_unit(p, it & 31, 15 - (it >> 5), lds); __syncthreads(); }
    for (;;) { if (tid == 0) *slot = (int)atomicAdd(ctl + 16, 1u); __syncthreads(); const int it = *slot; __syncthreads(); if (it >= 512) break; swa_unit(p, l, it, lds); __syncthreads(); }
}
__device__ __forceinline__ void ph_attn(KP p, int l, LAS unsigned char* lds) {
    dsa_scores(p, lds);
    rwkv_post(p, l);
}
__device__ __forceinline__ void ph_dsa_xb(KP p, int l, LAS unsigned char* lds) {
    {
        const int w = blockIdx.x, b = w >> 5, s = (w >> 1) & 15, hp = w & 1;
        dsa_unit(p, b, 31 - s, hp, lds);
        __syncthreads();
        dsa_unit(p, b, s, hp, lds);
        __syncthreads();
    }
}

struct SchedMerge {
    static constexpr int PERM = 1;
    const char* XB; const char* WIN; const char* OCT; const char* WB; int G, c;
    __device__ __forceinline__ bool next(int i, mg::Unit& u) const {
        int pm, pn; if (!mg::static_tile(i >> 3, G, c, T / 256, 4, pm, pn)) return false;
        const int j = i & 7, br = j >> 1; u.pm = pm; u.pn = pn; u.tag = j;
        if ((j & 1) == 0) { u.A = XB + (size_t)pm * 256 * 2048; u.B = WIN + (size_t)(3328 + 1024 * br + 256 * pn) * 2048; u.ld = 2048; u.nt = 16; }
        else { const int koff = (br == 0) ? 0 : 256 + 256 * br, kk = (br == 0) ? 512 : 256;
            u.A = OCT + (size_t)pm * 256 * (OC * 2) + koff * 2; u.B = WB + (size_t)pn * 256 * (OC * 2) + koff * 2; u.ld = OC * 2; u.nt = kk / 64; }
        return true;
    }
};
struct EpiMerge {
    const float* gbias; u32x4* gsc; u32x4* macc; bf16_t* MB;
    __device__ __forceinline__ void operator()(const AccT& acc, const mg::Unit& u, int wr, int wc, int fr, int fq, int tid) const {
        const int br = u.tag >> 1; const int col0 = u.pn * 256 + wc * 32 + 8 * fq, row0 = u.pm * 256 + wr * 64 + fr;
        if ((u.tag & 1) == 0) {
            f32x4 bv[2][2];
#pragma unroll
            for (int bj = 0; bj < 2; ++bj)
#pragma unroll
                for (int n = 0; n < 2; ++n) bv[bj][n] = *(const f32x4*)(gbias + br * 1024 + col0 + bj * 128 + 4 * n);
#pragma unroll
            for (int ai = 0; ai < 2; ++ai)
#pragma unroll
                for (int m = 0; m < 4; ++m)
#pragma unroll
                    for (int bj = 0; bj < 2; ++bj) { f32x4 g[2];
#pragma unroll
                        for (int n = 0; n < 2; ++n) { const f32x4 x = acc[ai][bj][m][n] + bv[bj][n];
#pragma unroll
                            for (int j = 0; j < 4; ++j) g[n][j] = sigm(x[j]); }
                        u32x4 w; w.x = pk2(g[0][0], g[0][1]); w.y = pk2(g[0][2], g[0][3]); w.z = pk2(g[1][0], g[1][1]); w.w = pk2(g[1][2], g[1][3]);
                        gsc[(((ai * 4 + m) * 2 + bj) * 512) + tid] = w; asm volatile("" ::: "memory"); }
        } else {
#pragma unroll
            for (int ai = 0; ai < 2; ++ai)
#pragma unroll
                for (int m = 0; m < 4; ++m) { bf16_t* rowp = MB + (size_t)(row0 + ai * 128 + m * 16) * D + col0;
#pragma unroll
                    for (int bj = 0; bj < 2; ++bj) { const int idx = (((ai * 4 + m) * 2 + bj) * 512) + tid; float g[8], r[8]; unpack8(gsc[idx], g);
#pragma unroll
                        for (int n = 0; n < 2; ++n)
#pragma unroll
                            for (int j = 0; j < 4; ++j) r[4 * n + j] = g[4 * n + j] * acc[ai][bj][m][n][j];
                        if (br > 0) { float pm[8]; unpack8(macc[idx], pm);
#pragma unroll
                            for (int j = 0; j < 8; ++j) r[j] += pm[j]; }
                        u32x4 w; w.x = pk2(r[0], r[1]); w.y = pk2(r[2], r[3]); w.z = pk2(r[4], r[5]); w.w = pk2(r[6], r[7]);
                        if (br < 3) macc[idx] = w; else *(u32x4*)(rowp + bj * 128) = w;
                        asm volatile("" ::: "memory"); } }
        }
    }
};
__device__ __forceinline__ void ph_merge(KP p, int l, LAS unsigned char* lds) {
    SchedMerge S{(const char*)(p->ws + WS_XB2), (const char*)(p->ws + WS_WIN), (const char*)(p->ws + WS_OCAT), (const char*)(p->ws + WS_WB), (int)gridDim.x, (int)blockIdx.x};
    EpiMerge E{p->in[I_GB] + (size_t)l * 4096, (u32x4*)(p->ws + WS_GSC) + (size_t)blockIdx.x * 8192, (u32x4*)(p->ws + WS_MACC) + (size_t)blockIdx.x * 8192, (bf16_t*)(p->ws + WS_MERGED)};
    mg::gemm_run(lds, S, E);
}

struct EpiResid {
    const float* base; float* out; float alpha;
    __device__ __forceinline__ void operator()(const AccT& acc, const mg::Unit& u, int wr, int wc, int fr, int fq, int) const {
        const int row0 = u.pm * 256 + wr * 64 + fr, col0 = u.pn * 256 + wc * 32 + 4 * fq;
#pragma unroll
        for (int ai = 0; ai < 2; ++ai)
#pragma unroll
            for (int m = 0; m < 4; ++m) { const size_t off = (size_t)(row0 + ai * 128 + m * 16) * D + col0;
#pragma unroll
                for (int bj = 0; bj < 2; ++bj)
#pragma unroll
                    for (int n = 0; n < 2; ++n) { const f32x4 bs = *(const f32x4*)(base + off + bj * 128 + n * 16); *(f32x4*)(out + off + bj * 128 + n * 16) = bs * alpha + acc[ai][bj][m][n]; } }
    }
};
__device__ __forceinline__ void ph_outproj(KP p, int l, LAS unsigned char* lds) {
    SchedPlain<0, 4, D> S{(const char*)(p->ws + WS_MERGED), (const char*)(p->ws + WS_WO), (int)gridDim.x, (int)blockIdx.x};
    EpiResid E{(l == 0) ? p->in[I_X] : p->out, p->out, DN_ALPHA};
    mg::gemm_run(lds, S, E);
}

__device__ __forceinline__ void ln_rows(KP p, int l, int mode, LAS unsigned char* lds) {
    const int tid = my_tid(), lane = tid & 63, wave = tid >> 6;
    const float* g = p->in[I_LNG] + (size_t)(l * 2 + mode) * D; const float* bb = p->in[I_LNB] + (size_t)(l * 2 + mode) * D;
    bf16_t* OB = (bf16_t*)(p->ws + (mode == 0 ? WS_X1B : WS_XB)); const bool wb = (mode == 0) || (l == 0);
    const bool moe = (mode == 0) && (l & 1); const float* rw = p->in[I_RTW] + (size_t)(l >> 1) * D * NE; const float* rb = p->in[I_RTB] + (l >> 1) * NE;
    int* TOKE = (int*)(p->ws + WS_TOKE); float* TOKW = (float*)(p->ws + WS_TOKW);
    f32x4 gv[4], bv[4];
#pragma unroll
    for (int j = 0; j < 4; ++j) { gv[j] = *(const f32x4*)(g + 4 * lane + 256 * j); bv[j] = *(const f32x4*)(bb + 4 * lane + 256 * j); }
    const int rows_per_wg = T / gridDim.x;
#pragma unroll 2
    for (int rr = wave; rr < rows_per_wg; rr += 8) {
        const int row = blockIdx.x * rows_per_wg + rr; float* xr = p->out + (size_t)row * D;
        f32x4 v[4]; float s = 0.f;
#pragma unroll
        for (int j = 0; j < 4; ++j) v[j] = *(const f32x4*)(xr + 4 * lane + 256 * j);
        if (mode == 1 && (l & 1)) {
            const int* RO = (const int*)(p->ws + WS_ROWOF); const bf16_t* YB = (const bf16_t*)(p->ws + WS_AG);
#pragma unroll
            for (int sl = 0; sl < 2; ++sl) { const int yr = RO[row * 2 + sl]; const float w = TOKW[row * 2 + sl];
#pragma unroll
                for (int j = 0; j < 4; ++j) { const u32x2 y = *(const u32x2*)(YB + (size_t)yr * D + 4 * lane + 256 * j);
                    v[j].x += w * bflo(y.x); v[j].y += w * bfhi(y.x); v[j].z += w * bflo(y.y); v[j].w += w * bfhi(y.y); } } }
#pragma unroll
        for (int j = 0; j < 4; ++j) s += (v[j].x + v[j].y) + (v[j].z + v[j].w);
        const float mean = wave_sum(s) * (1.f / D); float s2 = 0.f;
#pragma unroll
        for (int j = 0; j < 4; ++j) { v[j] = v[j] - mean; s2 += (v[j].x * v[j].x + v[j].y * v[j].y) + (v[j].z * v[j].z + v[j].w * v[j].w); }
        const float rstd = rsqrtf(wave_sum(s2) * (1.f / D) + LN_EPS);
        const float osc = (mode == 0) ? DN_ALPHA : 1.f;
#pragma unroll
        for (int j = 0; j < 4; ++j) { v[j] = v[j] * rstd * gv[j] + bv[j]; *(f32x4*)(xr + 4 * lane + 256 * j) = v[j] * osc;
            if (wb) *(unsigned long long*)(OB + (size_t)row * D + 4 * lane + 256 * j) = (unsigned long long)pk2(v[j].x, v[j].y) | ((unsigned long long)pk2(v[j].z, v[j].w) << 32); }
        if (moe) {
            float lg[8];
#pragma unroll
            for (int e = 0; e < 8; ++e) lg[e] = 0.f;
#pragma unroll
            for (int j = 0; j < 4; ++j)
#pragma unroll
                for (int q = 0; q < 4; ++q) { const int c = 4 * lane + 256 * j + q; const f32x4 w0 = *(const f32x4*)(rw + (size_t)c * 8), w1 = *(const f32x4*)(rw + (size_t)c * 8 + 4); const float x = v[j][q];
                    lg[0] += x * w0.x; lg[1] += x * w0.y; lg[2] += x * w0.z; lg[3] += x * w0.w; lg[4] += x * w1.x; lg[5] += x * w1.y; lg[6] += x * w1.z; lg[7] += x * w1.w; }
#pragma unroll
            for (int e = 0; e < 8; ++e) lg[e] = wave_sum(lg[e]) + rb[e];
            int e1 = 0; float v1 = lg[0];
#pragma unroll
            for (int e = 1; e < 8; ++e) if (lg[e] > v1) { v1 = lg[e]; e1 = e; }
            int e2 = -1; float v2 = -INFINITY;
#pragma unroll
            for (int e = 0; e < 8; ++e) if (e != e1 && lg[e] > v2) { v2 = lg[e]; e2 = e; }
            const float w1 = 1.f / (1.f + __expf(v2 - v1));
            if (lane == 0) { TOKE[row * 2] = e1; TOKE[row * 2 + 1] = e2; TOKW[row * 2] = w1; TOKW[row * 2 + 1] = 1.f - w1; }
        }
    }
    if (moe) {
        __syncthreads();
        if (tid < 8) { int cnt = 0; for (int rr = 0; rr < rows_per_wg; ++rr) { const int row = blockIdx.x * rows_per_wg + rr; cnt += (TOKE[row * 2] == tid) + (TOKE[row * 2 + 1] == tid); }
            ((int*)(p->ws + WS_WGCNT))[blockIdx.x * 8 + tid] = cnt; }
    }
}
__device__ __forceinline__ void ph_ln1(KP p, int l, LAS unsigned char* lds) {
    ln_rows(p, l, 0, lds);
    __syncthreads();
    const int tid_ = my_tid(); const int lane = tid_ & 63, wave = tid_ >> 6, gw = blockIdx.x * 8 + wave, NGW = gridDim.x * 8;
    LAS float* scr = (LAS float*)(lds + wave * 8448);
    bf16_t* W13 = (bf16_t*)(p->ws + WS_WF13);
    if ((l & 1) == 0) {
        const int j = l >> 1; const float* w1 = p->in[I_F1] + (size_t)j * D * DFF; const float* w3 = p->in[I_F3] + (size_t)j * D * DFF; const float* w2 = p->in[I_F2] + (size_t)j * DFF * D;
        bf16_t* W2 = (bf16_t*)(p->ws + WS_WF2_DENSE);
        const int n1 = tr_nitems(D, DFF), n2 = tr_nitems(DFF, D);
        for (int it = gw; it < 2 * n1 + n2; it += NGW) { int r = it;
            if (r < n1) { tr_item(w1, D, DFF, W13, D, 2, 0, scr, r, lane); continue; } r -= n1;
            if (r < n1) { tr_item(w3, D, DFF, W13, D, 3, 0, scr, r, lane); continue; } r -= n1;
            tr_item(w2, DFF, D, W2, DFF, 0, 0, scr, r, lane); }
    } else {
        const int j = l >> 1; bf16_t* W2 = (bf16_t*)(p->ws + WS_WF2_MOE);
        const int n1 = tr_nitems(D, DFE), n2 = tr_nitems(DFE, D), per = 2 * n1 + n2;
        for (int it = gw; it < NE * per; it += NGW) { const int e = it / per; int r = it % per;
            const float* w1 = p->in[I_E1] + ((size_t)j * NE + e) * D * DFE; const float* w3 = p->in[I_E3] + ((size_t)j * NE + e) * D * DFE; const float* w2 = p->in[I_E2] + ((size_t)j * NE + e) * DFE * D;
            if (r < n1) { tr_item(w1, D, DFE, W13, D, 2, e * 2 * DFE, scr, r, lane); continue; } r -= n1;
            if (r < n1) { tr_item(w3, D, DFE, W13, D, 3, e * 2 * DFE, scr, r, lane); continue; } r -= n1;
            tr_item(w2, DFE, D, W2, DFE, 0, e * D, scr, r, lane); }
    }
}

__device__ __forceinline__ void moe_tables(KP p, LAS int* tb  ) {
    const int tid = my_tid(), lane = tid & 63, e = tid >> 6; const int* WG = (const int*)(p->ws + WS_WGCNT);
    { int tot = 0, mine = 0;
#pragma unroll
        for (int k = 0; k < 4; ++k) { const int w = lane + 64 * k; const int c = (w < (int)gridDim.x) ? WG[w * 8 + e] : 0; tot += c; mine += (w < (int)blockIdx.x) ? c : 0; }
        tot = (int)wave_sum((float)tot); mine = (int)wave_sum((float)mine);
        if (lane == 0) { tb[e] = tot; tb[16 + e] = mine; } }
    __syncthreads();
    if (tid == 0) { int base = 0; for (int x = 0; x < 8; ++x) { tb[8 + x] = base; base += ((tb[x] + 255) >> 8) << 8; } tb[24] = base; }
    __syncthreads();
}
__device__ __forceinline__ void ph_moe_assign(KP p, int l, LAS unsigned char* lds) {
    const int tid = my_tid(), lane = tid & 63, wave = tid >> 6;
    LAS int* tb = (LAS int*)lds; LAS int* rowof = tb + 32;
    moe_tables(p, tb);
    const int rows_per_wg = T / gridDim.x; const int* TOKE = (const int*)(p->ws + WS_TOKE); const float* TOKW = (const float*)(p->ws + WS_TOKW);
    int* ROWTOK = (int*)(p->ws + WS_ROWTOK); float* ROWW = (float*)(p->ws + WS_ROWW);
    LAS int* wcnt = tb + 192;
    if (tid < 128) {
        const int row = blockIdx.x * rows_per_wg + (tid >> 1), s = tid & 1, e = TOKE[row * 2 + s]; const unsigned long long ltm = (1ull << lane) - 1ull;
        int rank = 0;
#pragma unroll
        for (int x = 0; x < 8; ++x) { const unsigned long long m = __ballot(e == x); if (e == x) rank = __builtin_popcountll(m & ltm); if (lane == 0) wcnt[wave * 8 + x] = __builtin_popcountll(m); }
        asm volatile("s_waitcnt lgkmcnt(0)" ::: "memory");
        __builtin_amdgcn_s_barrier();
        if (wave == 1) rank += wcnt[e];
        const int run = tb[8 + e] + tb[16 + e] + rank;
        ROWTOK[run] = row; ROWW[run] = TOKW[row * 2 + s]; rowof[tid] = run; ((int*)(p->ws + WS_ROWOF))[row * 2 + s] = run;
    } else { __builtin_amdgcn_s_barrier(); }
    bf16_t* AG = (bf16_t*)(p->ws + WS_AG);
    if (blockIdx.x < 8) { const int e = blockIdx.x, lo = tb[8 + e] + tb[e], hi = tb[8 + e] + (((tb[e] + 255) >> 8) << 8);
        for (int r = lo + wave; r < hi; r += 8) { if (lane == 0) { ROWTOK[r] = -1; ROWW[r] = 0.f; }
#pragma unroll
            for (int j = 0; j < 2; ++j) *(u32x4*)(AG + (size_t)r * D + 8 * lane + 512 * j) = (u32x4){0u, 0u, 0u, 0u}; } }
    __syncthreads();
    const bf16_t* X1B = (const bf16_t*)(p->ws + WS_X1B);
    for (int pr = wave; pr < rows_per_wg * 2; pr += 8) { const int row = blockIdx.x * rows_per_wg + (pr >> 1), dst = rowof[pr];
#pragma unroll
        for (int j = 0; j < 2; ++j) *(u32x4*)(AG + (size_t)dst * D + 8 * lane + 512 * j) = *(const u32x4*)(X1B + (size_t)row * D + 8 * lane + 512 * j); }
}

struct EpiSwiglu {
    bf16_t* H; int ldh;
    __device__ __forceinline__ void operator()(const AccT& acc, const mg::Unit& u, int wr, int wc, int fr, int fq, int) const {
        const int row0 = u.pm * 256 + wr * 64 + fr, col0 = u.pn * 128 + wc * 32 + 8 * fq;
#pragma unroll
        for (int ai = 0; ai < 2; ++ai)
#pragma unroll
            for (int m = 0; m < 4; ++m) { float hv[8];
#pragma unroll
                for (int n = 0; n < 2; ++n)
#pragma unroll
                    for (int j = 0; j < 4; ++j) { const float a = acc[ai][0][m][n][j], b = acc[ai][1][m][n][j]; hv[4 * n + j] = a * sigm(a) * b; }
                u32x4 w; w.x = pk2(hv[0], hv[1]); w.y = pk2(hv[2], hv[3]); w.z = pk2(hv[4], hv[5]); w.w = pk2(hv[6], hv[7]);
                *(u32x4*)(H + (size_t)(row0 + ai * 128 + m * 16) * ldh + col0) = w; asm volatile("" ::: "memory"); }
    }
};
template <int PERM_, int NN, int K, int BROWS> struct SchedMoe {
    static constexpr int PERM = PERM_;
    const char* A; const char* B; const LAS int* tstart; int G, c;
    __device__ __forceinline__ bool next(int i, mg::Unit& u) const {
        const int L = i * G + c; if (L >= tstart[8] * NN) return false;
        const int rt = L / NN, pn = L % NN; int e = 0;
#pragma unroll
        for (int x = 1; x < 8; ++x) if (rt >= tstart[x]) e = x;
        u.A = A + (size_t)rt * 256 * (K * 2); u.B = B + ((size_t)e * BROWS + (size_t)pn * 256) * (K * 2); u.ld = K * 2; u.nt = K / 64; u.pm = rt; u.pn = pn; u.tag = 0; return true;
    }
};
template <class SM> __device__ __forceinline__ void moe_sched_tiles(KP p, LAS unsigned char* lds, SM& S) {
    LAS int* tb = (LAS int*)(lds + LDS_BYTES - 512);
    moe_tables(p, tb);
    { const int t_ = my_tid(); if (t_ < 8) tb[32 + t_] = tb[8 + t_] >> 8; if (t_ == 8) tb[40] = tb[24] >> 8; }
    __syncthreads();
    S.tstart = tb + 32;
}
__device__ __forceinline__ void ph_ffn_up(KP p, int l, LAS unsigned char* lds) {
    if ((l & 1) == 0) {
        SchedPlain<1, 2 * DFF / 256, D> S{(const char*)(p->ws + WS_X1B), (const char*)(p->ws + WS_WF13), (int)gridDim.x, (int)blockIdx.x};
        EpiSwiglu E{(bf16_t*)(p->ws + WS_H), DFF};
        mg::gemm_run(lds, S, E);
    } else {
        SchedMoe<1, 2 * DFE / 256, D, 2 * DFE> S; S.A = (const char*)(p->ws + WS_AG); S.B = (const char*)(p->ws + WS_WF13);
        S.G = (int)gridDim.x; S.c = (int)blockIdx.x; moe_sched_tiles(p, lds, S);
        EpiSwiglu E{(bf16_t*)(p->ws + WS_H), DFE};
        mg::gemm_run(lds, S, E);
    }
}

struct EpiAccum {
    float* out;
    __device__ __forceinline__ void operator()(const AccT& acc, const mg::Unit& u, int wr, int wc, int fr, int fq, int) const {
        const int row0 = u.pm * 256 + wr * 64 + fr, col0 = u.pn * 256 + wc * 32 + 4 * fq;
#pragma unroll
        for (int ai = 0; ai < 2; ++ai)
#pragma unroll
            for (int m = 0; m < 4; ++m) { float* rp = out + (size_t)(row0 + ai * 128 + m * 16) * D + col0;
#pragma unroll
                for (int bj = 0; bj < 2; ++bj)
#pragma unroll
                    for (int n = 0; n < 2; ++n) { f32x4* q = (f32x4*)(rp + bj * 128 + n * 16); *q = *q + acc[ai][bj][m][n]; } }
    }
};
struct EpiScatter {
    float* out; const int* rowtok; const float* roww;
    __device__ __forceinline__ void operator()(const AccT& acc, const mg::Unit& u, int wr, int wc, int fr, int fq, int) const {
        const int row0 = u.pm * 256 + wr * 64 + fr, col0 = u.pn * 256 + wc * 32 + 4 * fq;
#pragma unroll
        for (int ai = 0; ai < 2; ++ai)
#pragma unroll
            for (int m = 0; m < 4; ++m) { const int r = row0 + ai * 128 + m * 16; const int tok = rowtok[r]; const float w = roww[r];
                if (tok >= 0) { float* rp = out + (size_t)tok * D + col0;
#pragma unroll
                    for (int bj = 0; bj < 2; ++bj)
#pragma unroll
                        for (int n = 0; n < 2; ++n)
#pragma unroll
                            for (int j = 0; j < 4; ++j) unsafeAtomicAdd(rp + bj * 128 + n * 16 + j, w * acc[ai][bj][m][n][j]); } }
    }
};
__device__ __forceinline__ void ph_ffn_down(KP p, int l, LAS unsigned char* lds) {
    if ((l & 1) == 0) {
        SchedPlain<0, 4, DFF> S{(const char*)(p->ws + WS_H), (const char*)(p->ws + WS_WF2_DENSE), (int)gridDim.x, (int)blockIdx.x};
        EpiAccum E{p->out};
        mg::gemm_run(lds, S, E);
    } else {
        SchedMoe<1, 4, DFE, D> S; S.A = (const char*)(p->ws + WS_H); S.B = (const char*)(p->ws + WS_WF2_MOE);
        S.G = (int)gridDim.x; S.c = (int)blockIdx.x; moe_sched_tiles(p, lds, S);
        EpiBf16Store E{(bf16_t*)(p->ws + WS_AG), D};
        mg::gemm_run(lds, S, E);
    }
}


#define XB_TMO      128
#define XB_XCNT(j)  (256  + 64 * (j))
#define XB_XSUB(j)  (1280 + 64 * (j))
#define XB_XGEN(j)  (2304 + 64 * (j))
#define XB_TOP      3328
#define XB_TOPGEN   3392
#define XCD_BAR_WORDS 3456
#define XB_SPIN_CAP (1u << 18)
__device__ __forceinline__ unsigned xb_ld(unsigned* p)              { return __hip_atomic_load(p, __ATOMIC_RELAXED, __HIP_MEMORY_SCOPE_AGENT); }
__device__ __forceinline__ unsigned xb_add(unsigned* p, unsigned v) { return __hip_atomic_fetch_add(p, v, __ATOMIC_RELAXED, __HIP_MEMORY_SCOPE_AGENT); }
__device__ __forceinline__ unsigned xb_xcc_id() { return (unsigned)__builtin_amdgcn_s_getreg((3 << 11) | 20) & 0xFu; }
#define XB_SPIN(cond, bar) do { unsigned _sp = 0; while (cond) { __builtin_amdgcn_s_sleep(1); \
    if ((++_sp & 255u) == 0u) { if (xb_ld(&(bar)[XB_TMO])) break; if (_sp > XB_SPIN_CAP) { atomicAdd(&(bar)[XB_TMO], 1u); break; } } } } while (0)
struct XcdBarrier { unsigned* bar; unsigned x; volatile LAS unsigned* st; };
__device__ __forceinline__ XcdBarrier xcd_barrier_post(unsigned* bar, volatile LAS unsigned* st) {
    XcdBarrier b; b.bar = bar; b.x = xb_xcc_id(); b.st = st;
    if (threadIdx.x == 0) (void)xb_add(&bar[XB_XCNT(b.x)], 1u);
    return b;
}
__device__ __forceinline__ void xcd_barrier_complete(unsigned* bar, unsigned x, unsigned& nloc, unsigned& nx) {
    const unsigned G = gridDim.x * gridDim.y * gridDim.z;
    unsigned sum, cnt, mine, sp = 0u;
    for (;;) {
        sum = 0u; cnt = 0u; mine = 0u;
#pragma unroll
        for (unsigned j = 0; j < 16; ++j) { const unsigned c = xb_ld(&bar[XB_XCNT(j)]); sum += c; cnt += (c > 0u) ? 1u : 0u; mine = (j == x) ? c : mine; }
        if (sum == G) break;
        __builtin_amdgcn_s_sleep(1);
        if ((++sp & 255u) == 0u) { if (xb_ld(&bar[XB_TMO])) break; if (sp > XB_SPIN_CAP) { atomicAdd(&bar[XB_TMO], 1u); break; } }
    }
    nloc = mine > 0u ? mine : 1u; nx = cnt > 0u ? cnt : 1u;
}
__device__ __forceinline__ void xcd_barrier(const XcdBarrier& b) {
    asm volatile("s_waitcnt vmcnt(0)" ::: "memory");
    __syncthreads();
    if (threadIdx.x == 0) {
        unsigned* bar = b.bar;
        __builtin_amdgcn_s_waitcnt(0);
        unsigned nloc = b.st[0], nx = b.st[1];
        if (nloc == 0u) { xcd_barrier_complete(bar, b.x, nloc, nx); b.st[0] = nloc; b.st[1] = nx; }
        const unsigned old = xb_add(&bar[XB_XSUB(b.x)], 1u);
        const unsigned gen = old / nloc;
        if (old + 1u == (gen + 1u) * nloc) {
            __builtin_amdgcn_fence(__ATOMIC_RELEASE, "agent");
            asm volatile("s_waitcnt vmcnt(0)" ::: "memory");
            const unsigned og = xb_add(&bar[XB_TOP], 1u);
            const unsigned tg = og / nx;
            if (og + 1u == (tg + 1u) * nx) xb_add(&bar[XB_TOPGEN], 1u);
            else XB_SPIN(xb_ld(&bar[XB_TOPGEN]) == tg, bar);
            __builtin_amdgcn_fence(__ATOMIC_ACQUIRE, "agent");
            xb_add(&bar[XB_XGEN(b.x)], 1u);
            asm volatile("s_waitcnt vmcnt(0)" ::: "memory");
        } else {
            XB_SPIN(xb_ld(&bar[XB_XGEN(b.x)]) == gen, bar);
            __builtin_amdgcn_fence(__ATOMIC_ACQUIRE, "agent");
            asm volatile("s_waitcnt vmcnt(0)" ::: "memory");
        }
    }
    __syncthreads();
}

constexpr int PH_PER_LAYER = 12, NPHASE = 2 * PH_PER_LAYER;
template <int K> __device__ __forceinline__ void run_phase(KP p, int l, LAS unsigned char* lds) {
    asm volatile("" : "+s"(lds));
    if constexpr (K == 0) ph_conv_mixer(p, l, lds);
    else if constexpr (K == 1) ph_inproj(p, l, lds);
    else if constexpr (K == 2) ph_prep(p, l, lds);
    else if constexpr (K == 21) ph_lora(p, l, lds);
    else if constexpr (K == 30) ph_scan(p, l, lds);
    else if constexpr (K == 31) ph_attn(p, l, lds);
    else if constexpr (K == 32) { dsa_select(p, lds);
        const int tid = my_tid(), lane = tid & 63, wave = tid >> 6, gw = blockIdx.x * 8 + wave, NGW = gridDim.x * 8;
        const float* srcp = (l == 0) ? p->in[I_X] : p->out; bf16_t* XB = (bf16_t*)(p->ws + WS_XB2);
        for (int m = gw; m < T; m += NGW) row_to_bf16(srcp + (size_t)m * D, XB + (size_t)m * D, lane); }
    else if constexpr (K == 4) ph_dsa_xb(p, l, lds);
    else if constexpr (K == 5) ph_merge(p, l, lds);
    else if constexpr (K == 6) ph_outproj(p, l, lds);
    else if constexpr (K == 7) ph_ln1(p, l, lds);
    else if constexpr (K == 8) ph_moe_assign(p, l, lds);
    else if constexpr (K == 9) ph_ffn_up(p, l, lds);
    else if constexpr (K == 10) ph_ffn_down(p, l, lds);
    else ln_rows(p, l, 1, lds);
}
template <int K> __global__ void __launch_bounds__(NTHREADS, 2) k_phase(Params, int l) {
    extern __shared__ __attribute__((aligned(16))) unsigned char lds_raw[];
    run_phase<K>(get_params(), l, (LAS unsigned char*)lds_raw);
}
#if FUSED
#define PH(K, L) do { run_phase<K>(get_params(), L, lds); __syncthreads(); } while (0)
#define SYNC() xcd_barrier(xbar)
__global__ void __launch_bounds__(NTHREADS, 2) k_fused(Params) {
    extern __shared__ __attribute__((aligned(16))) unsigned char lds_raw[];
    LAS unsigned char* lds = (LAS unsigned char*)lds_raw;
    cg::grid_group grid = cg::this_grid();
    volatile LAS unsigned* bst = (volatile LAS unsigned*)(lds + LDS_BYTES - 128);
    if (threadIdx.x < 2) bst[threadIdx.x] = 0u;
    __syncthreads();
    const XcdBarrier xbar = xcd_barrier_post((unsigned*)(get_params()->ws + WS_CTL) + 1024, bst);
    PH(0, 0); grid.sync();
    PH(1, 0); SYNC(); PH(2, 0); SYNC(); PH(21, 0); SYNC(); PH(30, 0); SYNC(); PH(31, 0); SYNC(); PH(32, 0); SYNC(); PH(4, 0); SYNC(); PH(5, 0); SYNC(); PH(6, 0); SYNC(); PH(7, 0); PH(0, 1); SYNC();
    PH(9, 0); SYNC(); PH(10, 0); SYNC(); PH(11, 0); SYNC();
    PH(1, 1); SYNC(); PH(2, 1); SYNC(); PH(21, 1); SYNC(); PH(30, 1); SYNC(); PH(31, 1); SYNC(); PH(32, 1); SYNC(); PH(4, 1); SYNC(); PH(5, 1); SYNC(); PH(6, 1); SYNC(); PH(7, 1); SYNC();
    PH(8, 1); SYNC(); PH(9, 1); SYNC(); PH(10, 1); SYNC(); PH(11, 1);
}
#undef PH
#undef SYNC
#endif
template <int K> static void launch_phase(const Params& p, int l, hipStream_t stream) {
    static bool attr = false;
    if (!attr) { (void)hipFuncSetAttribute((const void*)k_phase<K>, hipFuncAttributeMaxDynamicSharedMemorySize, LDS_BYTES); attr = true; }
    hipLaunchKernelGGL(k_phase<K>, dim3(256), dim3(NTHREADS), LDS_BYTES, stream, p, l);
}

extern "C" void kernel_launch(void* const* d_in, const int* in_sizes, int n_in, void* d_out, int out_size, void* d_ws, size_t ws_size, hipStream_t stream) {
    if (n_in != 28 || out_size != T * D || ws_size < WS_END) { fprintf(stderr, "kernel_launch: unexpected problem (n_in %d out %d ws %zu)\n", n_in, out_size, ws_size); return; }
    (void)hipMemsetAsync((char*)d_ws + WS_CTL, 0, 32768, stream);
    Params p{};
    for (int i = 0; i < 28; ++i) p.in[i] = (const float*)d_in[i];
    p.out = (float*)d_out; p.ws = (unsigned char*)d_ws;
#if FUSED
    static bool attr = false;
    if (!attr) { (void)hipFuncSetAttribute((const void*)k_fused, hipFuncAttributeMaxDynamicSharedMemorySize, LDS_BYTES); attr = true; }
    void* args[] = {&p};
    hipError_t e = hipLaunchCooperativeKernel((const void*)k_fused, dim3(256), dim3(NTHREADS), args, LDS_BYTES, stream);
    if (e != hipSuccess) fprintf(stderr, "cooperative launch failed: %s\n", hipGetErrorString(e));
    return;
#endif
    for (int l = 0; l < 2; ++l) {
        launch_phase<0>(p, l, stream); launch_phase<1>(p, l, stream); launch_phase<2>(p, l, stream); launch_phase<21>(p, l, stream);
        launch_phase<30>(p, l, stream); launch_phase<31>(p, l, stream); launch_phase<32>(p, l, stream);
        launch_phase<4>(p, l, stream); launch_phase<5>(p, l, stream); launch_phase<6>(p, l, stream); launch_phase<7>(p, l, stream);
        if (l & 1) launch_phase<8>(p, l, stream);
        launch_phase<9>(p, l, stream); launch_phase<10>(p, l, stream); launch_phase<11>(p, l, stream);
    }
}
```

```cpp
#include <hip/hip_runtime.h>
#include <hip/hip_cooperative_groups.h>
#include <cstdio>
#include <cstdint>
namespace cg = cooperative_groups;

#ifndef FUSED
#define FUSED 1
#endif

#define LAS __attribute__((address_space(3)))
typedef unsigned short bf16_t;
typedef short bf16x8 __attribute__((ext_vector_type(8)));
typedef float f32x4 __attribute__((ext_vector_type(4)));
typedef float f32x2 __attribute__((ext_vector_type(2)));
typedef unsigned u32x4 __attribute__((ext_vector_type(4)));
typedef unsigned u32x2 __attribute__((ext_vector_type(2)));

constexpr int T = 16384, D = 1024, SEQ = 2048, NB = 8;
constexpr int NPM = 3328;
constexpr int C_SWA_Q = 0, C_SWA_K = 512, C_SWA_V = 640, C_RW = 768;
constexpr int C_FOX_Q = 1792, C_FOX_K = 2048, C_FOX_V = 2304;
constexpr int C_DSA_Q = 2560, C_DSA_K = 2816, C_DSA_V = 2880, C_DSA_KI = 2944, C_FLOG = 3008, C_WIDX = 3012, C_DSA_QI = 3072;
constexpr int D_IN = 7368, NWIN = 7424;
constexpr int OC = 1280;
constexpr int DFF = 2816, DFE = 1408, NE = 8;
constexpr int MAXROWS = 34816;
constexpr float DN_ALPHA = 1.41421356237f;
constexpr float LN_EPS = 1e-5f;

constexpr size_t MiB = 1u << 20;
constexpr size_t WS_CTL = 0;
constexpr size_t WS_WIN = 1 * MiB, WS_WB = 16 * MiB, WS_WO = 19 * MiB;
constexpr size_t WS_THR = 21 * MiB + 256 * 1024  , WS_ROWOF = 21 * MiB  , WS_FOXC = 21 * MiB, WS_TOKE = 21 * MiB + 256 * 1024, WS_TOKW = 21 * MiB + 384 * 1024, WS_ROWTOK = 21 * MiB + 512 * 1024,
                 WS_ROWW = 21 * MiB + 768 * 1024, WS_WGCNT = 21 * MiB + 920 * 1024;
constexpr size_t WS_OCAT = 22 * MiB, WS_X1B = 22 * MiB;
constexpr size_t WS_PMIX = 62 * MiB, WS_MERGED = 62 * MiB, WS_MACC = 94 * MiB;
constexpr size_t WS_WF13 = 62 * MiB, WS_WF2_DENSE = 73 * MiB, WS_WF2_MOE = 106 * MiB, WS_H = 128 * MiB;
constexpr size_t WS_RW = 166 * MiB, WS_XB = 22 * MiB  , WS_SCORES = 166 * MiB, WS_XB2 = 246 * MiB, WS_GSC = 158 * MiB, WS_AG = 222 * MiB;
constexpr size_t WS_BONUS = 278 * MiB, WS_Y = 279 * MiB, WS_LORA_A = 279 * MiB  ;
constexpr size_t WS_WLORA = 15 * MiB + 512 * 1024;
constexpr size_t WS_MASKB = 295 * MiB;
constexpr size_t WS_END = 299 * MiB;
constexpr size_t RWSZ = 16 * MiB;

constexpr int LDS_BYTES = 155648;
constexpr int NTHREADS = 512;

struct Params { const float* in[28]; float* out; unsigned char* ws; };
typedef const __attribute__((address_space(4))) Params* KP;
__device__ __forceinline__ KP get_params() { KP k = (KP)__builtin_amdgcn_kernarg_segment_ptr(); asm volatile("" : "+s"(k)); return k; }
enum { I_X = 0, I_WIN, I_SINKS, I_MU, I_W0, I_WUP, I_A0, I_AUP, I_GUP, I_KK, I_KA, I_RK, I_GNG, I_GNB, I_FB, I_GB, I_WBR, I_WOUT, I_LNG, I_LNB,
       I_F1, I_F3, I_F2, I_RTW, I_RTB, I_E1, I_E3, I_E2 };

__device__ __forceinline__ float bflo(unsigned u) { return __uint_as_float(u << 16); }
__device__ __forceinline__ float bfhi(unsigned u) { return __uint_as_float(u & 0xffff0000u); }
__device__ __forceinline__ float bf2f(bf16_t b) { return __uint_as_float((unsigned)b << 16); }
__device__ __forceinline__ unsigned f2bf(float f) { unsigned u = __float_as_uint(f); return (u + 0x7fffu + ((u >> 16) & 1u)) >> 16; }
__device__ __forceinline__ unsigned pk2(float lo, float hi) { unsigned r; asm("v_cvt_pk_bf16_f32 %0, %1, %2" : "=v"(r) : "v"(lo), "v"(hi)); return r; }
__device__ __forceinline__ float wave_sum(float v) {
#pragma unroll
    for (int o = 1; o < 64; o <<= 1) v += __shfl_xor(v, o);
    return v;
}
__device__ __forceinline__ float wave_max(float v) {
#pragma unroll
    for (int o = 1; o < 64; o <<= 1) v = fmaxf(v, __shfl_xor(v, o));
    return v;
}
__device__ __forceinline__ float sigm(float x) { return 1.f / (1.f + __expf(-x)); }
#define LDS_FENCE() asm volatile("s_waitcnt lgkmcnt(0)" ::: "memory")
__device__ __forceinline__ int my_tid() { int t = threadIdx.x; asm volatile("" : "+v"(t)); return t; }
__device__ __forceinline__ void unpack8(const u32x4 v, float* f) {
    f[0] = bflo(v.x); f[1] = bfhi(v.x); f[2] = bflo(v.y); f[3] = bfhi(v.y); f[4] = bflo(v.z); f[5] = bfhi(v.z); f[6] = bflo(v.w); f[7] = bfhi(v.w);
}

namespace mg {
constexpr int BM = 256, BK = 64, HALF = 128, HTB = HALF * BK * 2, STAGE_BYTES = 8 * HTB;
__device__ __forceinline__ int lds_byte(int r, int c) { const int st = (r >> 4) * 2 + (c >> 5), rr = r & 15, cc = c & 31, ob = rr * 64 + cc * 2; return st * 1024 + (ob ^ (((ob >> 9) & 1) << 5)); }
__device__ __forceinline__ void stage_rc(int b, int& R, int& C) { const int st = b / 1024, sb = b % 1024, swz = sb ^ (((sb >> 9) & 1) << 5); R = (st >> 1) * 16 + swz / 64; C = (st & 1) * 32 + (swz % 64) / 2; }
__device__ __forceinline__ int perm32(int rho) { const int n = rho >> 4, i = rho & 15; return 8 * (i >> 2) + 4 * n + (i & 3); }

struct Unit { const char* A; const char* B; unsigned ld; int nt; int pm, pn, tag; };

__device__ __forceinline__ bool static_tile(int i, int G, int c, int nM, int nN, int& pm, int& pn) {
    const int nwg = nM * nN; const long L = (long)i * G + c; if (L >= nwg) return false;
    int wgid = (int)L; { const int q = nwg / 8, r = nwg % 8, xcd = wgid % 8, off = wgid / 8; wgid = (xcd < r ? xcd * (q + 1) : r * (q + 1) + (xcd - r) * q) + off; }
    const int nig = 8 * nN, gid = wgid / nig, fm = gid * 8, gsz = (nM - fm) < 8 ? (nM - fm) : 8;
    pm = fm + ((wgid % nig) % gsz); pn = (wgid % nig) / gsz; return true;
}

template <class Sched, class Epi>
__device__ __forceinline__ void gemm_run(LAS unsigned char* lds, const Sched& S, const Epi& E) {
    const int tid = my_tid(), wid = __builtin_amdgcn_readfirstlane(tid >> 6), lane = tid & 63, wr = wid >> 2, wc = wid & 3, fr = lane & 15, fq = lane >> 4;
    int R0, C0; stage_rc(tid * 16, R0, C0); const unsigned RA = (unsigned)R0, RB = (unsigned)(Sched::PERM ? ((R0 & ~31) + perm32(R0 & 31)) : R0), C02 = (unsigned)C0 * 2u;
    const unsigned ldsw = (unsigned)wid * 1024u;
    const int aoff = lds_byte(wr * 64 + fr, fq * 8), boff = lds_byte(wc * 32 + fr, fq * 8);
#define MG_SA(b, h) (((b) * 2 + (h)) * HTB)
#define MG_SB(b, h) ((4 + (b) * 2 + (h)) * HTB)
#define MG_STAGE(bufoff, gptr, v0, s64) do { \
        __builtin_amdgcn_global_load_lds((const unsigned*)((gptr) + (v0)), (LAS unsigned*)(lds + (bufoff) + ldsw), 16, 0, 0); \
        __builtin_amdgcn_global_load_lds((const unsigned*)((gptr) + (s64) + (v0)), (LAS unsigned*)(lds + (bufoff) + ldsw + 8192), 16, 0, 0); } while (0)
#define MG_LDA(dst, b, h) do { _Pragma("unroll") for (int m = 0; m < 4; ++m) _Pragma("unroll") for (int k = 0; k < 2; ++k) dst[m][k] = *(const LAS bf16x8*)(lds + MG_SA(b, h) + aoff + m * 2048 + k * 1024); } while (0)
#define MG_LDB(dst, b, h) do { _Pragma("unroll") for (int n = 0; n < 2; ++n) _Pragma("unroll") for (int k = 0; k < 2; ++k) dst[n][k] = *(const LAS bf16x8*)(lds + MG_SB(b, h) + boff + n * 2048 + k * 1024); } while (0)
#define MG_MMA(ai, bj, At, Bt) do { __builtin_amdgcn_s_setprio(1); _Pragma("unroll") for (int m = 0; m < 4; ++m) _Pragma("unroll") for (int n = 0; n < 2; ++n) _Pragma("unroll") for (int k = 0; k < 2; ++k) \
        acc[ai][bj][m][n] = __builtin_amdgcn_mfma_f32_16x16x32_bf16(Bt[n][k], At[m][k], acc[ai][bj][m][n], 0, 0, 0); __builtin_amdgcn_s_setprio(0); } while (0)
#define MG_WAIT_V(n) asm volatile("s_waitcnt vmcnt(" #n ")" ::: "memory")
#define MG_WAIT_L(n) asm volatile("s_waitcnt lgkmcnt(" #n ")" ::: "memory")
#define MG_BAR __builtin_amdgcn_s_barrier()
#define MG_SCHED __builtin_amdgcn_sched_barrier(0)
    Unit cur; int ui = 0;
    if (!S.next(0, cur)) return;
    f32x4 acc[2][2][4][2];
#pragma unroll
    for (int a = 0; a < 2; ++a)
#pragma unroll
        for (int b = 0; b < 2; ++b)
#pragma unroll
            for (int m = 0; m < 4; ++m)
#pragma unroll
                for (int n = 0; n < 2; ++n) acc[a][b][m][n] = (f32x4){0.f, 0.f, 0.f, 0.f};
    bf16x8 At[4][2], B0[2][2], B1[2][2];
    const size_t kstep = (size_t)(BK * 2);
    {
        const char* cA = cur.A; const char* cB = cur.B; const unsigned ld = cur.ld, vA = RA * ld + C02, vB = RB * ld + C02, s64 = 64u * ld, sh = 128u * ld;
        MG_STAGE(MG_SB(0, 0), cB, vB, s64); MG_STAGE(MG_SB(0, 1), cB + sh, vB, s64); MG_STAGE(MG_SA(0, 0), cA, vA, s64); MG_STAGE(MG_SA(0, 1), cA + sh, vA, s64);
        if (wr == 1) MG_BAR;
        MG_WAIT_V(2); MG_BAR;
        MG_STAGE(MG_SB(1, 0), cB + kstep, vB, s64); MG_STAGE(MG_SA(1, 0), cA + kstep, vA, s64); MG_STAGE(MG_SB(1, 1), cB + sh + kstep, vB, s64);
        MG_WAIT_V(6); MG_BAR;
    }
    for (;;) {
        const char* cA = cur.A; const char* cB = cur.B; const unsigned cld = cur.ld; const int nt = cur.nt;
        for (int t = 0; t < nt; t += 2) {
            const bool last = (t == nt - 2);
            const char* a1 = cA + (size_t)(t + 1) * kstep;
            const char* a2 = cA + (size_t)(t + 2) * kstep; const char* b2 = cB + (size_t)(t + 2) * kstep; unsigned xld = cld;
            if (last) { Unit n2; if (S.next(ui + 1, n2)) { a2 = n2.A; b2 = n2.B; xld = n2.ld; } else { a2 = cA; b2 = cB; } }
            const char* a3 = a2 + kstep; const char* b3 = b2 + kstep;
            const unsigned cvA = RA * cld + C02, c64 = 64u * cld, ch = 128u * cld;
            const unsigned xvA = RA * xld + C02, xvB = RB * xld + C02, x64 = 64u * xld, xh = 128u * xld;
            MG_LDB(B0, 0, 0); MG_LDB(B1, 0, 1); MG_SCHED; MG_LDA(At, 0, 0); MG_STAGE(MG_SA(1, 1), a1 + ch, cvA, c64);
            MG_WAIT_V(8); MG_WAIT_L(0); MG_BAR; MG_MMA(0, 0, At, B0); MG_MMA(0, 1, At, B1); MG_BAR; MG_SCHED;
            MG_LDA(At, 0, 1); MG_STAGE(MG_SB(0, 0), b2, xvB, x64); MG_STAGE(MG_SB(0, 1), b2 + xh, xvB, x64); MG_STAGE(MG_SA(0, 0), a2, xvA, x64);
            MG_WAIT_V(8); MG_WAIT_L(0); MG_BAR; MG_MMA(1, 0, At, B0); MG_MMA(1, 1, At, B1); MG_BAR; MG_SCHED;
            MG_LDB(B0, 1, 0); MG_LDB(B1, 1, 1); MG_SCHED; MG_LDA(At, 1, 0); MG_STAGE(MG_SA(0, 1), a2 + xh, xvA, x64);
            MG_WAIT_V(8); MG_WAIT_L(0); MG_BAR; MG_MMA(0, 0, At, B0); MG_MMA(0, 1, At, B1); MG_BAR; MG_SCHED;
            MG_LDA(At, 1, 1); MG_STAGE(MG_SB(1, 0), b3, xvB, x64); MG_STAGE(MG_SB(1, 1), b3 + xh, xvB, x64); MG_STAGE(MG_SA(1, 0), a3, xvA, x64);
            MG_WAIT_V(8); MG_WAIT_L(0); MG_BAR; MG_MMA(1, 0, At, B0); MG_MMA(1, 1, At, B1); MG_BAR; MG_SCHED;
        }
        if (wr == 0) MG_BAR;
        { int e_fr = fr, e_fq = fq, e_tid = tid; asm volatile("" : "+v"(e_fr), "+v"(e_fq), "+v"(e_tid));
          E(acc, cur, wr, wc, e_fr, e_fq, e_tid); }
        Unit nxt;
        if (!S.next(ui + 1, nxt)) break;
#pragma unroll
        for (int a = 0; a < 2; ++a)
#pragma unroll
            for (int b = 0; b < 2; ++b)
#pragma unroll
                for (int m = 0; m < 4; ++m)
#pragma unroll
                    for (int n = 0; n < 2; ++n) acc[a][b][m][n] = (f32x4){0.f, 0.f, 0.f, 0.f};
        cur = nxt; ++ui;
        if (wr == 1) MG_BAR;
    }
    MG_WAIT_V(0);
    MG_BAR;
#undef MG_SA
#undef MG_SB
#undef MG_STAGE
#undef MG_LDA
#undef MG_LDB
#undef MG_MMA
#undef MG_WAIT_V
#undef MG_WAIT_L
#undef MG_BAR
#undef MG_SCHED
}
}

typedef f32x4 AccT[2][2][4][2];

__device__ __forceinline__ int rowmap(int mode, int n) {
    if (mode == 0) return n;
    if (mode == 1) { if (n < 2560) return n; if (n < 2564) return C_FLOG + (n - 2560); if (n < 2948) return n - 4; if (n < 3204) return C_DSA_QI + (n - 2948); if (n < 3268) return C_DSA_KI + (n - 3204); if (n < 3272) return C_WIDX + (n - 3268); return n + 56; }
    if (mode == 2) return 256 * (n >> 7) + (n & 127);
    return 256 * (n >> 7) + 128 + (n & 127);
}
__device__ __forceinline__ void tr_item(const float* __restrict__ W, int K, int N, bf16_t* WT, int ldt, int mode, int row_off, LAS float* scr, int item, int lane) {
    const int nblk = (N + 31) / 32, kb = item / nblk, nb = item % nblk, k0 = 64 * kb, n0 = 32 * nb;
    const int nl = lane & 31, n = n0 + nl;
    float tv[32];
    const int nc = (n < N) ? n : N - 1;
#pragma unroll
    for (int i = 0; i < 32; ++i) { const int kk = 2 * i + (lane >> 5); tv[i] = W[(size_t)(k0 + kk) * N + nc]; }
#pragma unroll
    for (int i = 0; i < 32; ++i) { const int kk = 2 * i + (lane >> 5); scr[kk * 33 + nl] = (n < N) ? tv[i] : 0.f; }
    LDS_FENCE();
    const int c = lane & 7;
#pragma unroll
    for (int j = 0; j < 4; ++j) { const int n2l = (lane >> 3) + 8 * j, n2 = n0 + n2l; const LAS float* s = scr + (8 * c) * 33 + n2l;
        u32x4 o; o.x = pk2(s[0 * 33], s[1 * 33]); o.y = pk2(s[2 * 33], s[3 * 33]); o.z = pk2(s[4 * 33], s[5 * 33]); o.w = pk2(s[6 * 33], s[7 * 33]);
        if (n2 < N) *(u32x4*)(WT + (size_t)(row_off + rowmap(mode, n2)) * ldt + k0 + 8 * c) = o; }
    LDS_FENCE();
}
__device__ __forceinline__ int tr_nitems(int K, int N) { return (K / 64) * ((N + 31) / 32); }

__device__ __forceinline__ void row_to_bf16(const float* xrow, bf16_t* orow, int lane) {
    const f32x4* xr = (const f32x4*)xrow + lane; unsigned long long* o8 = (unsigned long long*)orow + lane;
#pragma unroll
    for (int j = 0; j < 4; ++j) { const f32x4 v = xr[64 * j]; o8[64 * j] = (unsigned long long)pk2(v.x, v.y) | ((unsigned long long)pk2(v.z, v.w) << 32); }
}

__device__ __forceinline__ void ph_conv_mixer(KP p, int l, LAS unsigned char* lds) {
    const int tid_ = my_tid(); const int lane = tid_ & 63, wave = tid_ >> 6, gw = blockIdx.x * 8 + wave, NGW = gridDim.x * 8;
    LAS float* scr = (LAS float*)(lds + wave * 8448);
    const float* win = p->in[I_WIN] + (size_t)l * D * D_IN; const float* wbr = p->in[I_WBR] + (size_t)l * OC * D; const float* wo = p->in[I_WOUT] + (size_t)l * D * D;
    bf16_t* WIN = (bf16_t*)(p->ws + WS_WIN); bf16_t* WB = (bf16_t*)(p->ws + WS_WB); bf16_t* WO = (bf16_t*)(p->ws + WS_WO);
    const int n1 = tr_nitems(D, D_IN), n2 = tr_nitems(OC, D), n3 = tr_nitems(D, D);
    for (int it = gw; it < n1 + n2 + n3; it += NGW) {
        int r = it;
        if (r < n1) { tr_item(win, D, D_IN, WIN, D, 1, 0, scr, r, lane); continue; } r -= n1;
        if (r < n2) { tr_item(wbr, OC, D, WB, OC, 0, 0, scr, r, lane); continue; } r -= n2;
        tr_item(wo, D, D, WO, D, 0, 0, scr, r, lane);
    }
    {
        bf16_t* WL = (bf16_t*)(p->ws + WS_WLORA);
        const float* wup = p->in[I_WUP] + (size_t)l * 64 * 256; const float* aup = p->in[I_AUP] + (size_t)l * 64 * 256; const float* gup = p->in[I_GUP] + (size_t)l * 128 * 256;
        const int m1 = tr_nitems(64, 256), m2 = tr_nitems(128, 256);
        for (int it = gw; it < 2 * m1 + m2; it += NGW) { int r = it;
            if (r < m1) { tr_item(wup, 64, 256, WL, 256, 0, 0, scr, r, lane); continue; } r -= m1;
            if (r < m1) { tr_item(aup, 64, 256, WL + 64, 256, 0, 256, scr, r, lane); continue; } r -= m1;
            tr_item(gup, 128, 256, WL + 128, 256, 0, 512, scr, r, lane); }
        for (int ch = gw * 64 + lane; ch < 768 * 32; ch += NGW * 64) { const int row = ch >> 5, k8 = (ch & 31) * 8, blk = row >> 8;
            const bool used = (blk == 0) ? (k8 < 64) : ((blk == 1) ? (k8 >= 64 && k8 < 128) : (k8 >= 128));
            if (!used) *(u32x4*)(WL + (size_t)row * 256 + k8) = (u32x4){0u, 0u, 0u, 0u}; }
    }
    if (l == 0) { bf16_t* XB = (bf16_t*)(p->ws + WS_XB); for (int m = gw; m < T; m += NGW) row_to_bf16(p->in[I_X] + (size_t)m * D, XB + (size_t)m * D, lane); }
}

struct SchedInproj {
    static constexpr int PERM = 1;
    const char* A; const char* B; int G, c;
    __device__ __forceinline__ bool next(int i, mg::Unit& u) const {
        int pm, pn; if (!mg::static_tile(i, G, c, T / 256, NPM / 256 - 1, pm, pn)) return false;
        u.A = A + (size_t)pm * 256 * 2048; u.B = B + (size_t)pn * 256 * 2048; u.ld = 2048; u.nt = 16; u.pm = pm; u.pn = pn; u.tag = 0; return true;
    }
};
template <int PERM_, int NN, int K> struct SchedPlain {
    static constexpr int PERM = PERM_;
    const char* A; const char* B; int G, c;
    __device__ __forceinline__ bool next(int i, mg::Unit& u) const {
        int pm, pn; if (!mg::static_tile(i, G, c, T / 256, NN, pm, pn)) return false;
        u.A = A + (size_t)pm * 256 * K * 2; u.B = B + (size_t)pn * 256 * K * 2; u.ld = K * 2; u.nt = K / 64; u.pm = pm; u.pn = pn; u.tag = 0; return true;
    }
};
struct EpiBf16Store {
    bf16_t* O; int ldo;
    __device__ __forceinline__ void operator()(const AccT& acc, const mg::Unit& u, int wr, int wc, int fr, int fq, int) const {
        const int row0 = u.pm * 256 + wr * 64 + fr, col0 = u.pn * 256 + wc * 32 + 8 * fq;
#pragma unroll
        for (int ai = 0; ai < 2; ++ai)
#pragma unroll
            for (int m = 0; m < 4; ++m) { bf16_t* rowp = O + (size_t)(row0 + ai * 128 + m * 16) * ldo + col0;
#pragma unroll
                for (int bj = 0; bj < 2; ++bj) { const f32x4 v0 = acc[ai][bj][m][0], v1 = acc[ai][bj][m][1];
                    u32x4 w; w.x = pk2(v0[0], v0[1]); w.y = pk2(v0[2], v0[3]); w.z = pk2(v1[0], v1[1]); w.w = pk2(v1[2], v1[3]);
                    *(u32x4*)(rowp + bj * 128) = w; } }
    }
};
__device__ __forceinline__ void ph_inproj(KP p, int l, LAS unsigned char* lds) {
    SchedInproj S{(const char*)(p->ws + WS_XB), (const char*)(p->ws + WS_WIN), (int)gridDim.x, (int)blockIdx.x};
    EpiBf16Store E{(bf16_t*)(p->ws + WS_PMIX), NPM};
    mg::gemm_run(lds, S, E);
}

__device__ __forceinline__ void ph_prep(KP p, int l, LAS unsigned char* lds) {
    const int tid = my_tid(), lane = tid & 63, wave = tid >> 6;
    const bf16_t* P = (const bf16_t*)(p->ws + WS_PMIX);
    if (blockIdx.x < 8 && wave < 4) {
        const int b = blockIdx.x, h = wave; const float fb = p->in[I_FB][l * 4 + h];
        float v[32]; float s = 0.f;
#pragma unroll
        for (int i = 0; i < 32; ++i) { const int t = 32 * lane + i; const float x = bf2f(P[(size_t)(b * SEQ + t) * NPM + C_FLOG + h]) + fb;
            const float ls = fminf(x, 0.f) - log1pf(__expf(-fabsf(x))); s += ls; v[i] = s; }
        float incl = s;
#pragma unroll
        for (int o = 1; o < 64; o <<= 1) { const float n = __shfl_up(incl, o); if (lane >= o) incl += n; }
        const float excl = incl - s; float* C = (float*)(p->ws + WS_FOXC) + (size_t)(b * 4 + h) * SEQ + 32 * lane;
#pragma unroll
        for (int i = 0; i < 32; ++i) C[i] = v[i] + excl;
    }
    const float* mu = p->in[I_MU] + l * 1024; const float* kkw = p->in[I_KK] + l * 256;
    float* RWr = (float*)(p->ws + WS_RW); float* RWk = RWr + (size_t)2 * T * 256; float* RWkk = RWr + (size_t)3 * T * 256; float* RWv = RWr + (size_t)5 * T * 256;
    bf16_t* LA = (bf16_t*)(p->ws + WS_LORA_A);
    const int gw = blockIdx.x * 8 + wave, NGW = gridDim.x * 8;
    float m0[8], m1[8], kkc[8];
    { const f32x4 a = *(const f32x4*)(mu + 8 * lane), b = *(const f32x4*)(mu + 8 * lane + 4), c = *(const f32x4*)(mu + 512 + 8 * lane), d = *(const f32x4*)(mu + 512 + 8 * lane + 4);
      m0[0] = a.x; m0[1] = a.y; m0[2] = a.z; m0[3] = a.w; m0[4] = b.x; m0[5] = b.y; m0[6] = b.z; m0[7] = b.w; m1[0] = c.x; m1[1] = c.y; m1[2] = c.z; m1[3] = c.w; m1[4] = d.x; m1[5] = d.y; m1[6] = d.z; m1[7] = d.w;
      const f32x4 e = *(const f32x4*)(kkw + 8 * (lane & 31)), f = *(const f32x4*)(kkw + 8 * (lane & 31) + 4); kkc[0] = e.x; kkc[1] = e.y; kkc[2] = e.z; kkc[3] = e.w; kkc[4] = f.x; kkc[5] = f.y; kkc[6] = f.z; kkc[7] = f.w; }
#pragma unroll 2
    for (int t = gw; t < T; t += NGW) {
        const bf16_t* pr = P + (size_t)t * NPM + C_RW; const bool first = (t & (SEQ - 1)) == 0; const bf16_t* pp = first ? pr : pr - NPM;
        float x0[8], x1[8], y0[8], y1[8];
        unpack8(*(const u32x4*)(pr + 8 * lane), x0); unpack8(*(const u32x4*)(pr + 512 + 8 * lane), x1);
        unpack8(*(const u32x4*)(pp + 8 * lane), y0); unpack8(*(const u32x4*)(pp + 512 + 8 * lane), y1);
#pragma unroll
        for (int j = 0; j < 8; ++j) { const float q0 = first ? 0.f : y0[j], q1 = first ? 0.f : y1[j]; x0[j] += m0[j] * (q0 - x0[j]); x1[j] += m1[j] * (q1 - x1[j]); }
        const size_t o = (size_t)t * 256 + 8 * (lane & 31);
        if (lane < 32) {
            *(f32x4*)(RWr + o) = (f32x4){x0[0], x0[1], x0[2], x0[3]}; *(f32x4*)(RWr + o + 4) = (f32x4){x0[4], x0[5], x0[6], x0[7]};
            *(f32x4*)(RWv + o) = (f32x4){x1[0], x1[1], x1[2], x1[3]}; *(f32x4*)(RWv + o + 4) = (f32x4){x1[4], x1[5], x1[6], x1[7]};
        }
        float kk[8], ss = 0.f;
#pragma unroll
        for (int j = 0; j < 8; ++j) { kk[j] = x0[j] * kkc[j]; ss += kk[j] * kk[j]; }
        ss += __shfl_xor(ss, 1); ss += __shfl_xor(ss, 2); ss += __shfl_xor(ss, 4);
        const float rn = rsqrtf(ss + 1e-12f);
        if (lane >= 32) {
            *(f32x4*)(RWk + o) = (f32x4){x0[0], x0[1], x0[2], x0[3]}; *(f32x4*)(RWk + o + 4) = (f32x4){x0[4], x0[5], x0[6], x0[7]};
            *(f32x4*)(RWkk + o) = (f32x4){kk[0] * rn, kk[1] * rn, kk[2] * rn, kk[3] * rn}; *(f32x4*)(RWkk + o + 4) = (f32x4){kk[4] * rn, kk[5] * rn, kk[6] * rn, kk[7] * rn};
            float a[8];
#pragma unroll
            for (int j = 0; j < 8; ++j) a[j] = (lane < 40) ? tanhf(x1[j]) : ((lane < 48) ? x1[j] : sigm(x1[j]));
            u32x4 w; w.x = pk2(a[0], a[1]); w.y = pk2(a[2], a[3]); w.z = pk2(a[4], a[5]); w.w = pk2(a[6], a[7]);
            *(u32x4*)(LA + (size_t)t * 256 + 8 * (lane - 32)) = w;
        }
    }
}
struct SchedLoraPlus {
    static constexpr int PERM = 1; static constexpr bool DUAL = false;
    const char* LA; const char* WL; const char* XB; const char* WIN; int c;
    __device__ __forceinline__ bool next(int i, mg::Unit& u) const {
        if (i > 0) return false;
        if (c < 192) { int pm, pn; mg::static_tile(0, 256, c, T / 256, 3, pm, pn); u.A = LA + (size_t)pm * 256 * 512; u.B = WL + (size_t)pn * 256 * 512; u.ld = 512; u.nt = 4; u.pm = pm; u.pn = pn; u.tag = 0; }
        else { const int pm = c - 192; u.A = XB + (size_t)pm * 256 * 2048; u.B = WIN + (size_t)12 * 256 * 2048; u.ld = 2048; u.nt = 16; u.pm = pm; u.pn = 12; u.tag = 1; }
        return true;
    }
};
struct EpiLora {
    const float* w0; const float* a0; const float* ka; float* RW; bf16_t* PM;
    __device__ __forceinline__ void operator()(const AccT& acc, const mg::Unit& u, int wr, int wc, int fr, int fq, int) const {
        const int row0 = u.pm * 256 + wr * 64 + fr, col0 = wc * 32 + 8 * fq;
        if (u.tag == 1) {
#pragma unroll
            for (int ai = 0; ai < 2; ++ai)
#pragma unroll
                for (int m = 0; m < 4; ++m) { bf16_t* rowp = PM + (size_t)(row0 + ai * 128 + m * 16) * NPM + u.pn * 256 + col0;
#pragma unroll
                    for (int bj = 0; bj < 2; ++bj) { const f32x4 v0 = acc[ai][bj][m][0], v1 = acc[ai][bj][m][1];
                        u32x4 w; w.x = pk2(v0[0], v0[1]); w.y = pk2(v0[2], v0[3]); w.z = pk2(v1[0], v1[1]); w.w = pk2(v1[2], v1[3]);
                        *(u32x4*)(rowp + bj * 128) = w; } }
            return;
        }
        float* RWw = RW + (size_t)1 * T * 256; float* RWk = RW + (size_t)2 * T * 256; float* RWkk = RW + (size_t)3 * T * 256; float* RWkka = RW + (size_t)4 * T * 256; float* RWg = RW + (size_t)6 * T * 256;
#pragma unroll
        for (int bj = 0; bj < 2; ++bj)
#pragma unroll
            for (int n = 0; n < 2; ++n) { const int c = col0 + bj * 128 + 4 * n;
                f32x4 c0 = (f32x4){0.f, 0.f, 0.f, 0.f}, c1 = c0;
                if (u.pn == 0) c0 = *(const f32x4*)(w0 + c); else if (u.pn == 1) { c0 = *(const f32x4*)(a0 + c); c1 = *(const f32x4*)(ka + c); }
#pragma unroll
                for (int ai = 0; ai < 2; ++ai)
#pragma unroll
                    for (int m = 0; m < 4; ++m) { const size_t o = (size_t)(row0 + ai * 128 + m * 16) * 256 + c; const f32x4 x = acc[ai][bj][m][n];
                        if (u.pn == 0) { f32x4 w;
#pragma unroll
                            for (int j = 0; j < 4; ++j) w[j] = __expf(-sigm(c0[j] + x[j]) * 0.60653065971f);
                            *(f32x4*)(RWw + o) = w; }
                        else if (u.pn == 1) { const f32x4 k = *(const f32x4*)(RWk + o), kk = *(const f32x4*)(RWkk + o); f32x4 k2, kka;
#pragma unroll
                            for (int j = 0; j < 4; ++j) { const float a = sigm(c0[j] + x[j]); k2[j] = k[j] * (1.f + (a - 1.f) * c1[j]); kka[j] = kk[j] * a; }
                            *(f32x4*)(RWk + o) = k2; *(f32x4*)(RWkka + o) = kka; }
                        else *(f32x4*)(RWg + o) = x;
                        asm volatile("" ::: "memory"); } }
    }
};
__device__ __forceinline__ void ph_lora(KP p, int l, LAS unsigned char* lds) {
    SchedLoraPlus S{(const char*)(p->ws + WS_LORA_A), (const char*)(p->ws + WS_WLORA), (const char*)(p->ws + WS_XB), (const char*)(p->ws + WS_WIN), (int)blockIdx.x};
    EpiLora E{p->in[I_W0] + l * 256, p->in[I_A0] + l * 256, p->in[I_KA] + l * 256, (float*)(p->ws + WS_RW), (bf16_t*)(p->ws + WS_PMIX)};
    mg::gemm_run(lds, S, E);
}

template <int CTRL, int ROWM, int BANKM> __device__ __forceinline__ float dpp_add(float acc, float src) {
    return acc + __int_as_float(__builtin_amdgcn_update_dpp(0, __float_as_int(src), CTRL, ROWM, BANKM, true));
}
__device__ __forceinline__ float wave_sum_s(float v) {
    float a = v;
    a = dpp_add<0x111, 0xf, 0xf>(a, v); a = dpp_add<0x112, 0xf, 0xf>(a, v); a = dpp_add<0x113, 0xf, 0xf>(a, v);
    a = dpp_add<0x114, 0xf, 0xe>(a, a); a = dpp_add<0x118, 0xf, 0xc>(a, a);
    a = dpp_add<0x142, 0xa, 0xf>(a, a); a = dpp_add<0x143, 0xc, 0xf>(a, a);
    return __int_as_float(__builtin_amdgcn_readlane(__float_as_int(a), 63));
}
typedef float f32x16 __attribute__((ext_vector_type(16)));
constexpr int KT_PITCH = 144, VT_PITCH = 136;
constexpr int AT_K_BYTES = 64 * KT_PITCH, AT_V_BYTES = 64 * VT_PITCH, AT_TILE_BYTES = AT_K_BYTES + AT_V_BYTES + 256;
constexpr float LOG2E = 1.4426950408889634f;
constexpr float NEGBIG = -1e30f;
__device__ __forceinline__ int crow(int reg, int h) { return (reg & 3) + 8 * (reg >> 2) + 4 * h; }
__device__ __forceinline__ unsigned fkey(float f) { const unsigned u = __float_as_uint(f); return (u & 0x80000000u) ? ~u : (u | 0x80000000u); }

__device__ __forceinline__ void at_stage(LAS unsigned char* tile, const bf16_t* Krows, const bf16_t* Vrows, int tid) {
    { const int row = tid >> 3, ch = tid & 7; const u32x4 v = *(const u32x4*)(Krows + (size_t)row * NPM + 8 * ch); *(LAS u32x4*)(tile + row * KT_PITCH + ch * 16) = v; }
    { const int kv = tid & 63, dch = tid >> 6; const u32x4 v = *(const u32x4*)(Vrows + (size_t)kv * NPM + 8 * dch);
      LAS bf16_t* vt = (LAS bf16_t*)(tile + AT_K_BYTES + (8 * dch) * VT_PITCH) + kv; constexpr int P2 = VT_PITCH / 2;
      vt[0 * P2] = (bf16_t)(v.x & 0xffffu); vt[1 * P2] = (bf16_t)(v.x >> 16); vt[2 * P2] = (bf16_t)(v.y & 0xffffu); vt[3 * P2] = (bf16_t)(v.y >> 16);
      vt[4 * P2] = (bf16_t)(v.z & 0xffffu); vt[5 * P2] = (bf16_t)(v.z >> 16); vt[6 * P2] = (bf16_t)(v.w & 0xffffu); vt[7 * P2] = (bf16_t)(v.w >> 16); }
}
struct AtRegs { u32x4 k, v; };
__device__ __forceinline__ AtRegs at_gload(const bf16_t* Krows, const bf16_t* Vrows, int tid) {
    AtRegs a; a.k = *(const u32x4*)(Krows + (size_t)(tid >> 3) * NPM + 8 * (tid & 7)); a.v = *(const u32x4*)(Vrows + (size_t)(tid & 63) * NPM + 8 * (tid >> 6)); return a;
}
__device__ __forceinline__ void at_sstore(LAS unsigned char* tile, const AtRegs& a, int tid) {
    *(LAS u32x4*)(tile + (tid >> 3) * KT_PITCH + (tid & 7) * 16) = a.k;
    const u32x4 v = a.v; LAS bf16_t* vt = (LAS bf16_t*)(tile + AT_K_BYTES + (8 * (tid >> 6)) * VT_PITCH) + (tid & 63); constexpr int P2 = VT_PITCH / 2;
    vt[0 * P2] = (bf16_t)(v.x & 0xffffu); vt[1 * P2] = (bf16_t)(v.x >> 16); vt[2 * P2] = (bf16_t)(v.y & 0xffffu); vt[3 * P2] = (bf16_t)(v.y >> 16);
    vt[4 * P2] = (bf16_t)(v.z & 0xffffu); vt[5 * P2] = (bf16_t)(v.z >> 16); vt[6 * P2] = (bf16_t)(v.w & 0xffffu); vt[7 * P2] = (bf16_t)(v.w >> 16);
}
__device__ __forceinline__ void at_qk(f32x16& p0, f32x16& p1, const LAS unsigned char* Kt, const bf16x8 (&qr)[4], int r, int h) {
#pragma unroll
    for (int i = 0; i < 16; ++i) { p0[i] = 0.f; p1[i] = 0.f; }
#pragma unroll
    for (int ds = 0; ds < 4; ++ds) {
        const bf16x8 a0 = *(const LAS bf16x8*)(Kt + r * KT_PITCH + (16 * ds + 8 * h) * 2);
        const bf16x8 a1 = *(const LAS bf16x8*)(Kt + (32 + r) * KT_PITCH + (16 * ds + 8 * h) * 2);
        p0 = __builtin_amdgcn_mfma_f32_32x32x16_bf16(a0, qr[ds], p0, 0, 0, 0);
        p1 = __builtin_amdgcn_mfma_f32_32x32x16_bf16(a1, qr[ds], p1, 0, 0, 0);
    }
}
__device__ __forceinline__ void at_pv(f32x16 (&o)[2], const LAS unsigned char* Vt, const bf16x8 (&pk)[4], int r, int h) {
#pragma unroll
    for (int dh = 0; dh < 2; ++dh)
#pragma unroll
        for (int ks = 0; ks < 4; ++ks) { const LAS unsigned char* bp = Vt + (32 * dh + r) * VT_PITCH + (16 * ks + 4 * h) * 2;
            const u32x2 lo = *(const LAS u32x2*)bp, hi = *(const LAS u32x2*)(bp + 16);
            const u32x4 av = (u32x4){lo.x, lo.y, hi.x, hi.y};
            o[dh] = __builtin_amdgcn_mfma_f32_32x32x16_bf16(__builtin_bit_cast(bf16x8, av), pk[ks], o[dh], 0, 0, 0); }
}
template <bool BIAS, bool MASK, bool DSAM = false>
__device__ __forceinline__ void at_softmax(f32x16& p0, f32x16& p1, float& m, float& l, f32x16 (&o)[2], bf16x8 (&pk)[4], float sc2, const LAS float* bias2, int kmax, int h, unsigned mb = 0u) {
    float mt = NEGBIG;
#pragma unroll
    for (int g = 0; g < 4; ++g) {
        f32x4 b0 = (f32x4){0.f, 0.f, 0.f, 0.f}, b1 = b0;
        if (BIAS) { b0 = *(const LAS f32x4*)(bias2 + 8 * g + 4 * h); b1 = *(const LAS f32x4*)(bias2 + 32 + 8 * g + 4 * h); }
#pragma unroll
        for (int j = 0; j < 4; ++j) { const int reg = 4 * g + j, kv = 8 * g + 4 * h + j;
            float x0 = p0[reg] * sc2 + b0[j], x1 = p1[reg] * sc2 + b1[j];
            if (MASK) { if (kv > kmax) x0 = NEGBIG; if (kv + 32 > kmax) x1 = NEGBIG; }
            if (DSAM) { if (!((mb >> reg) & 1u)) x0 = NEGBIG; if (!((mb >> (16 + reg)) & 1u)) x1 = NEGBIG; }
            p0[reg] = x0; p1[reg] = x1; mt = fmaxf(mt, fmaxf(x0, x1)); }
    }
    mt = fmaxf(mt, __shfl_xor(mt, 32));
    const float mn = fmaxf(m, mt);
    if (__any(mn > m)) { const float al = __builtin_amdgcn_exp2f(m - mn); l *= al;
#pragma unroll
        for (int i = 0; i < 16; ++i) { o[0][i] *= al; o[1][i] *= al; }
        m = mn; }
    float s = 0.f;
#pragma unroll
    for (int i = 0; i < 16; ++i) { const float e0 = (p0[i] > -1e29f) ? __builtin_amdgcn_exp2f(p0[i] - m) : 0.f, e1 = (p1[i] > -1e29f) ? __builtin_amdgcn_exp2f(p1[i] - m) : 0.f; p0[i] = e0; p1[i] = e1; s += e0 + e1; }
    l += s;
#pragma unroll
    for (int ks = 0; ks < 2; ++ks) { u32x4 w0, w1;
        w0.x = pk2(p0[8 * ks + 0], p0[8 * ks + 1]); w0.y = pk2(p0[8 * ks + 2], p0[8 * ks + 3]); w0.z = pk2(p0[8 * ks + 4], p0[8 * ks + 5]); w0.w = pk2(p0[8 * ks + 6], p0[8 * ks + 7]);
        w1.x = pk2(p1[8 * ks + 0], p1[8 * ks + 1]); w1.y = pk2(p1[8 * ks + 2], p1[8 * ks + 3]); w1.z = pk2(p1[8 * ks + 4], p1[8 * ks + 5]); w1.w = pk2(p1[8 * ks + 6], p1[8 * ks + 7]);
        pk[ks] = __builtin_bit_cast(bf16x8, w0); pk[2 + ks] = __builtin_bit_cast(bf16x8, w1); }
}
__device__ __forceinline__ void at_loadq(bf16x8 (&qr)[4], const bf16_t* qrow, int h) {
#pragma unroll
    for (int ds = 0; ds < 4; ++ds) qr[ds] = *(const bf16x8*)(qrow + 16 * ds + 8 * h);
}
__device__ __forceinline__ void at_store(bf16_t* orow, const f32x16 (&o)[2], float inv, int h) {
#pragma unroll
    for (int dh = 0; dh < 2; ++dh)
#pragma unroll
        for (int g = 0; g < 4; ++g) { u32x2 w; w.x = pk2(o[dh][4 * g] * inv, o[dh][4 * g + 1] * inv); w.y = pk2(o[dh][4 * g + 2] * inv, o[dh][4 * g + 3] * inv);
            *(u32x2*)(orow + 32 * dh + 8 * g + 4 * h) = w; }
}

__device__ __forceinline__ void fox_unit(KP p, int bh, int qb, LAS unsigned char* lds) {
    const int tid = my_tid(), lane = tid & 63, wave = tid >> 6, r = lane & 31, h = lane >> 5, wv = wave & 3, g = wave >> 2;
    const int b = bh >> 2, hd = bh & 3;
    const bf16_t* P = (const bf16_t*)(p->ws + WS_PMIX) + (size_t)b * SEQ * NPM; bf16_t* OCT = (bf16_t*)(p->ws + WS_OCAT); const float* FC = (const float*)(p->ws + WS_FOXC) + (size_t)bh * SEQ;
    const int q0 = 128 * qb, qbase = q0 + 32 * wv; const float cref = FC[q0];
    bf16x8 qr[4]; at_loadq(qr, P + (size_t)(qbase + r) * NPM + C_FOX_Q + hd * 64, h);
    f32x16 o[2]; float m = NEGBIG, l = 0.f;
#pragma unroll
    for (int i = 0; i < 16; ++i) { o[0][i] = 0.f; o[1][i] = 0.f; }
    const bf16_t* Kc = P + C_FOX_K + hd * 64; const bf16_t* Vc = P + C_FOX_V + hd * 64;
    AtRegs pre0 = at_gload(Kc, Vc, tid), pre1 = at_gload(Kc + (size_t)64 * NPM, Vc + (size_t)64 * NPM, tid);
    float bpre = (tid < 128) ? FC[tid] : 0.f;
#pragma unroll 1
    for (int st = 0; st <= qb; ++st) {
        __syncthreads();
        at_sstore(lds, pre0, tid); at_sstore(lds + AT_TILE_BYTES, pre1, tid);
        if (tid < 128) ((LAS float*)(lds + (tid >> 6) * AT_TILE_BYTES + AT_K_BYTES + AT_V_BYTES))[tid & 63] = (cref - bpre) * LOG2E;
        __syncthreads();
        if (st < qb) { const size_t ko = (size_t)(128 * (st + 1)) * NPM; pre0 = at_gload(Kc + ko, Vc + ko, tid); pre1 = at_gload(Kc + ko + (size_t)64 * NPM, Vc + ko + (size_t)64 * NPM, tid);
            if (tid < 128) bpre = FC[128 * (st + 1) + tid]; }
        const int k0 = 64 * (2 * st + g); const LAS unsigned char* tile = lds + g * AT_TILE_BYTES;
        if (k0 <= qbase + 31) {
            f32x16 p0, p1; bf16x8 pk[4];
            at_qk(p0, p1, tile, qr, r, h);
            const LAS float* b2 = (const LAS float*)(tile + AT_K_BYTES + AT_V_BYTES);
            if (k0 + 63 > qbase) at_softmax<true, true>(p0, p1, m, l, o, pk, 0.125f * LOG2E, b2, qbase + r - k0, h);
            else at_softmax<true, false>(p0, p1, m, l, o, pk, 0.125f * LOG2E, b2, 0, h);
            at_pv(o, tile + AT_K_BYTES, pk, r, h);
        }
    }
    __syncthreads();
    LAS float* cb = (LAS float*)lds + (size_t)wv * (34 * 64);
    if (g == 1) { cb[lane] = m; cb[64 + lane] = l;
#pragma unroll
        for (int i = 0; i < 16; ++i) { cb[(2 + i) * 64 + lane] = o[0][i]; cb[(18 + i) * 64 + lane] = o[1][i]; } }
    __syncthreads();
    if (g == 0) { const float mb = cb[lane], lb = cb[64 + lane]; const float M = fmaxf(m, mb), sa = __builtin_amdgcn_exp2f(m - M), sb = __builtin_amdgcn_exp2f(mb - M);
        l = l * sa + lb * sb;
#pragma unroll
        for (int i = 0; i < 16; ++i) { o[0][i] = o[0][i] * sa + cb[(2 + i) * 64 + lane] * sb; o[1][i] = o[1][i] * sa + cb[(18 + i) * 64 + lane] * sb; }
        const float lt = l + __shfl_xor(l, 32);
        at_store(OCT + (size_t)(b * SEQ + qbase + r) * OC + 768 + hd * 64, o, 1.f / lt, h); }
}
__device__ __forceinline__ void swa_unit(KP p, int l_, int item, LAS unsigned char* lds) {
    const int tid = my_tid(), lane = tid & 63, wave = tid >> 6, r = lane & 31, h = lane >> 5;
    const int hk = item & 1, c = (item >> 1) & 31, b = item >> 6, head = hk * 4 + (wave >> 1), qpos = c * 64 + 32 * (wave & 1);
    const bf16_t* P = (const bf16_t*)(p->ws + WS_PMIX) + (size_t)b * SEQ * NPM; bf16_t* OCT = (bf16_t*)(p->ws + WS_OCAT);
    bf16x8 qr[4]; at_loadq(qr, P + (size_t)(qpos + r) * NPM + C_SWA_Q + head * 64, h);
    f32x16 o[2]; float m = p->in[I_SINKS][l_ * 8 + head] * LOG2E, l = (h == 0) ? 1.f : 0.f;
#pragma unroll
    for (int i = 0; i < 16; ++i) { o[0][i] = 0.f; o[1][i] = 0.f; }
    const int nch = (c + 1 < 3) ? (c + 1) : 3;
    const bf16_t* Kc = P + (size_t)(64 * (c - nch + 1)) * NPM + C_SWA_K + hk * 64; const bf16_t* Vc = P + (size_t)(64 * (c - nch + 1)) * NPM + C_SWA_V + hk * 64;
    AtRegs pre = at_gload(Kc, Vc, tid);
#pragma unroll 1
    for (int st = 0; st < nch; ++st) {
        __syncthreads();
        at_sstore(lds, pre, tid);
        __syncthreads();
        if (st + 1 < nch) pre = at_gload(Kc + (size_t)(64 * (st + 1)) * NPM, Vc + (size_t)(64 * (st + 1)) * NPM, tid);
        f32x16 p0, p1; bf16x8 pk[4];
        at_qk(p0, p1, lds, qr, r, h);
        at_softmax<false, false>(p0, p1, m, l, o, pk, 0.125f * LOG2E, nullptr, 0, h);
        at_pv(o, lds + AT_K_BYTES, pk, r, h);
    }
    const float lt = l + __shfl_xor(l, 32);
    at_store(OCT + (size_t)(b * SEQ + qpos + r) * OC + head * 64, o, 1.f / lt, h);
}

__device__ __forceinline__ size_t dsa_chunk_off(int b, int c) { return (size_t)b * (4096 * 528) + (size_t)4096 * (c * (c + 1) / 2); }
__device__ __forceinline__ void dsa_scores(KP p, LAS unsigned char* lds) {
    const int tid = my_tid(), lane = tid & 63, wave = tid >> 6, r = lane & 31, h = lane >> 5;
    const bf16_t* Pm = (const bf16_t*)(p->ws + WS_PMIX); float* SCR = (float*)(p->ws + WS_SCORES);
    LAS float* tb = (LAS float*)(lds + wave * (32 * 36 * 4));
    const int gw = blockIdx.x * 8 + wave, NGW = gridDim.x * 8;
    constexpr int PERB = 1036;
    for (int it = gw; it < NB * PERB; it += NGW) {
        const int b = it / PERB; int rem = it % PERB; const int qh = rem & 1; rem >>= 1;
        int c = 4; { int acc = 0; while (rem >= acc + c + 1) { acc += c + 1; ++c; } rem -= acc; } const int kb = rem;
        const bf16_t* Pb = Pm + (size_t)b * SEQ * NPM; const int qbase = c * 64 + 32 * qh;
        const bf16_t* qrow = Pb + (size_t)(qbase + r) * NPM;
        float wq[4];
#pragma unroll
        for (int hh = 0; hh < 4; ++hh) wq[hh] = bf2f(qrow[C_WIDX + hh]) * 0.0625f;
        float* dst = SCR + dsa_chunk_off(b, c) + (size_t)(32 * qh) * (64 * (c + 1)) + 64 * kb;
        bf16x8 qf[4][4], kf[2][4];
#pragma unroll
        for (int hh = 0; hh < 4; ++hh)
#pragma unroll
            for (int ds = 0; ds < 4; ++ds) qf[hh][ds] = *(const bf16x8*)(qrow + C_DSA_QI + hh * 64 + 16 * ds + 8 * h);
#pragma unroll
        for (int kh = 0; kh < 2; ++kh)
#pragma unroll
            for (int ds = 0; ds < 4; ++ds) kf[kh][ds] = *(const bf16x8*)(Pb + (size_t)(64 * kb + 32 * kh + r) * NPM + C_DSA_KI + 16 * ds + 8 * h);
#pragma unroll
        for (int kh = 0; kh < 2; ++kh) {
            f32x16 sc;
#pragma unroll
            for (int i = 0; i < 16; ++i) sc[i] = 0.f;
#pragma unroll
            for (int hh = 0; hh < 4; ++hh) { f32x16 a;
#pragma unroll
                for (int i = 0; i < 16; ++i) a[i] = 0.f;
#pragma unroll
                for (int ds = 0; ds < 4; ++ds) a = __builtin_amdgcn_mfma_f32_32x32x16_bf16(kf[kh][ds], qf[hh][ds], a, 0, 0, 0);
#pragma unroll
                for (int i = 0; i < 16; ++i) sc[i] += fmaxf(a[i], 0.f) * wq[hh]; }
#pragma unroll
            for (int g = 0; g < 4; ++g) *(LAS f32x4*)(tb + r * 36 + 8 * g + 4 * h) = (f32x4){sc[4 * g] + 0.f, sc[4 * g + 1] + 0.f, sc[4 * g + 2] + 0.f, sc[4 * g + 3] + 0.f};
            LDS_FENCE();
#pragma unroll
            for (int i = 0; i < 4; ++i) { const int q = 8 * i + (lane >> 3), cc = (lane & 7) * 4; const f32x4 v = *(const LAS f32x4*)(tb + q * 36 + cc);
                *(f32x4*)(dst + (size_t)q * (64 * (c + 1)) + 32 * kh + cc) = v; }
            LDS_FENCE();
        }
    }
}
__device__ __forceinline__ int count_ge8(int cnt, unsigned cand, unsigned k0, unsigned k1, unsigned k2, unsigned k3, unsigned k4, unsigned k5, unsigned k6, unsigned k7) {
    int t; unsigned long long m0, m1, m2, m3;
    asm volatile("v_cmp_ge_u32_e64 %2, %7, %6\n\tv_cmp_ge_u32_e64 %3, %8, %6\n\tv_cmp_ge_u32_e64 %4, %9, %6\n\tv_cmp_ge_u32_e64 %5, %10, %6\n\t"
                 "s_bcnt1_i32_b64 %1, %2\n\ts_add_i32 %0, %0, %1\n\tv_cmp_ge_u32_e64 %2, %11, %6\n\t"
                 "s_bcnt1_i32_b64 %1, %3\n\ts_add_i32 %0, %0, %1\n\tv_cmp_ge_u32_e64 %3, %12, %6\n\t"
                 "s_bcnt1_i32_b64 %1, %4\n\ts_add_i32 %0, %0, %1\n\tv_cmp_ge_u32_e64 %4, %13, %6\n\t"
                 "s_bcnt1_i32_b64 %1, %5\n\ts_add_i32 %0, %0, %1\n\tv_cmp_ge_u32_e64 %5, %14, %6\n\t"
                 "s_bcnt1_i32_b64 %1, %2\n\ts_add_i32 %0, %0, %1\n\t"
                 "s_bcnt1_i32_b64 %1, %3\n\ts_add_i32 %0, %0, %1\n\t"
                 "s_bcnt1_i32_b64 %1, %4\n\ts_add_i32 %0, %0, %1\n\t"
                 "s_bcnt1_i32_b64 %1, %5\n\ts_add_i32 %0, %0, %1"
                 : "+s"(cnt), "=&s"(t), "=&s"(m0), "=&s"(m1), "=&s"(m2), "=&s"(m3)
                 : "v"(cand), "v"(k0), "v"(k1), "v"(k2), "v"(k3), "v"(k4), "v"(k5), "v"(k6), "v"(k7) : "scc");
    return cnt;
}
__device__ __forceinline__ int count_lane4(int cnt, unsigned cand, unsigned k0, unsigned k1, unsigned k2, unsigned k3) {
    asm volatile("v_cmp_ge_u32_e32 vcc, %2, %1\n\tv_addc_co_u32_e32 %0, vcc, 0, %0, vcc\n\t"
                 "v_cmp_ge_u32_e32 vcc, %3, %1\n\tv_addc_co_u32_e32 %0, vcc, 0, %0, vcc\n\t"
                 "v_cmp_ge_u32_e32 vcc, %4, %1\n\tv_addc_co_u32_e32 %0, vcc, 0, %0, vcc\n\t"
                 "v_cmp_ge_u32_e32 vcc, %5, %1\n\tv_addc_co_u32_e32 %0, vcc, 0, %0, vcc"
                 : "+v"(cnt) : "v"(cand), "v"(k0), "v"(k1), "v"(k2), "v"(k3) : "vcc");
    return cnt;
}
__device__ __forceinline__ int count_ge32(const unsigned (&key)[32], unsigned cand) {
    int cnt = 0;
#pragma unroll
    for (int i = 0; i < 32; i += 8) cnt = count_ge8(cnt, cand, key[i], key[i + 1], key[i + 2], key[i + 3], key[i + 4], key[i + 5], key[i + 6], key[i + 7]);
    return cnt;
}
__device__ __forceinline__ void dsa_select(KP p, LAS unsigned char* lds) {
    const int tid = my_tid(), lane0 = tid & 63, wave = tid >> 6, gw = blockIdx.x * 8 + wave, NGW = gridDim.x * 8;
#pragma unroll 1
    for (int it = gw; it < NB * 28 * 64; it += NGW) {
        int lane = lane0; asm volatile("" : "+v"(lane));
        const int b = it / (28 * 64), rem = it % (28 * 64), c = 4 + (rem >> 6), ql = rem & 63, nadm = 64 * (c + 1);
        const float* srow = (const float*)(p->ws + WS_SCORES) + dsa_chunk_off(b, c) + (size_t)ql * nadm;
        unsigned key[32];
#pragma unroll
        for (int i = 0; i < 32; ++i) { const int kv = 64 * i + lane; key[i] = __float_as_uint(srow[kv < nadm ? kv : nadm - 1]); }
#pragma unroll
        for (int i = 0; i < 32; ++i) asm volatile("" : "+v"(key[i]));
#pragma unroll
        for (int i = 0; i < 32; ++i) { const int kv = 64 * i + lane; key[i] = (kv < nadm) ? fkey(__uint_as_float(key[i]) + 0.f) : 0u; }
        unsigned Tk = 0u;
#define SEL_COUNT(cnt_, cand_) do { int cl_ = 0; cl_ = count_lane4(cl_, cand_, key[0], key[1], key[2], key[3]); \
            cnt_ = count_ge8(0, cand_, key[4], key[5], key[6], key[7], key[8], key[9], key[10], key[11]); \
            if (c >= 12) { cl_ = count_lane4(cl_, cand_, key[12], key[13], key[14], key[15]); \
                if (c >= 16) { cnt_ = count_ge8(cnt_, cand_, key[16], key[17], key[18], key[19], key[20], key[21], key[22], key[23]); \
                    if (c >= 24) { cl_ = count_lane4(cl_, cand_, key[24], key[25], key[26], key[27]); if (c >= 28) cl_ = count_lane4(cl_, cand_, key[28], key[29], key[30], key[31]); } } } \
            cnt_ += (int)wave_sum_s((float)cl_); } while (0)
#pragma unroll 1
        for (int bit = 31; bit >= 12; --bit) { const unsigned cand = Tk | (1u << bit); int cnt; SEL_COUNT(cnt, cand); if (cnt >= 256) Tk = cand; }
        { const unsigned pfx = Tk >> 12; unsigned e0 = 0u, e1 = 0u; int nb = 0;
#pragma unroll
            for (int i = 0; i < 32; ++i) { const bool inb = (key[i] >> 12) == pfx && key[i] != 0u; e1 = (inb && nb == 1) ? key[i] : e1; e0 = (inb && nb == 0) ? key[i] : e0; nb += inb ? 1 : 0; }
            if (__any(nb > 2)) {
#pragma unroll 1
                for (int bit = 11; bit >= 0; --bit) { const unsigned cand = Tk | (1u << bit); int cnt; SEL_COUNT(cnt, cand); if (cnt >= 256) Tk = cand; }
            } else {
                int above = 0; if (pfx != 0xfffffu) { SEL_COUNT(above, Tk + 0x1000u); }
                const int need = 256 - above;
#pragma unroll 1
                for (int bit = 11; bit >= 0; --bit) { const unsigned cand = Tk | (1u << bit); const int cl = ((e0 >= cand) ? 1 : 0) + ((e1 >= cand) ? 1 : 0);
                    if ((int)wave_sum_s((float)cl) >= need) Tk = cand; }
            }
        }
#undef SEL_COUNT
        const int cge = count_ge32(key, Tk), cgt = count_ge32(key, Tk + 1u), quota = 256 - cgt, nt = cge - cgt;
        int cut = -1, acc = 0; const unsigned long long ltm = (1ull << lane) - 1ull;
#pragma unroll
        for (int i = 0; i < 32; ++i) { const unsigned long long tm = __ballot(key[i] == Tk); const int n = __builtin_popcountll(tm);
            if (acc < quota && acc + n >= quota) { const unsigned long long hit = __ballot(key[i] == Tk && __builtin_popcountll(tm & ltm) == quota - acc - 1); cut = 64 * i + (int)__builtin_ctzll(hit); }
            acc += n; }
        (void)nt;
        unsigned long long mine = 0ull;
#pragma unroll
        for (int i = 0; i < 32; ++i) { const unsigned long long sm = __ballot((key[i] > Tk) || (key[i] == Tk && 64 * i + lane <= cut)); mine = (lane == i) ? sm : mine; }
        if (lane < 32) ((unsigned long long*)(p->ws + WS_MASKB))[(size_t)(b * SEQ + c * 64 + ql) * 32 + lane] = mine;
    }
}
__device__ __forceinline__ void dsa_unit(KP p, int b, int c, int hp, LAS unsigned char* lds) {
    const int tid = my_tid(), lane = tid & 63, wave = tid >> 6, r = lane & 31, h = lane >> 5, wv = wave & 3, g = wave >> 2;
    const bf16_t* P = (const bf16_t*)(p->ws + WS_PMIX) + (size_t)b * SEQ * NPM; bf16_t* OCT = (bf16_t*)(p->ws + WS_OCAT);
    const int nadm = 64 * (c + 1);
    const float* SCRc = (const float*)(p->ws + WS_SCORES) + dsa_chunk_off(b, c);
    const bool sel = nadm > 256;
    const int head = 2 * hp + (wv >> 1), ql = 32 * (wv & 1) + r, qbase = 64 * c + 32 * (wv & 1);
    const unsigned long long* mrow = (const unsigned long long*)(p->ws + WS_MASKB) + (size_t)(b * SEQ + c * 64 + ql) * 32;
    bf16x8 qr[4]; at_loadq(qr, P + (size_t)(qbase + r) * NPM + C_DSA_Q + head * 64, h);
    f32x16 o[2]; float m = NEGBIG, l = 0.f;
#pragma unroll
    for (int i = 0; i < 16; ++i) { o[0][i] = 0.f; o[1][i] = 0.f; }
    const int nst = (c + 2) >> 1;
    const bf16_t* Kc = P + C_DSA_K; const bf16_t* Vc = P + C_DSA_V;
    AtRegs pre0 = at_gload(Kc, Vc, tid), pre1 = at_gload(Kc + (size_t)((c >= 1) ? 64 : 0) * NPM, Vc + (size_t)((c >= 1) ? 64 : 0) * NPM, tid);
#pragma unroll 1
    for (int st = 0; st < nst; ++st) {
        __syncthreads();
        at_sstore(lds, pre0, tid); at_sstore(lds + AT_TILE_BYTES, pre1, tid);
        __syncthreads();
        if (st + 1 < nst) { const int j0 = 2 * st + 2, j1 = (j0 + 1 <= c) ? j0 + 1 : j0; pre0 = at_gload(Kc + (size_t)(64 * j0) * NPM, Vc + (size_t)(64 * j0) * NPM, tid); pre1 = at_gload(Kc + (size_t)(64 * j1) * NPM, Vc + (size_t)(64 * j1) * NPM, tid); }
        const int jt = 2 * st + g; const LAS unsigned char* tile = lds + g * AT_TILE_BYTES;
        if (jt <= c) {
            unsigned mb = 0u;
            if (sel) { const unsigned long long m64 = mrow[jt] >> (4 * h);
#pragma unroll
                for (int kvh = 0; kvh < 2; ++kvh)
#pragma unroll
                    for (int reg = 0; reg < 16; ++reg) mb |= (unsigned)((m64 >> (32 * kvh + (reg & 3) + 8 * (reg >> 2))) & 1ull) << (16 * kvh + reg); }
            f32x16 p0, p1; bf16x8 pk[4];
            at_qk(p0, p1, tile, qr, r, h);
            if (sel) at_softmax<false, false, true>(p0, p1, m, l, o, pk, 0.125f * LOG2E, nullptr, 0, h, mb);
            else at_softmax<false, false>(p0, p1, m, l, o, pk, 0.125f * LOG2E, nullptr, 0, h);
            at_pv(o, tile + AT_K_BYTES, pk, r, h);
        }
    }
    __syncthreads();
    LAS float* cb = (LAS float*)lds + (size_t)wv * (34 * 64);
    if (g == 1) { cb[lane] = m; cb[64 + lane] = l;
#pragma unroll
        for (int i = 0; i < 16; ++i) { cb[(2 + i) * 64 + lane] = o[0][i]; cb[(18 + i) * 64 + lane] = o[1][i]; } }
    __syncthreads();
    if (g == 0) { const float mb = cb[lane], lb = cb[64 + lane]; const float M = fmaxf(m, mb), sa = __builtin_amdgcn_exp2f(m - M), sb = __builtin_amdgcn_exp2f(mb - M);
        l = l * sa + lb * sb;
#pragma unroll
        for (int i = 0; i < 16; ++i) { o[0][i] = o[0][i] * sa + cb[(2 + i) * 64 + lane] * sb; o[1][i] = o[1][i] * sa + cb[(18 + i) * 64 + lane] * sb; }
        const float lt = l + __shfl_xor(l, 32);
        at_store(OCT + (size_t)(b * SEQ + qbase + r) * OC + 1024 + head * 64, o, 1.f / lt, h); }
}

template <int N> __device__ __forceinline__ float dpp_ror(float x) { return __int_as_float(__builtin_amdgcn_update_dpp(0, __float_as_int(x), 0x120 + N, 0xf, 0xf, false)); }
__device__ __forceinline__ void row16_sum2(float& a, float& b) {
    a += dpp_ror<8>(a); b += dpp_ror<8>(b); a += dpp_ror<4>(a); b += dpp_ror<4>(b); a += dpp_ror<2>(a); b += dpp_ror<2>(b); a += dpp_ror<1>(a); b += dpp_ror<1>(b);
}
__device__ __forceinline__ float row16_sum(float x) { x += dpp_ror<8>(x); x += dpp_ror<4>(x); x += dpp_ror<2>(x); x += dpp_ror<1>(x); return x; }
__device__ __forceinline__ void rwkv_scan2(KP p, int l, int sw, LAS unsigned char* lds) {
    const int tid = my_tid(), lane = tid & 63, wave = tid >> 6; const int bh = sw >> 2, b = bh >> 2, h = bh & 3, rowbase = 16 * (sw & 3);
    const int rl = lane >> 4, c = lane & 15, r16 = 4 * (wave & 3) + rl;
    const float* RW = (const float*)(p->ws + WS_RW);
    const float* RWv = RW + (size_t)5 * T * 256; float* Y = (float*)(p->ws + WS_Y); float* BONW = (float*)(p->ws + WS_BONUS); const float rkl = p->in[I_RK][l * 256 + h * 64 + lane];
    LAS float* L = (LAS float*)lds;
    LAS float* Lv = L + 5 * 1024; LAS float* Ly = Lv + 256;
    f32x4 S = (f32x4){0.f, 0.f, 0.f, 0.f}, rprev = (f32x4){0.f, 0.f, 0.f, 0.f};
    const size_t hb = (size_t)b * SEQ * 256 + h * 64;
    f32x2 pre[5]; float vpre = 0.f;
#pragma unroll
    for (int a = 0; a < 5; ++a) { const int e = 2 * tid; pre[a] = *(const f32x2*)(RW + (size_t)a * T * 256 + hb + (size_t)(e >> 6) * 256 + (e & 63)); }
    if (tid < 256) vpre = RWv[hb + (size_t)(tid >> 4) * 256 + rowbase + (tid & 15)];
#pragma unroll 1
    for (int tb = 0; tb < SEQ; tb += 16) {
        __syncthreads();
        if (tb > 0 && tid < 256) { const int st = tb - 17 + (tid >> 4); if (st >= 0) Y[hb + (size_t)st * 256 + rowbase + (tid & 15)] = Ly[tid]; }
#pragma unroll
        for (int a = 0; a < 5; ++a) *(LAS f32x2*)(L + a * 1024 + 2 * tid) = pre[a];
        if (tid < 256) Lv[tid] = vpre;
        __syncthreads();
        if (tb + 16 < SEQ) {
#pragma unroll
            for (int a = 0; a < 5; ++a) { const int e = 2 * tid; pre[a] = *(const f32x2*)(RW + (size_t)a * T * 256 + hb + (size_t)(tb + 16 + (e >> 6)) * 256 + (e & 63)); }
            if (tid < 256) vpre = RWv[hb + (size_t)(tb + 16 + (tid >> 4)) * 256 + rowbase + (tid & 15)];
        }
        if ((sw & 3) == 0 && wave >= 4) {
#pragma unroll
            for (int i4 = 0; i4 < 4; ++i4) { const int i = 4 * (wave - 4) + i4; const float s = wave_sum(L[0 * 1024 + i * 64 + lane] * L[2 * 1024 + i * 64 + lane] * rkl);
                if (lane == 0) BONW[(size_t)(b * SEQ + tb + i) * 4 + h] = s; }
        }
        if (wave < 4) {
            f32x4 r_ = *(const LAS f32x4*)(L + 0 * 1024 + 4 * c), w_ = *(const LAS f32x4*)(L + 1 * 1024 + 4 * c), k_ = *(const LAS f32x4*)(L + 2 * 1024 + 4 * c);
            f32x4 kk_ = *(const LAS f32x4*)(L + 3 * 1024 + 4 * c), ka_ = *(const LAS f32x4*)(L + 4 * 1024 + 4 * c); float v_ = Lv[r16];
#pragma unroll
            for (int i = 0; i < 16; ++i) {
                f32x4 rn = r_, wn = w_, kn = k_, kkn = kk_, kan = ka_; float vn = v_;
                if (i < 15) { rn = *(const LAS f32x4*)(L + 0 * 1024 + (i + 1) * 64 + 4 * c); wn = *(const LAS f32x4*)(L + 1 * 1024 + (i + 1) * 64 + 4 * c); kn = *(const LAS f32x4*)(L + 2 * 1024 + (i + 1) * 64 + 4 * c);
                    kkn = *(const LAS f32x4*)(L + 3 * 1024 + (i + 1) * 64 + 4 * c); kan = *(const LAS f32x4*)(L + 4 * 1024 + (i + 1) * 64 + 4 * c); vn = Lv[(i + 1) * 16 + r16]; }
                float pa = (S.x * kk_.x + S.y * kk_.y) + (S.z * kk_.z + S.w * kk_.w);
                float py = (S.x * rprev.x + S.y * rprev.y) + (S.z * rprev.z + S.w * rprev.w);
                row16_sum2(pa, py);
                Ly[i * 16 + r16] = py;
                S = S * w_ - ka_ * pa + k_ * v_;
                rprev = r_;
                r_ = rn; w_ = wn; k_ = kn; kk_ = kkn; ka_ = kan; v_ = vn;
            }
        }
    }
    __syncthreads();
    if (tid < 256) { const int st = SEQ - 17 + (tid >> 4); Y[hb + (size_t)st * 256 + rowbase + (tid & 15)] = Ly[tid]; }
    if (wave < 4) { const float py = row16_sum((S.x * rprev.x + S.y * rprev.y) + (S.z * rprev.z + S.w * rprev.w)); if (c == 0) Y[hb + (size_t)(SEQ - 1) * 256 + rowbase + r16] = py; }
}
__device__ __forceinline__ void rwkv_post(KP p, int l) {
    const int tid = my_tid(), lane = tid & 63, wave = tid >> 6, gw = blockIdx.x * 8 + wave, NGW = gridDim.x * 8;
    const float* RW = (const float*)(p->ws + WS_RW); const float* RWv = RW + (size_t)5 * T * 256; const float* RWg = RW + (size_t)6 * T * 256;
    const float* Y = (const float*)(p->ws + WS_Y); const float* BON = (const float*)(p->ws + WS_BONUS); bf16_t* OCT = (bf16_t*)(p->ws + WS_OCAT);
    float gng[4], gnb[4];
#pragma unroll
    for (int hh = 0; hh < 4; ++hh) { gng[hh] = p->in[I_GNG][l * 256 + hh * 64 + lane]; gnb[hh] = p->in[I_GNB][l * 256 + hh * 64 + lane]; }
#pragma unroll 2
    for (int t = gw; t < T; t += NGW) {
#pragma unroll
        for (int hh = 0; hh < 4; ++hh) { const size_t o = (size_t)t * 256 + hh * 64 + lane; const float yy = Y[o];
            const float mean = wave_sum(yy) * (1.f / 64.f); const float d = yy - mean; const float var = wave_sum(d * d) * (1.f / 64.f);
            const float ov = (d * rsqrtf(var + 64e-5f) * gng[hh] + gnb[hh] + BON[t * 4 + hh] * RWv[o]) * RWg[o];
            OCT[(size_t)t * OC + 512 + hh * 64 + lane] = (bf16_t)f2bf(ov); }
    }
}

__device__ __forceinline__ void ph_scan(KP p, int l, LAS unsigned char* lds) {
    if (blockIdx.x < 128) { rwkv_scan2(p, l, blockIdx.x, lds); return; }
    const int tid = my_tid(); unsigned* ctl = (unsigned*)(p->ws + WS_CTL) + 512 + 64 * l; LAS int* slot = (LAS int*)(lds + LDS_BYTES - 256);
    for (;;) { if (tid == 0) *slot = (int)atomicAdd(ctl, 1u); __syncthreads(); const int it = *slot; __syncthreads(); if (it >= 512) break; fox_unit(p, it & 31, 15 - (it >> 5), lds); __syncthreads(); }
    for (;;) { if (tid == 0) *slot = (int)atomicAdd(ctl + 16, 1u); __syncthreads(); const int it = *slot; __syncthreads(); if (it >= 512) break; swa_unit(p, l, it, lds); __syncthreads(); }
}
__device__ __forceinline__ void ph_attn(KP p, int l, LAS unsigned char* lds) {
    dsa_scores(p, lds);
    rwkv_post(p, l);
}
__device__ __forceinline__ void ph_dsa_xb(KP p, int l, LAS unsigned char* lds) {
    {
        const int w = blockIdx.x, b = w >> 5, s = (w >> 1) & 15, hp = w & 1;
        dsa_unit(p, b, 31 - s, hp, lds);
        __syncthreads();
        dsa_unit(p, b, s, hp, lds);
        __syncthreads();
    }
}

struct SchedMerge {
    static constexpr int PERM = 1;
    const char* XB; const char* WIN; const char* OCT; const char* WB; int G, c;
    __device__ __forceinline__ bool next(int i, mg::Unit& u) const {
        int pm, pn; if (!mg::static_tile(i >> 3, G, c, T / 256, 4, pm, pn)) return false;
        const int j = i & 7, br = j >> 1; u.pm = pm; u.pn = pn; u.tag = j;
        if ((j & 1) == 0) { u.A = XB + (size_t)pm * 256 * 2048; u.B = WIN + (size_t)(3328 + 1024 * br + 256 * pn) * 2048; u.ld = 2048; u.nt = 16; }
        else { const int koff = (br == 0) ? 0 : 256 + 256 * br, kk = (br == 0) ? 512 : 256;
            u.A = OCT + (size_t)pm * 256 * (OC * 2) + koff * 2; u.B = WB + (size_t)pn * 256 * (OC * 2) + koff * 2; u.ld = OC * 2; u.nt = kk / 64; }
        return true;
    }
};
struct EpiMerge {
    const float* gbias; u32x4* gsc; u32x4* macc; bf16_t* MB;
    __device__ __forceinline__ void operator()(const AccT& acc, const mg::Unit& u, int wr, int wc, int fr, int fq, int tid) const {
        const int br = u.tag >> 1; const int col0 = u.pn * 256 + wc * 32 + 8 * fq, row0 = u.pm * 256 + wr * 64 + fr;
        if ((u.tag & 1) == 0) {
            f32x4 bv[2][2];
#pragma unroll
            for (int bj = 0; bj < 2; ++bj)
#pragma unroll
                for (int n = 0; n < 2; ++n) bv[bj][n] = *(const f32x4*)(gbias + br * 1024 + col0 + bj * 128 + 4 * n);
#pragma unroll
            for (int ai = 0; ai < 2; ++ai)
#pragma unroll
                for (int m = 0; m < 4; ++m)
#pragma unroll
                    for (int bj = 0; bj < 2; ++bj) { f32x4 g[2];
#pragma unroll
                        for (int n = 0; n < 2; ++n) { const f32x4 x = acc[ai][bj][m][n] + bv[bj][n];
#pragma unroll
                            for (int j = 0; j < 4; ++j) g[n][j] = sigm(x[j]); }
                        u32x4 w; w.x = pk2(g[0][0], g[0][1]); w.y = pk2(g[0][2], g[0][3]); w.z = pk2(g[1][0], g[1][1]); w.w = pk2(g[1][2], g[1][3]);
                        gsc[(((ai * 4 + m) * 2 + bj) * 512) + tid] = w; asm volatile("" ::: "memory"); }
        } else {
#pragma unroll
            for (int ai = 0; ai < 2; ++ai)
#pragma unroll
                for (int m = 0; m < 4; ++m) { bf16_t* rowp = MB + (size_t)(row0 + ai * 128 + m * 16) * D + col0;
#pragma unroll
                    for (int bj = 0; bj < 2; ++bj) { const int idx = (((ai * 4 + m) * 2 + bj) * 512) + tid; float g[8], r[8]; unpack8(gsc[idx], g);
#pragma unroll
                        for (int n = 0; n < 2; ++n)
#pragma unroll
                            for (int j = 0; j < 4; ++j) r[4 * n + j] = g[4 * n + j] * acc[ai][bj][m][n][j];
                        if (br > 0) { float pm[8]; unpack8(macc[idx], pm);
#pragma unroll
                            for (int j = 0; j < 8; ++j) r[j] += pm[j]; }
                        u32x4 w; w.x = pk2(r[0], r[1]); w.y = pk2(r[2], r[3]); w.z = pk2(r[4], r[5]); w.w = pk2(r[6], r[7]);
                        if (br < 3) macc[idx] = w; else *(u32x4*)(rowp + bj * 128) = w;
                        asm volatile("" ::: "memory"); } }
        }
    }
};
__device__ __forceinline__ void ph_merge(KP p, int l, LAS unsigned char* lds) {
    SchedMerge S{(const char*)(p->ws + WS_XB2), (const char*)(p->ws + WS_WIN), (const char*)(p->ws + WS_OCAT), (const char*)(p->ws + WS_WB), (int)gridDim.x, (int)blockIdx.x};
    EpiMerge E{p->in[I_GB] + (size_t)l * 4096, (u32x4*)(p->ws + WS_GSC) + (size_t)blockIdx.x * 8192, (u32x4*)(p->ws + WS_MACC) + (size_t)blockIdx.x * 8192, (bf16_t*)(p->ws + WS_MERGED)};
    mg::gemm_run(lds, S, E);
}

struct EpiResid {
    const float* base; float* out; float alpha;
    __device__ __forceinline__ void operator()(const AccT& acc, const mg::Unit& u, int wr, int wc, int fr, int fq, int) const {
        const int row0 = u.pm * 256 + wr * 64 + fr, col0 = u.pn * 256 + wc * 32 + 4 * fq;
#pragma unroll
        for (int ai = 0; ai < 2; ++ai)
#pragma unroll
            for (int m = 0; m < 4; ++m) { const size_t off = (size_t)(row0 + ai * 128 + m * 16) * D + col0;
#pragma unroll
                for (int bj = 0; bj < 2; ++bj)
#pragma unroll
                    for (int n = 0; n < 2; ++n) { const f32x4 bs = *(const f32x4*)(base + off + bj * 128 + n * 16); *(f32x4*)(out + off + bj * 128 + n * 16) = bs * alpha + acc[ai][bj][m][n]; } }
    }
};
__device__ __forceinline__ void ph_outproj(KP p, int l, LAS unsigned char* lds) {
    SchedPlain<0, 4, D> S{(const char*)(p->ws + WS_MERGED), (const char*)(p->ws + WS_WO), (int)gridDim.x, (int)blockIdx.x};
    EpiResid E{(l == 0) ? p->in[I_X] : p->out, p->out, DN_ALPHA};
    mg::gemm_run(lds, S, E);
}

__device__ __forceinline__ void ln_rows(KP p, int l, int mode, LAS unsigned char* lds) {
    const int tid = my_tid(), lane = tid & 63, wave = tid >> 6;
    const float* g = p->in[I_LNG] + (size_t)(l * 2 + mode) * D; const float* bb = p->in[I_LNB] + (size_t)(l * 2 + mode) * D;
    bf16_t* OB = (bf16_t*)(p->ws + (mode == 0 ? WS_X1B : WS_XB)); const bool wb = (mode == 0) || (l == 0);
    const bool moe = (mode == 0) && (l & 1); const float* rw = p->in[I_RTW] + (size_t)(l >> 1) * D * NE; const float* rb = p->in[I_RTB] + (l >> 1) * NE;
    int* TOKE = (int*)(p->ws + WS_TOKE); float* TOKW = (float*)(p->ws + WS_TOKW);
    f32x4 gv[4], bv[4];
#pragma unroll
    for (int j = 0; j < 4; ++j) { gv[j] = *(const f32x4*)(g + 4 * lane + 256 * j); bv[j] = *(const f32x4*)(bb + 4 * lane + 256 * j); }
    const int rows_per_wg = T / gridDim.x;
#pragma unroll 2
    for (int rr = wave; rr < rows_per_wg; rr += 8) {
        const int row = blockIdx.x * rows_per_wg + rr; float* xr = p->out + (size_t)row * D;
        f32x4 v[4]; float s = 0.f;
#pragma unroll
        for (int j = 0; j < 4; ++j) v[j] = *(const f32x4*)(xr + 4 * lane + 256 * j);
        if (mode == 1 && (l & 1)) {
            const int* RO = (const int*)(p->ws + WS_ROWOF); const bf16_t* YB = (const bf16_t*)(p->ws + WS_AG);
#pragma unroll
            for (int sl = 0; sl < 2; ++sl) { const int yr = RO[row * 2 + sl]; const float w = TOKW[row * 2 + sl];
#pragma unroll
                for (int j = 0; j < 4; ++j) { const u32x2 y = *(const u32x2*)(YB + (size_t)yr * D + 4 * lane + 256 * j);
                    v[j].x += w * bflo(y.x); v[j].y += w * bfhi(y.x); v[j].z += w * bflo(y.y); v[j].w += w * bfhi(y.y); } } }
#pragma unroll
        for (int j = 0; j < 4; ++j) s += (v[j].x + v[j].y) + (v[j].z + v[j].w);
        const float mean = wave_sum(s) * (1.f / D); float s2 = 0.f;
#pragma unroll
        for (int j = 0; j < 4; ++j) { v[j] = v[j] - mean; s2 += (v[j].x * v[j].x + v[j].y * v[j].y) + (v[j].z * v[j].z + v[j].w * v[j].w); }
        const float rstd = rsqrtf(wave_sum(s2) * (1.f / D) + LN_EPS);
        const float osc = (mode == 0) ? DN_ALPHA : 1.f;
#pragma unroll
        for (int j = 0; j < 4; ++j) { v[j] = v[j] * rstd * gv[j] + bv[j]; *(f32x4*)(xr + 4 * lane + 256 * j) = v[j] * osc;
            if (wb) *(unsigned long long*)(OB + (size_t)row * D + 4 * lane + 256 * j) = (unsigned long long)pk2(v[j].x, v[j].y) | ((unsigned long long)pk2(v[j].z, v[j].w) << 32); }
        if (moe) {
            float lg[8];
#pragma unroll
            for (int e = 0; e < 8; ++e) lg[e] = 0.f;
#pragma unroll
            for (int j = 0; j < 4; ++j)
#pragma unroll
                for (int q = 0; q < 4; ++q) { const int c = 4 * lane + 256 * j + q; const f32x4 w0 = *(const f32x4*)(rw + (size_t)c * 8), w1 = *(const f32x4*)(rw + (size_t)c * 8 + 4); const float x = v[j][q];
                    lg[0] += x * w0.x; lg[1] += x * w0.y; lg[2] += x * w0.z; lg[3] += x * w0.w; lg[4] += x * w1.x; lg[5] += x * w1.y; lg[6] += x * w1.z; lg[7] += x * w1.w; }
#pragma unroll
            for (int e = 0; e < 8; ++e) lg[e] = wave_sum(lg[e]) + rb[e];
            int e1 = 0; float v1 = lg[0];
#pragma unroll
            for (int e = 1; e < 8; ++e) if (lg[e] > v1) { v1 = lg[e]; e1 = e; }
            int e2 = -1; float v2 = -INFINITY;
#pragma unroll
            for (int e = 0; e < 8; ++e) if (e != e1 && lg[e] > v2) { v2 = lg[e]; e2 = e; }
            const float w1 = 1.f / (1.f + __expf(v2 - v1));
            if (lane == 0) { TOKE[row * 2] = e1; TOKE[row * 2 + 1] = e2; TOKW[row * 2] = w1; TOKW[row * 2 + 1] = 1.f - w1; }
        }
    }
    if (moe) {
        __syncthreads();
        if (tid < 8) { int cnt = 0; for (int rr = 0; rr < rows_per_wg; ++rr) { const int row = blockIdx.x * rows_per_wg + rr; cnt += (TOKE[row * 2] == tid) + (TOKE[row * 2 + 1] == tid); }
            ((int*)(p->ws + WS_WGCNT))[blockIdx.x * 8 + tid] = cnt; }
    }
}
__device__ __forceinline__ void ph_ln1(KP p, int l, LAS unsigned char* lds) {
    ln_rows(p, l, 0, lds);
    __syncthreads();
    const int tid_ = my_tid(); const int lane = tid_ & 63, wave = tid_ >> 6, gw = blockIdx.x * 8 + wave, NGW = gridDim.x * 8;
    LAS float* scr = (LAS float*)(lds + wave * 8448);
    bf16_t* W13 = (bf16_t*)(p->ws + WS_WF13);
    if ((l & 1) == 0) {
        const int j = l >> 1; const float* w1 = p->in[I_F1] + (size_t)j * D * DFF; const float* w3 = p->in[I_F3] + (size_t)j * D * DFF; const float* w2 = p->in[I_F2] + (size_t)j * DFF * D;
        bf16_t* W2 = (bf16_t*)(p->ws + WS_WF2_DENSE);
        const int n1 = tr_nitems(D, DFF), n2 = tr_nitems(DFF, D);
        for (int it = gw; it < 2 * n1 + n2; it += NGW) { int r = it;
            if (r < n1) { tr_item(w1, D, DFF, W13, D, 2, 0, scr, r, lane); continue; } r -= n1;
            if (r < n1) { tr_item(w3, D, DFF, W13, D, 3, 0, scr, r, lane); continue; } r -= n1;
            tr_item(w2, DFF, D, W2, DFF, 0, 0, scr, r, lane); }
    } else {
        const int j = l >> 1; bf16_t* W2 = (bf16_t*)(p->ws + WS_WF2_MOE);
        const int n1 = tr_nitems(D, DFE), n2 = tr_nitems(DFE, D), per = 2 * n1 + n2;
        for (int it = gw; it < NE * per; it += NGW) { const int e = it / per; int r = it % per;
            const float* w1 = p->in[I_E1] + ((size_t)j * NE + e) * D * DFE; const float* w3 = p->in[I_E3] + ((size_t)j * NE + e) * D * DFE; const float* w2 = p->in[I_E2] + ((size_t)j * NE + e) * DFE * D;
            if (r < n1) { tr_item(w1, D, DFE, W13, D, 2, e * 2 * DFE, scr, r, lane); continue; } r -= n1;
            if (r < n1) { tr_item(w3, D, DFE, W13, D, 3, e * 2 * DFE, scr, r, lane); continue; } r -= n1;
            tr_item(w2, DFE, D, W2, DFE, 0, e * D, scr, r, lane); }
    }
}

__device__ __forceinline__ void moe_tables(KP p, LAS int* tb  ) {
    const int tid = my_tid(), lane = tid & 63, e = tid >> 6; const int* WG = (const int*)(p->ws + WS_WGCNT);
    { int tot = 0, mine = 0;
#pragma unroll
        for (int k = 0; k < 4; ++k) { const int w = lane + 64 * k; const int c = (w < (int)gridDim.x) ? WG[w * 8 + e] : 0; tot += c; mine += (w < (int)blockIdx.x) ? c : 0; }
        tot = (int)wave_sum((float)tot); mine = (int)wave_sum((float)mine);
        if (lane == 0) { tb[e] = tot; tb[16 + e] = mine; } }
    __syncthreads();
    if (tid == 0) { int base = 0; for (int x = 0; x < 8; ++x) { tb[8 + x] = base; base += ((tb[x] + 255) >> 8) << 8; } tb[24] = base; }
    __syncthreads();
}
__device__ __forceinline__ void ph_moe_assign(KP p, int l, LAS unsigned char* lds) {
    const int tid = my_tid(), lane = tid & 63, wave = tid >> 6;
    LAS int* tb = (LAS int*)lds; LAS int* rowof = tb + 32;
    moe_tables(p, tb);
    const int rows_per_wg = T / gridDim.x; const int* TOKE = (const int*)(p->ws + WS_TOKE); const float* TOKW = (const float*)(p->ws + WS_TOKW);
    int* ROWTOK = (int*)(p->ws + WS_ROWTOK); float* ROWW = (float*)(p->ws + WS_ROWW);
    LAS int* wcnt = tb + 192;
    if (tid < 128) {
        const int row = blockIdx.x * rows_per_wg + (tid >> 1), s = tid & 1, e = TOKE[row * 2 + s]; const unsigned long long ltm = (1ull << lane) - 1ull;
        int rank = 0;
#pragma unroll
        for (int x = 0; x < 8; ++x) { const unsigned long long m = __ballot(e == x); if (e == x) rank = __builtin_popcountll(m & ltm); if (lane == 0) wcnt[wave * 8 + x] = __builtin_popcountll(m); }
        asm volatile("s_waitcnt lgkmcnt(0)" ::: "memory");
        __builtin_amdgcn_s_barrier();
        if (wave == 1) rank += wcnt[e];
        const int run = tb[8 + e] + tb[16 + e] + rank;
        ROWTOK[run] = row; ROWW[run] = TOKW[row * 2 + s]; rowof[tid] = run; ((int*)(p->ws + WS_ROWOF))[row * 2 + s] = run;
    } else { __builtin_amdgcn_s_barrier(); }
    bf16_t* AG = (bf16_t*)(p->ws + WS_AG);
    if (blockIdx.x < 8) { const int e = blockIdx.x, lo = tb[8 + e] + tb[e], hi = tb[8 + e] + (((tb[e] + 255) >> 8) << 8);
        for (int r = lo + wave; r < hi; r += 8) { if (lane == 0) { ROWTOK[r] = -1; ROWW[r] = 0.f; }
#pragma unroll
            for (int j = 0; j < 2; ++j) *(u32x4*)(AG + (size_t)r * D + 8 * lane + 512 * j) = (u32x4){0u, 0u, 0u, 0u}; } }
    __syncthreads();
    const bf16_t* X1B = (const bf16_t*)(p->ws + WS_X1B);
    for (int pr = wave; pr < rows_per_wg * 2; pr += 8) { const int row = blockIdx.x * rows_per_wg + (pr >> 1), dst = rowof[pr];
#pragma unroll
        for (int j = 0; j < 2; ++j) *(u32x4*)(AG + (size_t)dst * D + 8 * lane + 512 * j) = *(const u32x4*)(X1B + (size_t)row * D + 8 * lane + 512 * j); }
}

struct EpiSwiglu {
    bf16_t* H; int ldh;
    __device__ __forceinline__ void operator()(const AccT& acc, const mg::Unit& u, int wr, int wc, int fr, int fq, int) const {
        const int row0 = u.pm * 256 + wr * 64 + fr, col0 = u.pn * 128 + wc * 32 + 8 * fq;
#pragma unroll
        for (int ai = 0; ai < 2; ++ai)
#pragma unroll
            for (int m = 0; m < 4; ++m) { float hv[8];
#pragma unroll
                for (int n = 0; n < 2; ++n)
#pragma unroll
                    for (int j = 0; j < 4; ++j) { const float a = acc[ai][0][m][n][j], b = acc[ai][1][m][n][j]; hv[4 * n + j] = a * sigm(a) * b; }
                u32x4 w; w.x = pk2(hv[0], hv[1]); w.y = pk2(hv[2], hv[3]); w.z = pk2(hv[4], hv[5]); w.w = pk2(hv[6], hv[7]);
                *(u32x4*)(H + (size_t)(row0 + ai * 128 + m * 16) * ldh + col0) = w; asm volatile("" ::: "memory"); }
    }
};
template <int PERM_, int NN, int K, int BROWS> struct SchedMoe {
    static constexpr int PERM = PERM_;
    const char* A; const char* B; const LAS int* tstart; int G, c;
    __device__ __forceinline__ bool next(int i, mg::Unit& u) const {
        const int nwg = tstart[8] * NN; int L = i * G + c; if (L >= nwg) return false;
        { const int q = nwg / 8, r = nwg % 8, xcd = L % 8, off = L / 8; L = (xcd < r ? xcd * (q + 1) : r * (q + 1) + (xcd - r) * q) + off; }
        const int rt = L / NN, pn = L % NN; int e = 0;
#pragma unroll
        for (int x = 1; x < 8; ++x) if (rt >= tstart[x]) e = x;
        u.A = A + (size_t)rt * 256 * (K * 2); u.B = B + ((size_t)e * BROWS + (size_t)pn * 256) * (K * 2); u.ld = K * 2; u.nt = K / 64; u.pm = rt; u.pn = pn; u.tag = 0; return true;
    }
};
template <class SM> __device__ __forceinline__ void moe_sched_tiles(KP p, LAS unsigned char* lds, SM& S) {
    LAS int* tb = (LAS int*)(lds + LDS_BYTES - 512);
    moe_tables(p, tb);
    { const int t_ = my_tid(); if (t_ < 8) tb[32 + t_] = tb[8 + t_] >> 8; if (t_ == 8) tb[40] = tb[24] >> 8; }
    __syncthreads();
    S.tstart = tb + 32;
}
__device__ __forceinline__ void ph_ffn_up(KP p, int l, LAS unsigned char* lds) {
    if ((l & 1) == 0) {
        SchedPlain<1, 2 * DFF / 256, D> S{(const char*)(p->ws + WS_X1B), (const char*)(p->ws + WS_WF13), (int)gridDim.x, (int)blockIdx.x};
        EpiSwiglu E{(bf16_t*)(p->ws + WS_H), DFF};
        mg::gemm_run(lds, S, E);
    } else {
        SchedMoe<1, 2 * DFE / 256, D, 2 * DFE> S; S.A = (const char*)(p->ws + WS_AG); S.B = (const char*)(p->ws + WS_WF13);
        S.G = (int)gridDim.x; S.c = (int)blockIdx.x; moe_sched_tiles(p, lds, S);
        EpiSwiglu E{(bf16_t*)(p->ws + WS_H), DFE};
        mg::gemm_run(lds, S, E);
    }
}

struct EpiAccum {
    float* out;
    __device__ __forceinline__ void operator()(const AccT& acc, const mg::Unit& u, int wr, int wc, int fr, int fq, int) const {
        const int row0 = u.pm * 256 + wr * 64 + fr, col0 = u.pn * 256 + wc * 32 + 4 * fq;
#pragma unroll
        for (int ai = 0; ai < 2; ++ai)
#pragma unroll
            for (int m = 0; m < 4; ++m) { float* rp = out + (size_t)(row0 + ai * 128 + m * 16) * D + col0;
#pragma unroll
                for (int bj = 0; bj < 2; ++bj)
#pragma unroll
                    for (int n = 0; n < 2; ++n) { f32x4* q = (f32x4*)(rp + bj * 128 + n * 16); *q = *q + acc[ai][bj][m][n]; } }
    }
};
struct EpiScatter {
    float* out; const int* rowtok; const float* roww;
    __device__ __forceinline__ void operator()(const AccT& acc, const mg::Unit& u, int wr, int wc, int fr, int fq, int) const {
        const int row0 = u.pm * 256 + wr * 64 + fr, col0 = u.pn * 256 + wc * 32 + 4 * fq;
#pragma unroll
        for (int ai = 0; ai < 2; ++ai)
#pragma unroll
            for (int m = 0; m < 4; ++m) { const int r = row0 + ai * 128 + m * 16; const int tok = rowtok[r]; const float w = roww[r];
                if (tok >= 0) { float* rp = out + (size_t)tok * D + col0;
#pragma unroll
                    for (int bj = 0; bj < 2; ++bj)
#pragma unroll
                        for (int n = 0; n < 2; ++n)
#pragma unroll
                            for (int j = 0; j < 4; ++j) unsafeAtomicAdd(rp + bj * 128 + n * 16 + j, w * acc[ai][bj][m][n][j]); } }
    }
};
__device__ __forceinline__ void ph_ffn_down(KP p, int l, LAS unsigned char* lds) {
    if ((l & 1) == 0) {
        SchedPlain<0, 4, DFF> S{(const char*)(p->ws + WS_H), (const char*)(p->ws + WS_WF2_DENSE), (int)gridDim.x, (int)blockIdx.x};
        EpiAccum E{p->out};
        mg::gemm_run(lds, S, E);
    } else {
        SchedMoe<1, 4, DFE, D> S; S.A = (const char*)(p->ws + WS_H); S.B = (const char*)(p->ws + WS_WF2_MOE);
        S.G = (int)gridDim.x; S.c = (int)blockIdx.x; moe_sched_tiles(p, lds, S);
        EpiBf16Store E{(bf16_t*)(p->ws + WS_AG), D};
        mg::gemm_run(lds, S, E);
    }
}


#define XB_TMO      128
#define XB_XCNT(j)  (256  + 64 * (j))
#define XB_XSUB(j)  (1280 + 64 * (j))
#define XB_XGEN(j)  (2304 + 64 * (j))
#define XB_TOP      3328
#define XB_TOPGEN   3392
#define XCD_BAR_WORDS 3456
#define XB_SPIN_CAP (1u << 18)
__device__ __forceinline__ unsigned xb_ld(unsigned* p)              { return __hip_atomic_load(p, __ATOMIC_RELAXED, __HIP_MEMORY_SCOPE_AGENT); }
__device__ __forceinline__ unsigned xb_add(unsigned* p, unsigned v) { return __hip_atomic_fetch_add(p, v, __ATOMIC_RELAXED, __HIP_MEMORY_SCOPE_AGENT); }
__device__ __forceinline__ unsigned xb_xcc_id() { return (unsigned)__builtin_amdgcn_s_getreg((3 << 11) | 20) & 0xFu; }
#define XB_SPIN(cond, bar) do { unsigned _sp = 0; while (cond) { __builtin_amdgcn_s_sleep(1); \
    if ((++_sp & 255u) == 0u) { if (xb_ld(&(bar)[XB_TMO])) break; if (_sp > XB_SPIN_CAP) { atomicAdd(&(bar)[XB_TMO], 1u); break; } } } } while (0)
struct XcdBarrier { unsigned* bar; unsigned x; volatile LAS unsigned* st; };
__device__ __forceinline__ XcdBarrier xcd_barrier_post(unsigned* bar, volatile LAS unsigned* st) {
    XcdBarrier b; b.bar = bar; b.x = xb_xcc_id(); b.st = st;
    if (threadIdx.x == 0) (void)xb_add(&bar[XB_XCNT(b.x)], 1u);
    return b;
}
__device__ __forceinline__ void xcd_barrier_complete(unsigned* bar, unsigned x, unsigned& nloc, unsigned& nx) {
    const unsigned G = gridDim.x * gridDim.y * gridDim.z;
    unsigned sum, cnt, mine, sp = 0u;
    for (;;) {
        sum = 0u; cnt = 0u; mine = 0u;
#pragma unroll
        for (unsigned j = 0; j < 16; ++j) { const unsigned c = xb_ld(&bar[XB_XCNT(j)]); sum += c; cnt += (c > 0u) ? 1u : 0u; mine = (j == x) ? c : mine; }
        if (sum == G) break;
        __builtin_amdgcn_s_sleep(1);
        if ((++sp & 255u) == 0u) { if (xb_ld(&bar[XB_TMO])) break; if (sp > XB_SPIN_CAP) { atomicAdd(&bar[XB_TMO], 1u); break; } }
    }
    nloc = mine > 0u ? mine : 1u; nx = cnt > 0u ? cnt : 1u;
}
__device__ __forceinline__ void xcd_barrier(const XcdBarrier& b) {
    asm volatile("s_waitcnt vmcnt(0)" ::: "memory");
    __syncthreads();
    if (threadIdx.x == 0) {
        unsigned* bar = b.bar;
        __builtin_amdgcn_s_waitcnt(0);
        unsigned nloc = b.st[0], nx = b.st[1];
        if (nloc == 0u) { xcd_barrier_complete(bar, b.x, nloc, nx); b.st[0] = nloc; b.st[1] = nx; }
        const unsigned old = xb_add(&bar[XB_XSUB(b.x)], 1u);
        const unsigned gen = old / nloc;
        if (old + 1u == (gen + 1u) * nloc) {
            __builtin_amdgcn_fence(__ATOMIC_RELEASE, "agent");
            asm volatile("s_waitcnt vmcnt(0)" ::: "memory");
            const unsigned og = xb_add(&bar[XB_TOP], 1u);
            const unsigned tg = og / nx;
            if (og + 1u == (tg + 1u) * nx) xb_add(&bar[XB_TOPGEN], 1u);
            else XB_SPIN(xb_ld(&bar[XB_TOPGEN]) == tg, bar);
            __builtin_amdgcn_fence(__ATOMIC_ACQUIRE, "agent");
            xb_add(&bar[XB_XGEN(b.x)], 1u);
            asm volatile("s_waitcnt vmcnt(0)" ::: "memory");
        } else {
            XB_SPIN(xb_ld(&bar[XB_XGEN(b.x)]) == gen, bar);
            __builtin_amdgcn_fence(__ATOMIC_ACQUIRE, "agent");
            asm volatile("s_waitcnt vmcnt(0)" ::: "memory");
        }
    }
    __syncthreads();
}

constexpr int PH_PER_LAYER = 12, NPHASE = 2 * PH_PER_LAYER;
template <int K> __device__ __forceinline__ void run_phase(KP p, int l, LAS unsigned char* lds) {
    asm volatile("" : "+s"(lds));
    if constexpr (K == 0) ph_conv_mixer(p, l, lds);
    else if constexpr (K == 1) ph_inproj(p, l, lds);
    else if constexpr (K == 2) ph_prep(p, l, lds);
    else if constexpr (K == 21) ph_lora(p, l, lds);
    else if constexpr (K == 30) ph_scan(p, l, lds);
    else if constexpr (K == 31) ph_attn(p, l, lds);
    else if constexpr (K == 32) { dsa_select(p, lds);
        const int tid = my_tid(), lane = tid & 63, wave = tid >> 6, gw = blockIdx.x * 8 + wave, NGW = gridDim.x * 8;
        const float* srcp = (l == 0) ? p->in[I_X] : p->out; bf16_t* XB = (bf16_t*)(p->ws + WS_XB2);
        for (int m = gw; m < T; m += NGW) row_to_bf16(srcp + (size_t)m * D, XB + (size_t)m * D, lane); }
    else if constexpr (K == 4) ph_dsa_xb(p, l, lds);
    else if constexpr (K == 5) ph_merge(p, l, lds);
    else if constexpr (K == 6) ph_outproj(p, l, lds);
    else if constexpr (K == 7) ph_ln1(p, l, lds);
    else if constexpr (K == 8) ph_moe_assign(p, l, lds);
    else if constexpr (K == 9) ph_ffn_up(p, l, lds);
    else if constexpr (K == 10) ph_ffn_down(p, l, lds);
    else ln_rows(p, l, 1, lds);
}
template <int K> __global__ void __launch_bounds__(NTHREADS, 2) k_phase(Params, int l) {
    extern __shared__ __attribute__((aligned(16))) unsigned char lds_raw[];
    run_phase<K>(get_params(), l, (LAS unsigned char*)lds_raw);
}
#if FUSED
#define PH(K, L) do { run_phase<K>(get_params(), L, lds); __syncthreads(); } while (0)
#define SYNC() xcd_barrier(xbar)
__global__ void __launch_bounds__(NTHREADS, 2) k_fused(Params) {
    extern __shared__ __attribute__((aligned(16))) unsigned char lds_raw[];
    LAS unsigned char* lds = (LAS unsigned char*)lds_raw;
    volatile LAS unsigned* bst = (volatile LAS unsigned*)(lds + LDS_BYTES - 128);
    if (threadIdx.x < 2) bst[threadIdx.x] = 0u;
    __syncthreads();
    const XcdBarrier xbar = xcd_barrier_post((unsigned*)(get_params()->ws + WS_CTL) + 1024, bst);
    PH(0, 0); SYNC();
    PH(1, 0); SYNC(); PH(2, 0); SYNC(); PH(21, 0); SYNC(); PH(30, 0); SYNC(); PH(31, 0); SYNC(); PH(32, 0); SYNC(); PH(4, 0); SYNC(); PH(5, 0); SYNC(); PH(6, 0); SYNC(); PH(7, 0); PH(0, 1); SYNC();
    PH(9, 0); SYNC(); PH(10, 0); SYNC(); PH(11, 0); SYNC();
    PH(1, 1); SYNC(); PH(2, 1); SYNC(); PH(21, 1); SYNC(); PH(30, 1); SYNC(); PH(31, 1); SYNC(); PH(32, 1); SYNC(); PH(4, 1); SYNC(); PH(5, 1); SYNC(); PH(6, 1); SYNC(); PH(7, 1); SYNC();
    PH(8, 1); SYNC(); PH(9, 1); SYNC(); PH(10, 1); SYNC(); PH(11, 1);
}
#undef PH
#undef SYNC
#endif
template <int K> static void launch_phase(const Params& p, int l, hipStream_t stream) {
    static bool attr = false;
    if (!attr) { (void)hipFuncSetAttribute((const void*)k_phase<K>, hipFuncAttributeMaxDynamicSharedMemorySize, LDS_BYTES); attr = true; }
    hipLaunchKernelGGL(k_phase<K>, dim3(256), dim3(NTHREADS), LDS_BYTES, stream, p, l);
}

extern "C" void kernel_launch(void* const* d_in, const int* in_sizes, int n_in, void* d_out, int out_size, void* d_ws, size_t ws_size, hipStream_t stream) {
    if (n_in != 28 || out_size != T * D || ws_size < WS_END) { fprintf(stderr, "kernel_launch: unexpected problem (n_in %d out %d ws %zu)\n", n_in, out_size, ws_size); return; }
    (void)hipMemsetAsync((char*)d_ws + WS_CTL, 0, 32768, stream);
    Params p{};
    for (int i = 0; i < 28; ++i) p.in[i] = (const float*)d_in[i];
    p.out = (float*)d_out; p.ws = (unsigned char*)d_ws;
#if FUSED
    static int ok = 0;
    if (ok == 0) {
        int dev = 0, cus = 0, per_cu = 0;
        (void)hipFuncSetAttribute((const void*)k_fused, hipFuncAttributeMaxDynamicSharedMemorySize, LDS_BYTES);
        if (hipGetDevice(&dev) != hipSuccess || hipDeviceGetAttribute(&cus, hipDeviceAttributeMultiprocessorCount, dev) != hipSuccess ||
            hipOccupancyMaxActiveBlocksPerMultiprocessor(&per_cu, (const void*)k_fused, NTHREADS, LDS_BYTES) != hipSuccess) { cus = 0; per_cu = 0; }
        (void)hipGetLastError();
        ok = (cus * per_cu >= 256) ? 1 : -1;
        if (ok < 0) fprintf(stderr, "kernel_launch: %d CUs x %d workgroups per CU cannot hold the 256-workgroup grid; nothing launched\n", cus, per_cu);
    }
    if (ok < 0) return;
    void* args[] = {&p};
    hipError_t e = hipLaunchCooperativeKernel((const void*)k_fused, dim3(256), dim3(NTHREADS), args, LDS_BYTES, stream);
    if (e != hipSuccess) fprintf(stderr, "cooperative launch failed: %s\n", hipGetErrorString(e));
    return;
#endif
    for (int l = 0; l < 2; ++l) {
        launch_phase<0>(p, l, stream); launch_phase<1>(p, l, stream); launch_phase<2>(p, l, stream); launch_phase<21>(p, l, stream);
        launch_phase<30>(p, l, stream); launch_phase<31>(p, l, stream); launch_phase<32>(p, l, stream);
        launch_phase<4>(p, l, stream); launch_phase<5>(p, l, stream); launch_phase<6>(p, l, stream); launch_phase<7>(p, l, stream);
        if (l & 1) launch_phase<8>(p, l, stream);
        launch_phase<9>(p, l, stream); launch_phase<10>(p, l, stream); launch_phase<11>(p, l, stream);
    }
}
```
